# Optimizing an MI355X kernel written in HIP

```python
import jax, jax.numpy as jnp
from jax import lax
import numpy as np

D_MODEL = 1024
BATCH = 32
SEQ = 2048
DEPTH = 2

CHUNK = 64
P_DIM = 256
SB_HEAD_DIM = 64
SB_WIDTH = 3 * D_MODEL // 8
SB_HEADS = SB_WIDTH // SB_HEAD_DIM
SB_QBLOCK = 128
ML_HEADS = 4
ML_WIDTH = 3 * D_MODEL // 8
ML_HEAD_DIM = ML_WIDTH // ML_HEADS
CONV_K = 4
SGU_WIDTH = D_MODEL - SB_WIDTH - ML_WIDTH
SGU_GROUPS = 4
SGU_GROUP_DIM = SGU_WIDTH // SGU_GROUPS
SGU_BLOCK = 128
IN_SPLITS = (SB_WIDTH, SB_WIDTH, SB_WIDTH, ML_WIDTH, ML_WIDTH, ML_WIDTH, ML_WIDTH, ML_HEADS, ML_HEADS, SGU_WIDTH, SGU_WIDTH)
N_IN = 3 * SB_WIDTH + 4 * ML_WIDTH + 2 * ML_HEADS + 2 * SGU_WIDTH
N_GROUPS = 4
EXPERTS_PER_GROUP = 8
N_EXPERTS = N_GROUPS * EXPERTS_PER_GROUP
TOP_K = 2
D_EXPERT = D_MODEL // 4
MOE_BLOCK = 512
EPS = 1e-6

kernel_name = "hymba_style_sb_mlstm_gmlp_hmoe_ple"

F32 = jnp.float32


def rms_norm(x, g):
    x32 = x.astype(F32)
    return x32 * lax.rsqrt(jnp.mean(x32 * x32, axis=-1, keepdims=True) + EPS) * g.astype(F32)


def split_cols(z, sizes):
    idx = np.cumsum(sizes)[:-1].tolist()
    return jnp.split(z, idx, axis=-1)


def causal_depthwise_conv(x, w, b):
    y = lax.conv_general_dilated(x.astype(F32), w.astype(F32)[:, None, :], window_strides=(1,),
                                 padding=[(CONV_K - 1, 0)], dimension_numbers=('NWC', 'WIO', 'NWC'),
                                 feature_group_count=x.shape[-1])
    return y + b.astype(F32)


def stick_breaking_attention(q, k, v):
    S = q.shape[1]
    scale = q.shape[-1] ** -0.5
    outs = []
    for n in range(S // SB_QBLOCK):
        t0 = n * SB_QBLOCK
        kend = t0 + SB_QBLOCK
        z = jnp.einsum('bthd,bshd->bhts', q[:, t0:kend], k[:, :kend]) * scale
        tpos = t0 + jnp.arange(SB_QBLOCK)
        spos = jnp.arange(kend)
        mask = spos[None, :] < tpos[:, None]
        log_1m = jnp.where(mask, -jax.nn.softplus(z), 0.0)
        after = lax.cumsum(log_1m, axis=3, reverse=True) - log_1m
        a = jnp.where(mask, jnp.exp(jax.nn.log_sigmoid(z) + after), 0.0)
        outs.append(jnp.einsum('bhts,bshd->bthd', a, v[:, :kend]))
    return jnp.concatenate(outs, axis=1)


def mlstm_chunkwise(q, k, v, i_pre, f_pre):
    Bn, S, H, d = q.shape
    N, L = S // CHUNK, CHUNK
    q = q.reshape(Bn, N, L, H, d)
    k = k.reshape(Bn, N, L, H, d) * (d ** -0.5)
    v = v.reshape(Bn, N, L, H, d)
    ig = i_pre.reshape(Bn, N, L, H)
    bcum = jnp.cumsum(jax.nn.log_sigmoid(f_pre.reshape(Bn, N, L, H)), axis=2)
    btot = bcum[:, :, -1]
    a = btot[:, :, None] - bcum + ig

    def step(carry, xs):
        c, nvec, m = carry
        k_c, v_c, a_c, bt_c = xs
        m_new = jnp.maximum(bt_c + m, a_c.max(axis=1))
        decay = jnp.exp(bt_c + m - m_new)
        w = jnp.exp(a_c - m_new[:, None])
        c_new = decay[..., None, None] * c + jnp.einsum('blh,blhd,blhe->bhde', w, k_c, v_c)
        n_new = decay[..., None] * nvec + jnp.einsum('blh,blhd->bhd', w, k_c)
        return (c_new, n_new, m_new), (c, nvec, m)

    init = (jnp.zeros((Bn, H, d, d), F32), jnp.zeros((Bn, H, d), F32), jnp.zeros((Bn, H), F32))
    xs = (jnp.moveaxis(k, 1, 0), jnp.moveaxis(v, 1, 0), jnp.moveaxis(a, 1, 0), jnp.moveaxis(btot, 1, 0))
    _, (c_in, n_in, m_in) = lax.scan(step, init, xs)
    c_in = jnp.moveaxis(c_in, 0, 1)
    n_in = jnp.moveaxis(n_in, 0, 1)
    m_in = jnp.moveaxis(m_in, 0, 1)

    bT = jnp.moveaxis(bcum, 2, -1)
    igT = jnp.moveaxis(ig, 2, -1)
    causal = jnp.tril(jnp.ones((L, L), dtype=bool))
    dmat = jnp.where(causal, bT[..., :, None] - bT[..., None, :] + igT[..., None, :], -jnp.inf)
    m_inter = bT + m_in[..., None]
    m_t = jnp.maximum(m_inter, dmat.max(axis=-1))
    wd = jnp.where(causal, jnp.exp(dmat - m_t[..., None]), 0.0)
    s = jnp.einsum('bnthd,bnshd->bnhts', q, k) * wd
    inter = jnp.exp(m_inter - m_t)
    num = jnp.einsum('bnhts,bnshd->bnthd', s, v) + jnp.einsum('bnhl,bnlhd,bnhde->bnlhe', inter, q, c_in)
    den = s.sum(axis=-1) + inter * jnp.einsum('bnlhd,bnhd->bnhl', q, n_in)
    den = jnp.maximum(jnp.abs(den), jnp.exp(-m_t))
    h = num / jnp.moveaxis(den, 2, -1)[..., None]
    return h.reshape(Bn, S, H, d)


def spatial_gating(u, v, ln_g, ln_b, w_s, b_s):
    Bn, S, _ = u.shape
    v = v.reshape(Bn, S, SGU_GROUPS, SGU_GROUP_DIM)
    mu = v.mean(axis=-1, keepdims=True)
    var = jnp.mean(jnp.square(v - mu), axis=-1, keepdims=True)
    v = (v - mu) * lax.rsqrt(var + EPS) * ln_g.reshape(SGU_GROUPS, SGU_GROUP_DIM) + ln_b.reshape(SGU_GROUPS, SGU_GROUP_DIM)
    v = v.reshape(Bn, S // SGU_BLOCK, SGU_BLOCK, SGU_GROUPS, SGU_GROUP_DIM)
    cpos = jnp.arange(SGU_BLOCK) // CHUNK
    mask = cpos[None, :] <= cpos[:, None]
    w = jnp.where(mask[None], w_s.astype(F32), 0.0)
    mixed = jnp.einsum('gts,bnsgc->bntgc', w, v) + b_s.astype(F32).T[:, :, None]
    return u * mixed.reshape(Bn, S, SGU_WIDTH)


def routed_experts(xt, e_idx, e_w, w_gate, w_up, w_down):
    T, D = xt.shape
    M = T * TOP_K
    flat_e = e_idx.reshape(M)
    order = jnp.argsort(flat_e)
    sorted_e = flat_e[order]
    sorted_tok = order // TOP_K
    sorted_w = e_w.reshape(M)[order]
    sizes = jnp.bincount(flat_e, length=N_EXPERTS)
    padded = (sizes + MOE_BLOCK - 1) // MOE_BLOCK * MOE_BLOCK
    start = jnp.cumsum(sizes) - sizes
    pend = jnp.cumsum(padded)
    pstart = pend - padded
    dest = pstart[sorted_e] + jnp.arange(M) - start[sorted_e]
    n_blocks = -(-(M + N_EXPERTS * (MOE_BLOCK - 1)) // MOE_BLOCK)
    rows = n_blocks * MOE_BLOCK
    row_tok = jnp.zeros((rows,), jnp.int32).at[dest].set(sorted_tok.astype(jnp.int32))
    row_w = jnp.zeros((rows,), F32).at[dest].set(sorted_w)
    block_e = jnp.minimum(jnp.searchsorted(pend, jnp.arange(n_blocks) * MOE_BLOCK, side='right'), N_EXPERTS - 1)

    def block_ffn(args):
        tok, wt, e = args
        xb = xt[tok]
        hb = jax.nn.silu(xb @ w_gate[e]) * (xb @ w_up[e])
        return (hb @ w_down[e]).astype(F32) * wt[:, None]

    yb = lax.map(block_ffn, (row_tok.reshape(n_blocks, MOE_BLOCK), row_w.reshape(n_blocks, MOE_BLOCK), block_e))
    return jnp.zeros((T, D), F32).at[row_tok].add(yb.reshape(rows, D))


def hierarchical_moe(h, rg_w, rg_b, re_w, re_b, w_gate, w_up, w_down):
    Bn, S, D = h.shape
    xt = h.reshape(Bn * S, D)
    g_logits = (xt @ rg_w + rg_b).astype(F32)
    g_prob = jax.nn.softmax(g_logits, axis=-1)
    g_top = jnp.argmax(g_logits, axis=-1)
    g_w = jnp.take_along_axis(g_prob, g_top[:, None], axis=-1)[:, 0]
    e_logits = (xt @ re_w + re_b).astype(F32).reshape(-1, N_GROUPS, EXPERTS_PER_GROUP)
    e_in = jnp.take_along_axis(e_logits, g_top[:, None, None], axis=1)[:, 0]
    e_val, e_loc = lax.top_k(e_in, TOP_K)
    e_w = jax.nn.softmax(e_val, axis=-1) * g_w[:, None]
    e_idx = g_top[:, None].astype(jnp.int32) * EXPERTS_PER_GROUP + e_loc.astype(jnp.int32)
    y = routed_experts(xt, e_idx, e_w, w_gate, w_up, w_down)
    return y.reshape(Bn, S, D)


def setup_inputs(seed: int = 0) -> dict:
    key = jax.random.key(seed)
    ks = jax.random.split(key, 32)

    def nrm(k, shape, scale):
        return jax.random.normal(k, shape, F32) * scale

    def gain(k, shape):
        return 1.0 + 0.05 * jax.random.normal(k, shape, F32)

    D = D_MODEL
    return {
        "x": nrm(ks[0], (BATCH, SEQ, D), 1.0),
        "p": nrm(ks[1], (DEPTH, BATCH, SEQ, P_DIM), 1.0),
        "norm1_g": gain(ks[2], (DEPTH, D)),
        "w_in": nrm(ks[3], (DEPTH, D, N_IN), D ** -0.5),
        "conv_w": nrm(ks[4], (DEPTH, CONV_K, 2 * ML_WIDTH), CONV_K ** -0.5),
        "conv_b": nrm(ks[5], (DEPTH, 2 * ML_WIDTH), 0.01),
        "igate_b": nrm(ks[6], (DEPTH, ML_HEADS), 0.1),
        "fgate_b": jnp.linspace(3.0, 6.0, ML_HEADS, dtype=F32)[None, :] + nrm(ks[7], (DEPTH, ML_HEADS), 0.1),
        "mnorm_g": gain(ks[8], (DEPTH, ML_WIDTH)),
        "sb_out_g": gain(ks[9], (DEPTH, SB_WIDTH)),
        "sgu_ln_g": gain(ks[10], (DEPTH, SGU_WIDTH)),
        "sgu_ln_b": nrm(ks[11], (DEPTH, SGU_WIDTH), 0.01),
        "sgu_w": nrm(ks[12], (DEPTH, SGU_GROUPS, SGU_BLOCK, SGU_BLOCK), SGU_BLOCK ** -0.5),
        "sgu_b": gain(ks[13], (DEPTH, SGU_GROUPS, SGU_BLOCK)),
        "sgu_out_g": gain(ks[14], (DEPTH, SGU_WIDTH)),
        "w_out": nrm(ks[15], (DEPTH, D, D), D ** -0.5),
        "norm2_g": gain(ks[16], (DEPTH, D)),
        "router_gw": nrm(ks[17], (DEPTH, D, N_GROUPS), D ** -0.5),
        "router_gb": nrm(ks[18], (DEPTH, N_GROUPS), 0.01),
        "router_ew": nrm(ks[19], (DEPTH, D, N_EXPERTS), D ** -0.5),
        "router_eb": nrm(ks[20], (DEPTH, N_EXPERTS), 0.01),
        "w_gate": nrm(ks[21], (DEPTH, N_EXPERTS, D, D_EXPERT), D ** -0.5),
        "w_up": nrm(ks[22], (DEPTH, N_EXPERTS, D, D_EXPERT), D ** -0.5),
        "w_down": nrm(ks[23], (DEPTH, N_EXPERTS, D_EXPERT, D), D_EXPERT ** -0.5),
        "ple_norm_g": gain(ks[24], (DEPTH, D)),
        "ple_gate_w": nrm(ks[25], (DEPTH, D, D), D ** -0.5),
        "ple_proj_w": nrm(ks[26], (DEPTH, P_DIM, D), P_DIM ** -0.5),
        "final_g": gain(ks[27], (D,)),
    }


def reference(x, p, norm1_g, w_in, conv_w, conv_b, igate_b, fgate_b, mnorm_g, sb_out_g,
              sgu_ln_g, sgu_ln_b, sgu_w, sgu_b, sgu_out_g, w_out, norm2_g,
              router_gw, router_gb, router_ew, router_eb, w_gate, w_up, w_down,
              ple_norm_g, ple_gate_w, ple_proj_w, final_g):
    Bn, S, D = x.shape
    h = x.astype(F32)
    for i in range(DEPTH):
        hn = rms_norm(h, norm1_g[i])
        z = hn @ w_in[i]
        qa, ka, va, qb, kb, vb, ob, ib, fb, uc, vc = split_cols(z, IN_SPLITS)
        ya = stick_breaking_attention(qa.reshape(Bn, S, SB_HEADS, SB_HEAD_DIM),
                                      ka.reshape(Bn, S, SB_HEADS, SB_HEAD_DIM),
                                      va.reshape(Bn, S, SB_HEADS, SB_HEAD_DIM)).reshape(Bn, S, SB_WIDTH)
        ya = rms_norm(ya, sb_out_g[i])
        qk = jax.nn.silu(causal_depthwise_conv(jnp.concatenate([qb, kb], axis=-1), conv_w[i], conv_b[i]))
        qb, kb = jnp.split(qk, 2, axis=-1)
        hb = mlstm_chunkwise(qb.reshape(Bn, S, ML_HEADS, ML_HEAD_DIM),
                             kb.reshape(Bn, S, ML_HEADS, ML_HEAD_DIM),
                             vb.astype(F32).reshape(Bn, S, ML_HEADS, ML_HEAD_DIM),
                             ib + igate_b[i], fb + fgate_b[i])
        hb = rms_norm(hb, mnorm_g[i].reshape(ML_HEADS, ML_HEAD_DIM)).reshape(Bn, S, ML_WIDTH)
        yb = hb * jax.nn.sigmoid(ob)
        yc = spatial_gating(jax.nn.gelu(uc), jax.nn.gelu(vc), sgu_ln_g[i], sgu_ln_b[i], sgu_w[i], sgu_b[i])
        yc = rms_norm(yc, sgu_out_g[i])
        h = h + jnp.concatenate([ya, yb, yc], axis=-1) @ w_out[i]
        h = h + hierarchical_moe(rms_norm(h, norm2_g[i]), router_gw[i], router_gb[i], router_ew[i], router_eb[i],
                                 w_gate[i], w_up[i], w_down[i])
        gate = jax.nn.sigmoid(rms_norm(h, ple_norm_g[i]) @ ple_gate_w[i])
        h = h + gate * (p[i] @ ple_proj_w[i]).astype(F32)
    return rms_norm(h, final_g).astype(x.dtype)
```

```cpp
#include <hip/hip_runtime.h>
#include <cstdio>
#include <cstdint>
namespace pg8 {
#define PG8_LAS __attribute__((address_space(3)))
typedef unsigned short bf16_t;
typedef short bf16x8 __attribute__((ext_vector_type(8)));
typedef float f32x4 __attribute__((ext_vector_type(4)));
typedef unsigned u32x4 __attribute__((ext_vector_type(4)));
constexpr int BM = 256, BK = 64, HALF = 128, HTB = HALF * BK * 2  , STAGE_BYTES = 8 * HTB, NXCD = 8, WGM = 8;

__host__ __device__ __forceinline__ int lds_byte(int r, int c) { const int st = (r >> 4) * 2 + (c >> 5), rr = r & 15, cc = c & 31, ob = rr * 64 + cc * 2; return st * 1024 + (ob ^ (((ob >> 9) & 1) << 5)); }
__host__ __device__ __forceinline__ void stage_rc(int b, int& R, int& C) { const int st = b / 1024, sb = b % 1024, swz = sb ^ (((sb >> 9) & 1) << 5); R = (st >> 1) * 16 + swz / 64; C = (st & 1) * 32 + (swz % 64) / 2; }
__host__ __device__ __forceinline__ int perm32(int rho) { const int n = rho >> 4, i = rho & 15; return 8 * (i >> 2) + 4 * n + (i & 3); }

struct Unit { int pm, pn; };
struct Gemm { const bf16_t* A; const bf16_t* Bt; int M, N, K, pad; };

struct StaticOrder {
    int nM, nN, nwg, G, c;
    __host__ __device__ void init(int M, int N, int G_, int c_) { nM = M / BM; nN = N / BM; nwg = nM * nN; G = G_; c = c_; }
    __host__ __device__ bool next(int i, Unit& u) const {
        const long L = (long)i * G + c; if (L >= nwg) return false;
        int wgid = (int)L; { const int q = nwg / NXCD, r = nwg % NXCD, xcd = wgid % NXCD, off = wgid / NXCD; wgid = (xcd < r ? xcd * (q + 1) : r * (q + 1) + (xcd - r) * q) + off; }
        const int nig = WGM * nN, gid = wgid / nig, fm = gid * WGM, gsz = (nM - fm) < WGM ? (nM - fm) : WGM;
        u.pm = fm + ((wgid % nig) % gsz); u.pn = (wgid % nig) / gsz; return true;
    }
    __device__ __forceinline__ size_t bbase(const Unit& u, size_t tstep) const { return (size_t)u.pn * tstep; }
    __device__ __forceinline__ void a_ready(const Unit&) const {}
    __device__ __forceinline__ void done(const Unit&) const {}
};

__device__ __forceinline__ unsigned cvt_pk_bf16(float lo, float hi) { unsigned r; asm volatile("v_cvt_pk_bf16_f32 %0, %1, %2" : "=v"(r) : "v"(lo), "v"(hi)); return r; }
typedef float f32x2 __attribute__((ext_vector_type(2)));
template <class Epi, class Sched, bool ALIGN_EPI = false, bool SP2 = false>
__device__ __forceinline__ void gemm_phase(PG8_LAS unsigned char* lds, const Gemm g, const Sched& S, const Epi& E) {
    const int tid = threadIdx.x, wid = __builtin_amdgcn_readfirstlane(tid >> 6), lane = tid & 63, wr = wid >> 2, wc = wid & 3, fr = lane & 15, fq = lane >> 4;
    const int K = g.K, nt = K / BK;
    unsigned voffA[2], voffB[2];
#pragma unroll
    for (int i = 0; i < 2; ++i) { int R, C; stage_rc(tid * 16 + i * 8192, R, C); const int Rb = Epi::PERM ? ((R & ~31) + perm32(R & 31)) : R;
        voffA[i] = (unsigned)(R * K + C) * 2u; voffB[i] = (unsigned)(Rb * K + C) * 2u; }
    const size_t kstep = (size_t)(BK * 2);
    const size_t hstep = (size_t)HALF * K * 2;
    const size_t tstep = 2 * hstep;
    const unsigned ldsw = (unsigned)wid * 1024u;
    const int aoff = lds_byte(wr * 64 + fr, fq * 8), boff = lds_byte(wc * 32 + fr, fq * 8);
#define PG8_SA(b, h) (((b) * 2 + (h)) * HTB)
#define PG8_SB(b, h) ((4 + (b) * 2 + (h)) * HTB)
#define PG8_STAGE(bufoff, gbase, voff) do { _Pragma("unroll") for (int _i = 0; _i < 2; ++_i) \
        __builtin_amdgcn_global_load_lds((const unsigned*)((const char*)(gbase) + (voff)[_i]), (PG8_LAS unsigned*)(lds + (bufoff) + ldsw + _i * 8192), 16, 0, 0); } while (0)
#define PG8_LDA(dst, b, h) do { _Pragma("unroll") for (int m = 0; m < 4; ++m) _Pragma("unroll") for (int k = 0; k < 2; ++k) dst[m][k] = *(const PG8_LAS bf16x8*)(lds + PG8_SA(b, h) + aoff + m * 2048 + k * 1024); } while (0)
#define PG8_LDB(dst, b, h) do { _Pragma("unroll") for (int n = 0; n < 2; ++n) _Pragma("unroll") for (int k = 0; k < 2; ++k) dst[n][k] = *(const PG8_LAS bf16x8*)(lds + PG8_SB(b, h) + boff + n * 2048 + k * 1024); } while (0)
#define PG8_MMA(ai, bj, At, Bt) do { __builtin_amdgcn_s_setprio(1); _Pragma("unroll") for (int m = 0; m < 4; ++m) _Pragma("unroll") for (int n = 0; n < 2; ++n) _Pragma("unroll") for (int k = 0; k < 2; ++k) \
        acc[ai][bj][m][n] = __builtin_amdgcn_mfma_f32_16x16x32_bf16(Bt[n][k], At[m][k], acc[ai][bj][m][n], 0, 0, 0); __builtin_amdgcn_s_setprio(0); } while (0)
#define PG8_WAIT_V(n) asm volatile("s_waitcnt vmcnt(" #n ")" ::: "memory")
#define PG8_WAIT_L(n) asm volatile("s_waitcnt lgkmcnt(" #n ")" ::: "memory")
#define PG8_BAR __builtin_amdgcn_s_barrier()
#define PG8_SCHED __builtin_amdgcn_sched_barrier(0)
    Unit cur, nxt; int ui = 0;
    if (!S.next(0, cur)) return;
    f32x4 acc[2][2][4][2];
#pragma unroll
    for (int a = 0; a < 2; ++a)
#pragma unroll
        for (int b = 0; b < 2; ++b)
#pragma unroll
            for (int m = 0; m < 4; ++m)
#pragma unroll
                for (int n = 0; n < 2; ++n) acc[a][b][m][n] = (f32x4){0.f, 0.f, 0.f, 0.f};
    bf16x8 At[4][2], B0[2][2], B1[2][2];
    const char* cA = (const char*)g.A + (size_t)cur.pm * tstep; const char* cB = (const char*)g.Bt + S.bbase(cur, tstep);
    S.a_ready(cur);
    if constexpr (SP2) {
        PG8_STAGE(PG8_SB(0, 0), cB, voffB); PG8_STAGE(PG8_SB(0, 1), cB + hstep, voffB); PG8_STAGE(PG8_SA(0, 0), cA, voffA); PG8_STAGE(PG8_SA(0, 1), cA + hstep, voffA);
        if (wr == 1) PG8_BAR;
        PG8_WAIT_V(2); PG8_BAR;
        PG8_STAGE(PG8_SB(1, 0), cB + kstep, voffB); PG8_STAGE(PG8_SA(1, 0), cA + kstep, voffA); PG8_STAGE(PG8_SB(1, 1), cB + hstep + kstep, voffB);
        PG8_WAIT_V(6); PG8_BAR;
    } else {
        PG8_STAGE(PG8_SB(0, 0), cB, voffB); PG8_STAGE(PG8_SA(0, 0), cA, voffA); PG8_STAGE(PG8_SB(0, 1), cB + hstep, voffB); PG8_STAGE(PG8_SA(0, 1), cA + hstep, voffA);
        if (wr == 1) PG8_BAR;
        PG8_WAIT_V(4); PG8_BAR;
        PG8_STAGE(PG8_SB(1, 0), cB + kstep, voffB); PG8_STAGE(PG8_SA(1, 0), cA + kstep, voffA); PG8_STAGE(PG8_SB(1, 1), cB + hstep + kstep, voffB);
        PG8_WAIT_V(6); PG8_BAR;
    }
    for (;;) {
        const bool has_next = S.next(ui + 1, nxt);
        const char* nA = has_next ? (const char*)g.A + (size_t)nxt.pm * tstep : cA; const char* nB = has_next ? (const char*)g.Bt + S.bbase(nxt, tstep) : cB;
        for (int t = 0; t < nt; t += 2) {
            const bool last = (t == nt - 2);
            const char* a1 = cA + (size_t)(t + 1) * kstep;
            const char* a2 = last ? nA : cA + (size_t)(t + 2) * kstep; const char* b2 = last ? nB : cB + (size_t)(t + 2) * kstep;
            const char* a3 = a2 + kstep; const char* b3 = b2 + kstep;
            if (last && has_next) S.a_ready(nxt);
            if constexpr (SP2) {
            PG8_LDB(B0, 0, 0); PG8_LDB(B1, 0, 1); PG8_SCHED; PG8_LDA(At, 0, 0); PG8_STAGE(PG8_SA(1, 1), a1 + hstep, voffA);
            PG8_WAIT_V(8); PG8_WAIT_L(0); PG8_BAR; PG8_MMA(0, 0, At, B0); PG8_MMA(0, 1, At, B1); PG8_BAR; PG8_SCHED;
            PG8_LDA(At, 0, 1); PG8_STAGE(PG8_SB(0, 0), b2, voffB); PG8_STAGE(PG8_SB(0, 1), b2 + hstep, voffB); PG8_STAGE(PG8_SA(0, 0), a2, voffA);
            PG8_WAIT_V(8); PG8_WAIT_L(0); PG8_BAR; PG8_MMA(1, 0, At, B0); PG8_MMA(1, 1, At, B1); PG8_BAR; PG8_SCHED;
            PG8_LDB(B0, 1, 0); PG8_LDB(B1, 1, 1); PG8_SCHED; PG8_LDA(At, 1, 0); PG8_STAGE(PG8_SA(0, 1), a2 + hstep, voffA);
            PG8_WAIT_V(8); PG8_WAIT_L(0); PG8_BAR; PG8_MMA(0, 0, At, B0); PG8_MMA(0, 1, At, B1); PG8_BAR; PG8_SCHED;
            PG8_LDA(At, 1, 1); PG8_STAGE(PG8_SB(1, 0), b3, voffB); PG8_STAGE(PG8_SB(1, 1), b3 + hstep, voffB); PG8_STAGE(PG8_SA(1, 0), a3, voffA);
            PG8_WAIT_V(8); PG8_WAIT_L(0); PG8_BAR; PG8_MMA(1, 0, At, B0); PG8_MMA(1, 1, At, B1); PG8_BAR; PG8_SCHED;
            } else {
            PG8_LDB(B0, 0, 0); PG8_SCHED; PG8_LDA(At, 0, 0); PG8_STAGE(PG8_SA(1, 1), a1 + hstep, voffA);
            PG8_WAIT_L(8); PG8_BAR; PG8_WAIT_L(0); PG8_MMA(0, 0, At, B0); PG8_BAR; PG8_SCHED;
            PG8_LDB(B1, 0, 1); PG8_STAGE(PG8_SB(0, 0), b2, voffB);
            PG8_BAR; PG8_WAIT_L(0); PG8_MMA(0, 1, At, B1); PG8_BAR;
            PG8_LDA(At, 0, 1); PG8_STAGE(PG8_SA(0, 0), a2, voffA);
            PG8_BAR; PG8_WAIT_L(0); PG8_MMA(1, 0, At, B0); PG8_BAR; PG8_SCHED;
            PG8_STAGE(PG8_SB(0, 1), b2 + hstep, voffB);
            PG8_WAIT_V(6); PG8_BAR; PG8_MMA(1, 1, At, B1); PG8_BAR;
            PG8_LDB(B0, 1, 0); PG8_SCHED; PG8_LDA(At, 1, 0); PG8_STAGE(PG8_SA(0, 1), a2 + hstep, voffA);
            PG8_WAIT_L(8); PG8_BAR; PG8_WAIT_L(0); PG8_MMA(0, 0, At, B0); PG8_BAR; PG8_SCHED;
            PG8_LDB(B1, 1, 1); PG8_STAGE(PG8_SB(1, 0), b3, voffB);
            PG8_BAR; PG8_WAIT_L(0); PG8_MMA(0, 1, At, B1); PG8_BAR;
            PG8_LDA(At, 1, 1); PG8_STAGE(PG8_SA(1, 0), a3, voffA);
            PG8_BAR; PG8_WAIT_L(0); PG8_MMA(1, 0, At, B0); PG8_BAR; PG8_SCHED;
            PG8_STAGE(PG8_SB(1, 1), b3 + hstep, voffB);
            PG8_WAIT_V(6); PG8_BAR; PG8_MMA(1, 1, At, B1); PG8_BAR;
            }
        }
        if constexpr (ALIGN_EPI) { if (wr == 0) PG8_BAR; }
        if constexpr (!Epi::AFTER_DRAIN) { E(acc, cur, wr, wc, fr, fq); S.done(cur); }
        if (!has_next) break;
#pragma unroll
        for (int a = 0; a < 2; ++a)
#pragma unroll
            for (int b = 0; b < 2; ++b)
#pragma unroll
                for (int m = 0; m < 4; ++m)
#pragma unroll
                    for (int n = 0; n < 2; ++n) acc[a][b][m][n] = (f32x4){0.f, 0.f, 0.f, 0.f};
        cur = nxt; cA = nA; cB = nB; ++ui;
        if constexpr (ALIGN_EPI) { if (wr == 1) PG8_BAR; }
    }
    PG8_WAIT_V(0);
    if constexpr (!ALIGN_EPI) { if (wr == 0) PG8_BAR; }
    PG8_BAR;
    if constexpr (Epi::AFTER_DRAIN) { E.fused(acc, cur, wr, wc, fr, fq, lds, wid, lane); S.done(cur); }
#undef PG8_SA
#undef PG8_SB
#undef PG8_STAGE
#undef PG8_LDA
#undef PG8_LDB
#undef PG8_MMA
#undef PG8_WAIT_V
#undef PG8_WAIT_L
#undef PG8_BAR
#undef PG8_SCHED
}
}

#define DEVI __device__ __forceinline__
typedef unsigned short bf16_t;
typedef float f32x4 __attribute__((ext_vector_type(4)));
typedef unsigned u32x4 __attribute__((ext_vector_type(4)));
typedef unsigned u32x2 __attribute__((ext_vector_type(2)));

constexpr int T = 65536, D = 1024, SEQ = 2048, NB = 32, DEPTH = 2;
constexpr int NZ = 3328;
constexpr int ZQA = 0, ZKA = 384, ZVA = 768, ZIF = 1152, ZQB = 1280, ZKB = 1664, ZVB = 2048, ZOB = 2432, ZUC = 2816, ZVC = 3072;
constexpr int NEXP = 32, DEXP = 256, PDIM = 256;
constexpr int MAXROWS = 2 * T + NEXP * 256;
constexpr float EPS = 1e-6f;

constexpr size_t MiB = 1u << 20;
constexpr size_t WS_CTL = 0;
constexpr size_t WS_GATES = 1 * MiB;
constexpr size_t WS_SSP = 3 * MiB;
constexpr size_t WS_TOKE = 7 * MiB;
constexpr size_t WS_TOKW = 7 * MiB + 512 * 1024;
constexpr size_t WS_RSTD2 = 8 * MiB;
constexpr size_t WS_RSTD3 = 8 * MiB + 256 * 1024;
constexpr size_t WS_RANK = 8 * MiB + 512 * 1024;
constexpr size_t WS_ROWTS = 9 * MiB;
constexpr size_t WS_ROWW = 10 * MiB;
constexpr size_t WS_TILEE = 11 * MiB;
constexpr size_t WS_PSTART = 11 * MiB + 4096;
constexpr size_t WS_WR = 12 * MiB;
constexpr size_t WS_WTS = 16 * MiB;
constexpr size_t WL_IN = 0, WL_OUT = 6656 * 1024, WL_GU = WL_OUT + 2 * MiB, WL_DN = WL_GU + 32 * MiB, WL_PG = WL_DN + 16 * MiB, WL_PP = WL_PG + 2 * MiB, WL_SIZE = 59 * MiB;
constexpr size_t WS_PB = 134 * MiB;
constexpr size_t WS_HBA = 198 * MiB;
constexpr size_t WS_HBB = 326 * MiB;
constexpr size_t WS_YMIX = 454 * MiB;
constexpr size_t WS_Z = 582 * MiB;
constexpr size_t WS_XS = WS_Z, WS_Y = WS_Z, WS_HID = WS_Z + 272 * MiB;
constexpr size_t WS_END = 998 * MiB;
static_assert(WL_PP + 512 * 1024 <= WL_SIZE, "weights map");
static_assert((size_t)MAXROWS * 1024 * 2 <= 272 * MiB && (size_t)MAXROWS * 256 * 2 <= 68 * MiB, "overlay map");
constexpr int CW_COUNT = 0;
constexpr int CW_NTILES = 64;

DEVI float bf2f(unsigned short b) { return __uint_as_float((unsigned)b << 16); }
DEVI unsigned f2bf(float f) { unsigned u = __float_as_uint(f); return (u + 0x7fffu + ((u >> 16) & 1u)) >> 16; }
DEVI unsigned pk2(float lo, float hi) { return f2bf(lo) | (f2bf(hi) << 16); }
DEVI float wave_sum(float v) {
#pragma unroll
    for (int o = 1; o < 64; o <<= 1) v += __shfl_xor(v, o);
    return v;
}
DEVI float sigmoidf_(float x) { return 1.0f / (1.0f + __expf(-x)); }
DEVI float siluf_(float x) { return x * sigmoidf_(x); }
DEVI float gelu_tanh(float x) { const float u = 0.7978845608028654f * (x + 0.044715f * x * x * x); return 0.5f * x * (1.0f + tanhf(u)); }
DEVI float softplusf_(float x) { return fmaxf(x, 0.f) + log1pf(__expf(-fabsf(x))); }

using pg8::Unit;
struct EpiZ {
    static constexpr bool PERM = true, AFTER_DRAIN = false;
    bf16_t* Z; const float* ssp; float* gates;
    DEVI void operator()(const f32x4 (&acc)[2][2][4][2], const Unit& u, int wr, int wc, int fr, int fq) const {
        const int row0 = u.pm * 256 + wr * 64 + fr, col0 = u.pn * 256 + wc * 32 + 8 * fq;
#pragma unroll
        for (int ai = 0; ai < 2; ++ai)
#pragma unroll
            for (int m = 0; m < 4; ++m) {
                const int row = row0 + ai * 128 + m * 16;
                const f32x4* sp = (const f32x4*)(ssp + (size_t)row * 16);
                const f32x4 s0 = sp[0], s1 = sp[1], s2 = sp[2], s3 = sp[3];
                const f32x4 st = (s0 + s1) + (s2 + s3);
                const float rs = rsqrtf(((st[0] + st[1]) + (st[2] + st[3])) * (1.0f / 1024.0f) + EPS);
                bf16_t* rowp = Z + (size_t)row * NZ + col0;
#pragma unroll
                for (int bj = 0; bj < 2; ++bj) {
                    const f32x4 v0 = acc[ai][bj][m][0] * rs, v1 = acc[ai][bj][m][1] * rs;
                    u32x4 w; w.x = pk2(v0[0], v0[1]); w.y = pk2(v0[2], v0[3]); w.z = pk2(v1[0], v1[1]); w.w = pk2(v1[2], v1[3]);
                    *(u32x4*)(rowp + bj * 128) = w;
                    if (bj == 1 && u.pn == 4 && wc == 0 && fq == 0) { *(f32x4*)(gates + (size_t)row * 8) = v0; *(f32x4*)(gates + (size_t)row * 8 + 4) = v1; }
                }
            }
    }
};
struct EpiResid {
    static constexpr bool PERM = false, AFTER_DRAIN = false;
    const float* hin; float* hout; bf16_t* hb;
    DEVI void operator()(const f32x4 (&acc)[2][2][4][2], const Unit& u, int wr, int wc, int fr, int fq) const {
        const int row0 = u.pm * 256 + wr * 64 + fr, col0 = u.pn * 256 + wc * 32 + 4 * fq;
#pragma unroll
        for (int ai = 0; ai < 2; ++ai)
#pragma unroll
            for (int m = 0; m < 4; ++m) {
                const size_t off = (size_t)(row0 + ai * 128 + m * 16) * D + col0;
#pragma unroll
                for (int bj = 0; bj < 2; ++bj)
#pragma unroll
                    for (int n = 0; n < 2; ++n) {
                        const size_t o2 = off + bj * 128 + n * 16;
                        const f32x4 o = *(const f32x4*)(hin + o2) + acc[ai][bj][m][n];
                        *(f32x4*)(hout + o2) = o;
                        u32x2 w; w.x = pk2(o[0], o[1]); w.y = pk2(o[2], o[3]);
                        *(u32x2*)(hb + o2) = w;
                    }
            }
    }
};
struct EpiPLE {
    static constexpr bool PERM = false, AFTER_DRAIN = false;
    const float* rstd3; const bf16_t* pp; float* h; bf16_t* hb; float* ssp;
    DEVI void operator()(const f32x4 (&acc)[2][2][4][2], const Unit& u, int wr, int wc, int fr, int fq) const {
        const int row0 = u.pm * 256 + wr * 64 + fr, col0 = u.pn * 256 + wc * 32 + 4 * fq;
#pragma unroll
        for (int ai = 0; ai < 2; ++ai)
#pragma unroll
            for (int m = 0; m < 4; ++m) {
                const int row = row0 + ai * 128 + m * 16;
                const size_t off = (size_t)row * D + col0;
                const float rs = rstd3[row];
                float sacc = 0.f;
#pragma unroll
                for (int bj = 0; bj < 2; ++bj)
#pragma unroll
                    for (int n = 0; n < 2; ++n) {
                        const size_t o2 = off + bj * 128 + n * 16;
                        const u32x2 pw = *(const u32x2*)(pp + o2);
                        const f32x4 pv = {__uint_as_float(pw.x << 16), __uint_as_float(pw.x & 0xffff0000u), __uint_as_float(pw.y << 16), __uint_as_float(pw.y & 0xffff0000u)};
                        const f32x4 a = acc[ai][bj][m][n] * rs;
                        f32x4 o = *(const f32x4*)(h + o2);
                        o[0] += sigmoidf_(a[0]) * pv[0]; o[1] += sigmoidf_(a[1]) * pv[1]; o[2] += sigmoidf_(a[2]) * pv[2]; o[3] += sigmoidf_(a[3]) * pv[3];
                        *(f32x4*)(h + o2) = o;
                        u32x2 w; w.x = pk2(o[0], o[1]); w.y = pk2(o[2], o[3]);
                        *(u32x2*)(hb + o2) = w;
                        sacc += (o[0] * o[0] + o[1] * o[1]) + (o[2] * o[2] + o[3] * o[3]);
                    }
                sacc += __shfl_xor(sacc, 16); sacc += __shfl_xor(sacc, 32);
                if (fq == 0) ssp[(size_t)row * 16 + u.pn * 4 + wc] = sacc;
            }
    }
};
struct EpiGU {
    static constexpr bool PERM = true, AFTER_DRAIN = false;
    const float* rstd2; const int* row_ts; bf16_t* hid;
    DEVI void operator()(const f32x4 (&acc)[2][2][4][2], const Unit& u, int wr, int wc, int fr, int fq) const {
        const int row0 = u.pm * 256 + wr * 64 + fr;
#pragma unroll
        for (int ai = 0; ai < 2; ++ai)
#pragma unroll
            for (int m = 0; m < 4; ++m) {
                const int row = row0 + ai * 128 + m * 16;
                const int ts = row_ts[row];
                const float rs = ts >= 0 ? rstd2[ts >> 1] : 0.f;
                float hv[8];
#pragma unroll
                for (int n = 0; n < 2; ++n)
#pragma unroll
                    for (int i = 0; i < 4; ++i) { const float g = acc[ai][0][m][n][i] * rs, uu = acc[ai][1][m][n][i] * rs; hv[n * 4 + i] = siluf_(g) * uu; }
                u32x4 w; w.x = pk2(hv[0], hv[1]); w.y = pk2(hv[2], hv[3]); w.z = pk2(hv[4], hv[5]); w.w = pk2(hv[6], hv[7]);
                *(u32x4*)(hid + (size_t)row * DEXP + u.pn * 128 + wc * 32 + 8 * fq) = w;
            }
    }
};
struct EpiDown {
    static constexpr bool PERM = true, AFTER_DRAIN = false;
    const int* row_ts; const float* row_w; bf16_t* Y;
    DEVI void operator()(const f32x4 (&acc)[2][2][4][2], const Unit& u, int wr, int wc, int fr, int fq) const {
        const int row0 = u.pm * 256 + wr * 64 + fr, col0 = u.pn * 256 + wc * 32 + 8 * fq;
#pragma unroll
        for (int ai = 0; ai < 2; ++ai)
#pragma unroll
            for (int m = 0; m < 4; ++m) {
                const int row = row0 + ai * 128 + m * 16;
                const int ts = row_ts[row];
                if (ts >= 0) {
                    const float wt = row_w[row];
                    bf16_t* rowp = Y + ((size_t)(ts & 1) * T + (size_t)(ts >> 1)) * D + col0;
#pragma unroll
                    for (int bj = 0; bj < 2; ++bj) {
                        const f32x4 v0 = acc[ai][bj][m][0] * wt, v1 = acc[ai][bj][m][1] * wt;
                        u32x4 w; w.x = pk2(v0[0], v0[1]); w.y = pk2(v0[2], v0[3]); w.z = pk2(v1[0], v1[1]); w.w = pk2(v1[2], v1[3]);
                        *(u32x4*)(rowp + bj * 128) = w;
                    }
                }
            }
    }
};
struct EpiPlain {
    static constexpr bool PERM = true, AFTER_DRAIN = false;
    bf16_t* O; int ldc, pad;
    DEVI void operator()(const f32x4 (&acc)[2][2][4][2], const Unit& u, int wr, int wc, int fr, int fq) const {
        const int row0 = u.pm * 256 + wr * 64 + fr, col0 = u.pn * 256 + wc * 32 + 8 * fq;
#pragma unroll
        for (int ai = 0; ai < 2; ++ai)
#pragma unroll
            for (int m = 0; m < 4; ++m) {
                bf16_t* rowp = O + (size_t)(row0 + ai * 128 + m * 16) * ldc + col0;
#pragma unroll
                for (int bj = 0; bj < 2; ++bj) {
                    const f32x4 v0 = acc[ai][bj][m][0], v1 = acc[ai][bj][m][1];
                    u32x4 w; w.x = pk2(v0[0], v0[1]); w.y = pk2(v0[2], v0[3]); w.z = pk2(v1[0], v1[1]); w.w = pk2(v1[2], v1[3]);
                    *(u32x4*)(rowp + bj * 128) = w;
                }
            }
    }
};
struct MoeOrder {
    int ntot, nN, G, c; const int* tile_e; size_t estride;
    DEVI void bind(const int* n_tiles_ptr, int G_, int c_) { ntot = __builtin_amdgcn_readfirstlane(*n_tiles_ptr) * nN; G = G_; c = c_; }
    DEVI bool next(int i, Unit& u) const { const long L = (long)i * G + c; if (L >= ntot) return false; u.pm = (int)(L / nN); u.pn = (int)(L % nN); return true; }
    DEVI size_t bbase(const Unit& u, size_t tstep) const { return (size_t)__builtin_amdgcn_readfirstlane(tile_e[u.pm]) * estride + (size_t)u.pn * tstep; }
    DEVI void a_ready(const Unit&) const {}
    DEVI void done(const Unit&) const {}
};

constexpr int GEMM_LDS = 131072;
template <class Epi> __global__ void __launch_bounds__(512, 2) k_gemm_static(pg8::Gemm g, Epi E) {
    extern __shared__ __attribute__((aligned(16))) unsigned char lds[];
    pg8::StaticOrder S; S.init(g.M, g.N, (int)gridDim.x, (int)blockIdx.x);
    pg8::gemm_phase<Epi, pg8::StaticOrder, true, true>((PG8_LAS unsigned char*)lds, g, S, E);
}
template <class Epi> __global__ void __launch_bounds__(512, 2) k_gemm_moe(pg8::Gemm g, MoeOrder S, const int* n_tiles, Epi E) {
    extern __shared__ __attribute__((aligned(16))) unsigned char lds[];
    S.bind(n_tiles, (int)gridDim.x, (int)blockIdx.x);
    pg8::gemm_phase<Epi, MoeOrder, true, true>((PG8_LAS unsigned char*)lds, g, S, E);
}

struct PrepJob { const float* in; const float* in2; const float* gain; bf16_t* out; int ldin, K, Nout, mode, ne, pad; size_t in_es, out_es; };
__global__ void __launch_bounds__(256) k_prep_w(PrepJob j) {
    __shared__ float tile[32][33];
    const int nb = j.Nout / 32, kb = j.K / 32, per = nb * kb, tx = threadIdx.x & 31, ty = threadIdx.x >> 5;
    for (int it = blockIdx.x; it < per * j.ne; it += gridDim.x) {
        const int e = it / per, r = it % per, n0 = (r % nb) * 32, k0 = (r / nb) * 32;
        const int n = n0 + tx; const float* src = j.in + (size_t)e * j.in_es; int col = n; bool valid = true;
        if (j.mode == 1) {
            if (n < 1152) col = n; else if (n < 1160) col = 2688 + (n - 1152); else if (n < 1280) valid = false; else if (n < 2816) col = 1152 + (n - 1280); else col = 2696 + (n - 2816);
        } else if (j.mode == 2) { const int pn = n >> 8, bj = (n >> 7) & 1; col = pn * 128 + (n & 127); if (bj) src = j.in2 + (size_t)e * j.in_es; }
#pragma unroll
        for (int i = 0; i < 4; ++i) { const int k = k0 + ty + 8 * i; tile[ty + 8 * i][tx] = valid ? src[(size_t)k * j.ldin + col] * (j.gain ? j.gain[k] : 1.0f) : 0.f; }
        __syncthreads();
        bf16_t* o = j.out + (size_t)e * j.out_es;
#pragma unroll
        for (int i = 0; i < 4; ++i) { const int nn = n0 + ty + 8 * i; o[(size_t)nn * j.K + k0 + tx] = (bf16_t)f2bf(tile[tx][ty + 8 * i]); }
        __syncthreads();
    }
}
__global__ void __launch_bounds__(256) k_prep_router(const float* rgw, const float* rew, const float* g, float* WR) {
    const int idx = blockIdx.x * 256 + threadIdx.x; if (idx >= 36 * 1024) return;
    const int n = idx / 1024, k = idx % 1024;
    WR[idx] = g[k] * (n < 4 ? rgw[k * 4 + n] : rew[k * 32 + (n - 4)]);
}
__global__ void __launch_bounds__(256) k_prep_x(const float* x, bf16_t* hb, float* ssp) {
    const int lane = threadIdx.x & 63, gw = blockIdx.x * 4 + (threadIdx.x >> 6), ngw = gridDim.x * 4;
    for (int row = gw; row < T; row += ngw) {
        const f32x4* xr = (const f32x4*)(x + (size_t)row * D) + lane; float s = 0.f;
        u32x2* o = (u32x2*)(hb + (size_t)row * D) + lane;
#pragma unroll
        for (int jj = 0; jj < 4; ++jj) { const f32x4 v = xr[64 * jj]; s += (v[0] * v[0] + v[1] * v[1]) + (v[2] * v[2] + v[3] * v[3]); u32x2 w; w.x = pk2(v[0], v[1]); w.y = pk2(v[2], v[3]); o[64 * jj] = w; }
        s = wave_sum(s);
        if (lane < 16) ssp[(size_t)row * 16 + lane] = lane == 0 ? s : 0.f;
    }
}
__global__ void __launch_bounds__(256) k_cvt_bf16(const float* in, bf16_t* out, size_t n4) {
    for (size_t i = (size_t)blockIdx.x * 256 + threadIdx.x; i < n4; i += (size_t)gridDim.x * 256) {
        const f32x4 v = ((const f32x4*)in)[i]; u32x2 w; w.x = pk2(v[0], v[1]); w.y = pk2(v[2], v[3]); ((u32x2*)out)[i] = w; }
}

__global__ void __launch_bounds__(256) k_sb_naive(const bf16_t* Z, const float* og, float* tmpA, bf16_t* Ymix) {
    const int row = blockIdx.x * 256 + threadIdx.x; const int b = row / SEQ, t = row % SEQ;
    float ss = 0.f;
    for (int h = 0; h < 6; ++h) {
        float q[64], o[64];
        const u32x4* qp = (const u32x4*)(Z + (size_t)row * NZ + ZQA + h * 64);
#pragma unroll
        for (int i = 0; i < 8; ++i) { const u32x4 w = qp[i];
            q[i * 8 + 0] = __uint_as_float(w.x << 16) * 0.125f; q[i * 8 + 1] = __uint_as_float(w.x & 0xffff0000u) * 0.125f;
            q[i * 8 + 2] = __uint_as_float(w.y << 16) * 0.125f; q[i * 8 + 3] = __uint_as_float(w.y & 0xffff0000u) * 0.125f;
            q[i * 8 + 4] = __uint_as_float(w.z << 16) * 0.125f; q[i * 8 + 5] = __uint_as_float(w.z & 0xffff0000u) * 0.125f;
            q[i * 8 + 6] = __uint_as_float(w.w << 16) * 0.125f; q[i * 8 + 7] = __uint_as_float(w.w & 0xffff0000u) * 0.125f; }
#pragma unroll
        for (int d = 0; d < 64; ++d) o[d] = 0.f;
        float cum = 0.f;
        for (int s = t - 1; s >= 0; --s) {
            const size_t kr = (size_t)(b * SEQ + s) * NZ;
            const u32x4* kp = (const u32x4*)(Z + kr + ZKA + h * 64);
            float zz = 0.f;
#pragma unroll
            for (int i = 0; i < 8; ++i) { const u32x4 w = kp[i];
                zz += q[i * 8 + 0] * __uint_as_float(w.x << 16) + q[i * 8 + 1] * __uint_as_float(w.x & 0xffff0000u);
                zz += q[i * 8 + 2] * __uint_as_float(w.y << 16) + q[i * 8 + 3] * __uint_as_float(w.y & 0xffff0000u);
                zz += q[i * 8 + 4] * __uint_as_float(w.z << 16) + q[i * 8 + 5] * __uint_as_float(w.z & 0xffff0000u);
                zz += q[i * 8 + 6] * __uint_as_float(w.w << 16) + q[i * 8 + 7] * __uint_as_float(w.w & 0xffff0000u); }
            cum += softplusf_(zz);
            const float a = __expf(zz - cum);
            const u32x4* vp = (const u32x4*)(Z + kr + ZVA + h * 64);
#pragma unroll
            for (int i = 0; i < 8; ++i) { const u32x4 w = vp[i];
                o[i * 8 + 0] += a * __uint_as_float(w.x << 16); o[i * 8 + 1] += a * __uint_as_float(w.x & 0xffff0000u);
                o[i * 8 + 2] += a * __uint_as_float(w.y << 16); o[i * 8 + 3] += a * __uint_as_float(w.y & 0xffff0000u);
                o[i * 8 + 4] += a * __uint_as_float(w.z << 16); o[i * 8 + 5] += a * __uint_as_float(w.z & 0xffff0000u);
                o[i * 8 + 6] += a * __uint_as_float(w.w << 16); o[i * 8 + 7] += a * __uint_as_float(w.w & 0xffff0000u); }
            if (cum > 88.f) break;
        }
        float* tp = tmpA + (size_t)row * 384 + h * 64;
#pragma unroll
        for (int d = 0; d < 64; d += 4) { ss += (o[d] * o[d] + o[d + 1] * o[d + 1]) + (o[d + 2] * o[d + 2] + o[d + 3] * o[d + 3]); *(f32x4*)(tp + d) = (f32x4){o[d], o[d + 1], o[d + 2], o[d + 3]}; }
    }
    const float rs = rsqrtf(ss * (1.0f / 384.0f) + EPS);
    const float* tp = tmpA + (size_t)row * 384;
    bf16_t* yp = Ymix + (size_t)row * D;
    for (int c = 0; c < 384; c += 4) { const f32x4 v = *(const f32x4*)(tp + c); const f32x4 g = *(const f32x4*)(og + c);
        u32x2 w; w.x = pk2(v[0] * rs * g[0], v[1] * rs * g[1]); w.y = pk2(v[2] * rs * g[2], v[3] * rs * g[3]); *(u32x2*)(yp + c) = w; }
}

constexpr int ML_LDS_FLOATS = 96 * 97 + 3 * 64 * 97 + 64 * 65 + 96 + 64 * 4 + 16;
__global__ void __launch_bounds__(256) k_mlstm_naive(const bf16_t* Z, const float* gates, const float* conv_w, const float* conv_b, const float* igb, const float* fgb,
                                                    const float* mng, bf16_t* Ymix) {
    extern __shared__ float sm[];
    float* C = sm; float* Q = C + 96 * 97; float* Kk = Q + 64 * 97; float* V = Kk + 64 * 97; float* S = V + 64 * 97; float* nv = S + 64 * 65;
    float* bc = nv + 96; float* ig = bc + 64; float* aw = ig + 64; float* wl = aw + 64; float* sc = wl + 64;
    const int b = blockIdx.x >> 2, h = blockIdx.x & 3, tid = threadIdx.x;
    for (int i = tid; i < 96 * 97; i += 256) C[i] = 0.f;
    if (tid < 96) nv[tid] = 0.f;
    if (tid == 0) sc[0] = 0.f;
    __syncthreads();
    for (int n = 0; n < 32; ++n) {
        const int s0 = n * 64; const size_t r0 = (size_t)b * SEQ + s0;
        for (int idx = tid; idx < 64 * 96; idx += 256) {
            const int l = idx / 96, d = idx % 96, ch = h * 96 + d;
            float qa = conv_b[ch], ka = conv_b[384 + ch];
#pragma unroll
            for (int jj = 0; jj < 4; ++jj) { const int sp = s0 + l - 3 + jj;
                if (sp >= 0) { const size_t zr = ((size_t)b * SEQ + sp) * NZ; qa += conv_w[jj * 768 + ch] * bf2f(Z[zr + ZQB + ch]); ka += conv_w[jj * 768 + 384 + ch] * bf2f(Z[zr + ZKB + ch]); } }
            Q[l * 97 + d] = siluf_(qa); Kk[l * 97 + d] = siluf_(ka) * 0.10206207261596575f; V[l * 97 + d] = bf2f(Z[(r0 + l) * NZ + ZVB + ch]);
        }
        if (tid < 64) { const float ip = gates[(r0 + tid) * 8 + h] + igb[h], fp = gates[(r0 + tid) * 8 + 4 + h] + fgb[h]; ig[tid] = ip; bc[tid] = -softplusf_(-fp); }
        __syncthreads();
        if (tid == 0) { float c = 0.f; for (int l = 0; l < 64; ++l) { c += bc[l]; bc[l] = c; } sc[1] = c; float am = -INFINITY; for (int l = 0; l < 64; ++l) { const float a = c - bc[l] + ig[l]; aw[l] = a; am = fmaxf(am, a); } sc[2] = am; }
        __syncthreads();
        for (int idx = tid; idx < 64 * 64; idx += 256) { const int t = idx >> 6, s = idx & 63;
            if (s <= t) { float a = 0.f; for (int d = 0; d < 96; ++d) a += Q[t * 97 + d] * Kk[s * 97 + d]; S[t * 65 + s] = a; } }
        __syncthreads();
        {
            const int t = tid >> 2, e0 = (tid & 3) * 24; const float m_in = sc[0], bt = bc[t], m_inter = bt + m_in;
            float mt = m_inter; for (int s = 0; s <= t; ++s) mt = fmaxf(mt, bt - bc[s] + ig[s]);
            float num[24]; float den = 0.f;
#pragma unroll
            for (int e = 0; e < 24; ++e) num[e] = 0.f;
            for (int s = 0; s <= t; ++s) { const float sw = S[t * 65 + s] * __expf(bt - bc[s] + ig[s] - mt); den += sw;
#pragma unroll
                for (int e = 0; e < 24; ++e) num[e] += sw * V[s * 97 + e0 + e]; }
            const float inter = __expf(m_inter - mt); float qn = 0.f;
            for (int d = 0; d < 96; ++d) { const float qv = Q[t * 97 + d]; qn += qv * nv[d]; const float qi = qv * inter;
#pragma unroll
                for (int e = 0; e < 24; ++e) num[e] += qi * C[d * 97 + e0 + e]; }
            den += inter * qn; den = fmaxf(fabsf(den), __expf(-mt));
            const float rden = 1.0f / den; float ss = 0.f;
#pragma unroll
            for (int e = 0; e < 24; ++e) { num[e] *= rden; ss += num[e] * num[e]; }
            ss += __shfl_xor(ss, 1); ss += __shfl_xor(ss, 2);
            const float rs = rsqrtf(ss * (1.0f / 96.0f) + EPS);
            const size_t zr = (r0 + t) * NZ + ZOB + h * 96 + e0; bf16_t* yp = Ymix + (r0 + t) * D + 384 + h * 96 + e0;
#pragma unroll
            for (int e = 0; e < 24; ++e) yp[e] = (bf16_t)f2bf(num[e] * rs * mng[h * 96 + e0 + e] * sigmoidf_(bf2f(Z[zr + e])));
        }
        __syncthreads();
        const float m_in = sc[0], btot = sc[1], m_new = fmaxf(btot + m_in, sc[2]), decay = __expf(btot + m_in - m_new);
        if (tid < 64) wl[tid] = __expf(aw[tid] - m_new);
        __syncthreads();
        for (int idx = tid; idx < 96 * 96; idx += 256) { const int d = idx / 96, e = idx % 96; float a = 0.f;
            for (int l = 0; l < 64; ++l) a += wl[l] * Kk[l * 97 + d] * V[l * 97 + e];
            C[d * 97 + e] = decay * C[d * 97 + e] + a; }
        if (tid < 96) { float a = 0.f; for (int l = 0; l < 64; ++l) a += wl[l] * Kk[l * 97 + tid]; nv[tid] = decay * nv[tid] + a; }
        __syncthreads();
        if (tid == 0) sc[0] = m_new;
        __syncthreads();
    }
}

__global__ void __launch_bounds__(512) k_sgu_naive(const bf16_t* Z, const float* ln_g, const float* ln_b, const float* Ws, const float* bs, const float* og, float* tmpC, bf16_t* Ymix) {
    __shared__ float vn[128 * 65];
    const int tid = threadIdx.x, t = tid >> 2, hf = tid & 3; const size_t row = (size_t)blockIdx.x * 128 + t;
    float ss = 0.f;
#pragma unroll 1
    for (int g = 0; g < 4; ++g) {
        float v[16]; float s1 = 0.f;
#pragma unroll
        for (int c = 0; c < 16; ++c) { v[c] = gelu_tanh(bf2f(Z[row * NZ + ZVC + g * 64 + hf * 16 + c])); s1 += v[c]; }
        s1 += __shfl_xor(s1, 1); s1 += __shfl_xor(s1, 2); const float mu = s1 * (1.0f / 64.0f); float s2 = 0.f;
#pragma unroll
        for (int c = 0; c < 16; ++c) { v[c] -= mu; s2 += v[c] * v[c]; }
        s2 += __shfl_xor(s2, 1); s2 += __shfl_xor(s2, 2); const float rstd = rsqrtf(s2 * (1.0f / 64.0f) + EPS);
#pragma unroll
        for (int c = 0; c < 16; ++c) vn[t * 65 + hf * 16 + c] = v[c] * rstd * ln_g[g * 64 + hf * 16 + c] + ln_b[g * 64 + hf * 16 + c];
        __syncthreads();
        float mx[16]; const float bias = bs[g * 128 + t];
#pragma unroll
        for (int c = 0; c < 16; ++c) mx[c] = bias;
        const int send = t < 64 ? 64 : 128; const float* wrow = Ws + ((size_t)g * 128 + t) * 128;
#pragma unroll 2
        for (int s = 0; s < send; ++s) { const float w = wrow[s];
#pragma unroll
            for (int c = 0; c < 16; ++c) mx[c] += w * vn[s * 65 + hf * 16 + c]; }
#pragma unroll
        for (int c = 0; c < 16; ++c) { const float y = gelu_tanh(bf2f(Z[row * NZ + ZUC + g * 64 + hf * 16 + c])) * mx[c]; ss += y * y; tmpC[row * 256 + g * 64 + hf * 16 + c] = y; }
        __syncthreads();
    }
    ss += __shfl_xor(ss, 1); ss += __shfl_xor(ss, 2); const float rs = rsqrtf(ss * (1.0f / 256.0f) + EPS);
#pragma unroll 1
    for (int g = 0; g < 4; ++g)
#pragma unroll
        for (int c = 0; c < 16; ++c) Ymix[row * D + 768 + g * 64 + hf * 16 + c] = (bf16_t)f2bf(tmpC[row * 256 + g * 64 + hf * 16 + c] * rs * og[g * 64 + hf * 16 + c]);
}

__global__ void __launch_bounds__(256) k_router(const float* h, const float* WR, const float* rgb, const float* reb, int* tokE, float* tokW, float* rstd2, int* rank, unsigned* count) {
    __shared__ int hist[32], wgb[32], selE[512], selR[512]; __shared__ float lgs[4 * 36];
    const int tid = threadIdx.x, lane = tid & 63, wave = tid >> 6, tok0 = blockIdx.x * 256;
    if (tid < 32) hist[tid] = 0;
    __syncthreads();
    for (int i = 0; i < 64; ++i) {
        const int li = wave * 64 + i, t = tok0 + li;
        const f32x4* hr = (const f32x4*)(h + (size_t)t * D) + lane; f32x4 v[4]; float s = 0.f;
#pragma unroll
        for (int jj = 0; jj < 4; ++jj) { v[jj] = hr[64 * jj]; s += (v[jj][0] * v[jj][0] + v[jj][1] * v[jj][1]) + (v[jj][2] * v[jj][2] + v[jj][3] * v[jj][3]); }
        const float rs = rsqrtf(wave_sum(s) * (1.0f / 1024.0f) + EPS);
#pragma unroll 1
        for (int n = 0; n < 36; ++n) { const f32x4* wr = (const f32x4*)(WR + (size_t)n * D) + lane; float p = 0.f;
#pragma unroll
            for (int jj = 0; jj < 4; ++jj) { const f32x4 w = wr[64 * jj]; p += (v[jj][0] * w[0] + v[jj][1] * w[1]) + (v[jj][2] * w[2] + v[jj][3] * w[3]); }
            p = wave_sum(p) * rs; if (lane == 0) lgs[wave * 36 + n] = p; }
        __builtin_amdgcn_wave_barrier();
        const float* lg = lgs + wave * 36;
        float gl[4]; int gtop = 0; float gmax;
#pragma unroll
        for (int n = 0; n < 4; ++n) gl[n] = lg[n] + rgb[n];
        gmax = gl[0];
#pragma unroll
        for (int n = 1; n < 4; ++n) if (gl[n] > gmax) { gmax = gl[n]; gtop = n; }
        float den = 0.f;
#pragma unroll
        for (int n = 0; n < 4; ++n) den += __expf(gl[n] - gmax);
        const float gw = 1.0f / den;
        float el[8];
#pragma unroll
        for (int jj = 0; jj < 8; ++jj) { float x = lg[4 + jj]; x = gtop == 1 ? lg[12 + jj] : x; x = gtop == 2 ? lg[20 + jj] : x; x = gtop == 3 ? lg[28 + jj] : x; el[jj] = x + reb[gtop * 8 + jj]; }
        int i1 = 0; float v1 = el[0];
#pragma unroll
        for (int jj = 1; jj < 8; ++jj) if (el[jj] > v1) { v1 = el[jj]; i1 = jj; }
        int i2 = -1; float v2 = -INFINITY;
#pragma unroll
        for (int jj = 0; jj < 8; ++jj) if (jj != i1 && el[jj] > v2) { v2 = el[jj]; i2 = jj; }
        const float ex = __expf(v2 - v1), w1 = 1.0f / (1.0f + ex), w2 = ex * w1;
        if (lane == 0) {
            const int e1 = gtop * 8 + i1, e2 = gtop * 8 + i2;
            tokE[t * 2] = e1; tokE[t * 2 + 1] = e2; tokW[t * 2] = w1 * gw; tokW[t * 2 + 1] = w2 * gw; rstd2[t] = rs;
            selE[li * 2] = e1; selE[li * 2 + 1] = e2; selR[li * 2] = atomicAdd(&hist[e1], 1); selR[li * 2 + 1] = atomicAdd(&hist[e2], 1);
        }
    }
    __syncthreads();
    if (tid < 32) wgb[tid] = (int)atomicAdd(&count[tid], (unsigned)hist[tid]);
    __syncthreads();
    for (int idx = tid; idx < 512; idx += 256) rank[tok0 * 2 + idx] = wgb[selE[idx]] + selR[idx];
}
__global__ void __launch_bounds__(256) k_offsets(const unsigned* count, int* pstart, int* tile_e, int* n_tiles, int* row_ts) {
    __shared__ int ps[33], cnt[32];
    const int tid = threadIdx.x;
    if (tid == 0) { int acc = 0, nt = 0;
        for (int e = 0; e < 32; ++e) { const int c = (int)count[e]; cnt[e] = c; ps[e] = acc; const int ntile = (c + 255) >> 8; for (int i = 0; i < ntile; ++i) tile_e[nt + i] = e; nt += ntile; acc += ntile * 256; }
        ps[32] = acc; *n_tiles = nt; }
    __syncthreads();
    if (tid < 32) pstart[tid] = ps[tid];
    for (int e = 0; e < 32; ++e) for (int r = cnt[e] + tid; r < ps[e + 1] - ps[e]; r += 256) row_ts[ps[e] + r] = -1;
}
__global__ void __launch_bounds__(256) k_place(const int* tokE, const float* tokW, const int* rank, const int* pstart, int* row_ts, float* row_w) {
    const int idx = blockIdx.x * 256 + threadIdx.x; if (idx >= 2 * T) return;
    const int pos = pstart[tokE[idx]] + rank[idx]; row_ts[pos] = idx; row_w[pos] = tokW[idx];
}
__global__ void __launch_bounds__(256) k_gather(const bf16_t* hb, const int* row_ts, const int* n_tiles, bf16_t* XS) {
    const int lane = threadIdx.x & 63, gw = blockIdx.x * 4 + (threadIdx.x >> 6), ngw = gridDim.x * 4, nrows = *n_tiles * 256;
    for (int pos = gw; pos < nrows; pos += ngw) {
        const int ts = row_ts[pos]; u32x4* o = (u32x4*)(XS + (size_t)pos * D) + lane;
        if (ts >= 0) { const u32x4* s = (const u32x4*)(hb + (size_t)(ts >> 1) * D) + lane; o[0] = s[0]; o[64] = s[64]; }
        else { o[0] = (u32x4){0u, 0u, 0u, 0u}; o[64] = (u32x4){0u, 0u, 0u, 0u}; }
    }
}
__global__ void __launch_bounds__(256) k_combine(float* h, const bf16_t* Y, bf16_t* hb, float* rstd3) {
    const int lane = threadIdx.x & 63, gw = blockIdx.x * 4 + (threadIdx.x >> 6), ngw = gridDim.x * 4;
    for (int row = gw; row < T; row += ngw) {
        f32x4* hr = (f32x4*)(h + (size_t)row * D) + lane; const u32x2* y0 = (const u32x2*)(Y + (size_t)row * D) + lane; const u32x2* y1 = (const u32x2*)(Y + ((size_t)T + row) * D) + lane;
        u32x2* o = (u32x2*)(hb + (size_t)row * D) + lane; float s = 0.f;
#pragma unroll
        for (int jj = 0; jj < 4; ++jj) { f32x4 v = hr[64 * jj]; const u32x2 a = y0[64 * jj], bb = y1[64 * jj];
            v[0] += __uint_as_float(a.x << 16) + __uint_as_float(bb.x << 16); v[1] += __uint_as_float(a.x & 0xffff0000u) + __uint_as_float(bb.x & 0xffff0000u);
            v[2] += __uint_as_float(a.y << 16) + __uint_as_float(bb.y << 16); v[3] += __uint_as_float(a.y & 0xffff0000u) + __uint_as_float(bb.y & 0xffff0000u);
            hr[64 * jj] = v; u32x2 w; w.x = pk2(v[0], v[1]); w.y = pk2(v[2], v[3]); o[64 * jj] = w;
            s += (v[0] * v[0] + v[1] * v[1]) + (v[2] * v[2] + v[3] * v[3]); }
        s = wave_sum(s);
        if (lane == 0) rstd3[row] = rsqrtf(s * (1.0f / 1024.0f) + EPS);
    }
}
__global__ void __launch_bounds__(256) k_final(float* out, const float* ssp, const float* g) {
    const int lane = threadIdx.x & 63, gw = blockIdx.x * 4 + (threadIdx.x >> 6), ngw = gridDim.x * 4;
    for (int row = gw; row < T; row += ngw) {
        float s = lane < 16 ? ssp[(size_t)row * 16 + lane] : 0.f; s = wave_sum(s);
        const float rs = rsqrtf(s * (1.0f / 1024.0f) + EPS);
        f32x4* hr = (f32x4*)(out + (size_t)row * D) + lane; const f32x4* gp = (const f32x4*)g + lane;
#pragma unroll
        for (int jj = 0; jj < 4; ++jj) { f32x4 v = hr[64 * jj]; const f32x4 gg = gp[64 * jj]; v = v * rs * gg; hr[64 * jj] = v; }
    }
}

enum { IN_X = 0, IN_P, IN_NORM1G, IN_WIN, IN_CONVW, IN_CONVB, IN_IGB, IN_FGB, IN_MNG, IN_SBOG, IN_SGULNG, IN_SGULNB, IN_SGUW, IN_SGUB, IN_SGUOG, IN_WOUT, IN_NORM2G,
       IN_RGW, IN_RGB, IN_REW, IN_REB, IN_WGATE, IN_WUP, IN_WDOWN, IN_PLENG, IN_PLEGW, IN_PLEPW, IN_FINALG, N_INPUTS };

extern "C" void kernel_launch(void* const* d_in, const int* in_sizes, int n_in, void* d_out, int out_size, void* d_ws, size_t ws_size, hipStream_t stream) {
    static int ok = 0;
    if (ok == 0) {
        ok = 1;
        if (n_in != N_INPUTS || in_sizes[0] != T * D || out_size != T * D || ws_size < WS_END) { fprintf(stderr, "kernel_launch: unexpected shapes / workspace (%d inputs, ws %zu)\n", n_in, ws_size); ok = -1; }
        hipFuncSetAttribute((const void*)k_gemm_static<EpiZ>, hipFuncAttributeMaxDynamicSharedMemorySize, GEMM_LDS);
        hipFuncSetAttribute((const void*)k_gemm_static<EpiResid>, hipFuncAttributeMaxDynamicSharedMemorySize, GEMM_LDS);
        hipFuncSetAttribute((const void*)k_gemm_static<EpiPLE>, hipFuncAttributeMaxDynamicSharedMemorySize, GEMM_LDS);
        hipFuncSetAttribute((const void*)k_gemm_static<EpiPlain>, hipFuncAttributeMaxDynamicSharedMemorySize, GEMM_LDS);
        hipFuncSetAttribute((const void*)k_gemm_moe<EpiGU>, hipFuncAttributeMaxDynamicSharedMemorySize, GEMM_LDS);
        hipFuncSetAttribute((const void*)k_gemm_moe<EpiDown>, hipFuncAttributeMaxDynamicSharedMemorySize, GEMM_LDS);
        hipFuncSetAttribute((const void*)k_mlstm_naive, hipFuncAttributeMaxDynamicSharedMemorySize, ML_LDS_FLOATS * 4);
    }
    if (ok < 0) return;
    auto F = [&](int i) { return (const float*)d_in[i]; };
    unsigned char* ws = (unsigned char*)d_ws;
    float* out = (float*)d_out;
    unsigned* ctl = (unsigned*)(ws + WS_CTL);
    float* gates = (float*)(ws + WS_GATES); float* ssp = (float*)(ws + WS_SSP);
    int* tokE = (int*)(ws + WS_TOKE); float* tokW = (float*)(ws + WS_TOKW); float* rstd2 = (float*)(ws + WS_RSTD2); float* rstd3 = (float*)(ws + WS_RSTD3);
    int* rank = (int*)(ws + WS_RANK); int* row_ts = (int*)(ws + WS_ROWTS); float* row_w = (float*)(ws + WS_ROWW); int* tile_e = (int*)(ws + WS_TILEE); int* pstart = (int*)(ws + WS_PSTART);
    bf16_t* PB = (bf16_t*)(ws + WS_PB); bf16_t* HBA = (bf16_t*)(ws + WS_HBA); bf16_t* HBB = (bf16_t*)(ws + WS_HBB); bf16_t* YMIX = (bf16_t*)(ws + WS_YMIX);
    bf16_t* Zb = (bf16_t*)(ws + WS_Z); bf16_t* XS = (bf16_t*)(ws + WS_XS); bf16_t* Yb = (bf16_t*)(ws + WS_Y); bf16_t* HID = (bf16_t*)(ws + WS_HID);
    float* tmpA = (float*)(ws + WS_HBB);
    const int G = 256;

    hipMemsetAsync(ws + WS_CTL, 0, 1 * MiB, stream);
    for (int l = 0; l < DEPTH; ++l) {
        unsigned char* wl = ws + WS_WTS + (size_t)l * WL_SIZE;
        PrepJob j{};
        j = PrepJob{F(IN_WIN) + (size_t)l * D * 3208, nullptr, F(IN_NORM1G) + l * D, (bf16_t*)(wl + WL_IN), 3208, D, NZ, 1, 1, 0, 0, 0}; k_prep_w<<<1024, 256, 0, stream>>>(j);
        j = PrepJob{F(IN_WOUT) + (size_t)l * D * D, nullptr, nullptr, (bf16_t*)(wl + WL_OUT), D, D, D, 0, 1, 0, 0, 0}; k_prep_w<<<1024, 256, 0, stream>>>(j);
        j = PrepJob{F(IN_WGATE) + (size_t)l * NEXP * D * DEXP, F(IN_WUP) + (size_t)l * NEXP * D * DEXP, F(IN_NORM2G) + l * D, (bf16_t*)(wl + WL_GU), DEXP, D, 512, 2, NEXP, 0, (size_t)D * DEXP, (size_t)512 * D};
        k_prep_w<<<2048, 256, 0, stream>>>(j);
        j = PrepJob{F(IN_WDOWN) + (size_t)l * NEXP * DEXP * D, nullptr, nullptr, (bf16_t*)(wl + WL_DN), D, DEXP, D, 0, NEXP, 0, (size_t)DEXP * D, (size_t)D * DEXP}; k_prep_w<<<2048, 256, 0, stream>>>(j);
        j = PrepJob{F(IN_PLEGW) + (size_t)l * D * D, nullptr, F(IN_PLENG) + l * D, (bf16_t*)(wl + WL_PG), D, D, D, 0, 1, 0, 0, 0}; k_prep_w<<<1024, 256, 0, stream>>>(j);
        j = PrepJob{F(IN_PLEPW) + (size_t)l * PDIM * D, nullptr, nullptr, (bf16_t*)(wl + WL_PP), D, PDIM, D, 0, 1, 0, 0, 0}; k_prep_w<<<256, 256, 0, stream>>>(j);
        k_prep_router<<<144, 256, 0, stream>>>(F(IN_RGW) + l * D * 4, F(IN_REW) + l * D * 32, F(IN_NORM2G) + l * D, (float*)(ws + WS_WR) + (size_t)l * 36 * D);
    }
    k_prep_x<<<2048, 256, 0, stream>>>(F(IN_X), HBA, ssp);
    k_cvt_bf16<<<2048, 256, 0, stream>>>(F(IN_P), PB, (size_t)DEPTH * T * PDIM / 4);

    for (int l = 0; l < DEPTH; ++l) {
        unsigned char* wl = ws + WS_WTS + (size_t)l * WL_SIZE;
        const float* WR = (const float*)(ws + WS_WR) + (size_t)l * 36 * D;
        { pg8::Gemm g{HBA, (const bf16_t*)(wl + WL_IN), T, NZ, D}; EpiZ E{Zb, ssp, gates}; k_gemm_static<EpiZ><<<G, 512, GEMM_LDS, stream>>>(g, E); }
        k_sb_naive<<<T / 256, 256, 0, stream>>>(Zb, F(IN_SBOG) + l * 384, tmpA, YMIX);
        k_mlstm_naive<<<NB * 4, 256, ML_LDS_FLOATS * 4, stream>>>(Zb, gates, F(IN_CONVW) + l * 4 * 768, F(IN_CONVB) + l * 768, F(IN_IGB) + l * 4, F(IN_FGB) + l * 4, F(IN_MNG) + l * 384, YMIX);
        k_sgu_naive<<<T / 128, 512, 0, stream>>>(Zb, F(IN_SGULNG) + l * 256, F(IN_SGULNB) + l * 256, F(IN_SGUW) + (size_t)l * 4 * 128 * 128, F(IN_SGUB) + l * 4 * 128, F(IN_SGUOG) + l * 256, (float*)(ws + WS_HBA), YMIX);
        { pg8::Gemm g{YMIX, (const bf16_t*)(wl + WL_OUT), T, D, D}; EpiResid E{l == 0 ? F(IN_X) : out, out, HBB}; k_gemm_static<EpiResid><<<G, 512, GEMM_LDS, stream>>>(g, E); }
        k_router<<<T / 256, 256, 0, stream>>>(out, WR, F(IN_RGB) + l * 4, F(IN_REB) + l * 32, tokE, tokW, rstd2, rank, ctl + CW_COUNT + 32 * l);
        k_offsets<<<1, 256, 0, stream>>>(ctl + CW_COUNT + 32 * l, pstart, tile_e, (int*)(ctl + CW_NTILES + l), row_ts);
        k_place<<<2 * T / 256, 256, 0, stream>>>(tokE, tokW, rank, pstart, row_ts, row_w);
        k_gather<<<2048, 256, 0, stream>>>(HBB, row_ts, (const int*)(ctl + CW_NTILES + l), XS);
        { pg8::Gemm g{XS, (const bf16_t*)(wl + WL_GU), MAXROWS, 512, D}; MoeOrder S{0, 2, 0, 0, tile_e, (size_t)512 * D * 2}; EpiGU E{rstd2, row_ts, HID};
          k_gemm_moe<EpiGU><<<G, 512, GEMM_LDS, stream>>>(g, S, (const int*)(ctl + CW_NTILES + l), E); }
        { pg8::Gemm g{HID, (const bf16_t*)(wl + WL_DN), MAXROWS, D, DEXP}; MoeOrder S{0, 4, 0, 0, tile_e, (size_t)D * DEXP * 2}; EpiDown E{row_ts, row_w, Yb};
          k_gemm_moe<EpiDown><<<G, 512, GEMM_LDS, stream>>>(g, S, (const int*)(ctl + CW_NTILES + l), E); }
        k_combine<<<2048, 256, 0, stream>>>(out, Yb, HBB, rstd3);
        { pg8::Gemm g{PB + (size_t)l * T * PDIM, (const bf16_t*)(wl + WL_PP), T, D, PDIM}; EpiPlain E{YMIX, D, 0}; k_gemm_static<EpiPlain><<<G, 512, GEMM_LDS, stream>>>(g, E); }
        { pg8::Gemm g{HBB, (const bf16_t*)(wl + WL_PG), T, D, D}; EpiPLE E{rstd3, YMIX, out, HBA, ssp}; k_gemm_static<EpiPLE><<<G, 512, GEMM_LDS, stream>>>(g, E); }
    }
    k_final<<<2048, 256, 0, stream>>>(out, ssp, F(IN_FINALG));
}
```

```cpp
#include <hip/hip_runtime.h>
#include <cstdio>
#include <cstdint>
namespace pg8 {
#define PG8_LAS __attribute__((address_space(3)))
typedef unsigned short bf16_t;
typedef short bf16x8 __attribute__((ext_vector_type(8)));
typedef float f32x4 __attribute__((ext_vector_type(4)));
typedef unsigned u32x4 __attribute__((ext_vector_type(4)));
constexpr int BM = 256, BK = 64, HALF = 128, HTB = HALF * BK * 2  , STAGE_BYTES = 8 * HTB, NXCD = 8, WGM = 8;

__host__ __device__ __forceinline__ int lds_byte(int r, int c) { const int st = (r >> 4) * 2 + (c >> 5), rr = r & 15, cc = c & 31, ob = rr * 64 + cc * 2; return st * 1024 + (ob ^ (((ob >> 9) & 1) << 5)); }
__host__ __device__ __forceinline__ void stage_rc(int b, int& R, int& C) { const int st = b / 1024, sb = b % 1024, swz = sb ^ (((sb >> 9) & 1) << 5); R = (st >> 1) * 16 + swz / 64; C = (st & 1) * 32 + (swz % 64) / 2; }
__host__ __device__ __forceinline__ int perm32(int rho) { const int n = rho >> 4, i = rho & 15; return 8 * (i >> 2) + 4 * n + (i & 3); }

struct Unit { int pm, pn; };
struct Gemm { const bf16_t* A; const bf16_t* Bt; int M, N, K, pad; };

struct StaticOrder {
    int nM, nN, nwg, G, c;
    __host__ __device__ void init(int M, int N, int G_, int c_) { nM = M / BM; nN = N / BM; nwg = nM * nN; G = G_; c = c_; }
    __host__ __device__ bool next(int i, Unit& u) const {
        const long L = (long)i * G + c; if (L >= nwg) return false;
        int wgid = (int)L; { const int q = nwg / NXCD, r = nwg % NXCD, xcd = wgid % NXCD, off = wgid / NXCD; wgid = (xcd < r ? xcd * (q + 1) : r * (q + 1) + (xcd - r) * q) + off; }
        const int nig = WGM * nN, gid = wgid / nig, fm = gid * WGM, gsz = (nM - fm) < WGM ? (nM - fm) : WGM;
        u.pm = fm + ((wgid % nig) % gsz); u.pn = (wgid % nig) / gsz; return true;
    }
    __device__ __forceinline__ size_t bbase(const Unit& u, size_t tstep) const { return (size_t)u.pn * tstep; }
    __device__ __forceinline__ void a_ready(const Unit&) const {}
    __device__ __forceinline__ void done(const Unit&) const {}
};

__device__ __forceinline__ unsigned cvt_pk_bf16(float lo, float hi) { unsigned r; asm volatile("v_cvt_pk_bf16_f32 %0, %1, %2" : "=v"(r) : "v"(lo), "v"(hi)); return r; }
typedef float f32x2 __attribute__((ext_vector_type(2)));
template <class Epi, class Sched, bool ALIGN_EPI = false, bool SP2 = false>
__device__ __forceinline__ void gemm_phase(PG8_LAS unsigned char* lds, const Gemm g, const Sched& S, const Epi& E) {
    int tid_ = threadIdx.x; asm volatile("" : "+v"(tid_));
    const int tid = tid_, wid = __builtin_amdgcn_readfirstlane(tid >> 6), lane = tid & 63, wr = wid >> 2, wc = wid & 3, fr = lane & 15, fq = lane >> 4;
    int K_ = g.K; asm volatile("" : "+s"(K_));
    const int K = K_, nt = K / BK;
    unsigned voffA[2], voffB[2];
#pragma unroll
    for (int i = 0; i < 2; ++i) { int R, C; stage_rc(tid * 16 + i * 8192, R, C); const int Rb = Epi::PERM ? ((R & ~31) + perm32(R & 31)) : R;
        voffA[i] = (unsigned)(R * K + C) * 2u; voffB[i] = (unsigned)(Rb * K + C) * 2u; }
    const size_t kstep = (size_t)(BK * 2);
    const size_t hstep = (size_t)HALF * K * 2;
    const size_t tstep = 2 * hstep;
    const unsigned ldsw = (unsigned)wid * 1024u;
    const int aoff = lds_byte(wr * 64 + fr, fq * 8), boff = lds_byte(wc * 32 + fr, fq * 8);
#define PG8_SA(b, h) (((b) * 2 + (h)) * HTB)
#define PG8_SB(b, h) ((4 + (b) * 2 + (h)) * HTB)
#define PG8_STAGE(bufoff, gbase, voff) do { _Pragma("unroll") for (int _i = 0; _i < 2; ++_i) \
        __builtin_amdgcn_global_load_lds((const unsigned*)((const char*)(gbase) + (voff)[_i]), (PG8_LAS unsigned*)(lds + (bufoff) + ldsw + _i * 8192), 16, 0, 0); } while (0)
#define PG8_LDA(dst, b, h) do { _Pragma("unroll") for (int m = 0; m < 4; ++m) _Pragma("unroll") for (int k = 0; k < 2; ++k) dst[m][k] = *(const PG8_LAS bf16x8*)(lds + PG8_SA(b, h) + aoff + m * 2048 + k * 1024); } while (0)
#define PG8_LDB(dst, b, h) do { _Pragma("unroll") for (int n = 0; n < 2; ++n) _Pragma("unroll") for (int k = 0; k < 2; ++k) dst[n][k] = *(const PG8_LAS bf16x8*)(lds + PG8_SB(b, h) + boff + n * 2048 + k * 1024); } while (0)
#define PG8_MMA(ai, bj, At, Bt) do { __builtin_amdgcn_s_setprio(1); _Pragma("unroll") for (int m = 0; m < 4; ++m) _Pragma("unroll") for (int n = 0; n < 2; ++n) _Pragma("unroll") for (int k = 0; k < 2; ++k) \
        acc[ai][bj][m][n] = __builtin_amdgcn_mfma_f32_16x16x32_bf16(Bt[n][k], At[m][k], acc[ai][bj][m][n], 0, 0, 0); __builtin_amdgcn_s_setprio(0); } while (0)
#define PG8_WAIT_V(n) asm volatile("s_waitcnt vmcnt(" #n ")" ::: "memory")
#define PG8_WAIT_L(n) asm volatile("s_waitcnt lgkmcnt(" #n ")" ::: "memory")
#define PG8_BAR __builtin_amdgcn_s_barrier()
#define PG8_SCHED __builtin_amdgcn_sched_barrier(0)
    Unit cur, nxt; int ui = 0;
    if (!S.next(0, cur)) return;
    f32x4 acc[2][2][4][2];
#pragma unroll
    for (int a = 0; a < 2; ++a)
#pragma unroll
        for (int b = 0; b < 2; ++b)
#pragma unroll
            for (int m = 0; m < 4; ++m)
#pragma unroll
                for (int n = 0; n < 2; ++n) acc[a][b][m][n] = (f32x4){0.f, 0.f, 0.f, 0.f};
    bf16x8 At[4][2], B0[2][2], B1[2][2];
    const char* cA = (const char*)g.A + (size_t)cur.pm * tstep; const char* cB = (const char*)g.Bt + S.bbase(cur, tstep);
    S.a_ready(cur);
    if constexpr (SP2) {
        PG8_STAGE(PG8_SB(0, 0), cB, voffB); PG8_STAGE(PG8_SB(0, 1), cB + hstep, voffB); PG8_STAGE(PG8_SA(0, 0), cA, voffA); PG8_STAGE(PG8_SA(0, 1), cA + hstep, voffA);
        if (wr == 1) PG8_BAR;
        PG8_WAIT_V(2); PG8_BAR;
        PG8_STAGE(PG8_SB(1, 0), cB + kstep, voffB); PG8_STAGE(PG8_SA(1, 0), cA + kstep, voffA); PG8_STAGE(PG8_SB(1, 1), cB + hstep + kstep, voffB);
        PG8_WAIT_V(6); PG8_BAR;
    } else {
        PG8_STAGE(PG8_SB(0, 0), cB, voffB); PG8_STAGE(PG8_SA(0, 0), cA, voffA); PG8_STAGE(PG8_SB(0, 1), cB + hstep, voffB); PG8_STAGE(PG8_SA(0, 1), cA + hstep, voffA);
        if (wr == 1) PG8_BAR;
        PG8_WAIT_V(4); PG8_BAR;
        PG8_STAGE(PG8_SB(1, 0), cB + kstep, voffB); PG8_STAGE(PG8_SA(1, 0), cA + kstep, voffA); PG8_STAGE(PG8_SB(1, 1), cB + hstep + kstep, voffB);
        PG8_WAIT_V(6); PG8_BAR;
    }
    for (;;) {
        const bool has_next = S.next(ui + 1, nxt);
        const char* nA = has_next ? (const char*)g.A + (size_t)nxt.pm * tstep : cA; const char* nB = has_next ? (const char*)g.Bt + S.bbase(nxt, tstep) : cB;
        for (int t = 0; t < nt; t += 2) {
            const bool last = (t == nt - 2);
            const char* a1 = cA + (size_t)(t + 1) * kstep;
            const char* a2 = last ? nA : cA + (size_t)(t + 2) * kstep; const char* b2 = last ? nB : cB + (size_t)(t + 2) * kstep;
            const char* a3 = a2 + kstep; const char* b3 = b2 + kstep;
            if (last && has_next) S.a_ready(nxt);
            if constexpr (SP2) {
            PG8_LDB(B0, 0, 0); PG8_LDB(B1, 0, 1); PG8_SCHED; PG8_LDA(At, 0, 0); PG8_STAGE(PG8_SA(1, 1), a1 + hstep, voffA);
            PG8_WAIT_V(8); PG8_WAIT_L(0); PG8_BAR; PG8_MMA(0, 0, At, B0); PG8_MMA(0, 1, At, B1); PG8_BAR; PG8_SCHED;
            PG8_LDA(At, 0, 1); PG8_STAGE(PG8_SB(0, 0), b2, voffB); PG8_STAGE(PG8_SB(0, 1), b2 + hstep, voffB); PG8_STAGE(PG8_SA(0, 0), a2, voffA);
            PG8_WAIT_V(8); PG8_WAIT_L(0); PG8_BAR; PG8_MMA(1, 0, At, B0); PG8_MMA(1, 1, At, B1); PG8_BAR; PG8_SCHED;
            PG8_LDB(B0, 1, 0); PG8_LDB(B1, 1, 1); PG8_SCHED; PG8_LDA(At, 1, 0); PG8_STAGE(PG8_SA(0, 1), a2 + hstep, voffA);
            PG8_WAIT_V(8); PG8_WAIT_L(0); PG8_BAR; PG8_MMA(0, 0, At, B0); PG8_MMA(0, 1, At, B1); PG8_BAR; PG8_SCHED;
            PG8_LDA(At, 1, 1); PG8_STAGE(PG8_SB(1, 0), b3, voffB); PG8_STAGE(PG8_SB(1, 1), b3 + hstep, voffB); PG8_STAGE(PG8_SA(1, 0), a3, voffA);
            PG8_WAIT_V(8); PG8_WAIT_L(0); PG8_BAR; PG8_MMA(1, 0, At, B0); PG8_MMA(1, 1, At, B1); PG8_BAR; PG8_SCHED;
            } else {
            PG8_LDB(B0, 0, 0); PG8_SCHED; PG8_LDA(At, 0, 0); PG8_STAGE(PG8_SA(1, 1), a1 + hstep, voffA);
            PG8_WAIT_L(8); PG8_BAR; PG8_WAIT_L(0); PG8_MMA(0, 0, At, B0); PG8_BAR; PG8_SCHED;
            PG8_LDB(B1, 0, 1); PG8_STAGE(PG8_SB(0, 0), b2, voffB);
            PG8_BAR; PG8_WAIT_L(0); PG8_MMA(0, 1, At, B1); PG8_BAR;
            PG8_LDA(At, 0, 1); PG8_STAGE(PG8_SA(0, 0), a2, voffA);
            PG8_BAR; PG8_WAIT_L(0); PG8_MMA(1, 0, At, B0); PG8_BAR; PG8_SCHED;
            PG8_STAGE(PG8_SB(0, 1), b2 + hstep, voffB);
            PG8_WAIT_V(6); PG8_BAR; PG8_MMA(1, 1, At, B1); PG8_BAR;
            PG8_LDB(B0, 1, 0); PG8_SCHED; PG8_LDA(At, 1, 0); PG8_STAGE(PG8_SA(0, 1), a2 + hstep, voffA);
            PG8_WAIT_L(8); PG8_BAR; PG8_WAIT_L(0); PG8_MMA(0, 0, At, B0); PG8_BAR; PG8_SCHED;
            PG8_LDB(B1, 1, 1); PG8_STAGE(PG8_SB(1, 0), b3, voffB);
            PG8_BAR; PG8_WAIT_L(0); PG8_MMA(0, 1, At, B1); PG8_BAR;
            PG8_LDA(At, 1, 1); PG8_STAGE(PG8_SA(1, 0), a3, voffA);
            PG8_BAR; PG8_WAIT_L(0); PG8_MMA(1, 0, At, B0); PG8_BAR; PG8_SCHED;
            PG8_STAGE(PG8_SB(1, 1), b3 + hstep, voffB);
            PG8_WAIT_V(6); PG8_BAR; PG8_MMA(1, 1, At, B1); PG8_BAR;
            }
        }
        if constexpr (ALIGN_EPI) { if (wr == 0) PG8_BAR; }
        if constexpr (!Epi::AFTER_DRAIN) { E(acc, cur, wr, wc, fr, fq); S.done(cur); }
        if (!has_next) break;
#pragma unroll
        for (int a = 0; a < 2; ++a)
#pragma unroll
            for (int b = 0; b < 2; ++b)
#pragma unroll
                for (int m = 0; m < 4; ++m)
#pragma unroll
                    for (int n = 0; n < 2; ++n) acc[a][b][m][n] = (f32x4){0.f, 0.f, 0.f, 0.f};
        cur = nxt; cA = nA; cB = nB; ++ui;
        if constexpr (ALIGN_EPI) { if (wr == 1) PG8_BAR; }
    }
    PG8_WAIT_V(0);
    if constexpr (!ALIGN_EPI) { if (wr == 0) PG8_BAR; }
    PG8_BAR;
    if constexpr (Epi::AFTER_DRAIN) { E.fused(acc, cur, wr, wc, fr, fq, lds, wid, lane); S.done(cur); }
#undef PG8_SA
#undef PG8_SB
#undef PG8_STAGE
#undef PG8_LDA
#undef PG8_LDB
#undef PG8_MMA
#undef PG8_WAIT_V
#undef PG8_WAIT_L
#undef PG8_BAR
#undef PG8_SCHED
}
}

#define DEVI __device__ __forceinline__
typedef unsigned short bf16_t;
typedef float f32x4 __attribute__((ext_vector_type(4)));
typedef unsigned u32x4 __attribute__((ext_vector_type(4)));
typedef unsigned u32x2 __attribute__((ext_vector_type(2)));

constexpr int T = 65536, D = 1024, SEQ = 2048, NB = 32, DEPTH = 2;
constexpr int NZ = 3328;
constexpr int ZQA = 0, ZKA = 384, ZVA = 768, ZIF = 1152, ZQB = 1280, ZKB = 1664, ZVB = 2048, ZOB = 2432, ZUC = 2816, ZVC = 3072;
constexpr int NEXP = 32, DEXP = 256, PDIM = 256;
constexpr int MAXROWS = 2 * T + NEXP * 256;
constexpr float EPS = 1e-6f;

constexpr size_t MiB = 1u << 20;
constexpr size_t WS_CTL = 0;
constexpr size_t WS_GATES = 1 * MiB;
constexpr size_t WS_SSP = 3 * MiB;
constexpr size_t WS_TOKE = 7 * MiB;
constexpr size_t WS_TOKW = 7 * MiB + 512 * 1024;
constexpr size_t WS_RSTD2 = 8 * MiB;
constexpr size_t WS_RSTD3 = 8 * MiB + 256 * 1024;
constexpr size_t WS_RANK = 8 * MiB + 512 * 1024;
constexpr size_t WS_ROWTS = 9 * MiB;
constexpr size_t WS_ROWW = 10 * MiB;
constexpr size_t WS_TILEE = 11 * MiB;
constexpr size_t WS_PSTART = 11 * MiB + 4096;
constexpr size_t WS_WR = 12 * MiB;
constexpr size_t WS_WTS = 16 * MiB;
constexpr size_t WL_IN = 0, WL_OUT = 6656 * 1024, WL_GU = WL_OUT + 2 * MiB, WL_DN = WL_GU + 32 * MiB, WL_PG = WL_DN + 16 * MiB, WL_PP = WL_PG + 2 * MiB, WL_SIZE = 59 * MiB;
constexpr size_t WS_PB = 134 * MiB;
constexpr size_t WS_HBA = 198 * MiB;
constexpr size_t WS_HBB = 326 * MiB;
constexpr size_t WS_YMIX = 454 * MiB;
constexpr size_t WS_Z = 582 * MiB;
constexpr size_t WS_XS = WS_Z, WS_Y = WS_Z, WS_HID = WS_Z + 272 * MiB;
constexpr size_t WS_END = 998 * MiB;
static_assert(WL_PP + 512 * 1024 <= WL_SIZE, "weights map");
static_assert((size_t)MAXROWS * 1024 * 2 <= 272 * MiB && (size_t)MAXROWS * 256 * 2 <= 68 * MiB, "overlay map");
constexpr int CW_COUNT = 0;
constexpr int CW_NTILES = 64;

DEVI float bf2f(unsigned short b) { return __uint_as_float((unsigned)b << 16); }
DEVI unsigned f2bf(float f) { unsigned u = __float_as_uint(f); return (u + 0x7fffu + ((u >> 16) & 1u)) >> 16; }
DEVI unsigned pk2(float lo, float hi) { return f2bf(lo) | (f2bf(hi) << 16); }
DEVI float wave_sum(float v) {
#pragma unroll
    for (int o = 1; o < 64; o <<= 1) v += __shfl_xor(v, o);
    return v;
}
DEVI float sigmoidf_(float x) { return 1.0f / (1.0f + __expf(-x)); }
DEVI float siluf_(float x) { return x * sigmoidf_(x); }
DEVI float gelu_tanh(float x) { const float u = 0.7978845608028654f * (x + 0.044715f * x * x * x); return 0.5f * x * (1.0f + tanhf(u)); }
DEVI float softplusf_(float x) { return fmaxf(x, 0.f) + log1pf(__expf(-fabsf(x))); }

using pg8::Unit;
struct EpiZ {
    static constexpr bool PERM = true, AFTER_DRAIN = false;
    bf16_t* Z; const float* ssp; float* gates;
    DEVI void operator()(const f32x4 (&acc)[2][2][4][2], const Unit& u, int wr, int wc, int fr, int fq) const {
        int row0 = u.pm * 256 + wr * 64 + fr, col0 = u.pn * 256 + wc * 32 + 8 * fq; asm volatile("" : "+v"(row0), "+v"(col0));
#pragma unroll
        for (int ai = 0; ai < 2; ++ai)
#pragma unroll
            for (int m = 0; m < 4; ++m) {
                const int row = row0 + ai * 128 + m * 16;
                const f32x4* sp = (const f32x4*)(ssp + (size_t)row * 16);
                const f32x4 s0 = sp[0], s1 = sp[1], s2 = sp[2], s3 = sp[3];
                const f32x4 st = (s0 + s1) + (s2 + s3);
                const float rs = rsqrtf(((st[0] + st[1]) + (st[2] + st[3])) * (1.0f / 1024.0f) + EPS);
                bf16_t* rowp = Z + (size_t)row * NZ + col0;
#pragma unroll
                for (int bj = 0; bj < 2; ++bj) {
                    const f32x4 v0 = acc[ai][bj][m][0] * rs, v1 = acc[ai][bj][m][1] * rs;
                    u32x4 w; w.x = pk2(v0[0], v0[1]); w.y = pk2(v0[2], v0[3]); w.z = pk2(v1[0], v1[1]); w.w = pk2(v1[2], v1[3]);
                    *(u32x4*)(rowp + bj * 128) = w;
                    if (bj == 1 && u.pn == 4 && wc == 0 && fq == 0) { *(f32x4*)(gates + (size_t)row * 8) = v0; *(f32x4*)(gates + (size_t)row * 8 + 4) = v1; }
                }
            }
    }
};
struct EpiResid {
    static constexpr bool PERM = false, AFTER_DRAIN = false;
    const float* hin; float* hout; bf16_t* hb;
    DEVI void operator()(const f32x4 (&acc)[2][2][4][2], const Unit& u, int wr, int wc, int fr, int fq) const {
        int row0 = u.pm * 256 + wr * 64 + fr, col0 = u.pn * 256 + wc * 32 + 4 * fq; asm volatile("" : "+v"(row0), "+v"(col0));
#pragma unroll
        for (int ai = 0; ai < 2; ++ai)
#pragma unroll
            for (int m = 0; m < 4; ++m) {
                const size_t off = (size_t)(row0 + ai * 128 + m * 16) * D + col0;
#pragma unroll
                for (int bj = 0; bj < 2; ++bj)
#pragma unroll
                    for (int n = 0; n < 2; ++n) {
                        const size_t o2 = off + bj * 128 + n * 16;
                        const f32x4 o = *(const f32x4*)(hin + o2) + acc[ai][bj][m][n];
                        *(f32x4*)(hout + o2) = o;
                        u32x2 w; w.x = pk2(o[0], o[1]); w.y = pk2(o[2], o[3]);
                        *(u32x2*)(hb + o2) = w;
                    }
            }
    }
};
struct EpiPLE {
    static constexpr bool PERM = false, AFTER_DRAIN = false;
    const float* rstd3; const bf16_t* pp; float* h; bf16_t* hb; float* ssp;
    DEVI void operator()(const f32x4 (&acc)[2][2][4][2], const Unit& u, int wr, int wc, int fr, int fq) const {
        int row0 = u.pm * 256 + wr * 64 + fr, col0 = u.pn * 256 + wc * 32 + 4 * fq; asm volatile("" : "+v"(row0), "+v"(col0));
#pragma unroll
        for (int ai = 0; ai < 2; ++ai)
#pragma unroll
            for (int m = 0; m < 4; ++m) {
                const int row = row0 + ai * 128 + m * 16;
                const size_t off = (size_t)row * D + col0;
                const float rs = rstd3[row];
                float sacc = 0.f;
#pragma unroll
                for (int bj = 0; bj < 2; ++bj)
#pragma unroll
                    for (int n = 0; n < 2; ++n) {
                        const size_t o2 = off + bj * 128 + n * 16;
                        const u32x2 pw = *(const u32x2*)(pp + o2);
                        const f32x4 pv = {__uint_as_float(pw.x << 16), __uint_as_float(pw.x & 0xffff0000u), __uint_as_float(pw.y << 16), __uint_as_float(pw.y & 0xffff0000u)};
                        const f32x4 a = acc[ai][bj][m][n] * rs;
                        f32x4 o = *(const f32x4*)(h + o2);
                        o[0] += sigmoidf_(a[0]) * pv[0]; o[1] += sigmoidf_(a[1]) * pv[1]; o[2] += sigmoidf_(a[2]) * pv[2]; o[3] += sigmoidf_(a[3]) * pv[3];
                        *(f32x4*)(h + o2) = o;
                        u32x2 w; w.x = pk2(o[0], o[1]); w.y = pk2(o[2], o[3]);
                        *(u32x2*)(hb + o2) = w;
                        sacc += (o[0] * o[0] + o[1] * o[1]) + (o[2] * o[2] + o[3] * o[3]);
                    }
                sacc += __shfl_xor(sacc, 16); sacc += __shfl_xor(sacc, 32);
                if (fq == 0) ssp[(size_t)row * 16 + u.pn * 4 + wc] = sacc;
            }
    }
};
struct EpiGU {
    static constexpr bool PERM = true, AFTER_DRAIN = false;
    const float* rstd2; const int* row_ts; bf16_t* hid;
    DEVI void operator()(const f32x4 (&acc)[2][2][4][2], const Unit& u, int wr, int wc, int fr, int fq) const {
        int row0 = u.pm * 256 + wr * 64 + fr; asm volatile("" : "+v"(row0));
#pragma unroll
        for (int ai = 0; ai < 2; ++ai)
#pragma unroll
            for (int m = 0; m < 4; ++m) {
                const int row = row0 + ai * 128 + m * 16;
                const int ts = row_ts[row];
                const float rs = ts >= 0 ? rstd2[ts >> 1] : 0.f;
                float hv[8];
#pragma unroll
                for (int n = 0; n < 2; ++n)
#pragma unroll
                    for (int i = 0; i < 4; ++i) { const float g = acc[ai][0][m][n][i] * rs, uu = acc[ai][1][m][n][i] * rs; hv[n * 4 + i] = siluf_(g) * uu; }
                u32x4 w; w.x = pk2(hv[0], hv[1]); w.y = pk2(hv[2], hv[3]); w.z = pk2(hv[4], hv[5]); w.w = pk2(hv[6], hv[7]);
                *(u32x4*)(hid + (size_t)row * DEXP + u.pn * 128 + wc * 32 + 8 * fq) = w;
            }
    }
};
struct EpiDown {
    static constexpr bool PERM = true, AFTER_DRAIN = false;
    const int* row_ts; const float* row_w; bf16_t* Y;
    DEVI void operator()(const f32x4 (&acc)[2][2][4][2], const Unit& u, int wr, int wc, int fr, int fq) const {
        int row0 = u.pm * 256 + wr * 64 + fr, col0 = u.pn * 256 + wc * 32 + 8 * fq; asm volatile("" : "+v"(row0), "+v"(col0));
#pragma unroll
        for (int ai = 0; ai < 2; ++ai)
#pragma unroll
            for (int m = 0; m < 4; ++m) {
                const int row = row0 + ai * 128 + m * 16;
                const int ts = row_ts[row];
                if (ts >= 0) {
                    const float wt = row_w[row];
                    bf16_t* rowp = Y + ((size_t)(ts & 1) * T + (size_t)(ts >> 1)) * D + col0;
#pragma unroll
                    for (int bj = 0; bj < 2; ++bj) {
                        const f32x4 v0 = acc[ai][bj][m][0] * wt, v1 = acc[ai][bj][m][1] * wt;
                        u32x4 w; w.x = pk2(v0[0], v0[1]); w.y = pk2(v0[2], v0[3]); w.z = pk2(v1[0], v1[1]); w.w = pk2(v1[2], v1[3]);
                        *(u32x4*)(rowp + bj * 128) = w;
                    }
                }
            }
    }
};
struct EpiPlain {
    static constexpr bool PERM = true, AFTER_DRAIN = false;
    bf16_t* O; int ldc, pad;
    DEVI void operator()(const f32x4 (&acc)[2][2][4][2], const Unit& u, int wr, int wc, int fr, int fq) const {
        int row0 = u.pm * 256 + wr * 64 + fr, col0 = u.pn * 256 + wc * 32 + 8 * fq; asm volatile("" : "+v"(row0), "+v"(col0));
#pragma unroll
        for (int ai = 0; ai < 2; ++ai)
#pragma unroll
            for (int m = 0; m < 4; ++m) {
                bf16_t* rowp = O + (size_t)(row0 + ai * 128 + m * 16) * ldc + col0;
#pragma unroll
                for (int bj = 0; bj < 2; ++bj) {
                    const f32x4 v0 = acc[ai][bj][m][0], v1 = acc[ai][bj][m][1];
                    u32x4 w; w.x = pk2(v0[0], v0[1]); w.y = pk2(v0[2], v0[3]); w.z = pk2(v1[0], v1[1]); w.w = pk2(v1[2], v1[3]);
                    *(u32x4*)(rowp + bj * 128) = w;
                }
            }
    }
};
struct MoeOrder {
    int ntot, nN, G, c; const int* tile_e; size_t estride;
    DEVI void bind(const int* n_tiles_ptr, int G_, int c_) { ntot = __builtin_amdgcn_readfirstlane(*n_tiles_ptr) * nN; G = G_; c = c_; }
    DEVI bool next(int i, Unit& u) const { const long L = (long)i * G + c; if (L >= ntot) return false; u.pm = (int)(L / nN); u.pn = (int)(L % nN); return true; }
    DEVI size_t bbase(const Unit& u, size_t tstep) const { return (size_t)__builtin_amdgcn_readfirstlane(tile_e[u.pm]) * estride + (size_t)u.pn * tstep; }
    DEVI void a_ready(const Unit&) const {}
    DEVI void done(const Unit&) const {}
};


constexpr int NTHR = 512;
constexpr int RING_BYTES = 131072;
constexpr int MISC_OFF = RING_BYTES;
constexpr int LDS_BYTES = 147456;
constexpr int CW_BAR = 4096;

#define XB_TMO      128
#define XB_XCNT(j)  (256  + 64 * (j))
#define XB_XSUB(j)  (1280 + 64 * (j))
#define XB_XGEN(j)  (2304 + 64 * (j))
#define XB_TOP      3328
#define XB_TOPGEN   3392
#define XCD_BAR_WORDS 3456
#define XB_SPIN_CAP (1u << 18)
#define LAS __attribute__((address_space(3)))

__device__ __forceinline__ unsigned xb_ld(unsigned* p)              { return __hip_atomic_load(p, __ATOMIC_RELAXED, __HIP_MEMORY_SCOPE_AGENT); }
__device__ __forceinline__ unsigned xb_add(unsigned* p, unsigned v) { return __hip_atomic_fetch_add(p, v, __ATOMIC_RELAXED, __HIP_MEMORY_SCOPE_AGENT); }
__device__ __forceinline__ unsigned xb_xcc_id() { return (unsigned)__builtin_amdgcn_s_getreg((3 << 11) | 20) & 0xFu; }
#define XB_SPIN(cond, bar) do { unsigned _sp = 0; while (cond) { __builtin_amdgcn_s_sleep(1); \
    if ((++_sp & 255u) == 0u) { if (xb_ld(&(bar)[XB_TMO])) break; if (_sp > XB_SPIN_CAP) { atomicAdd(&(bar)[XB_TMO], 1u); break; } } } } while (0)

struct XcdBarrier {
    unsigned* bar; unsigned x;
    volatile LAS unsigned* st;
};

__device__ __forceinline__ XcdBarrier xcd_barrier_post(unsigned* bar, volatile LAS unsigned* st) {
    XcdBarrier b; b.bar = bar; b.x = xb_xcc_id(); b.st = st;
    if (threadIdx.x == 0) (void)xb_add(&bar[XB_XCNT(b.x)], 1u);
    return b;
}
__device__ __forceinline__ void xcd_barrier_complete(unsigned* bar, unsigned x, unsigned& nloc, unsigned& nx) {
    const unsigned G = gridDim.x * gridDim.y * gridDim.z;
    unsigned sum, cnt, mine, sp = 0u;
    for (;;) {
        sum = 0u; cnt = 0u; mine = 0u;
#pragma unroll
        for (unsigned j = 0; j < 16; ++j) { const unsigned c = xb_ld(&bar[XB_XCNT(j)]); sum += c; cnt += (c > 0u) ? 1u : 0u; mine = (j == x) ? c : mine; }
        if (sum == G) break;
        __builtin_amdgcn_s_sleep(1);
        if ((++sp & 255u) == 0u) { if (xb_ld(&bar[XB_TMO])) break; if (sp > XB_SPIN_CAP) { atomicAdd(&bar[XB_TMO], 1u); break; } }
    }
    nloc = mine > 0u ? mine : 1u; nx = cnt > 0u ? cnt : 1u;
}

__device__ __forceinline__ void xcd_barrier(const XcdBarrier& b) {
    asm volatile("s_waitcnt vmcnt(0)" ::: "memory");
    __syncthreads();
    if (threadIdx.x == 0) {
        unsigned* bar = b.bar;
        __builtin_amdgcn_s_waitcnt(0);
        unsigned nloc = b.st[0], nx = b.st[1];
        if (nloc == 0u) { xcd_barrier_complete(bar, b.x, nloc, nx); b.st[0] = nloc; b.st[1] = nx; }
        const unsigned old = xb_add(&bar[XB_XSUB(b.x)], 1u);
        const unsigned gen = old / nloc;
        if (old + 1u == (gen + 1u) * nloc) {
            __builtin_amdgcn_fence(__ATOMIC_RELEASE, "agent");
            asm volatile("s_waitcnt vmcnt(0)" ::: "memory");
            const unsigned og = xb_add(&bar[XB_TOP], 1u);
            const unsigned tg = og / nx;
            if (og + 1u == (tg + 1u) * nx) xb_add(&bar[XB_TOPGEN], 1u);
            else XB_SPIN(xb_ld(&bar[XB_TOPGEN]) == tg, bar);
            __builtin_amdgcn_fence(__ATOMIC_ACQUIRE, "agent");
            xb_add(&bar[XB_XGEN(b.x)], 1u);
            asm volatile("s_waitcnt vmcnt(0)" ::: "memory");
        } else {
            XB_SPIN(xb_ld(&bar[XB_XGEN(b.x)]) == gen, bar);
            __builtin_amdgcn_fence(__ATOMIC_ACQUIRE, "agent");
            asm volatile("s_waitcnt vmcnt(0)" ::: "memory");
        }
    }
    __syncthreads();
}


DEVI int otid() { int t = threadIdx.x; asm volatile("" : "+v"(t)); return t; }
struct PrepJob { const float* in; const float* in2; const float* gain; bf16_t* out; int ldin, K, Nout, mode, ne, pad; size_t in_es, out_es; };
DEVI void ph_prep_w(const PrepJob& j, unsigned char* sm, int wg, int nwg) {
    const int tid = otid(), sub = tid >> 8, t8 = tid & 255, tx = t8 & 31, ty = t8 >> 5;
    float* tile = (float*)sm + sub * (32 * 33);
    const int nb = j.Nout / 32, kb = j.K / 32, per = nb * kb, total = per * j.ne;
    for (int base = wg * 2; base < total; base += nwg * 2) {
        const int it = base + sub; const bool act = it < total;
        const int e = it / per, r = it % per, n0 = (r % nb) * 32, k0 = (r / nb) * 32;
        if (act) {
            const int n = n0 + tx; const float* src = j.in + (size_t)e * j.in_es; int col = n; bool valid = true;
            if (j.mode == 1) {
                if (n < 1152) col = n; else if (n < 1160) col = 2688 + (n - 1152); else if (n < 1280) valid = false; else if (n < 2816) col = 1152 + (n - 1280); else col = 2696 + (n - 2816);
            } else if (j.mode == 2) { const int pn = n >> 8, bj = (n >> 7) & 1; col = pn * 128 + (n & 127); if (bj) src = j.in2 + (size_t)e * j.in_es; }
#pragma unroll
            for (int i = 0; i < 4; ++i) { const int k = k0 + ty + 8 * i; tile[(ty + 8 * i) * 33 + tx] = valid ? src[(size_t)k * j.ldin + col] * (j.gain ? j.gain[k] : 1.0f) : 0.f; }
        }
        __syncthreads();
        if (act) {
            bf16_t* o = j.out + (size_t)e * j.out_es;
#pragma unroll
            for (int i = 0; i < 4; ++i) { const int nn = n0 + ty + 8 * i; o[(size_t)nn * j.K + k0 + tx] = (bf16_t)f2bf(tile[tx * 33 + ty + 8 * i]); }
        }
        __syncthreads();
    }
}
DEVI void ph_prep_router(const float* rgw, const float* rew, const float* g, float* WR, int wg, int nwg) {
    for (int idx = wg * NTHR + otid(); idx < 36 * 1024; idx += nwg * NTHR) { const int n = idx / 1024, k = idx % 1024; WR[idx] = g[k] * (n < 4 ? rgw[k * 4 + n] : rew[k * 32 + (n - 4)]); }
}
DEVI void ph_prep_x(const float* x, bf16_t* hb, float* ssp, int wg, int nwg) {
    const int tid = otid(), lane = tid & 63, gw = wg * 8 + (tid >> 6), ngw = nwg * 8;
    for (int row = gw; row < T; row += ngw) {
        const f32x4* xr = (const f32x4*)(x + (size_t)row * D) + lane; float s = 0.f;
        u32x2* o = (u32x2*)(hb + (size_t)row * D) + lane;
#pragma unroll
        for (int jj = 0; jj < 4; ++jj) { const f32x4 v = xr[64 * jj]; s += (v[0] * v[0] + v[1] * v[1]) + (v[2] * v[2] + v[3] * v[3]); u32x2 w; w.x = pk2(v[0], v[1]); w.y = pk2(v[2], v[3]); o[64 * jj] = w; }
        s = wave_sum(s);
        if (lane < 16) ssp[(size_t)row * 16 + lane] = lane == 0 ? s : 0.f;
    }
}
DEVI void ph_cvt_bf16(const float* in, bf16_t* out, size_t n4, int wg, int nwg) {
    for (size_t i = (size_t)wg * NTHR + otid(); i < n4; i += (size_t)nwg * NTHR) {
        const f32x4 v = ((const f32x4*)in)[i]; u32x2 w; w.x = pk2(v[0], v[1]); w.y = pk2(v[2], v[3]); ((u32x2*)out)[i] = w; }
}

DEVI void ph_sb_naive(const bf16_t* Z, const float* og, float* tmpA, bf16_t* Ymix, int wg, int nwg) {
    const int tid = otid(), hf = tid & 1;
    for (int row = wg * 256 + (tid >> 1); row < T; row += nwg * 256) {
    const int b = row / SEQ, t = row % SEQ;
    float ss = 0.f;
#pragma unroll 1
    for (int h = 0; h < 6; ++h) {
        u32x4 qw[8]; float o[32];
        const u32x4* qp = (const u32x4*)(Z + (size_t)row * NZ + ZQA + h * 64);
#pragma unroll
        for (int i = 0; i < 8; ++i) qw[i] = qp[i];
#pragma unroll
        for (int d = 0; d < 32; ++d) o[d] = 0.f;
        float cum = 0.f;
        for (int s = t - 1; s >= 0; --s) {
            const size_t kr = (size_t)(b * SEQ + s) * NZ;
            const u32x4* kp = (const u32x4*)(Z + kr + ZKA + h * 64);
            float zz = 0.f;
#pragma unroll
            for (int i = 0; i < 8; ++i) { const u32x4 w = kp[i], q = qw[i];
                zz += __uint_as_float(q.x << 16) * __uint_as_float(w.x << 16) + __uint_as_float(q.x & 0xffff0000u) * __uint_as_float(w.x & 0xffff0000u);
                zz += __uint_as_float(q.y << 16) * __uint_as_float(w.y << 16) + __uint_as_float(q.y & 0xffff0000u) * __uint_as_float(w.y & 0xffff0000u);
                zz += __uint_as_float(q.z << 16) * __uint_as_float(w.z << 16) + __uint_as_float(q.z & 0xffff0000u) * __uint_as_float(w.z & 0xffff0000u);
                zz += __uint_as_float(q.w << 16) * __uint_as_float(w.w << 16) + __uint_as_float(q.w & 0xffff0000u) * __uint_as_float(w.w & 0xffff0000u); }
            zz *= 0.125f;
            cum += softplusf_(zz);
            const float a = __expf(zz - cum);
            const u32x4* vp = (const u32x4*)(Z + kr + ZVA + h * 64 + hf * 32);
#pragma unroll
            for (int i = 0; i < 4; ++i) { const u32x4 w = vp[i];
                o[i * 8 + 0] += a * __uint_as_float(w.x << 16); o[i * 8 + 1] += a * __uint_as_float(w.x & 0xffff0000u);
                o[i * 8 + 2] += a * __uint_as_float(w.y << 16); o[i * 8 + 3] += a * __uint_as_float(w.y & 0xffff0000u);
                o[i * 8 + 4] += a * __uint_as_float(w.z << 16); o[i * 8 + 5] += a * __uint_as_float(w.z & 0xffff0000u);
                o[i * 8 + 6] += a * __uint_as_float(w.w << 16); o[i * 8 + 7] += a * __uint_as_float(w.w & 0xffff0000u); }
            if (cum > 88.f) break;
        }
        float* tp = tmpA + (size_t)row * 384 + h * 64 + hf * 32;
#pragma unroll
        for (int d = 0; d < 32; d += 4) { ss += (o[d] * o[d] + o[d + 1] * o[d + 1]) + (o[d + 2] * o[d + 2] + o[d + 3] * o[d + 3]); *(f32x4*)(tp + d) = (f32x4){o[d], o[d + 1], o[d + 2], o[d + 3]}; }
    }
    ss += __shfl_xor(ss, 1);
    const float rs = rsqrtf(ss * (1.0f / 384.0f) + EPS);
#pragma unroll 1
    for (int h = 0; h < 6; ++h) {
        const float* tp = tmpA + (size_t)row * 384 + h * 64 + hf * 32; bf16_t* yp = Ymix + (size_t)row * D + h * 64 + hf * 32; const float* gp = og + h * 64 + hf * 32;
#pragma unroll
        for (int c = 0; c < 32; c += 4) { const f32x4 v = *(const f32x4*)(tp + c); const f32x4 g = *(const f32x4*)(gp + c);
            u32x2 w; w.x = pk2(v[0] * rs * g[0], v[1] * rs * g[1]); w.y = pk2(v[2] * rs * g[2], v[3] * rs * g[3]); *(u32x2*)(yp + c) = w; }
    }
    }
}

constexpr int ML_LDS_FLOATS = 96 * 97 + 3 * 64 * 97 + 64 * 65 + 96 + 64 * 4 + 16;
static_assert(ML_LDS_FLOATS * 4 <= RING_BYTES, "mLSTM LDS");
DEVI void ph_mlstm_naive(const bf16_t* Z, const float* gates, const float* conv_w, const float* conv_b, const float* igb, const float* fgb, const float* mng, bf16_t* Ymix,
                         unsigned char* smb, int wg, int nwg) {
    float* sm = (float*)smb;
    float* C = sm; float* Q = C + 96 * 97; float* Kk = Q + 64 * 97; float* V = Kk + 64 * 97; float* S = V + 64 * 97; float* nv = S + 64 * 65;
    float* bc = nv + 96; float* ig = bc + 64; float* aw = ig + 64; float* wl = aw + 64; float* sc = wl + 64;
    const int tid = otid();
    for (int unit = wg; unit < NB * 4; unit += nwg) {
    const int b = unit >> 2, h = unit & 3;
    for (int i = tid; i < 96 * 97; i += NTHR) C[i] = 0.f;
    if (tid < 96) nv[tid] = 0.f;
    if (tid == 0) sc[0] = 0.f;
    __syncthreads();
    for (int n = 0; n < 32; ++n) {
        const int s0 = n * 64; const size_t r0 = (size_t)b * SEQ + s0;
        for (int idx = tid; idx < 64 * 96; idx += NTHR) {
            const int l = idx / 96, d = idx % 96, ch = h * 96 + d;
            float qa = conv_b[ch], ka = conv_b[384 + ch];
#pragma unroll
            for (int jj = 0; jj < 4; ++jj) { const int sp = s0 + l - 3 + jj;
                if (sp >= 0) { const size_t zr = ((size_t)b * SEQ + sp) * NZ; qa += conv_w[jj * 768 + ch] * bf2f(Z[zr + ZQB + ch]); ka += conv_w[jj * 768 + 384 + ch] * bf2f(Z[zr + ZKB + ch]); } }
            Q[l * 97 + d] = siluf_(qa); Kk[l * 97 + d] = siluf_(ka) * 0.10206207261596575f; V[l * 97 + d] = bf2f(Z[(r0 + l) * NZ + ZVB + ch]);
        }
        if (tid < 64) { const float ip = gates[(r0 + tid) * 8 + h] + igb[h], fp = gates[(r0 + tid) * 8 + 4 + h] + fgb[h]; ig[tid] = ip; bc[tid] = -softplusf_(-fp); }
        __syncthreads();
        if (tid == 0) { float c = 0.f; for (int l = 0; l < 64; ++l) { c += bc[l]; bc[l] = c; } sc[1] = c; float am = -INFINITY; for (int l = 0; l < 64; ++l) { const float a = c - bc[l] + ig[l]; aw[l] = a; am = fmaxf(am, a); } sc[2] = am; }
        __syncthreads();
        for (int idx = tid; idx < 64 * 64; idx += NTHR) { const int t = idx >> 6, s = idx & 63;
            if (s <= t) { float a = 0.f; for (int d = 0; d < 96; ++d) a += Q[t * 97 + d] * Kk[s * 97 + d]; S[t * 65 + s] = a; } }
        __syncthreads();
        {
            const int t = tid >> 3, e0 = (tid & 7) * 12; const float m_in = sc[0], bt = bc[t], m_inter = bt + m_in;
            float mt = m_inter; for (int s = 0; s <= t; ++s) mt = fmaxf(mt, bt - bc[s] + ig[s]);
            float num[12]; float den = 0.f;
#pragma unroll
            for (int e = 0; e < 12; ++e) num[e] = 0.f;
            for (int s = 0; s <= t; ++s) { const float sw = S[t * 65 + s] * __expf(bt - bc[s] + ig[s] - mt); den += sw;
#pragma unroll
                for (int e = 0; e < 12; ++e) num[e] += sw * V[s * 97 + e0 + e]; }
            const float inter = __expf(m_inter - mt); float qn = 0.f;
            for (int d = 0; d < 96; ++d) { const float qv = Q[t * 97 + d]; qn += qv * nv[d]; const float qi = qv * inter;
#pragma unroll
                for (int e = 0; e < 12; ++e) num[e] += qi * C[d * 97 + e0 + e]; }
            den += inter * qn; den = fmaxf(fabsf(den), __expf(-mt));
            const float rden = 1.0f / den; float ss = 0.f;
#pragma unroll
            for (int e = 0; e < 12; ++e) { num[e] *= rden; ss += num[e] * num[e]; }
            ss += __shfl_xor(ss, 1); ss += __shfl_xor(ss, 2); ss += __shfl_xor(ss, 4);
            const float rs = rsqrtf(ss * (1.0f / 96.0f) + EPS);
            const size_t zr = (r0 + t) * NZ + ZOB + h * 96 + e0; bf16_t* yp = Ymix + (r0 + t) * D + 384 + h * 96 + e0;
#pragma unroll
            for (int e = 0; e < 12; ++e) yp[e] = (bf16_t)f2bf(num[e] * rs * mng[h * 96 + e0 + e] * sigmoidf_(bf2f(Z[zr + e])));
        }
        __syncthreads();
        const float m_in = sc[0], btot = sc[1], m_new = fmaxf(btot + m_in, sc[2]), decay = __expf(btot + m_in - m_new);
        if (tid < 64) wl[tid] = __expf(aw[tid] - m_new);
        __syncthreads();
        for (int idx = tid; idx < 96 * 96; idx += NTHR) { const int d = idx / 96, e = idx % 96; float a = 0.f;
            for (int l = 0; l < 64; ++l) a += wl[l] * Kk[l * 97 + d] * V[l * 97 + e];
            C[d * 97 + e] = decay * C[d * 97 + e] + a; }
        if (tid < 96) { float a = 0.f; for (int l = 0; l < 64; ++l) a += wl[l] * Kk[l * 97 + tid]; nv[tid] = decay * nv[tid] + a; }
        __syncthreads();
        if (tid == 0) sc[0] = m_new;
        __syncthreads();
    }
    }
}

DEVI void ph_sgu_naive(const bf16_t* Z, const float* ln_g, const float* ln_b, const float* Ws, const float* bs, const float* og, float* tmpC, bf16_t* Ymix, unsigned char* smb, int wg, int nwg) {
    float* vn = (float*)smb;
    const int tid = otid(), t = tid >> 2, hf = tid & 3;
    for (int blk = wg; blk < T / 128; blk += nwg) {
    const size_t row = (size_t)blk * 128 + t;
    float ss = 0.f;
#pragma unroll 1
    for (int g = 0; g < 4; ++g) {
        float v[16]; float s1 = 0.f;
#pragma unroll
        for (int c = 0; c < 16; ++c) { v[c] = gelu_tanh(bf2f(Z[row * NZ + ZVC + g * 64 + hf * 16 + c])); s1 += v[c]; }
        s1 += __shfl_xor(s1, 1); s1 += __shfl_xor(s1, 2); const float mu = s1 * (1.0f / 64.0f); float s2 = 0.f;
#pragma unroll
        for (int c = 0; c < 16; ++c) { v[c] -= mu; s2 += v[c] * v[c]; }
        s2 += __shfl_xor(s2, 1); s2 += __shfl_xor(s2, 2); const float rstd = rsqrtf(s2 * (1.0f / 64.0f) + EPS);
#pragma unroll
        for (int c = 0; c < 16; ++c) vn[t * 65 + hf * 16 + c] = v[c] * rstd * ln_g[g * 64 + hf * 16 + c] + ln_b[g * 64 + hf * 16 + c];
        __syncthreads();
        float mx[16]; const float bias = bs[g * 128 + t];
#pragma unroll
        for (int c = 0; c < 16; ++c) mx[c] = bias;
        const int send = t < 64 ? 64 : 128; const float* wrow = Ws + ((size_t)g * 128 + t) * 128;
#pragma unroll 2
        for (int s = 0; s < send; ++s) { const float w = wrow[s];
#pragma unroll
            for (int c = 0; c < 16; ++c) mx[c] += w * vn[s * 65 + hf * 16 + c]; }
#pragma unroll
        for (int c = 0; c < 16; ++c) { const float y = gelu_tanh(bf2f(Z[row * NZ + ZUC + g * 64 + hf * 16 + c])) * mx[c]; ss += y * y; tmpC[row * 256 + g * 64 + hf * 16 + c] = y; }
        __syncthreads();
    }
    ss += __shfl_xor(ss, 1); ss += __shfl_xor(ss, 2); const float rs = rsqrtf(ss * (1.0f / 256.0f) + EPS);
#pragma unroll 1
    for (int g = 0; g < 4; ++g)
#pragma unroll
        for (int c = 0; c < 16; ++c) Ymix[row * D + 768 + g * 64 + hf * 16 + c] = (bf16_t)f2bf(tmpC[row * 256 + g * 64 + hf * 16 + c] * rs * og[g * 64 + hf * 16 + c]);
    }
}

DEVI void ph_router(const float* h, const float* WR, const float* rgb, const float* reb, int* tokE, float* tokW, float* rstd2, int* rank, unsigned* count, unsigned char* smb, int wg, int nwg) {
    int* hist = (int*)smb; int* wgb = hist + 32; int* selE = wgb + 32; int* selR = selE + 512; float* lgs = (float*)(selR + 512);
    const int tid = otid(), lane = tid & 63, wave = tid >> 6;
    for (int blk = wg; blk < T / 256; blk += nwg) {
    const int tok0 = blk * 256;
    if (tid < 32) hist[tid] = 0;
    __syncthreads();
    for (int i = 0; i < 32; ++i) {
        const int li = wave * 32 + i, t = tok0 + li;
        const f32x4* hr = (const f32x4*)(h + (size_t)t * D) + lane; f32x4 v[4]; float s = 0.f;
#pragma unroll
        for (int jj = 0; jj < 4; ++jj) { v[jj] = hr[64 * jj]; s += (v[jj][0] * v[jj][0] + v[jj][1] * v[jj][1]) + (v[jj][2] * v[jj][2] + v[jj][3] * v[jj][3]); }
        const float rs = rsqrtf(wave_sum(s) * (1.0f / 1024.0f) + EPS);
#pragma unroll 1
        for (int n = 0; n < 36; ++n) { const f32x4* wr = (const f32x4*)(WR + (size_t)n * D) + lane; float p = 0.f;
#pragma unroll
            for (int jj = 0; jj < 4; ++jj) { const f32x4 w = wr[64 * jj]; p += (v[jj][0] * w[0] + v[jj][1] * w[1]) + (v[jj][2] * w[2] + v[jj][3] * w[3]); }
            p = wave_sum(p) * rs; if (lane == 0) lgs[wave * 36 + n] = p; }
        __builtin_amdgcn_wave_barrier();
        const float* lg = lgs + wave * 36;
        float gl[4]; int gtop = 0; float gmax;
#pragma unroll
        for (int n = 0; n < 4; ++n) gl[n] = lg[n] + rgb[n];
        gmax = gl[0];
#pragma unroll
        for (int n = 1; n < 4; ++n) if (gl[n] > gmax) { gmax = gl[n]; gtop = n; }
        float den = 0.f;
#pragma unroll
        for (int n = 0; n < 4; ++n) den += __expf(gl[n] - gmax);
        const float gw = 1.0f / den;
        float el[8];
#pragma unroll
        for (int jj = 0; jj < 8; ++jj) el[jj] = lg[4 + gtop * 8 + jj] + reb[gtop * 8 + jj];
        int i1 = 0; float v1 = el[0];
#pragma unroll
        for (int jj = 1; jj < 8; ++jj) if (el[jj] > v1) { v1 = el[jj]; i1 = jj; }
        int i2 = -1; float v2 = -INFINITY;
#pragma unroll
        for (int jj = 0; jj < 8; ++jj) if (jj != i1 && el[jj] > v2) { v2 = el[jj]; i2 = jj; }
        const float ex = __expf(v2 - v1), w1 = 1.0f / (1.0f + ex), w2 = ex * w1;
        if (lane == 0) {
            const int e1 = gtop * 8 + i1, e2 = gtop * 8 + i2;
            tokE[t * 2] = e1; tokE[t * 2 + 1] = e2; tokW[t * 2] = w1 * gw; tokW[t * 2 + 1] = w2 * gw; rstd2[t] = rs;
            selE[li * 2] = e1; selE[li * 2 + 1] = e2; selR[li * 2] = atomicAdd(&hist[e1], 1); selR[li * 2 + 1] = atomicAdd(&hist[e2], 1);
        }
        __builtin_amdgcn_wave_barrier();
    }
    __syncthreads();
    if (tid < 32) wgb[tid] = (int)atomicAdd(&count[tid], (unsigned)hist[tid]);
    __syncthreads();
    rank[tok0 * 2 + tid] = wgb[selE[tid]] + selR[tid];
    __syncthreads();
    }
}
DEVI void ph_offsets(const unsigned* count, int* pstart, int* tile_e, int* n_tiles, int* row_ts, unsigned char* smb, int wg) {
    if (wg != 0) return;
    int* ps = (int*)smb; int* cnt = ps + 33;
    const int tid = otid();
    if (tid == 0) { int acc = 0, nt = 0;
        for (int e = 0; e < 32; ++e) { const int c = (int)__hip_atomic_load(count + e, __ATOMIC_RELAXED, __HIP_MEMORY_SCOPE_AGENT); cnt[e] = c; ps[e] = acc; const int ntile = (c + 255) >> 8; for (int i = 0; i < ntile; ++i) tile_e[nt + i] = e; nt += ntile; acc += ntile * 256; }
        ps[32] = acc; *n_tiles = nt; }
    __syncthreads();
    if (tid < 32) pstart[tid] = ps[tid];
    for (int e = 0; e < 32; ++e) for (int r = cnt[e] + tid; r < ps[e + 1] - ps[e]; r += NTHR) row_ts[ps[e] + r] = -1;
    __syncthreads();
}
DEVI void ph_place(const int* tokE, const float* tokW, const int* rank, const int* pstart, int* row_ts, float* row_w, int wg, int nwg) {
    for (int idx = wg * NTHR + otid(); idx < 2 * T; idx += nwg * NTHR) { const int pos = pstart[tokE[idx]] + rank[idx]; row_ts[pos] = idx; row_w[pos] = tokW[idx]; }
}
DEVI void ph_gather(const bf16_t* hb, const int* row_ts, const int* n_tiles, bf16_t* XS, int wg, int nwg) {
    const int tid = otid(), lane = tid & 63, gw = wg * 8 + (tid >> 6), ngw = nwg * 8, nrows = *n_tiles * 256;
    for (int pos = gw; pos < nrows; pos += ngw) {
        const int ts = row_ts[pos]; u32x4* o = (u32x4*)(XS + (size_t)pos * D) + lane;
        if (ts >= 0) { const u32x4* s = (const u32x4*)(hb + (size_t)(ts >> 1) * D) + lane; o[0] = s[0]; o[64] = s[64]; }
        else { o[0] = (u32x4){0u, 0u, 0u, 0u}; o[64] = (u32x4){0u, 0u, 0u, 0u}; }
    }
}
DEVI void ph_combine(float* h, const bf16_t* Y, bf16_t* hb, float* rstd3, int wg, int nwg) {
    const int tid = otid(), lane = tid & 63, gw = wg * 8 + (tid >> 6), ngw = nwg * 8;
    for (int row = gw; row < T; row += ngw) {
        f32x4* hr = (f32x4*)(h + (size_t)row * D) + lane; const u32x2* y0 = (const u32x2*)(Y + (size_t)row * D) + lane; const u32x2* y1 = (const u32x2*)(Y + ((size_t)T + row) * D) + lane;
        u32x2* o = (u32x2*)(hb + (size_t)row * D) + lane; float s = 0.f;
#pragma unroll
        for (int jj = 0; jj < 4; ++jj) { f32x4 v = hr[64 * jj]; const u32x2 a = y0[64 * jj], bb = y1[64 * jj];
            v[0] += __uint_as_float(a.x << 16) + __uint_as_float(bb.x << 16); v[1] += __uint_as_float(a.x & 0xffff0000u) + __uint_as_float(bb.x & 0xffff0000u);
            v[2] += __uint_as_float(a.y << 16) + __uint_as_float(bb.y << 16); v[3] += __uint_as_float(a.y & 0xffff0000u) + __uint_as_float(bb.y & 0xffff0000u);
            hr[64 * jj] = v; u32x2 w; w.x = pk2(v[0], v[1]); w.y = pk2(v[2], v[3]); o[64 * jj] = w;
            s += (v[0] * v[0] + v[1] * v[1]) + (v[2] * v[2] + v[3] * v[3]); }
        s = wave_sum(s);
        if (lane == 0) rstd3[row] = rsqrtf(s * (1.0f / 1024.0f) + EPS);
    }
}
DEVI void ph_final(float* out, const float* ssp, const float* g, int wg, int nwg) {
    const int tid = otid(), lane = tid & 63, gw = wg * 8 + (tid >> 6), ngw = nwg * 8;
    for (int row = gw; row < T; row += ngw) {
        float s = lane < 16 ? ssp[(size_t)row * 16 + lane] : 0.f; s = wave_sum(s);
        const float rs = rsqrtf(s * (1.0f / 1024.0f) + EPS);
        f32x4* hr = (f32x4*)(out + (size_t)row * D) + lane; const f32x4* gp = (const f32x4*)g + lane;
#pragma unroll
        for (int jj = 0; jj < 4; ++jj) { f32x4 v = hr[64 * jj]; const f32x4 gg = gp[64 * jj]; v = v * rs * gg; hr[64 * jj] = v; }
    }
}

enum { IN_X = 0, IN_P, IN_NORM1G, IN_WIN, IN_CONVW, IN_CONVB, IN_IGB, IN_FGB, IN_MNG, IN_SBOG, IN_SGULNG, IN_SGULNB, IN_SGUW, IN_SGUB, IN_SGUOG, IN_WOUT, IN_NORM2G,
       IN_RGW, IN_RGB, IN_REW, IN_REB, IN_WGATE, IN_WUP, IN_WDOWN, IN_PLENG, IN_PLEGW, IN_PLEPW, IN_FINALG, N_INPUTS };
constexpr int NPH_LAYER = 11, NPHASES = 1 + DEPTH * NPH_LAYER + 1;
struct Params { const float* in[N_INPUTS]; float* out; unsigned char* ws; int ph_lo, ph_hi; };
static_assert(sizeof(Params) == N_INPUTS * 8 + 8 + 8 + 8, "Params has no padding");

__global__ void __launch_bounds__(NTHR, 2) mega(Params p) {
    extern __shared__ __attribute__((aligned(16))) unsigned char lds[];
    const int tid = threadIdx.x, wg = blockIdx.x, nwg = gridDim.x;
    for (int u = tid; u < (LDS_BYTES - MISC_OFF) / 4; u += NTHR) ((LAS unsigned*)(lds + MISC_OFF))[u] = 0u;
    __syncthreads();
    unsigned char* const ws0 = p.ws;
    const bool fused = (p.ph_hi - p.ph_lo) > 1;
    XcdBarrier bar; bar.bar = (unsigned*)(ws0 + WS_CTL) + CW_BAR; bar.x = 0; bar.st = nullptr;
    if (fused) bar = xcd_barrier_post((unsigned*)(ws0 + WS_CTL) + CW_BAR, (volatile LAS unsigned*)(lds + MISC_OFF));
    PG8_LAS unsigned char* ring = (PG8_LAS unsigned char*)lds;
#define WSP(type, off) ((type)(ws + (off)))
#define PH_LOCALS unsigned char* ws = ws0; asm volatile("" : "+s"(ws)); float* out = p.out; asm volatile("" : "+s"(out)); \
        unsigned char* wl = ws + WS_WTS + (size_t)l * WL_SIZE; (void)wl; (void)out;

    int gp = 0;
#define PH_ON (p.ph_lo <= gp && gp < p.ph_hi)
#define PH_END do { if (fused && gp + 1 < p.ph_hi) xcd_barrier(bar); ++gp; } while (0)

    if (PH_ON) {
#pragma unroll 1
        for (int l = 0; l < DEPTH; ++l) {
            PH_LOCALS
            { const PrepJob j{p.in[IN_WIN] + (size_t)l * D * 3208, nullptr, p.in[IN_NORM1G] + l * D, (bf16_t*)(wl + WL_IN), 3208, D, NZ, 1, 1, 0, 0, 0}; ph_prep_w(j, lds, wg, nwg); }
            { const PrepJob j{p.in[IN_WOUT] + (size_t)l * D * D, nullptr, nullptr, (bf16_t*)(wl + WL_OUT), D, D, D, 0, 1, 0, 0, 0}; ph_prep_w(j, lds, wg, nwg); }
            { const PrepJob j{p.in[IN_WGATE] + (size_t)l * NEXP * D * DEXP, p.in[IN_WUP] + (size_t)l * NEXP * D * DEXP, p.in[IN_NORM2G] + l * D, (bf16_t*)(wl + WL_GU), DEXP, D, 512, 2, NEXP, 0, (size_t)D * DEXP, (size_t)512 * D};
              ph_prep_w(j, lds, wg, nwg); }
            { const PrepJob j{p.in[IN_WDOWN] + (size_t)l * NEXP * DEXP * D, nullptr, nullptr, (bf16_t*)(wl + WL_DN), D, DEXP, D, 0, NEXP, 0, (size_t)DEXP * D, (size_t)D * DEXP}; ph_prep_w(j, lds, wg, nwg); }
            { const PrepJob j{p.in[IN_PLEGW] + (size_t)l * D * D, nullptr, p.in[IN_PLENG] + l * D, (bf16_t*)(wl + WL_PG), D, D, D, 0, 1, 0, 0, 0}; ph_prep_w(j, lds, wg, nwg); }
            { const PrepJob j{p.in[IN_PLEPW] + (size_t)l * PDIM * D, nullptr, nullptr, (bf16_t*)(wl + WL_PP), D, PDIM, D, 0, 1, 0, 0, 0}; ph_prep_w(j, lds, wg, nwg); }
            ph_prep_router(p.in[IN_RGW] + l * D * 4, p.in[IN_REW] + l * D * 32, p.in[IN_NORM2G] + l * D, WSP(float*, WS_WR) + (size_t)l * 36 * D, wg, nwg);
        }
        { const int l = 0; PH_LOCALS
          ph_prep_x(p.in[IN_X], WSP(bf16_t*, WS_HBA), WSP(float*, WS_SSP), wg, nwg);
          ph_cvt_bf16(p.in[IN_P], WSP(bf16_t*, WS_PB), (size_t)DEPTH * T * PDIM / 4, wg, nwg); }
    }
    PH_END;

#pragma clang loop unroll(full)
    for (int l = 0; l < DEPTH; ++l) {
        if (PH_ON) { PH_LOCALS
            pg8::Gemm g{WSP(const bf16_t*, WS_HBA), (const bf16_t*)(wl + WL_IN), T, NZ, D, 0}; pg8::StaticOrder S; S.init(T, NZ, nwg, wg); EpiZ E{WSP(bf16_t*, WS_Z), WSP(const float*, WS_SSP), WSP(float*, WS_GATES)};
            pg8::gemm_phase<EpiZ, pg8::StaticOrder, true, true>(ring, g, S, E); }
        PH_END;
        if (PH_ON) { PH_LOCALS
            ph_sb_naive(WSP(const bf16_t*, WS_Z), p.in[IN_SBOG] + l * 384, WSP(float*, WS_HBB), WSP(bf16_t*, WS_YMIX), wg, nwg);
            __syncthreads();
            ph_mlstm_naive(WSP(const bf16_t*, WS_Z), WSP(const float*, WS_GATES), p.in[IN_CONVW] + l * 4 * 768, p.in[IN_CONVB] + l * 768, p.in[IN_IGB] + l * 4, p.in[IN_FGB] + l * 4, p.in[IN_MNG] + l * 384, WSP(bf16_t*, WS_YMIX), lds, wg, nwg);
            __syncthreads();
            ph_sgu_naive(WSP(const bf16_t*, WS_Z), p.in[IN_SGULNG] + l * 256, p.in[IN_SGULNB] + l * 256, p.in[IN_SGUW] + (size_t)l * 4 * 128 * 128, p.in[IN_SGUB] + l * 4 * 128, p.in[IN_SGUOG] + l * 256, WSP(float*, WS_HBA), WSP(bf16_t*, WS_YMIX), lds, wg, nwg);
        }
        PH_END;
        if (PH_ON) { PH_LOCALS
            pg8::Gemm g{WSP(const bf16_t*, WS_YMIX), (const bf16_t*)(wl + WL_OUT), T, D, D, 0}; pg8::StaticOrder S; S.init(T, D, nwg, wg); EpiResid E{l == 0 ? p.in[IN_X] : out, out, WSP(bf16_t*, WS_HBB)};
            pg8::gemm_phase<EpiResid, pg8::StaticOrder, true, true>(ring, g, S, E); }
        PH_END;
        if (PH_ON) { PH_LOCALS
            ph_router(out, WSP(const float*, WS_WR) + (size_t)l * 36 * D, p.in[IN_RGB] + l * 4, p.in[IN_REB] + l * 32, WSP(int*, WS_TOKE), WSP(float*, WS_TOKW), WSP(float*, WS_RSTD2), WSP(int*, WS_RANK),
                      WSP(unsigned*, WS_CTL) + CW_COUNT + 32 * l, lds, wg, nwg); }
        PH_END;
        if (PH_ON) { PH_LOCALS
            ph_offsets(WSP(const unsigned*, WS_CTL) + CW_COUNT + 32 * l, WSP(int*, WS_PSTART), WSP(int*, WS_TILEE), WSP(int*, WS_CTL) + CW_NTILES + l, WSP(int*, WS_ROWTS), lds, wg); }
        PH_END;
        if (PH_ON) { PH_LOCALS
            ph_place(WSP(const int*, WS_TOKE), WSP(const float*, WS_TOKW), WSP(const int*, WS_RANK), WSP(const int*, WS_PSTART), WSP(int*, WS_ROWTS), WSP(float*, WS_ROWW), wg, nwg); }
        PH_END;
        if (PH_ON) { PH_LOCALS
            ph_gather(WSP(const bf16_t*, WS_HBB), WSP(const int*, WS_ROWTS), WSP(const int*, WS_CTL) + CW_NTILES + l, WSP(bf16_t*, WS_XS), wg, nwg); }
        PH_END;
        if (PH_ON) { PH_LOCALS
            pg8::Gemm g{WSP(const bf16_t*, WS_XS), (const bf16_t*)(wl + WL_GU), MAXROWS, 512, D, 0}; MoeOrder S{0, 2, 0, 0, WSP(const int*, WS_TILEE), (size_t)512 * D * 2}; S.bind(WSP(const int*, WS_CTL) + CW_NTILES + l, nwg, wg);
            EpiGU E{WSP(const float*, WS_RSTD2), WSP(const int*, WS_ROWTS), WSP(bf16_t*, WS_HID)};
            pg8::gemm_phase<EpiGU, MoeOrder, true, true>(ring, g, S, E); }
        PH_END;
        if (PH_ON) { PH_LOCALS
            pg8::Gemm g{WSP(const bf16_t*, WS_HID), (const bf16_t*)(wl + WL_DN), MAXROWS, D, DEXP, 0}; MoeOrder S{0, 4, 0, 0, WSP(const int*, WS_TILEE), (size_t)D * DEXP * 2}; S.bind(WSP(const int*, WS_CTL) + CW_NTILES + l, nwg, wg);
            EpiDown E{WSP(const int*, WS_ROWTS), WSP(const float*, WS_ROWW), WSP(bf16_t*, WS_Y)};
            pg8::gemm_phase<EpiDown, MoeOrder, true, true>(ring, g, S, E); }
        PH_END;
        if (PH_ON) { PH_LOCALS
            ph_combine(out, WSP(const bf16_t*, WS_Y), WSP(bf16_t*, WS_HBB), WSP(float*, WS_RSTD3), wg, nwg);
            __syncthreads();
            pg8::Gemm g{WSP(const bf16_t*, WS_PB) + (size_t)l * T * PDIM, (const bf16_t*)(wl + WL_PP), T, D, PDIM, 0}; pg8::StaticOrder S; S.init(T, D, nwg, wg); EpiPlain E{WSP(bf16_t*, WS_YMIX), D, 0};
            pg8::gemm_phase<EpiPlain, pg8::StaticOrder, true, true>(ring, g, S, E);
        }
        PH_END;
        if (PH_ON) { PH_LOCALS
            pg8::Gemm g{WSP(const bf16_t*, WS_HBB), (const bf16_t*)(wl + WL_PG), T, D, D, 0}; pg8::StaticOrder S; S.init(T, D, nwg, wg); EpiPLE E{WSP(const float*, WS_RSTD3), WSP(const bf16_t*, WS_YMIX), out, WSP(bf16_t*, WS_HBA), WSP(float*, WS_SSP)};
            pg8::gemm_phase<EpiPLE, pg8::StaticOrder, true, true>(ring, g, S, E); }
        PH_END;
    }
    if (PH_ON) { const int l = 0; PH_LOCALS
        ph_final(out, WSP(const float*, WS_SSP), p.in[IN_FINALG], wg, nwg); }
#undef PH_ON
#undef PH_END
}

#ifndef MK_SPLIT
#define MK_SPLIT 0
#endif
extern "C" void kernel_launch(void* const* d_in, const int* in_sizes, int n_in, void* d_out, int out_size, void* d_ws, size_t ws_size, hipStream_t stream) {
    static int grid = 0;
    if (grid == 0) {
        if (n_in != N_INPUTS || in_sizes[0] != T * D || out_size != T * D || ws_size < WS_END) { fprintf(stderr, "kernel_launch: unexpected shapes / workspace (%d inputs, ws %zu)\n", n_in, ws_size); grid = -1; return; }
        int dev = 0, cus = 0;
        if (hipGetDevice(&dev) != hipSuccess || hipDeviceGetAttribute(&cus, hipDeviceAttributeMultiprocessorCount, dev) != hipSuccess) { grid = -1; return; }
        if (hipFuncSetAttribute((const void*)mega, hipFuncAttributeMaxDynamicSharedMemorySize, LDS_BYTES) != hipSuccess) { grid = -1; return; }
        int per_cu = 0;
        if (hipOccupancyMaxActiveBlocksPerMultiprocessor(&per_cu, (const void*)mega, NTHR, LDS_BYTES) != hipSuccess || per_cu < 1) fprintf(stderr, "kernel_launch: occupancy query says %d\n", per_cu);
        (void)hipGetLastError();
        grid = cus;
    }
    if (grid < 0) return;
    (void)hipMemsetAsync((unsigned char*)d_ws + WS_CTL, 0, 1 * MiB, stream);
    Params p{};
    for (int i = 0; i < N_INPUTS; ++i) p.in[i] = (const float*)d_in[i];
    p.out = (float*)d_out; p.ws = (unsigned char*)d_ws;
#if MK_SPLIT
    for (int ph = 0; ph < NPHASES; ++ph) { p.ph_lo = ph; p.ph_hi = ph + 1; hipLaunchKernelGGL(mega, dim3(grid), dim3(NTHR), LDS_BYTES, stream, p); }
#else
    p.ph_lo = 0; p.ph_hi = NPHASES;
    hipLaunchKernelGGL(mega, dim3(grid), dim3(NTHR), LDS_BYTES, stream, p);
#endif
}
```

```cpp
#include <hip/hip_runtime.h>
#include <cstdio>
#include <cstdint>
namespace pg8 {
#define PG8_LAS __attribute__((address_space(3)))
typedef unsigned short bf16_t;
typedef short bf16x8 __attribute__((ext_vector_type(8)));
typedef float f32x4 __attribute__((ext_vector_type(4)));
typedef unsigned u32x4 __attribute__((ext_vector_type(4)));
constexpr int BM = 256, BK = 64, HALF = 128, HTB = HALF * BK * 2  , STAGE_BYTES = 8 * HTB, NXCD = 8, WGM = 8;

__host__ __device__ __forceinline__ int lds_byte(int r, int c) { const int st = (r >> 4) * 2 + (c >> 5), rr = r & 15, cc = c & 31, ob = rr * 64 + cc * 2; return st * 1024 + (ob ^ (((ob >> 9) & 1) << 5)); }
__host__ __device__ __forceinline__ void stage_rc(int b, int& R, int& C) { const int st = b / 1024, sb = b % 1024, swz = sb ^ (((sb >> 9) & 1) << 5); R = (st >> 1) * 16 + swz / 64; C = (st & 1) * 32 + (swz % 64) / 2; }
__host__ __device__ __forceinline__ int perm32(int rho) { const int n = rho >> 4, i = rho & 15; return 8 * (i >> 2) + 4 * n + (i & 3); }

struct Unit { int pm, pn; };
struct Gemm { const bf16_t* A; const bf16_t* Bt; int M, N, K, pad; };

struct StaticOrder {
    static constexpr bool GATHER = false;
    int nM, nN, nwg, G, c;
    __host__ __device__ void init(int M, int N, int G_, int c_) { nM = M / BM; nN = N / BM; nwg = nM * nN; G = G_; c = c_; }
    __host__ __device__ bool next(int i, Unit& u) const {
        const long L = (long)i * G + c; if (L >= nwg) return false;
        int wgid = (int)L; { const int q = nwg / NXCD, r = nwg % NXCD, xcd = wgid % NXCD, off = wgid / NXCD; wgid = (xcd < r ? xcd * (q + 1) : r * (q + 1) + (xcd - r) * q) + off; }
        const int nig = WGM * nN, gid = wgid / nig, fm = gid * WGM, gsz = (nM - fm) < WGM ? (nM - fm) : WGM;
        u.pm = fm + ((wgid % nig) % gsz); u.pn = (wgid % nig) / gsz; return true;
    }
    __device__ __forceinline__ size_t bbase(const Unit& u, size_t tstep) const { return (size_t)u.pn * tstep; }
    __device__ __forceinline__ int arow(const Unit&, int) const { return 0; }
    __device__ __forceinline__ void a_ready(const Unit&) const {}
    __device__ __forceinline__ void done(const Unit&) const {}
};

__device__ __forceinline__ unsigned cvt_pk_bf16(float lo, float hi) { unsigned r; asm volatile("v_cvt_pk_bf16_f32 %0, %1, %2" : "=v"(r) : "v"(lo), "v"(hi)); return r; }
typedef float f32x2 __attribute__((ext_vector_type(2)));
template <class Epi, class Sched, bool ALIGN_EPI = false, bool SP2 = false>
__device__ __forceinline__ void gemm_phase(PG8_LAS unsigned char* lds, const Gemm g, const Sched& S, const Epi& E) {
    int tid_ = threadIdx.x; asm volatile("" : "+v"(tid_));
    const int tid = tid_, wid = __builtin_amdgcn_readfirstlane(tid >> 6), lane = tid & 63, wr = wid >> 2, wc = wid & 3, fr = lane & 15, fq = lane >> 4;
    int K_ = g.K; asm volatile("" : "+s"(K_));
    const int K = K_, nt = K / BK;
    unsigned voffA[2], voffB[2]; int gR[2], gC[2]; unsigned va[2][2], vnx[2][2];
#pragma unroll
    for (int i = 0; i < 2; ++i) { int R, C; stage_rc(tid * 16 + i * 8192, R, C); const int Rb = Epi::PERM ? ((R & ~31) + perm32(R & 31)) : R;
        voffA[i] = (unsigned)(R * K + C) * 2u; voffB[i] = (unsigned)(Rb * K + C) * 2u; gR[i] = R; gC[i] = C; }
    const size_t kstep = (size_t)(BK * 2);
    const size_t hstep = (size_t)HALF * K * 2;
    const size_t tstep = 2 * hstep;
    const unsigned ldsw = (unsigned)wid * 1024u;
    const int aoff = lds_byte(wr * 64 + fr, fq * 8), boff = lds_byte(wc * 32 + fr, fq * 8);
#define PG8_SA(b, h) (((b) * 2 + (h)) * HTB)
#define PG8_SB(b, h) ((4 + (b) * 2 + (h)) * HTB)
#define PG8_STAGE(bufoff, gbase, voff) do { _Pragma("unroll") for (int _i = 0; _i < 2; ++_i) \
        __builtin_amdgcn_global_load_lds((const unsigned*)((const char*)(gbase) + (voff)[_i]), (PG8_LAS unsigned*)(lds + (bufoff) + ldsw + _i * 8192), 16, 0, 0); } while (0)
#define PG8_STAGE_A(bufoff, kptr, h, nx) do { if constexpr (Sched::GATHER) { const unsigned o_[2] = {(nx) ? vnx[h][0] : va[h][0], (nx) ? vnx[h][1] : va[h][1]}; PG8_STAGE(bufoff, kptr, o_); } \
        else { PG8_STAGE(bufoff, (kptr) + (h) * hstep, voffA); } } while (0)
#define PG8_GOFF(dst, u) do { _Pragma("unroll") for (int h_ = 0; h_ < 2; ++h_) _Pragma("unroll") for (int i_ = 0; i_ < 2; ++i_) dst[h_][i_] = (unsigned)S.arow(u, h_ * HALF + gR[i_]) * (unsigned)(K * 2) + (unsigned)(gC[i_] * 2); } while (0)
#define PG8_LDA(dst, b, h) do { _Pragma("unroll") for (int m = 0; m < 4; ++m) _Pragma("unroll") for (int k = 0; k < 2; ++k) dst[m][k] = *(const PG8_LAS bf16x8*)(lds + PG8_SA(b, h) + aoff + m * 2048 + k * 1024); } while (0)
#define PG8_LDB(dst, b, h) do { _Pragma("unroll") for (int n = 0; n < 2; ++n) _Pragma("unroll") for (int k = 0; k < 2; ++k) dst[n][k] = *(const PG8_LAS bf16x8*)(lds + PG8_SB(b, h) + boff + n * 2048 + k * 1024); } while (0)
#define PG8_MMA(ai, bj, At, Bt) do { __builtin_amdgcn_s_setprio(1); _Pragma("unroll") for (int m = 0; m < 4; ++m) _Pragma("unroll") for (int n = 0; n < 2; ++n) _Pragma("unroll") for (int k = 0; k < 2; ++k) \
        acc[ai][bj][m][n] = __builtin_amdgcn_mfma_f32_16x16x32_bf16(Bt[n][k], At[m][k], acc[ai][bj][m][n], 0, 0, 0); __builtin_amdgcn_s_setprio(0); } while (0)
#define PG8_WAIT_V(n) asm volatile("s_waitcnt vmcnt(" #n ")" ::: "memory")
#define PG8_WAIT_L(n) asm volatile("s_waitcnt lgkmcnt(" #n ")" ::: "memory")
#define PG8_BAR __builtin_amdgcn_s_barrier()
#define PG8_SCHED __builtin_amdgcn_sched_barrier(0)
    Unit cur, nxt; int ui = 0;
    if (!S.next(0, cur)) return;
    f32x4 acc[2][2][4][2];
#pragma unroll
    for (int a = 0; a < 2; ++a)
#pragma unroll
        for (int b = 0; b < 2; ++b)
#pragma unroll
            for (int m = 0; m < 4; ++m)
#pragma unroll
                for (int n = 0; n < 2; ++n) acc[a][b][m][n] = (f32x4){0.f, 0.f, 0.f, 0.f};
    bf16x8 At[4][2], B0[2][2], B1[2][2];
    static_assert(!Sched::GATHER || SP2, "the gathered A operand is wired into the SP2 loop only");
    const char* cA = (const char*)g.A + (Sched::GATHER ? (size_t)0 : (size_t)cur.pm * tstep); const char* cB = (const char*)g.Bt + S.bbase(cur, tstep);
    if constexpr (Sched::GATHER) { PG8_GOFF(va, cur); _Pragma("unroll") for (int h_ = 0; h_ < 2; ++h_) _Pragma("unroll") for (int i_ = 0; i_ < 2; ++i_) vnx[h_][i_] = va[h_][i_]; }
    S.a_ready(cur);
    if constexpr (SP2) {
        PG8_STAGE(PG8_SB(0, 0), cB, voffB); PG8_STAGE(PG8_SB(0, 1), cB + hstep, voffB); PG8_STAGE_A(PG8_SA(0, 0), cA, 0, false); PG8_STAGE_A(PG8_SA(0, 1), cA, 1, false);
        if (wr == 1) PG8_BAR;
        PG8_WAIT_V(2); PG8_BAR;
        PG8_STAGE(PG8_SB(1, 0), cB + kstep, voffB); PG8_STAGE_A(PG8_SA(1, 0), cA + kstep, 0, false); PG8_STAGE(PG8_SB(1, 1), cB + hstep + kstep, voffB);
        PG8_WAIT_V(6); PG8_BAR;
    } else {
        PG8_STAGE(PG8_SB(0, 0), cB, voffB); PG8_STAGE(PG8_SA(0, 0), cA, voffA); PG8_STAGE(PG8_SB(0, 1), cB + hstep, voffB); PG8_STAGE(PG8_SA(0, 1), cA + hstep, voffA);
        if (wr == 1) PG8_BAR;
        PG8_WAIT_V(4); PG8_BAR;
        PG8_STAGE(PG8_SB(1, 0), cB + kstep, voffB); PG8_STAGE(PG8_SA(1, 0), cA + kstep, voffA); PG8_STAGE(PG8_SB(1, 1), cB + hstep + kstep, voffB);
        PG8_WAIT_V(6); PG8_BAR;
    }
    for (;;) {
        const bool has_next = S.next(ui + 1, nxt);
        if constexpr (Sched::GATHER) { if (has_next) PG8_GOFF(vnx, nxt); }
        const char* nA = (has_next && !Sched::GATHER) ? (const char*)g.A + (size_t)nxt.pm * tstep : cA; const char* nB = has_next ? (const char*)g.Bt + S.bbase(nxt, tstep) : cB;
        for (int t = 0; t < nt; t += 2) {
            const bool last = (t == nt - 2); const bool lastnx = last && has_next; (void)lastnx;
            const char* a1 = cA + (size_t)(t + 1) * kstep;
            const char* a2 = last ? nA : cA + (size_t)(t + 2) * kstep; const char* b2 = last ? nB : cB + (size_t)(t + 2) * kstep;
            const char* a3 = a2 + kstep; const char* b3 = b2 + kstep;
            if (last && has_next) S.a_ready(nxt);
            if constexpr (SP2) {
            PG8_LDB(B0, 0, 0); PG8_LDB(B1, 0, 1); PG8_SCHED; PG8_LDA(At, 0, 0); PG8_STAGE_A(PG8_SA(1, 1), a1, 1, false);
            PG8_WAIT_V(8); PG8_WAIT_L(0); PG8_BAR; PG8_MMA(0, 0, At, B0); PG8_MMA(0, 1, At, B1); PG8_BAR; PG8_SCHED;
            PG8_LDA(At, 0, 1); PG8_STAGE(PG8_SB(0, 0), b2, voffB); PG8_STAGE(PG8_SB(0, 1), b2 + hstep, voffB); PG8_STAGE_A(PG8_SA(0, 0), a2, 0, lastnx);
            PG8_WAIT_V(8); PG8_WAIT_L(0); PG8_BAR; PG8_MMA(1, 0, At, B0); PG8_MMA(1, 1, At, B1); PG8_BAR; PG8_SCHED;
            PG8_LDB(B0, 1, 0); PG8_LDB(B1, 1, 1); PG8_SCHED; PG8_LDA(At, 1, 0); PG8_STAGE_A(PG8_SA(0, 1), a2, 1, lastnx);
            PG8_WAIT_V(8); PG8_WAIT_L(0); PG8_BAR; PG8_MMA(0, 0, At, B0); PG8_MMA(0, 1, At, B1); PG8_BAR; PG8_SCHED;
            PG8_LDA(At, 1, 1); PG8_STAGE(PG8_SB(1, 0), b3, voffB); PG8_STAGE(PG8_SB(1, 1), b3 + hstep, voffB); PG8_STAGE_A(PG8_SA(1, 0), a3, 0, lastnx);
            PG8_WAIT_V(8); PG8_WAIT_L(0); PG8_BAR; PG8_MMA(1, 0, At, B0); PG8_MMA(1, 1, At, B1); PG8_BAR; PG8_SCHED;
            } else {
            PG8_LDB(B0, 0, 0); PG8_SCHED; PG8_LDA(At, 0, 0); PG8_STAGE(PG8_SA(1, 1), a1 + hstep, voffA);
            PG8_WAIT_L(8); PG8_BAR; PG8_WAIT_L(0); PG8_MMA(0, 0, At, B0); PG8_BAR; PG8_SCHED;
            PG8_LDB(B1, 0, 1); PG8_STAGE(PG8_SB(0, 0), b2, voffB);
            PG8_BAR; PG8_WAIT_L(0); PG8_MMA(0, 1, At, B1); PG8_BAR;
            PG8_LDA(At, 0, 1); PG8_STAGE(PG8_SA(0, 0), a2, voffA);
            PG8_BAR; PG8_WAIT_L(0); PG8_MMA(1, 0, At, B0); PG8_BAR; PG8_SCHED;
            PG8_STAGE(PG8_SB(0, 1), b2 + hstep, voffB);
            PG8_WAIT_V(6); PG8_BAR; PG8_MMA(1, 1, At, B1); PG8_BAR;
            PG8_LDB(B0, 1, 0); PG8_SCHED; PG8_LDA(At, 1, 0); PG8_STAGE(PG8_SA(0, 1), a2 + hstep, voffA);
            PG8_WAIT_L(8); PG8_BAR; PG8_WAIT_L(0); PG8_MMA(0, 0, At, B0); PG8_BAR; PG8_SCHED;
            PG8_LDB(B1, 1, 1); PG8_STAGE(PG8_SB(1, 0), b3, voffB);
            PG8_BAR; PG8_WAIT_L(0); PG8_MMA(0, 1, At, B1); PG8_BAR;
            PG8_LDA(At, 1, 1); PG8_STAGE(PG8_SA(1, 0), a3, voffA);
            PG8_BAR; PG8_WAIT_L(0); PG8_MMA(1, 0, At, B0); PG8_BAR; PG8_SCHED;
            PG8_STAGE(PG8_SB(1, 1), b3 + hstep, voffB);
            PG8_WAIT_V(6); PG8_BAR; PG8_MMA(1, 1, At, B1); PG8_BAR;
            }
        }
        if constexpr (ALIGN_EPI) { if (wr == 0) PG8_BAR; }
        if constexpr (!Epi::AFTER_DRAIN) { E(acc, cur, wr, wc, fr, fq); S.done(cur); }
        if (!has_next) break;
#pragma unroll
        for (int a = 0; a < 2; ++a)
#pragma unroll
            for (int b = 0; b < 2; ++b)
#pragma unroll
                for (int m = 0; m < 4; ++m)
#pragma unroll
                    for (int n = 0; n < 2; ++n) acc[a][b][m][n] = (f32x4){0.f, 0.f, 0.f, 0.f};
        cur = nxt; cA = nA; cB = nB; ++ui;
        if constexpr (Sched::GATHER) { _Pragma("unroll") for (int h_ = 0; h_ < 2; ++h_) _Pragma("unroll") for (int i_ = 0; i_ < 2; ++i_) va[h_][i_] = vnx[h_][i_]; }
        if constexpr (ALIGN_EPI) { if (wr == 1) PG8_BAR; }
    }
    PG8_WAIT_V(0);
    if constexpr (!ALIGN_EPI) { if (wr == 0) PG8_BAR; }
    PG8_BAR;
    if constexpr (Epi::AFTER_DRAIN) { E.fused(acc, cur, wr, wc, fr, fq, lds, wid, lane); S.done(cur); }
#undef PG8_SA
#undef PG8_SB
#undef PG8_STAGE
#undef PG8_STAGE_A
#undef PG8_GOFF
#undef PG8_LDA
#undef PG8_LDB
#undef PG8_MMA
#undef PG8_WAIT_V
#undef PG8_WAIT_L
#undef PG8_BAR
#undef PG8_SCHED
}
}

#define DEVI __device__ __forceinline__
typedef unsigned short bf16_t;
typedef float f32x4 __attribute__((ext_vector_type(4)));
typedef unsigned u32x4 __attribute__((ext_vector_type(4)));
typedef unsigned u32x2 __attribute__((ext_vector_type(2)));

constexpr int T = 65536, D = 1024, SEQ = 2048, NB = 32, DEPTH = 2;
constexpr int NZ = 3328;
constexpr int ZQA = 0, ZKA = 384, ZVA = 768, ZIF = 1152, ZQB = 1280, ZKB = 1664, ZVB = 2048, ZOB = 2432, ZUC = 2816, ZVC = 3072;
constexpr int NEXP = 32, DEXP = 256, PDIM = 256;
constexpr int MAXROWS = 2 * T + NEXP * 256;
constexpr float EPS = 1e-6f;

constexpr size_t MiB = 1u << 20;
constexpr size_t WS_CTL = 0;
constexpr size_t WS_GATES = 1 * MiB;
constexpr size_t WS_SSP = 3 * MiB;
constexpr size_t WS_TOKE = 7 * MiB;
constexpr size_t WS_TOKW = 7 * MiB + 512 * 1024;
constexpr size_t WS_RSTD2 = 8 * MiB;
constexpr size_t WS_RSTD3 = 8 * MiB + 256 * 1024;
constexpr size_t WS_RANK = 8 * MiB + 512 * 1024;
constexpr size_t WS_ROWTS = 9 * MiB;
constexpr size_t WS_ROWW = 10 * MiB;
constexpr size_t WS_TILEE = 11 * MiB;
constexpr size_t WS_PSTART = 11 * MiB + 4096;
constexpr size_t WS_WR = 12 * MiB;
constexpr size_t WS_WSGU = 13 * MiB;
constexpr size_t WS_WTS = 16 * MiB;
constexpr size_t WL_IN = 0, WL_OUT = 6656 * 1024, WL_GU = WL_OUT + 2 * MiB, WL_DN = WL_GU + 32 * MiB, WL_PG = WL_DN + 16 * MiB, WL_PP = WL_PG + 2 * MiB, WL_SIZE = 59 * MiB;
constexpr size_t WS_PB = 134 * MiB;
constexpr size_t WS_HBA = 198 * MiB;
constexpr size_t WS_HBB = 326 * MiB;
constexpr size_t WS_YMIX = 454 * MiB;
constexpr size_t WS_Z = 582 * MiB;
constexpr size_t WS_XS = WS_Z, WS_Y = WS_Z, WS_HID = WS_Z + 272 * MiB;
constexpr size_t WS_END = 998 * MiB;
static_assert(WL_PP + 512 * 1024 <= WL_SIZE, "weights map");
static_assert((size_t)MAXROWS * 1024 * 2 <= 272 * MiB && (size_t)MAXROWS * 256 * 2 <= 68 * MiB, "overlay map");
constexpr int CW_COUNT = 0;
constexpr int CW_NTILES = 64;

DEVI float bf2f(unsigned short b) { return __uint_as_float((unsigned)b << 16); }
DEVI unsigned f2bf(float f) { unsigned u = __float_as_uint(f); return (u + 0x7fffu + ((u >> 16) & 1u)) >> 16; }
DEVI unsigned pk2(float lo, float hi) { return f2bf(lo) | (f2bf(hi) << 16); }
DEVI float wave_sum(float v) {
#pragma unroll
    for (int o = 1; o < 64; o <<= 1) v += __shfl_xor(v, o);
    return v;
}
DEVI float sigmoidf_(float x) { return 1.0f / (1.0f + __expf(-x)); }
DEVI float siluf_(float x) { return x * sigmoidf_(x); }
DEVI float gelu_tanh(float x) { const float u = 0.7978845608028654f * (x + 0.044715f * x * x * x); return 0.5f * x * (1.0f + tanhf(u)); }
DEVI float softplusf_(float x) { return fmaxf(x, 0.f) + log1pf(__expf(-fabsf(x))); }

using pg8::Unit;
struct EpiZ {
    static constexpr bool PERM = true, AFTER_DRAIN = false;
    bf16_t* Z; const float* ssp; float* gates;
    DEVI void operator()(const f32x4 (&acc)[2][2][4][2], const Unit& u, int wr, int wc, int fr, int fq) const {
        int row0 = u.pm * 256 + wr * 64 + fr, col0 = u.pn * 256 + wc * 32 + 8 * fq; asm volatile("" : "+v"(row0), "+v"(col0));
#pragma unroll
        for (int ai = 0; ai < 2; ++ai)
#pragma unroll
            for (int m = 0; m < 4; ++m) {
                const int row = row0 + ai * 128 + m * 16;
                const f32x4* sp = (const f32x4*)(ssp + (size_t)row * 16);
                const f32x4 s0 = sp[0], s1 = sp[1], s2 = sp[2], s3 = sp[3];
                const f32x4 st = (s0 + s1) + (s2 + s3);
                const float rs = rsqrtf(((st[0] + st[1]) + (st[2] + st[3])) * (1.0f / 1024.0f) + EPS);
                bf16_t* rowp = Z + (size_t)row * NZ + col0;
#pragma unroll
                for (int bj = 0; bj < 2; ++bj) {
                    const float sc = (u.pn == 0 || (u.pn == 1 && bj == 0)) ? rs * (0.125f * 1.4426950408889634f) : rs;
                    const f32x4 v0 = acc[ai][bj][m][0] * sc, v1 = acc[ai][bj][m][1] * sc;
                    u32x4 w; w.x = pk2(v0[0], v0[1]); w.y = pk2(v0[2], v0[3]); w.z = pk2(v1[0], v1[1]); w.w = pk2(v1[2], v1[3]);
                    *(u32x4*)(rowp + bj * 128) = w;
                    if (bj == 1 && u.pn == 4 && wc == 0 && fq == 0) { *(f32x4*)(gates + (size_t)row * 8) = v0; *(f32x4*)(gates + (size_t)row * 8 + 4) = v1; }
                }
            }
    }
};
DEVI void unpack8(const u32x4 w, float (&f)[8]) { f[0] = __uint_as_float(w.x << 16); f[1] = __uint_as_float(w.x & 0xffff0000u); f[2] = __uint_as_float(w.y << 16); f[3] = __uint_as_float(w.y & 0xffff0000u);
    f[4] = __uint_as_float(w.z << 16); f[5] = __uint_as_float(w.z & 0xffff0000u); f[6] = __uint_as_float(w.w << 16); f[7] = __uint_as_float(w.w & 0xffff0000u); }
struct EpiResid {
    static constexpr bool PERM = true, AFTER_DRAIN = false;
    const bf16_t* hin; bf16_t* hout;
    DEVI void operator()(const f32x4 (&acc)[2][2][4][2], const Unit& u, int wr, int wc, int fr, int fq) const {
        int row0 = u.pm * 256 + wr * 64 + fr, col0 = u.pn * 256 + wc * 32 + 8 * fq; asm volatile("" : "+v"(row0), "+v"(col0));
#pragma unroll
        for (int ai = 0; ai < 2; ++ai)
#pragma unroll
            for (int m = 0; m < 4; ++m) {
                const size_t off = (size_t)(row0 + ai * 128 + m * 16) * D + col0;
#pragma unroll
                for (int bj = 0; bj < 2; ++bj) {
                    float f[8]; unpack8(*(const u32x4*)(hin + off + bj * 128), f);
                    const f32x4 v0 = acc[ai][bj][m][0], v1 = acc[ai][bj][m][1];
                    u32x4 w; w.x = pk2(f[0] + v0[0], f[1] + v0[1]); w.y = pk2(f[2] + v0[2], f[3] + v0[3]); w.z = pk2(f[4] + v1[0], f[5] + v1[1]); w.w = pk2(f[6] + v1[2], f[7] + v1[3]);
                    *(u32x4*)(hout + off + bj * 128) = w;
                }
            }
    }
};
struct EpiPLE {
    static constexpr bool PERM = true, AFTER_DRAIN = false;
    const float* rstd3; const bf16_t* pp; const bf16_t* hin; bf16_t* hout; float* ssp;
    DEVI void operator()(const f32x4 (&acc)[2][2][4][2], const Unit& u, int wr, int wc, int fr, int fq) const {
        int row0 = u.pm * 256 + wr * 64 + fr, col0 = u.pn * 256 + wc * 32 + 8 * fq; asm volatile("" : "+v"(row0), "+v"(col0));
#pragma unroll
        for (int ai = 0; ai < 2; ++ai)
#pragma unroll
            for (int m = 0; m < 4; ++m) {
                const int row = row0 + ai * 128 + m * 16;
                const size_t off = (size_t)row * D + col0;
                const float rs = rstd3[row];
                float sacc = 0.f;
#pragma unroll
                for (int bj = 0; bj < 2; ++bj) {
                    float hv[8], pv[8]; unpack8(*(const u32x4*)(hin + off + bj * 128), hv); unpack8(*(const u32x4*)(pp + off + bj * 128), pv);
                    float o[8];
#pragma unroll
                    for (int i = 0; i < 8; ++i) { const float a = acc[ai][bj][m][i >> 2][i & 3] * rs; o[i] = hv[i] + __builtin_amdgcn_rcpf(1.0f + __expf(-a)) * pv[i]; sacc += o[i] * o[i]; }
                    u32x4 w; w.x = pk2(o[0], o[1]); w.y = pk2(o[2], o[3]); w.z = pk2(o[4], o[5]); w.w = pk2(o[6], o[7]);
                    *(u32x4*)(hout + off + bj * 128) = w;
                }
                sacc += __shfl_xor(sacc, 16); sacc += __shfl_xor(sacc, 32);
                if (fq == 0) ssp[(size_t)row * 16 + u.pn * 4 + wc] = sacc;
            }
    }
};
struct EpiGU {
    static constexpr bool PERM = true, AFTER_DRAIN = false;
    const float* rstd2; const int* row_ts; bf16_t* hid;
    DEVI void operator()(const f32x4 (&acc)[2][2][4][2], const Unit& u, int wr, int wc, int fr, int fq) const {
        int row0 = u.pm * 256 + wr * 64 + fr; asm volatile("" : "+v"(row0));
#pragma unroll
        for (int ai = 0; ai < 2; ++ai)
#pragma unroll
            for (int m = 0; m < 4; ++m) {
                const int row = row0 + ai * 128 + m * 16;
                const int ts = row_ts[row];
                const float rs = ts >= 0 ? rstd2[ts >> 1] : 0.f;
                float hv[8];
#pragma unroll
                for (int n = 0; n < 2; ++n)
#pragma unroll
                    for (int i = 0; i < 4; ++i) { const float g = acc[ai][0][m][n][i] * rs, uu = acc[ai][1][m][n][i] * rs; hv[n * 4 + i] = siluf_(g) * uu; }
                u32x4 w; w.x = pk2(hv[0], hv[1]); w.y = pk2(hv[2], hv[3]); w.z = pk2(hv[4], hv[5]); w.w = pk2(hv[6], hv[7]);
                *(u32x4*)(hid + (size_t)row * DEXP + u.pn * 128 + wc * 32 + 8 * fq) = w;
            }
    }
};
struct EpiDown {
    static constexpr bool PERM = true, AFTER_DRAIN = false;
    const int* row_ts; const float* row_w; bf16_t* Y;
    DEVI void operator()(const f32x4 (&acc)[2][2][4][2], const Unit& u, int wr, int wc, int fr, int fq) const {
        int row0 = u.pm * 256 + wr * 64 + fr, col0 = u.pn * 256 + wc * 32 + 8 * fq; asm volatile("" : "+v"(row0), "+v"(col0));
#pragma unroll
        for (int ai = 0; ai < 2; ++ai)
#pragma unroll
            for (int m = 0; m < 4; ++m) {
                const int row = row0 + ai * 128 + m * 16;
                const int ts = row_ts[row];
                if (ts >= 0) {
                    const float wt = row_w[row];
                    bf16_t* rowp = Y + ((size_t)(ts & 1) * T + (size_t)(ts >> 1)) * D + col0;
#pragma unroll
                    for (int bj = 0; bj < 2; ++bj) {
                        const f32x4 v0 = acc[ai][bj][m][0] * wt, v1 = acc[ai][bj][m][1] * wt;
                        u32x4 w; w.x = pk2(v0[0], v0[1]); w.y = pk2(v0[2], v0[3]); w.z = pk2(v1[0], v1[1]); w.w = pk2(v1[2], v1[3]);
                        *(u32x4*)(rowp + bj * 128) = w;
                    }
                }
            }
    }
};
struct EpiPlain {
    static constexpr bool PERM = true, AFTER_DRAIN = false;
    bf16_t* O; int ldc, pad;
    DEVI void operator()(const f32x4 (&acc)[2][2][4][2], const Unit& u, int wr, int wc, int fr, int fq) const {
        int row0 = u.pm * 256 + wr * 64 + fr, col0 = u.pn * 256 + wc * 32 + 8 * fq; asm volatile("" : "+v"(row0), "+v"(col0));
#pragma unroll
        for (int ai = 0; ai < 2; ++ai)
#pragma unroll
            for (int m = 0; m < 4; ++m) {
                bf16_t* rowp = O + (size_t)(row0 + ai * 128 + m * 16) * ldc + col0;
#pragma unroll
                for (int bj = 0; bj < 2; ++bj) {
                    const f32x4 v0 = acc[ai][bj][m][0], v1 = acc[ai][bj][m][1];
                    u32x4 w; w.x = pk2(v0[0], v0[1]); w.y = pk2(v0[2], v0[3]); w.z = pk2(v1[0], v1[1]); w.w = pk2(v1[2], v1[3]);
                    *(u32x4*)(rowp + bj * 128) = w;
                }
            }
    }
};
struct MoeOrder {
    static constexpr bool GATHER = false;
    int ntot, nN, G, c; const int* tile_e; size_t estride;
    DEVI void bind(const int* n_tiles_ptr, int G_, int c_) { ntot = __builtin_amdgcn_readfirstlane(*n_tiles_ptr) * nN; G = G_; c = c_; }
    DEVI bool next(int i, Unit& u) const { const long L = (long)i * G + c; if (L >= ntot) return false; u.pm = (int)(L / nN); u.pn = (int)(L % nN); return true; }
    DEVI size_t bbase(const Unit& u, size_t tstep) const { return (size_t)__builtin_amdgcn_readfirstlane(tile_e[u.pm]) * estride + (size_t)u.pn * tstep; }
    DEVI int arow(const Unit&, int) const { return 0; }
    DEVI void a_ready(const Unit&) const {}
    DEVI void done(const Unit&) const {}
};
struct MoeGatherOrder : MoeOrder {
    static constexpr bool GATHER = true;
    const int* row_ts;
    DEVI int arow(const Unit& u, int r) const { const int ts = row_ts[u.pm * 256 + r]; return ts >= 0 ? (ts >> 1) : 0; }
};


#ifndef REP_SB
#define REP_SB 1
#endif
#ifndef REP_ML
#define REP_ML 1
#endif
#ifndef REP_SGU
#define REP_SGU 1
#endif
#ifndef REP_Z
#define REP_Z 1
#endif
#ifndef REP_PRO
#define REP_PRO 1
#endif
#ifndef REP_GATHER
#define REP_GATHER 1
#endif
#ifndef REP_GU
#define REP_GU 1
#endif
#ifndef REP_DOWN
#define REP_DOWN 1
#endif
#ifndef REP_PP
#define REP_PP 1
#endif
#ifndef REP_WOUT0
#define REP_WOUT0 1
#endif
#ifndef REP_BAR
#define REP_BAR 1
#endif
#ifndef REP_PLACE
#define REP_PLACE 1
#endif
#ifndef REP_PLE
#define REP_PLE 1
#endif
#ifndef REP_RTR
#define REP_RTR 1
#endif
constexpr int NTHR = 512;
constexpr int RING_BYTES = 147456;
constexpr int MISC_OFF = RING_BYTES;
constexpr int LDS_BYTES = RING_BYTES + 4096;
constexpr int CW_BAR = 4096;

#define XB_TMO      128
#define XB_XCNT(j)  (256  + 64 * (j))
#define XB_XSUB(j)  (1280 + 64 * (j))
#define XB_XGEN(j)  (2304 + 64 * (j))
#define XB_TOP      3328
#define XB_TOPGEN   3392
#define XCD_BAR_WORDS 3456
#define XB_SPIN_CAP (1u << 18)
#define LAS __attribute__((address_space(3)))

__device__ __forceinline__ unsigned xb_ld(unsigned* p)              { return __hip_atomic_load(p, __ATOMIC_RELAXED, __HIP_MEMORY_SCOPE_AGENT); }
__device__ __forceinline__ unsigned xb_add(unsigned* p, unsigned v) { return __hip_atomic_fetch_add(p, v, __ATOMIC_RELAXED, __HIP_MEMORY_SCOPE_AGENT); }
__device__ __forceinline__ unsigned xb_xcc_id() { return (unsigned)__builtin_amdgcn_s_getreg((3 << 11) | 20) & 0xFu; }
#define XB_SPIN(cond, bar) do { unsigned _sp = 0; while (cond) { __builtin_amdgcn_s_sleep(1); \
    if ((++_sp & 255u) == 0u) { if (xb_ld(&(bar)[XB_TMO])) break; if (_sp > XB_SPIN_CAP) { atomicAdd(&(bar)[XB_TMO], 1u); break; } } } } while (0)

struct XcdBarrier {
    unsigned* bar; unsigned x;
    volatile LAS unsigned* st;
};

__device__ __forceinline__ XcdBarrier xcd_barrier_post(unsigned* bar, volatile LAS unsigned* st) {
    XcdBarrier b; b.bar = bar; b.x = xb_xcc_id(); b.st = st;
    if (threadIdx.x == 0) (void)xb_add(&bar[XB_XCNT(b.x)], 1u);
    return b;
}
__device__ __forceinline__ void xcd_barrier_complete(unsigned* bar, unsigned x, unsigned& nloc, unsigned& nx) {
    const unsigned G = gridDim.x * gridDim.y * gridDim.z;
    unsigned sum, cnt, mine, sp = 0u;
    for (;;) {
        sum = 0u; cnt = 0u; mine = 0u;
#pragma unroll
        for (unsigned j = 0; j < 16; ++j) { const unsigned c = xb_ld(&bar[XB_XCNT(j)]); sum += c; cnt += (c > 0u) ? 1u : 0u; mine = (j == x) ? c : mine; }
        if (sum == G) break;
        __builtin_amdgcn_s_sleep(1);
        if ((++sp & 255u) == 0u) { if (xb_ld(&bar[XB_TMO])) break; if (sp > XB_SPIN_CAP) { atomicAdd(&bar[XB_TMO], 1u); break; } }
    }
    nloc = mine > 0u ? mine : 1u; nx = cnt > 0u ? cnt : 1u;
}

__device__ __forceinline__ void xcd_barrier(const XcdBarrier& b) {
    asm volatile("s_waitcnt vmcnt(0)" ::: "memory");
    __syncthreads();
    if (threadIdx.x == 0) {
        unsigned* bar = b.bar;
        __builtin_amdgcn_s_waitcnt(0);
        unsigned nloc = b.st[0], nx = b.st[1];
        if (nloc == 0u) { xcd_barrier_complete(bar, b.x, nloc, nx); b.st[0] = nloc; b.st[1] = nx; }
        const unsigned old = xb_add(&bar[XB_XSUB(b.x)], 1u);
        const unsigned gen = old / nloc;
        if (old + 1u == (gen + 1u) * nloc) {
            __builtin_amdgcn_fence(__ATOMIC_RELEASE, "agent");
            asm volatile("s_waitcnt vmcnt(0)" ::: "memory");
            const unsigned og = xb_add(&bar[XB_TOP], 1u);
            const unsigned tg = og / nx;
            if (og + 1u == (tg + 1u) * nx) xb_add(&bar[XB_TOPGEN], 1u);
            else XB_SPIN(xb_ld(&bar[XB_TOPGEN]) == tg, bar);
            __builtin_amdgcn_fence(__ATOMIC_ACQUIRE, "agent");
            xb_add(&bar[XB_XGEN(b.x)], 1u);
            asm volatile("s_waitcnt vmcnt(0)" ::: "memory");
        } else {
            XB_SPIN(xb_ld(&bar[XB_XGEN(b.x)]) == gen, bar);
            __builtin_amdgcn_fence(__ATOMIC_ACQUIRE, "agent");
            asm volatile("s_waitcnt vmcnt(0)" ::: "memory");
        }
    }
    __syncthreads();
}


DEVI int otid() { int t = threadIdx.x; asm volatile("" : "+v"(t)); return t; }
struct PrepJob { const float* in; const float* in2; const float* gain; bf16_t* out; int ldin, K, Nout, mode, ne, pad; size_t in_es, out_es; };
DEVI void ph_prep_w(const PrepJob& j, unsigned char* sm, int wg, int nwg) {
    const int tid = otid(), sub = tid >> 8, t8 = tid & 255, tx = t8 & 31, ty = t8 >> 5;
    float* tile = (float*)sm + sub * (32 * 33);
    const int nb = j.Nout / 32, kb = j.K / 32, per = nb * kb, total = per * j.ne;
    for (int base = wg * 2; base < total; base += nwg * 2) {
        const int it = base + sub; const bool act = it < total;
        const int e = it / per, r = it % per, n0 = (r % nb) * 32, k0 = (r / nb) * 32;
        if (act) {
            const int n = n0 + tx; const float* src = j.in + (size_t)e * j.in_es; int col = n; bool valid = true;
            if (j.mode == 1) {
                if (n < 1152) col = n; else if (n < 1160) col = 2688 + (n - 1152); else if (n < 1280) valid = false; else if (n < 2816) col = 1152 + (n - 1280); else col = 2696 + (n - 2816);
            } else if (j.mode == 2) { const int pn = n >> 8, bj = (n >> 7) & 1; col = pn * 128 + (n & 127); if (bj) src = j.in2 + (size_t)e * j.in_es; }
#pragma unroll
            for (int i = 0; i < 4; ++i) { const int k = k0 + ty + 8 * i; tile[(ty + 8 * i) * 33 + tx] = valid ? src[(size_t)k * j.ldin + col] * (j.gain ? j.gain[k] : 1.0f) : 0.f; }
        }
        __syncthreads();
        if (act) {
            bf16_t* o = j.out + (size_t)e * j.out_es;
#pragma unroll
            for (int i = 0; i < 4; ++i) { const int nn = n0 + ty + 8 * i; o[(size_t)nn * j.K + k0 + tx] = (bf16_t)f2bf(tile[tx * 33 + ty + 8 * i]); }
        }
        __syncthreads();
    }
}
DEVI void ph_prep_router(const float* rgw, const float* rew, const float* g, bf16_t* WRh, bf16_t* WRl, int wg, int nwg) {
    for (int idx = wg * NTHR + otid(); idx < 48 * 1024; idx += nwg * NTHR) { const int n = idx / 1024, k = idx % 1024;
        const float w = n < 36 ? g[k] * (n < 4 ? rgw[k * 4 + n] : rew[k * 32 + (n - 4)]) : 0.f; const unsigned hb = f2bf(w); WRh[idx] = (bf16_t)hb; WRl[idx] = (bf16_t)f2bf(w - __uint_as_float(hb << 16)); }
}
DEVI void ph_prep_x(const float* x, bf16_t* hb, float* ssp, int wg, int nwg) {
    const int tid = otid(), lane = tid & 63, gw = wg * 8 + (tid >> 6), ngw = nwg * 8;
    for (int row = gw; row < T; row += ngw) {
        const f32x4* xr = (const f32x4*)(x + (size_t)row * D) + lane; float s = 0.f;
        u32x2* o = (u32x2*)(hb + (size_t)row * D) + lane;
#pragma unroll
        for (int jj = 0; jj < 4; ++jj) { const f32x4 v = xr[64 * jj]; s += (v[0] * v[0] + v[1] * v[1]) + (v[2] * v[2] + v[3] * v[3]); u32x2 w; w.x = pk2(v[0], v[1]); w.y = pk2(v[2], v[3]); o[64 * jj] = w; }
        s = wave_sum(s);
        if (lane < 16) ssp[(size_t)row * 16 + lane] = lane == 0 ? s : 0.f;
    }
}
DEVI void ph_cvt_bf16(const float* in, bf16_t* out, size_t n4, int wg, int nwg) {
    for (size_t i = (size_t)wg * NTHR + otid(); i < n4; i += (size_t)nwg * NTHR) {
        const f32x4 v = ((const f32x4*)in)[i]; u32x2 w; w.x = pk2(v[0], v[1]); w.y = pk2(v[2], v[3]); ((u32x2*)out)[i] = w; }
}

namespace sb {
typedef short bf16x8 __attribute__((ext_vector_type(8)));
typedef short s16x4 __attribute__((ext_vector_type(4)));
typedef float f32x16 __attribute__((ext_vector_type(16)));
constexpr float QSCALE = 0.125f * 1.4426950408889634f;
constexpr int WAVE_LDS = 12288;
DEVI int crow(int r, int hi) { return (r & 3) + 8 * (r >> 2) + 4 * hi; }
DEVI void glds16(const void* gsrc, unsigned lds_dst) { unsigned keep;
    asm volatile("s_mov_b32 %0, m0\n\ts_mov_b32 m0, %2\n\ts_nop 0\n\tglobal_load_lds_dwordx4 %1, off\n\ts_mov_b32 m0, %0" : "=&s"(keep) : "v"(gsrc), "s"(lds_dst) : "memory"); }
DEVI unsigned cvtpk(float lo, float hi) { unsigned r; asm("v_cvt_pk_bf16_f32 %0, %1, %2" : "=v"(r) : "v"(lo), "v"(hi)); return r; }
DEVI void pv(f32x16* o, int vb, bf16x8 pa0, bf16x8 pa1, bf16x8 pa2, bf16x8 pa3) {
#pragma unroll
    for (int d0 = 0; d0 < 2; ++d0) { s16x4 lo[4], hi[4];
#pragma unroll
        for (int ks = 0; ks < 4; ++ks) {
            asm volatile("ds_read_b64_tr_b16 %0,%1 offset:%c2" : "=&v"(lo[ks]) : "v"(vb), "i"(d0 * 4096 + ks * 1024) : "memory");
            asm volatile("ds_read_b64_tr_b16 %0,%1 offset:%c2" : "=&v"(hi[ks]) : "v"(vb), "i"(d0 * 4096 + ks * 1024 + 512) : "memory"); }
        asm volatile("s_waitcnt lgkmcnt(0)" ::: "memory"); __builtin_amdgcn_sched_barrier(0);
#define SB_PK(k) (bf16x8){lo[k][0], lo[k][1], lo[k][2], lo[k][3], hi[k][0], hi[k][1], hi[k][2], hi[k][3]}
        o[d0] = __builtin_amdgcn_mfma_f32_32x32x16_bf16(pa0, SB_PK(0), o[d0], 0, 0, 0);
        o[d0] = __builtin_amdgcn_mfma_f32_32x32x16_bf16(pa1, SB_PK(1), o[d0], 0, 0, 0);
        o[d0] = __builtin_amdgcn_mfma_f32_32x32x16_bf16(pa2, SB_PK(2), o[d0], 0, 0, 0);
        o[d0] = __builtin_amdgcn_mfma_f32_32x32x16_bf16(pa3, SB_PK(3), o[d0], 0, 0, 0);
#undef SB_PK
    }
}
}
DEVI void ph_sb(const bf16_t* Z, const float* og, bf16_t* Ymix, unsigned char* smb, int wg, int nwg) {
    using namespace sb;
    const int tid = otid(), lane = tid & 63, wave = __builtin_amdgcn_readfirstlane(tid >> 6), r32 = lane & 31, hi = lane >> 5;
    unsigned char* vt = smb + wave * WAVE_LDS; bf16_t* stg = (bf16_t*)(vt + 8192);
    const unsigned vt_lds = (unsigned)(uintptr_t)vt;
    const int vb = (int)vt_lds + ((lane >> 4) & 1) * 32 + (lane & 3) * 8 + (4 * hi + ((lane & 15) >> 2)) * 64;
    for (int wu = wg * 8 + wave; wu < T / 32; wu += nwg * 8) {
        const int row0 = wu * 32, bbase = (row0 / SEQ) * SEQ, t0 = row0 - bbase, tq = t0 + r32;
        float ssq[4] = {0.f, 0.f, 0.f, 0.f};
#pragma unroll 1
        for (int h = 0; h < 6; ++h) {
            bf16x8 qr[4]; { const bf16_t* qp = Z + (size_t)(row0 + r32) * NZ + ZQA + h * 64 + hi * 8;
#pragma unroll
                for (int d0 = 0; d0 < 4; ++d0) qr[d0] = *(const bf16x8*)(qp + d0 * 16); }
            f32x16 o[2]; o[0] = f32x16{}; o[1] = f32x16{};
            float carry = 1.f; bool diag = true;
#pragma unroll 1
            for (int jt = t0 >> 6; ; --jt) {
                const int kv0 = jt * 64;
                const bf16_t* kb = Z + (size_t)(bbase + kv0) * NZ + h * 64;
#pragma unroll
                for (int w8 = 0; w8 < 8; ++w8) glds16(kb + (size_t)(16 * (w8 & 3) + (lane >> 2)) * NZ + ZVA + (w8 >> 2) * 32 + (lane & 3) * 8, (unsigned)__builtin_amdgcn_readfirstlane(vt_lds + w8 * 1024));
                bf16x8 kf[8];
#pragma unroll
                for (int d0 = 0; d0 < 4; ++d0)
#pragma unroll
                    for (int hf = 0; hf < 2; ++hf) kf[2 * d0 + hf] = *(const bf16x8*)(kb + (size_t)(32 * hf + r32) * NZ + ZKA + d0 * 16 + hi * 8);
                f32x16 p0 = f32x16{}, p1 = f32x16{};
#pragma unroll
                for (int d0 = 0; d0 < 4; ++d0) { p0 = __builtin_amdgcn_mfma_f32_32x32x16_bf16(kf[2 * d0], qr[d0], p0, 0, 0, 0); p1 = __builtin_amdgcn_mfma_f32_32x32x16_bf16(kf[2 * d0 + 1], qr[d0], p1, 0, 0, 0); }
                if (diag) {
#pragma unroll
                    for (int r = 0; r < 16; ++r) { const int kv = kv0 + crow(r, hi); if (kv >= tq) p0[r] = -INFINITY; if (kv + 32 >= tq) p1[r] = -INFINITY; }
                }
                f32x16 R0, R1;
#pragma unroll
                for (int r = 0; r < 16; ++r) {
                    const float e0 = __builtin_amdgcn_exp2f(fminf(p0[r], 100.f)), e1 = __builtin_amdgcn_exp2f(fminf(p1[r], 100.f));
                    R0[r] = __builtin_amdgcn_rcpf(1.0f + e0); R1[r] = __builtin_amdgcn_rcpf(1.0f + e1); p0[r] = e0 * R0[r]; p1[r] = e1 * R1[r]; }
                float gp[8], oth[8], ps[8];
#pragma unroll
                for (int g = 0; g < 4; ++g) { gp[g] = (R0[4 * g] * R0[4 * g + 1]) * (R0[4 * g + 2] * R0[4 * g + 3]); gp[4 + g] = (R1[4 * g] * R1[4 * g + 1]) * (R1[4 * g + 2] * R1[4 * g + 3]); }
#pragma unroll
                for (int g = 0; g < 8; ++g) oth[g] = __shfl_xor(gp[g], 32);
                ps[7] = 1.f;
#pragma unroll
                for (int g = 6; g >= 0; --g) ps[g] = ps[g + 1] * (gp[g + 1] * oth[g + 1]);
                const float total = ps[0] * (gp[0] * oth[0]);
#pragma unroll
                for (int g = 0; g < 8; ++g) {
                    float t = carry * ps[g]; if (hi == 0) t *= oth[g];
                    if (g < 4) { p0[4 * g + 3] *= t; t *= R0[4 * g + 3]; p0[4 * g + 2] *= t; t *= R0[4 * g + 2]; p0[4 * g + 1] *= t; t *= R0[4 * g + 1]; p0[4 * g] *= t; }
                    else { const int q = 4 * (g - 4); p1[q + 3] *= t; t *= R1[q + 3]; p1[q + 2] *= t; t *= R1[q + 2]; p1[q + 1] *= t; t *= R1[q + 1]; p1[q] *= t; }
                }
                carry *= total;
                u32x4 pw0, pw1, pw2, pw3;
                pw0 = (u32x4){cvtpk(p0[0], p0[1]), cvtpk(p0[2], p0[3]), cvtpk(p0[4], p0[5]), cvtpk(p0[6], p0[7])};
                pw1 = (u32x4){cvtpk(p0[8], p0[9]), cvtpk(p0[10], p0[11]), cvtpk(p0[12], p0[13]), cvtpk(p0[14], p0[15])};
                pw2 = (u32x4){cvtpk(p1[0], p1[1]), cvtpk(p1[2], p1[3]), cvtpk(p1[4], p1[5]), cvtpk(p1[6], p1[7])};
                pw3 = (u32x4){cvtpk(p1[8], p1[9]), cvtpk(p1[10], p1[11]), cvtpk(p1[12], p1[13]), cvtpk(p1[14], p1[15])};
                asm volatile("s_waitcnt vmcnt(0)" ::: "memory");
                pv(o, vb, __builtin_bit_cast(bf16x8, pw0), __builtin_bit_cast(bf16x8, pw1), __builtin_bit_cast(bf16x8, pw2), __builtin_bit_cast(bf16x8, pw3));
                diag = false;
                if (jt == 0 || !__any(carry > 9.0949470177e-13f)) break;
            }
#pragma unroll
            for (int r = 0; r < 16; ++r) { const int orow = crow(r, hi); stg[orow * 64 + r32] = (bf16_t)f2bf(o[0][r]); stg[orow * 64 + 32 + r32] = (bf16_t)f2bf(o[1][r]); }
            asm volatile("s_waitcnt lgkmcnt(0)" ::: "memory");
#pragma unroll
            for (int i = 0; i < 4; ++i) { const int row = i * 8 + (lane >> 3), ch = lane & 7; const u32x4 v = *(const u32x4*)(stg + row * 64 + ch * 8);
                const float a0 = __uint_as_float(v.x << 16), a1 = __uint_as_float(v.x & 0xffff0000u), a2 = __uint_as_float(v.y << 16), a3 = __uint_as_float(v.y & 0xffff0000u);
                const float a4 = __uint_as_float(v.z << 16), a5 = __uint_as_float(v.z & 0xffff0000u), a6 = __uint_as_float(v.w << 16), a7 = __uint_as_float(v.w & 0xffff0000u);
                ssq[i] += ((a0 * a0 + a1 * a1) + (a2 * a2 + a3 * a3)) + ((a4 * a4 + a5 * a5) + (a6 * a6 + a7 * a7));
                *(u32x4*)(Ymix + (size_t)(row0 + row) * D + h * 64 + ch * 8) = v; }
            asm volatile("s_waitcnt lgkmcnt(0)" ::: "memory");
        }
        asm volatile("s_waitcnt vmcnt(0)" ::: "memory");
        float rs[4];
#pragma unroll
        for (int i = 0; i < 4; ++i) { float s = ssq[i]; s += __shfl_xor(s, 1); s += __shfl_xor(s, 2); s += __shfl_xor(s, 4); rs[i] = rsqrtf(s * (1.0f / 384.0f) + EPS); }
#pragma unroll 1
        for (int h = 0; h < 6; ++h) { const int ch = lane & 7; const f32x4 g0 = *(const f32x4*)(og + h * 64 + ch * 8), g1 = *(const f32x4*)(og + h * 64 + ch * 8 + 4);
#pragma unroll
            for (int i = 0; i < 4; ++i) { const int row = i * 8 + (lane >> 3); u32x4* pp = (u32x4*)(Ymix + (size_t)(row0 + row) * D + h * 64 + ch * 8); const u32x4 v = *pp; const float r = rs[i];
                u32x4 w; w.x = pk2(__uint_as_float(v.x << 16) * r * g0[0], __uint_as_float(v.x & 0xffff0000u) * r * g0[1]); w.y = pk2(__uint_as_float(v.y << 16) * r * g0[2], __uint_as_float(v.y & 0xffff0000u) * r * g0[3]);
                w.z = pk2(__uint_as_float(v.z << 16) * r * g1[0], __uint_as_float(v.z & 0xffff0000u) * r * g1[1]); w.w = pk2(__uint_as_float(v.w << 16) * r * g1[2], __uint_as_float(v.w & 0xffff0000u) * r * g1[3]);
                *pp = w; } }
    }
}

namespace ml {
constexpr int QROW = 208, TROW = 144;
constexpr int O_QN = 0, O_KN = 13312, O_KWT = 26624, O_VT = 40448, O_CT = 54272, CT_BYTES = 96 * QROW, O_NV = O_CT + 2 * CT_BYTES, O_TB = O_NV + 768, O_SC = O_TB + 2048,
              O_MNG = O_SC + 64, O_RAW = O_MNG + 384, NP_QK = 67 * 24, NP_ALL = NP_QK + 64 * 12, O_RAWV = O_RAW + NP_QK * 16, O_END = O_RAW + 40 * 1024;
static_assert(O_END <= 147456 && NP_ALL <= 40 * 64 && O_RAW % 16 == 0, "mLSTM LDS map");
typedef short bf16x8 __attribute__((ext_vector_type(8)));
}
DEVI void ph_mlstm(const bf16_t* Z, const float* gates, const float* conv_w, const float* conv_b, const float* igb, const float* fgb, const float* mng, bf16_t* Ymix,
                   unsigned char* smb, int wg, int nwg) {
    using namespace ml;
    const int tid = otid(), lane = tid & 63, wave = __builtin_amdgcn_readfirstlane(tid >> 6), l16 = lane & 15, quad = lane >> 4;
    float* NV = (float*)(smb + O_NV);
    const unsigned raw_lds = (unsigned)(uintptr_t)(smb + O_RAW);
    for (int unit = wg; unit < NB * 4; unit += nwg) {
        const int b = unit >> 2, h = unit & 3; const size_t rb = (size_t)b * SEQ;
#define ML_DMA(n1) do { const char* zb_ = (const char*)Z + ((long)rb + (long)(n1) * 64 - 3) * (NZ * 2); \
            _Pragma("unroll") for (int ins = 0; ins < 5; ++ins) if ((ins * 8 + wave) * 64 + lane < NP_ALL) sb::glds16(zb_ + doff[ins], (unsigned)__builtin_amdgcn_readfirstlane(raw_lds + (ins * 8 + wave) * 1024)); } while (0)
        unsigned doff[5];
#pragma unroll
        for (int ins = 0; ins < 5; ++ins) { const int pidx = (ins * 8 + wave) * 64 + lane;
            if (pidx < NP_QK) { const int r = pidx / 24, seg = pidx - 24 * r; doff[ins] = (unsigned)(r * NZ + (seg < 12 ? ZQB + h * 96 + 8 * seg : ZKB + h * 96 + 8 * (seg - 12))) * 2u; }
            else { const int j = pidx - NP_QK, l = j / 12, seg = j - 12 * l; doff[ins] = (unsigned)((l + 3) * NZ + ZVB + h * 96 + 8 * seg) * 2u; } }
#define ML_GATES(n1, ip, fp) do { float* TBn = (float*)(smb + O_TB) + ((n1) & 1) * 256; float* SCn = (float*)(smb + O_SC) + ((n1) & 1) * 4; \
            float c = -softplusf_(-(fp)); _Pragma("unroll") for (int o = 1; o < 64; o <<= 1) { const float t_ = __shfl_up(c, o); if (lane >= o) c += t_; } \
            const float btot = __shfl(c, 63), a_ = btot - c + (ip), g_ = (ip) - c; float mloc = a_; \
            _Pragma("unroll") for (int o = 32; o >= 1; o >>= 1) mloc = fmaxf(mloc, __shfl_xor(mloc, o)); \
            float pm = g_; _Pragma("unroll") for (int o = 1; o < 64; o <<= 1) { const float t_ = __shfl_up(pm, o); if (lane >= o) pm = fmaxf(pm, t_); } \
            const float mn = fmaxf(btot + mrun, mloc); \
            TBn[lane] = a_; TBn[64 + lane] = g_; TBn[128 + lane] = pm; TBn[192 + lane] = c; \
            if (lane == 0) { SCn[0] = mrun; SCn[1] = mn; SCn[2] = __expf(btot + mrun - mn); } mrun = mn; } while (0)
#define ML_CONVERT(n1) do { const float* TBn = (const float*)(smb + O_TB) + ((n1) & 1) * 256; const float mnew_ = ((const float*)(smb + O_SC))[((n1) & 1) * 4 + 1]; \
            if (tid < 384) { const unsigned char* rw = smb + O_RAW + cc * 2; const int l0 = 32 * rseg; const bool z0 = ((n1) == 0 && rseg == 0); \
                float x0 = z0 ? 0.f : bf2f(*(const bf16_t*)(rw + (l0 + 0) * 384)), x1 = z0 ? 0.f : bf2f(*(const bf16_t*)(rw + (l0 + 1) * 384)), x2 = z0 ? 0.f : bf2f(*(const bf16_t*)(rw + (l0 + 2) * 384)); \
                bf16_t* qk = (bf16_t*)(smb + (which ? O_KN : O_QN)); bf16_t* kwt = (bf16_t*)(smb + O_KWT); \
                _Pragma("unroll 4") for (int i = 0; i < 32; ++i) { const int l = l0 + i; const float x3 = bf2f(*(const bf16_t*)(rw + (l + 3) * 384)); \
                    const float y = cbias + cw0 * x0 + cw1 * x1 + cw2 * x2 + cw3 * x3; float o = y * __builtin_amdgcn_rcpf(1.0f + __expf(-y)); x0 = x1; x1 = x2; x2 = x3; \
                    if (which) { o *= 0.10206207261596575f; kwt[cd * (TROW / 2) + l] = (bf16_t)f2bf(o * __expf(TBn[l] - mnew_)); } \
                    qk[l * (QROW / 2) + cd] = (bf16_t)f2bf(o); } \
            } else { const int idx = tid - 384, l = idx >> 1, hf = idx & 1; const u32x4* src = (const u32x4*)(smb + O_RAWV + l * 192 + hf * 96); \
                bf16_t* vt = (bf16_t*)(smb + O_VT) + (hf * 48) * (TROW / 2) + l; \
                _Pragma("unroll") for (int i = 0; i < 6; ++i) { const u32x4 w = src[i]; \
                    vt[(i * 8 + 0) * (TROW / 2)] = (bf16_t)(w.x & 0xffffu); vt[(i * 8 + 1) * (TROW / 2)] = (bf16_t)(w.x >> 16); vt[(i * 8 + 2) * (TROW / 2)] = (bf16_t)(w.y & 0xffffu); vt[(i * 8 + 3) * (TROW / 2)] = (bf16_t)(w.y >> 16); \
                    vt[(i * 8 + 4) * (TROW / 2)] = (bf16_t)(w.z & 0xffffu); vt[(i * 8 + 5) * (TROW / 2)] = (bf16_t)(w.z >> 16); vt[(i * 8 + 6) * (TROW / 2)] = (bf16_t)(w.w & 0xffffu); vt[(i * 8 + 7) * (TROW / 2)] = (bf16_t)(w.w >> 16); } } } while (0)
        const int cc = tid < 384 ? tid % 192 : 0, rseg = tid < 384 ? tid / 192 : 0, which = cc >= 96 ? 1 : 0, cd = cc - 96 * which, cch = which * 384 + h * 96 + cd;
        const float cw0 = conv_w[cch], cw1 = conv_w[768 + cch], cw2 = conv_w[2 * 768 + cch], cw3 = conv_w[3 * 768 + cch], cbias = conv_b[cch];
        float mrun = 0.f;
        ML_DMA(0);
        for (int i = tid; i < CT_BYTES / 4; i += NTHR) ((unsigned*)(smb + O_CT))[i] = 0u;
        if (tid < 96) { NV[tid] = 0.f; ((float*)(smb + O_MNG))[tid] = mng[h * 96 + tid]; }
        if (wave == 7) { const size_t row = rb + lane; const float ip = gates[row * 8 + h] + igb[h], fp = gates[row * 8 + 4 + h] + fgb[h]; ML_GATES(0, ip, fp); }
        asm volatile("s_waitcnt vmcnt(0)" ::: "memory");
        __syncthreads();
        ML_CONVERT(0);
        __syncthreads();
        f32x4 Cst[9];
#pragma unroll
        for (int k = 0; k < 9; ++k) Cst[k] = (f32x4){0.f, 0.f, 0.f, 0.f};
#pragma unroll 1
        for (int n = 0; n < 32; ++n) {
            const int cur = n & 1, nxt = cur ^ 1; const float* SCc = (const float*)(smb + O_SC) + cur * 4; const float m_in = SCc[0], dec = SCc[2];
            const float* TBc = (const float*)(smb + O_TB) + cur * 256;
            const size_t r0 = rb + n * 64;
            if (n + 1 < 32) ML_DMA(n + 1);
            if (wave < 4) {
                const int tt = wave, t = 16 * tt + l16; const size_t row = r0 + t;
                u32x2 obv[6];
#pragma unroll
                for (int et = 0; et < 6; ++et) obv[et] = *(const u32x2*)(Z + row * NZ + ZOB + h * 96 + 16 * et + 4 * quad);
                const unsigned char* qn = smb + O_QN; const unsigned char* kn = smb + O_KN; const unsigned char* vtb = smb + O_VT; const unsigned char* ct = smb + O_CT + cur * CT_BYTES;
                bf16x8 bq[3];
#pragma unroll
                for (int ks = 0; ks < 3; ++ks) bq[ks] = *(const bf16x8*)(qn + t * QROW + (32 * ks + 8 * quad) * 2);
                const float Mt = fmaxf(m_in, TBc[128 + t]), inter = __expf(m_in - Mt), flr = __expf(-(TBc[192 + t] + Mt));
                f32x4 P[4]; float psum = 0.f;
#pragma unroll
                for (int st = 0; st < 4; ++st) { P[st] = (f32x4){0.f, 0.f, 0.f, 0.f};
                    if (st <= tt) {
#pragma unroll
                        for (int ks = 0; ks < 3; ++ks) P[st] = __builtin_amdgcn_mfma_f32_16x16x32_bf16(*(const bf16x8*)(kn + (16 * st + l16) * QROW + (32 * ks + 8 * quad) * 2), bq[ks], P[st], 0, 0, 0);
                        const f32x4 gs = *(const f32x4*)(TBc + 64 + 16 * st + 4 * quad);
#pragma unroll
                        for (int j = 0; j < 4; ++j) { const int s_ = 16 * st + 4 * quad + j; const float w = s_ <= t ? __expf(gs[j] - Mt) : 0.f; P[st][j] *= w; psum += P[st][j]; }
                    } }
                psum += __shfl_xor(psum, 16); psum += __shfl_xor(psum, 32);
                float qn_ = 0.f; { const float* nv = NV + cur * 96 + quad * 24; const unsigned char* qp = qn + t * QROW + quad * 48;
#pragma unroll
                    for (int i = 0; i < 3; ++i) { const u32x4 w = *(const u32x4*)(qp + i * 16);
                        qn_ += __uint_as_float(w.x << 16) * nv[i * 8 + 0] + __uint_as_float(w.x & 0xffff0000u) * nv[i * 8 + 1] + __uint_as_float(w.y << 16) * nv[i * 8 + 2] + __uint_as_float(w.y & 0xffff0000u) * nv[i * 8 + 3]
                             + __uint_as_float(w.z << 16) * nv[i * 8 + 4] + __uint_as_float(w.z & 0xffff0000u) * nv[i * 8 + 5] + __uint_as_float(w.w << 16) * nv[i * 8 + 6] + __uint_as_float(w.w & 0xffff0000u) * nv[i * 8 + 7]; } }
                qn_ += __shfl_xor(qn_, 16); qn_ += __shfl_xor(qn_, 32);
                float den = psum + inter * qn_; den = fmaxf(fabsf(den), flr); const float rden = 1.0f / den;
                bf16x8 pk[2];
#pragma unroll
                for (int i = 0; i < 2; ++i) { u32x4 w; w.x = pk2(P[2 * i][0], P[2 * i][1]); w.y = pk2(P[2 * i][2], P[2 * i][3]); w.z = pk2(P[2 * i + 1][0], P[2 * i + 1][1]); w.w = pk2(P[2 * i + 1][2], P[2 * i + 1][3]); pk[i] = __builtin_bit_cast(bf16x8, w); }
                float hv[6][4]; float ss = 0.f;
#pragma unroll
                for (int et = 0; et < 6; ++et) {
                    f32x4 n1 = (f32x4){0.f, 0.f, 0.f, 0.f}, n2 = (f32x4){0.f, 0.f, 0.f, 0.f};
#pragma unroll
                    for (int i = 0; i < 2; ++i) if (2 * i <= tt) { const unsigned char* vp = vtb + (16 * et + l16) * TROW + (32 * i + 4 * quad) * 2;
                        const u32x2 lo = *(const u32x2*)vp, hi2 = *(const u32x2*)(vp + 32); const u32x4 a = {lo.x, lo.y, hi2.x, hi2.y};
                        n1 = __builtin_amdgcn_mfma_f32_16x16x32_bf16(__builtin_bit_cast(bf16x8, a), pk[i], n1, 0, 0, 0); }
#pragma unroll
                    for (int ks = 0; ks < 3; ++ks) n2 = __builtin_amdgcn_mfma_f32_16x16x32_bf16(*(const bf16x8*)(ct + (16 * et + l16) * QROW + (32 * ks + 8 * quad) * 2), bq[ks], n2, 0, 0, 0);
#pragma unroll
                    for (int j = 0; j < 4; ++j) { const float v = (n1[j] + inter * n2[j]) * rden; hv[et][j] = v; ss += v * v; }
                    __builtin_amdgcn_sched_barrier(0);
                }
                ss += __shfl_xor(ss, 16); ss += __shfl_xor(ss, 32);
                const float rs = rsqrtf(ss * (1.0f / 96.0f) + EPS);
#pragma unroll
                for (int et = 0; et < 6; ++et) { const int e = 16 * et + 4 * quad; const u32x2 ob = obv[et]; const f32x4 mg = *(const f32x4*)((const float*)(smb + O_MNG) + e);
                    u32x2 w; w.x = pk2(hv[et][0] * rs * mg[0] * sigmoidf_(__uint_as_float(ob.x << 16)), hv[et][1] * rs * mg[1] * sigmoidf_(__uint_as_float(ob.x & 0xffff0000u)));
                    w.y = pk2(hv[et][2] * rs * mg[2] * sigmoidf_(__uint_as_float(ob.y << 16)), hv[et][3] * rs * mg[3] * sigmoidf_(__uint_as_float(ob.y & 0xffff0000u)));
                    *(u32x2*)(Ymix + row * D + 384 + h * 96 + e) = w; }
            } else {
                const int wq = wave - 4; const unsigned char* kwt = smb + O_KWT; const unsigned char* vtb = smb + O_VT; unsigned char* ctn = smb + O_CT + nxt * CT_BYTES;
                float gip = 0.f, gfp = 0.f;
                if (wq == 3 && n + 1 < 32) { const size_t row = r0 + 64 + lane; gip = gates[row * 8 + h] + igb[h]; gfp = gates[row * 8 + 4 + h] + fgb[h]; }
#pragma unroll
                for (int k = 0; k < 9; ++k) { const int idx = wq + 4 * k, dt = idx / 6, et = idx - 6 * dt; f32x4 U = (f32x4){0.f, 0.f, 0.f, 0.f};
#pragma unroll
                    for (int ks = 0; ks < 2; ++ks) U = __builtin_amdgcn_mfma_f32_16x16x32_bf16(*(const bf16x8*)(kwt + (16 * dt + l16) * TROW + (32 * ks + 8 * quad) * 2), *(const bf16x8*)(vtb + (16 * et + l16) * TROW + (32 * ks + 8 * quad) * 2), U, 0, 0, 0);
                    Cst[k] = Cst[k] * dec + U;
                    u32x2 w; w.x = pk2(Cst[k][0], Cst[k][1]); w.y = pk2(Cst[k][2], Cst[k][3]);
                    *(u32x2*)(ctn + (16 * et + l16) * QROW + (16 * dt + 4 * quad) * 2) = w; __builtin_amdgcn_sched_barrier(0); }
                if (wq == 0 || (wq == 1 && lane < 32)) { const int d = wq * 64 + lane; const u32x4* kp = (const u32x4*)(kwt + d * TROW); float sacc = 0.f;
#pragma unroll
                    for (int i = 0; i < 8; ++i) { const u32x4 w = kp[i];
                        sacc += (__uint_as_float(w.x << 16) + __uint_as_float(w.x & 0xffff0000u)) + (__uint_as_float(w.y << 16) + __uint_as_float(w.y & 0xffff0000u))
                              + (__uint_as_float(w.z << 16) + __uint_as_float(w.z & 0xffff0000u)) + (__uint_as_float(w.w << 16) + __uint_as_float(w.w & 0xffff0000u)); }
                    NV[nxt * 96 + d] = dec * NV[cur * 96 + d] + sacc; }
                if (wq == 3 && n + 1 < 32) ML_GATES(n + 1, gip, gfp);
            }
            asm volatile("s_waitcnt vmcnt(0)" ::: "memory");
            __syncthreads();
            if (n + 1 < 32) ML_CONVERT(n + 1);
            __syncthreads();
        }
#undef ML_DMA
#undef ML_GATES
#undef ML_CONVERT
    }
}

namespace sgu {
constexpr int VROW = 272, VGRP = 64 * VROW + 32, MROW = 528, MST_OFF = 71680;
static_assert(4 * VGRP <= MST_OFF && MST_OFF + 128 * MROW <= 147456, "SGU LDS map");
DEVI float gelu_fast(float x) { const float u = 1.5957691216057308f * (x + 0.044715f * x * x * x); return x * __builtin_amdgcn_rcpf(1.0f + __expf(-u)); }
}
DEVI void ph_sgu(const bf16_t* Z, const float* ln_g, const float* ln_b, const bf16_t* Wm, const float* bs, const float* og, bf16_t* Ymix, unsigned char* smb, int wg, int nwg) {
    using namespace sgu; typedef short bf16x8 __attribute__((ext_vector_type(8))); typedef float f32x16 __attribute__((ext_vector_type(16)));
    const int tid = otid(), lane = tid & 63, wave = __builtin_amdgcn_readfirstlane(tid >> 6), r32 = lane & 31, hi = lane >> 5;
    for (int blk = wg; blk < T / 128; blk += nwg) {
        const size_t row0 = (size_t)blk * 128;
        {
            const int tp = tid >> 3, g = (tid >> 1) & 3, hf = tid & 1, c0 = g * 64 + hf * 32;
            float v[2][32];
#pragma unroll
            for (int k = 0; k < 2; ++k) { const u32x4* src = (const u32x4*)(Z + (row0 + 2 * tp + k) * NZ + ZVC + c0);
#pragma unroll
                for (int i = 0; i < 4; ++i) { const u32x4 w = src[i];
                    v[k][i * 8 + 0] = gelu_fast(__uint_as_float(w.x << 16)); v[k][i * 8 + 1] = gelu_fast(__uint_as_float(w.x & 0xffff0000u)); v[k][i * 8 + 2] = gelu_fast(__uint_as_float(w.y << 16)); v[k][i * 8 + 3] = gelu_fast(__uint_as_float(w.y & 0xffff0000u));
                    v[k][i * 8 + 4] = gelu_fast(__uint_as_float(w.z << 16)); v[k][i * 8 + 5] = gelu_fast(__uint_as_float(w.z & 0xffff0000u)); v[k][i * 8 + 6] = gelu_fast(__uint_as_float(w.w << 16)); v[k][i * 8 + 7] = gelu_fast(__uint_as_float(w.w & 0xffff0000u)); } }
            float mu[2], rstd[2];
#pragma unroll
            for (int k = 0; k < 2; ++k) { float s1 = 0.f;
#pragma unroll
                for (int c = 0; c < 32; ++c) s1 += v[k][c];
                s1 += __shfl_xor(s1, 1); mu[k] = s1 * (1.0f / 64.0f); float s2 = 0.f;
#pragma unroll
                for (int c = 0; c < 32; ++c) { const float dd = v[k][c] - mu[k]; s2 += dd * dd; }
                s2 += __shfl_xor(s2, 1); rstd[k] = rsqrtf(s2 * (1.0f / 64.0f) + EPS); }
            unsigned char* dst = smb + g * VGRP + (hf * 32) * VROW + tp * 4;
#pragma unroll
            for (int c = 0; c < 32; ++c) { const float gg = ln_g[c0 + c], bb = ln_b[c0 + c];
                *(unsigned*)(dst + c * VROW) = pk2((v[0][c] - mu[0]) * rstd[0] * gg + bb, (v[1][c] - mu[1]) * rstd[1] * gg + bb); }
        }
        __syncthreads();
        {
            const int g = wave >> 1, mh = wave & 1, nks = mh ? 8 : 4;
            f32x16 acc[2][2];
#pragma unroll
            for (int i = 0; i < 2; ++i)
#pragma unroll
                for (int j = 0; j < 2; ++j) acc[i][j] = f32x16{};
            const bf16_t* wa = Wm + ((size_t)g * 128 + 64 * mh + r32) * 128 + 8 * hi;
            const unsigned char* vb = smb + g * VGRP + r32 * VROW + 16 * hi;
#pragma unroll 2
            for (int ks = 0; ks < nks; ++ks) {
                const bf16x8 a0 = *(const bf16x8*)(wa + ks * 16), a1 = *(const bf16x8*)(wa + 32 * 128 + ks * 16);
                const bf16x8 b0 = *(const bf16x8*)(vb + ks * 32), b1 = *(const bf16x8*)(vb + 32 * VROW + ks * 32);
                acc[0][0] = __builtin_amdgcn_mfma_f32_32x32x16_bf16(a0, b0, acc[0][0], 0, 0, 0); acc[0][1] = __builtin_amdgcn_mfma_f32_32x32x16_bf16(a0, b1, acc[0][1], 0, 0, 0);
                acc[1][0] = __builtin_amdgcn_mfma_f32_32x32x16_bf16(a1, b0, acc[1][0], 0, 0, 0); acc[1][1] = __builtin_amdgcn_mfma_f32_32x32x16_bf16(a1, b1, acc[1][1], 0, 0, 0);
            }
            bf16_t* mst = (bf16_t*)(smb + MST_OFF);
#pragma unroll
            for (int mt = 0; mt < 2; ++mt)
#pragma unroll
                for (int r = 0; r < 16; ++r) { const int t = 64 * mh + 32 * mt + (r & 3) + 8 * (r >> 2) + 4 * hi; const float bias = bs[g * 128 + t];
                    bf16_t* mp = mst + t * (MROW / 2) + g * 64 + r32;
                    mp[0] = (bf16_t)f2bf(acc[mt][0][r] + bias); mp[32] = (bf16_t)f2bf(acc[mt][1][r] + bias); }
        }
        __syncthreads();
        {
            const int t = tid >> 2, g = tid & 3; const size_t row = row0 + t;
            const u32x4* up = (const u32x4*)(Z + row * NZ + ZUC + g * 64); const u32x4* mp = (const u32x4*)(smb + MST_OFF + t * MROW + g * 128);
            float y[64]; float ss = 0.f;
#pragma unroll
            for (int i = 0; i < 8; ++i) { const u32x4 u = up[i], m = mp[i];
                y[i * 8 + 0] = gelu_fast(__uint_as_float(u.x << 16)) * __uint_as_float(m.x << 16); y[i * 8 + 1] = gelu_fast(__uint_as_float(u.x & 0xffff0000u)) * __uint_as_float(m.x & 0xffff0000u);
                y[i * 8 + 2] = gelu_fast(__uint_as_float(u.y << 16)) * __uint_as_float(m.y << 16); y[i * 8 + 3] = gelu_fast(__uint_as_float(u.y & 0xffff0000u)) * __uint_as_float(m.y & 0xffff0000u);
                y[i * 8 + 4] = gelu_fast(__uint_as_float(u.z << 16)) * __uint_as_float(m.z << 16); y[i * 8 + 5] = gelu_fast(__uint_as_float(u.z & 0xffff0000u)) * __uint_as_float(m.z & 0xffff0000u);
                y[i * 8 + 6] = gelu_fast(__uint_as_float(u.w << 16)) * __uint_as_float(m.w << 16); y[i * 8 + 7] = gelu_fast(__uint_as_float(u.w & 0xffff0000u)) * __uint_as_float(m.w & 0xffff0000u); }
#pragma unroll
            for (int c = 0; c < 64; ++c) ss += y[c] * y[c];
            ss += __shfl_xor(ss, 1); ss += __shfl_xor(ss, 2);
            const float rs = rsqrtf(ss * (1.0f / 256.0f) + EPS);
            u32x4* yp = (u32x4*)(Ymix + row * D + 768 + g * 64); const f32x4* gp = (const f32x4*)(og + g * 64);
#pragma unroll
            for (int i = 0; i < 8; ++i) { const f32x4 g0 = gp[2 * i], g1 = gp[2 * i + 1];
                u32x4 w; w.x = pk2(y[i * 8 + 0] * rs * g0[0], y[i * 8 + 1] * rs * g0[1]); w.y = pk2(y[i * 8 + 2] * rs * g0[2], y[i * 8 + 3] * rs * g0[3]);
                w.z = pk2(y[i * 8 + 4] * rs * g1[0], y[i * 8 + 5] * rs * g1[1]); w.w = pk2(y[i * 8 + 6] * rs * g1[2], y[i * 8 + 7] * rs * g1[3]); yp[i] = w; }
        }
        __syncthreads();
    }
}
DEVI void ph_prep_sgu(const float* w, bf16_t* Wm, int wg, int nwg) {
    for (int idx = wg * NTHR + otid(); idx < 4 * 128 * 128; idx += nwg * NTHR) { const int t = (idx >> 7) & 127, s = idx & 127; Wm[idx] = (bf16_t)f2bf(((s >> 6) <= (t >> 6)) ? w[idx] : 0.f); }
}

DEVI void ph_router(const bf16_t* h, const bf16_t* WRh, const bf16_t* WRl, const float* rgb, const float* reb, int* tokE, float* tokW, float* rstd2, int* rank, unsigned* count, unsigned char* smb, int wg, int nwg) {
    typedef short bf16x8 __attribute__((ext_vector_type(8)));
    int* hist = (int*)smb; int* wgb = hist + 32; int* selE = wgb + 32; int* selR = selE + 512; float* lgs_all = (float*)(selR + 512);
    const int tid = otid(), lane = tid & 63, wave = __builtin_amdgcn_readfirstlane(tid >> 6), l16 = lane & 15, quad = lane >> 4;
    float* lgs = lgs_all + wave * (32 * 49 + 32);
    for (int blk = wg; blk < T / 256; blk += nwg) {
        const int tok0 = blk * 256, R0 = tok0 + wave * 32;
        if (tid < 32) hist[tid] = 0;
        f32x4 acc[2][3];
#pragma unroll
        for (int rt = 0; rt < 2; ++rt)
#pragma unroll
            for (int nt = 0; nt < 3; ++nt) acc[rt][nt] = (f32x4){0.f, 0.f, 0.f, 0.f};
        float ss[2] = {0.f, 0.f};
        const bf16_t* hp = h + (size_t)(R0 + l16) * D + 8 * quad; const bf16_t* wh = WRh + (size_t)l16 * D + 8 * quad; const bf16_t* wl = WRl + (size_t)l16 * D + 8 * quad;
#pragma unroll 4
        for (int ks = 0; ks < 32; ++ks) {
            bf16x8 av[2];
#pragma unroll
            for (int rt = 0; rt < 2; ++rt) { const u32x4 w = *(const u32x4*)(hp + (size_t)rt * 16 * D + ks * 32); av[rt] = __builtin_bit_cast(bf16x8, w); float f[8]; unpack8(w, f);
                ss[rt] += ((f[0] * f[0] + f[1] * f[1]) + (f[2] * f[2] + f[3] * f[3])) + ((f[4] * f[4] + f[5] * f[5]) + (f[6] * f[6] + f[7] * f[7])); }
#pragma unroll
            for (int nt = 0; nt < 3; ++nt) { const bf16x8 bh = *(const bf16x8*)(wh + (size_t)nt * 16 * D + ks * 32), bl = *(const bf16x8*)(wl + (size_t)nt * 16 * D + ks * 32);
#pragma unroll
                for (int rt = 0; rt < 2; ++rt) { acc[rt][nt] = __builtin_amdgcn_mfma_f32_16x16x32_bf16(bh, av[rt], acc[rt][nt], 0, 0, 0); acc[rt][nt] = __builtin_amdgcn_mfma_f32_16x16x32_bf16(bl, av[rt], acc[rt][nt], 0, 0, 0); } }
        }
#pragma unroll
        for (int rt = 0; rt < 2; ++rt) { float s = ss[rt]; s += __shfl_xor(s, 16); s += __shfl_xor(s, 32); if (quad == 0) lgs[32 * 49 + 16 * rt + l16] = s;
#pragma unroll
            for (int nt = 0; nt < 3; ++nt)
#pragma unroll
                for (int j = 0; j < 4; ++j) lgs[(16 * rt + l16) * 49 + 16 * nt + 4 * quad + j] = acc[rt][nt][j]; }
        __syncthreads();
        if (lane < 32) {
            const int li = wave * 32 + lane, t = tok0 + li; const float* lg = lgs + lane * 49;
            const float rs = rsqrtf(lgs[32 * 49 + lane] * (1.0f / 1024.0f) + EPS);
            float gl[4]; int gtop = 0; float gmax;
#pragma unroll
            for (int n = 0; n < 4; ++n) gl[n] = lg[n] * rs + rgb[n];
            gmax = gl[0];
#pragma unroll
            for (int n = 1; n < 4; ++n) if (gl[n] > gmax) { gmax = gl[n]; gtop = n; }
            float den = 0.f;
#pragma unroll
            for (int n = 0; n < 4; ++n) den += __expf(gl[n] - gmax);
            const float gw = 1.0f / den;
            float el[8];
#pragma unroll
            for (int jj = 0; jj < 8; ++jj) el[jj] = lg[4 + gtop * 8 + jj] * rs + reb[gtop * 8 + jj];
            int i1 = 0; float v1 = el[0];
#pragma unroll
            for (int jj = 1; jj < 8; ++jj) if (el[jj] > v1) { v1 = el[jj]; i1 = jj; }
            int i2 = -1; float v2 = -INFINITY;
#pragma unroll
            for (int jj = 0; jj < 8; ++jj) if (jj != i1 && el[jj] > v2) { v2 = el[jj]; i2 = jj; }
            const float ex = __expf(v2 - v1), w1 = 1.0f / (1.0f + ex), w2 = ex * w1;
            const int e1 = gtop * 8 + i1, e2 = gtop * 8 + i2;
            tokE[t * 2] = e1; tokE[t * 2 + 1] = e2; tokW[t * 2] = w1 * gw; tokW[t * 2 + 1] = w2 * gw; rstd2[t] = rs;
            selE[li * 2] = e1; selE[li * 2 + 1] = e2; selR[li * 2] = atomicAdd(&hist[e1], 1); selR[li * 2 + 1] = atomicAdd(&hist[e2], 1);
        }
        __syncthreads();
        if (tid < 32) wgb[tid] = (int)atomicAdd(&count[tid], (unsigned)hist[tid]);
        __syncthreads();
        rank[tok0 * 2 + tid] = wgb[selE[tid]] + selR[tid];
        __syncthreads();
    }
}
DEVI void ph_place_all(const unsigned* count, const int* tokE, const float* tokW, const int* rank, int* row_ts, float* row_w, int* tile_e, int* n_tiles, unsigned char* smb, int wg, int nwg) {
    int* ps = (int*)smb; int* cnt = ps + 40;
    const int tid = otid(), lane = tid & 63;
    if (tid < 64) { const int c = lane < 32 ? (int)__hip_atomic_load(count + lane, __ATOMIC_RELAXED, __HIP_MEMORY_SCOPE_AGENT) : 0; const int pad = (c + 255) & ~255;
        int incl = pad;
#pragma unroll
        for (int o = 1; o < 32; o <<= 1) { const int t_ = __shfl_up(incl, o); if (lane >= o) incl += t_; }
        if (lane < 32) { cnt[lane] = c; ps[lane] = incl - pad; if (lane == 31) ps[32] = incl; } }
    __syncthreads();
    if (wg == 0) {
        const int nt = ps[32] >> 8;
        if (tid == 0) *n_tiles = nt;
        for (int i = tid; i < nt; i += NTHR) { int e = 0;
#pragma unroll 1
            for (int k = 1; k < 32; ++k) if ((ps[k] >> 8) <= i) e = k;
            tile_e[i] = e; }
        for (int e = 0; e < 32; ++e) for (int r = cnt[e] + tid; r < ps[e + 1] - ps[e]; r += NTHR) row_ts[ps[e] + r] = -1;
    }
    for (int idx = wg * NTHR + tid; idx < 2 * T; idx += nwg * NTHR) { const int pos = ps[tokE[idx]] + rank[idx]; row_ts[pos] = idx; row_w[pos] = tokW[idx]; }
    __syncthreads();
}
DEVI void ph_combine(bf16_t* h, const bf16_t* Y, float* rstd3, int wg, int nwg) {
    const int tid = otid(), lane = tid & 63, gw = wg * 8 + (tid >> 6), ngw = nwg * 8;
    for (int row = gw; row < T; row += ngw) {
        u32x4* hr = (u32x4*)(h + (size_t)row * D) + lane; const u32x4* y0 = (const u32x4*)(Y + (size_t)row * D) + lane; const u32x4* y1 = (const u32x4*)(Y + ((size_t)T + row) * D) + lane;
        float s = 0.f;
#pragma unroll
        for (int jj = 0; jj < 2; ++jj) { float a[8], b0[8], b1[8]; unpack8(hr[64 * jj], a); unpack8(y0[64 * jj], b0); unpack8(y1[64 * jj], b1);
#pragma unroll
            for (int i = 0; i < 8; ++i) { a[i] += b0[i] + b1[i]; s += a[i] * a[i]; }
            u32x4 w; w.x = pk2(a[0], a[1]); w.y = pk2(a[2], a[3]); w.z = pk2(a[4], a[5]); w.w = pk2(a[6], a[7]); hr[64 * jj] = w; }
        s = wave_sum(s);
        if (lane == 0) rstd3[row] = rsqrtf(s * (1.0f / 1024.0f) + EPS);
    }
}
DEVI void ph_final(const bf16_t* h, float* out, const float* ssp, const float* g, int wg, int nwg) {
    const int tid = otid(), lane = tid & 63, gw = wg * 8 + (tid >> 6), ngw = nwg * 8;
    for (int row = gw; row < T; row += ngw) {
        float s = lane < 16 ? ssp[(size_t)row * 16 + lane] : 0.f; s = wave_sum(s);
        const float rs = rsqrtf(s * (1.0f / 1024.0f) + EPS);
        const u32x4* hr = (const u32x4*)(h + (size_t)row * D) + lane; f32x4* op = (f32x4*)(out + (size_t)row * D) + 2 * lane; const f32x4* gp = (const f32x4*)g + 2 * lane;
#pragma unroll
        for (int jj = 0; jj < 2; ++jj) { float a[8]; unpack8(hr[64 * jj], a); const f32x4 g0 = gp[128 * jj], g1 = gp[128 * jj + 1];
            op[128 * jj] = (f32x4){a[0] * rs * g0[0], a[1] * rs * g0[1], a[2] * rs * g0[2], a[3] * rs * g0[3]}; op[128 * jj + 1] = (f32x4){a[4] * rs * g1[0], a[5] * rs * g1[1], a[6] * rs * g1[2], a[7] * rs * g1[3]}; }
    }
}

enum { IN_X = 0, IN_P, IN_NORM1G, IN_WIN, IN_CONVW, IN_CONVB, IN_IGB, IN_FGB, IN_MNG, IN_SBOG, IN_SGULNG, IN_SGULNB, IN_SGUW, IN_SGUB, IN_SGUOG, IN_WOUT, IN_NORM2G,
       IN_RGW, IN_RGB, IN_REW, IN_REB, IN_WGATE, IN_WUP, IN_WDOWN, IN_PLENG, IN_PLEGW, IN_PLEPW, IN_FINALG, N_INPUTS };
constexpr int NPH_LAYER = 9, NPHASES = 1 + DEPTH * NPH_LAYER + 1;
struct Params { const float* in[N_INPUTS]; float* out; unsigned char* ws; int ph_lo, ph_hi; };
static_assert(sizeof(Params) == N_INPUTS * 8 + 8 + 8 + 8, "Params has no padding");

__global__ void __launch_bounds__(NTHR, 2) mega(Params p) {
    extern __shared__ __attribute__((aligned(16))) unsigned char lds[];
    const int tid = threadIdx.x, wg = blockIdx.x, nwg = gridDim.x;
    for (int u = tid; u < (LDS_BYTES - MISC_OFF) / 4; u += NTHR) ((LAS unsigned*)(lds + MISC_OFF))[u] = 0u;
    __syncthreads();
    unsigned char* const ws0 = p.ws;
    const bool fused = (p.ph_hi - p.ph_lo) > 1;
    XcdBarrier bar; bar.bar = (unsigned*)(ws0 + WS_CTL) + CW_BAR; bar.x = 0; bar.st = nullptr;
    if (fused) bar = xcd_barrier_post((unsigned*)(ws0 + WS_CTL) + CW_BAR, (volatile LAS unsigned*)(lds + MISC_OFF));
    PG8_LAS unsigned char* ring = (PG8_LAS unsigned char*)lds;
#define WSP(type, off) ((type)(ws + (off)))
#define PH_LOCALS unsigned char* ws = ws0; asm volatile("" : "+s"(ws)); float* out = p.out; asm volatile("" : "+s"(out)); \
        unsigned char* wl = ws + WS_WTS + (size_t)l * WL_SIZE; (void)wl; (void)out; \
        bf16_t* const HIN = (bf16_t*)(ws + ((l & 1) ? WS_HBB : WS_HBA)); bf16_t* const HOUT = (bf16_t*)(ws + ((l & 1) ? WS_HBA : WS_HBB)); (void)HIN; (void)HOUT;

    int gp = 0;
#define PH_ON (p.ph_lo <= gp && gp < p.ph_hi)
#define PH_END do { if (fused && gp + 1 < p.ph_hi) for (int rb_ = 0; rb_ < REP_BAR; ++rb_) xcd_barrier(bar); ++gp; } while (0)

    if (PH_ON) for (int rep = 0; rep < REP_PRO; ++rep) {
#pragma unroll 1
        for (int l = 0; l < DEPTH; ++l) {
            PH_LOCALS
            { const PrepJob j{p.in[IN_WIN] + (size_t)l * D * 3208, nullptr, p.in[IN_NORM1G] + l * D, (bf16_t*)(wl + WL_IN), 3208, D, NZ, 1, 1, 0, 0, 0}; ph_prep_w(j, lds, wg, nwg); }
            { const PrepJob j{p.in[IN_WOUT] + (size_t)l * D * D, nullptr, nullptr, (bf16_t*)(wl + WL_OUT), D, D, D, 0, 1, 0, 0, 0}; ph_prep_w(j, lds, wg, nwg); }
            { const PrepJob j{p.in[IN_WGATE] + (size_t)l * NEXP * D * DEXP, p.in[IN_WUP] + (size_t)l * NEXP * D * DEXP, p.in[IN_NORM2G] + l * D, (bf16_t*)(wl + WL_GU), DEXP, D, 512, 2, NEXP, 0, (size_t)D * DEXP, (size_t)512 * D};
              ph_prep_w(j, lds, wg, nwg); }
            { const PrepJob j{p.in[IN_WDOWN] + (size_t)l * NEXP * DEXP * D, nullptr, nullptr, (bf16_t*)(wl + WL_DN), D, DEXP, D, 0, NEXP, 0, (size_t)DEXP * D, (size_t)D * DEXP}; ph_prep_w(j, lds, wg, nwg); }
            { const PrepJob j{p.in[IN_PLEGW] + (size_t)l * D * D, nullptr, p.in[IN_PLENG] + l * D, (bf16_t*)(wl + WL_PG), D, D, D, 0, 1, 0, 0, 0}; ph_prep_w(j, lds, wg, nwg); }
            { const PrepJob j{p.in[IN_PLEPW] + (size_t)l * PDIM * D, nullptr, nullptr, (bf16_t*)(wl + WL_PP), D, PDIM, D, 0, 1, 0, 0, 0}; ph_prep_w(j, lds, wg, nwg); }
            ph_prep_sgu(p.in[IN_SGUW] + (size_t)l * 4 * 128 * 128, WSP(bf16_t*, WS_WSGU) + (size_t)l * 4 * 128 * 128, wg, nwg);
            ph_prep_router(p.in[IN_RGW] + l * D * 4, p.in[IN_REW] + l * D * 32, p.in[IN_NORM2G] + l * D, WSP(bf16_t*, WS_WR) + (size_t)l * 96 * D, WSP(bf16_t*, WS_WR) + (size_t)l * 96 * D + 48 * D, wg, nwg);
        }
        { const int l = 0; PH_LOCALS
          ph_prep_x(p.in[IN_X], WSP(bf16_t*, WS_HBA), WSP(float*, WS_SSP), wg, nwg);
          ph_cvt_bf16(p.in[IN_P], WSP(bf16_t*, WS_PB), (size_t)DEPTH * T * PDIM / 4, wg, nwg); }
    }
    PH_END;

#pragma clang loop unroll(full)
    for (int l = 0; l < DEPTH; ++l) {
        if (PH_ON) { PH_LOCALS
            pg8::Gemm g{HIN, (const bf16_t*)(wl + WL_IN), T, NZ, D, 0}; pg8::StaticOrder S; S.init(T, NZ, nwg, wg); EpiZ E{WSP(bf16_t*, WS_Z), WSP(const float*, WS_SSP), WSP(float*, WS_GATES)};
            for (int rep = 0; rep < REP_Z; ++rep) pg8::gemm_phase<EpiZ, pg8::StaticOrder, true, true>(ring, g, S, E); }
        PH_END;
        if (PH_ON) { PH_LOCALS
            const int nh = nwg >> 1;
            if (wg < nh) {
                for (int rep = 0; rep < REP_ML; ++rep) ph_mlstm(WSP(const bf16_t*, WS_Z), WSP(const float*, WS_GATES), p.in[IN_CONVW] + l * 4 * 768, p.in[IN_CONVB] + l * 768, p.in[IN_IGB] + l * 4, p.in[IN_FGB] + l * 4, p.in[IN_MNG] + l * 384, WSP(bf16_t*, WS_YMIX), lds, wg, nh);
            } else {
                for (int rep = 0; rep < REP_SB; ++rep) { ph_sb(WSP(const bf16_t*, WS_Z), p.in[IN_SBOG] + l * 384, WSP(bf16_t*, WS_YMIX), lds, wg - nh, nwg - nh); __syncthreads(); }
                for (int rep = 0; rep < REP_SGU; ++rep) ph_sgu(WSP(const bf16_t*, WS_Z), p.in[IN_SGULNG] + l * 256, p.in[IN_SGULNB] + l * 256, WSP(const bf16_t*, WS_WSGU) + (size_t)l * 4 * 128 * 128, p.in[IN_SGUB] + l * 4 * 128, p.in[IN_SGUOG] + l * 256, WSP(bf16_t*, WS_YMIX), lds, wg - nh, nwg - nh);
            }
        }
        PH_END;
        if (PH_ON) { PH_LOCALS
            pg8::Gemm g{WSP(const bf16_t*, WS_YMIX), (const bf16_t*)(wl + WL_OUT), T, D, D, 0}; pg8::StaticOrder S; S.init(T, D, nwg, wg); EpiResid E{HIN, HIN};
            for (int rep = 0; rep < (l == 0 ? REP_WOUT0 : 1); ++rep) pg8::gemm_phase<EpiResid, pg8::StaticOrder, true, true>(ring, g, S, E); }
        PH_END;
        if (PH_ON) { PH_LOCALS
for (int rep = 1; rep < REP_RTR; ++rep) {             ph_router(HIN, WSP(const bf16_t*, WS_WR) + (size_t)l * 96 * D, WSP(const bf16_t*, WS_WR) + (size_t)l * 96 * D + 48 * D, p.in[IN_RGB] + l * 4, p.in[IN_REB] + l * 32, WSP(int*, WS_TOKE), WSP(float*, WS_TOKW), WSP(float*, WS_RSTD2), WSP(int*, WS_RANK),
                      WSP(unsigned*, WS_CTL) + 1024 + 32 * rep, lds, wg, nwg); }
                        ph_router(HIN, WSP(const bf16_t*, WS_WR) + (size_t)l * 96 * D, WSP(const bf16_t*, WS_WR) + (size_t)l * 96 * D + 48 * D, p.in[IN_RGB] + l * 4, p.in[IN_REB] + l * 32, WSP(int*, WS_TOKE), WSP(float*, WS_TOKW), WSP(float*, WS_RSTD2), WSP(int*, WS_RANK),
                      WSP(unsigned*, WS_CTL) + CW_COUNT + 32 * l, lds, wg, nwg); }
        PH_END;
        if (PH_ON) { PH_LOCALS
            for (int rep = 0; rep < REP_PLACE; ++rep) ph_place_all(WSP(const unsigned*, WS_CTL) + CW_COUNT + 32 * l, WSP(const int*, WS_TOKE), WSP(const float*, WS_TOKW), WSP(const int*, WS_RANK), WSP(int*, WS_ROWTS), WSP(float*, WS_ROWW),
                         WSP(int*, WS_TILEE), WSP(int*, WS_CTL) + CW_NTILES + l, lds, wg, nwg); }
        PH_END;
        if (PH_ON) { PH_LOCALS
            pg8::Gemm g{HIN, (const bf16_t*)(wl + WL_GU), MAXROWS, 512, D, 0}; MoeGatherOrder S; S.ntot = 0; S.nN = 2; S.G = 0; S.c = 0; S.tile_e = WSP(const int*, WS_TILEE); S.estride = (size_t)512 * D * 2; S.row_ts = WSP(const int*, WS_ROWTS);
            S.bind(WSP(const int*, WS_CTL) + CW_NTILES + l, nwg, wg);
            EpiGU E{WSP(const float*, WS_RSTD2), WSP(const int*, WS_ROWTS), WSP(bf16_t*, WS_HID)};
            for (int rep = 0; rep < REP_GU; ++rep) pg8::gemm_phase<EpiGU, MoeGatherOrder, true, true>(ring, g, S, E); }
        PH_END;
        if (PH_ON) { PH_LOCALS
            pg8::Gemm g{WSP(const bf16_t*, WS_HID), (const bf16_t*)(wl + WL_DN), MAXROWS, D, DEXP, 0}; MoeOrder S{0, 4, 0, 0, WSP(const int*, WS_TILEE), (size_t)D * DEXP * 2}; S.bind(WSP(const int*, WS_CTL) + CW_NTILES + l, nwg, wg);
            EpiDown E{WSP(const int*, WS_ROWTS), WSP(const float*, WS_ROWW), WSP(bf16_t*, WS_Y)};
            for (int rep = 0; rep < REP_DOWN; ++rep) pg8::gemm_phase<EpiDown, MoeOrder, true, true>(ring, g, S, E); }
        PH_END;
        if (PH_ON) { PH_LOCALS
            ph_combine(HIN, WSP(const bf16_t*, WS_Y), WSP(float*, WS_RSTD3), wg, nwg);
            __syncthreads();
            pg8::Gemm g{WSP(const bf16_t*, WS_PB) + (size_t)l * T * PDIM, (const bf16_t*)(wl + WL_PP), T, D, PDIM, 0}; pg8::StaticOrder S; S.init(T, D, nwg, wg); EpiPlain E{WSP(bf16_t*, WS_YMIX), D, 0};
            for (int rep = 0; rep < REP_PP; ++rep) pg8::gemm_phase<EpiPlain, pg8::StaticOrder, true, true>(ring, g, S, E);
        }
        PH_END;
        if (PH_ON) { PH_LOCALS
            pg8::Gemm g{HIN, (const bf16_t*)(wl + WL_PG), T, D, D, 0}; pg8::StaticOrder S; S.init(T, D, nwg, wg); EpiPLE E{WSP(const float*, WS_RSTD3), WSP(const bf16_t*, WS_YMIX), HIN, HOUT, WSP(float*, WS_SSP)};
            if (REP_PLE > 1) { EpiPLE E2{WSP(const float*, WS_RSTD3), WSP(const bf16_t*, WS_YMIX), HIN, WSP(bf16_t*, WS_Z), WSP(float*, WS_Z + 400 * MiB)}; for (int rep = 1; rep < REP_PLE; ++rep) pg8::gemm_phase<EpiPLE, pg8::StaticOrder, true, true>(ring, g, S, E2); }
            pg8::gemm_phase<EpiPLE, pg8::StaticOrder, true, true>(ring, g, S, E); }
        PH_END;
    }
    if (PH_ON) { const int l = 0; PH_LOCALS
        ph_final(WSP(const bf16_t*, (DEPTH & 1) ? WS_HBB : WS_HBA), out, WSP(const float*, WS_SSP), p.in[IN_FINALG], wg, nwg); }
#undef PH_ON
#undef PH_END
}

#ifndef REP_SB
#define REP_SB 1
#endif
#ifndef REP_ML
#define REP_ML 1
#endif
#ifndef REP_SGU
#define REP_SGU 1
#endif
#ifndef MK_SPLIT
#define MK_SPLIT 0
#endif
extern "C" void kernel_launch(void* const* d_in, const int* in_sizes, int n_in, void* d_out, int out_size, void* d_ws, size_t ws_size, hipStream_t stream) {
    static int grid = 0;
    if (grid == 0) {
        if (n_in != N_INPUTS || in_sizes[0] != T * D || out_size != T * D || ws_size < WS_END) { fprintf(stderr, "kernel_launch: unexpected shapes / workspace (%d inputs, ws %zu)\n", n_in, ws_size); grid = -1; return; }
        int dev = 0, cus = 0;
        if (hipGetDevice(&dev) != hipSuccess || hipDeviceGetAttribute(&cus, hipDeviceAttributeMultiprocessorCount, dev) != hipSuccess) { grid = -1; return; }
        if (hipFuncSetAttribute((const void*)mega, hipFuncAttributeMaxDynamicSharedMemorySize, LDS_BYTES) != hipSuccess) { grid = -1; return; }
        int per_cu = 0;
        if (hipOccupancyMaxActiveBlocksPerMultiprocessor(&per_cu, (const void*)mega, NTHR, LDS_BYTES) != hipSuccess || per_cu < 1) fprintf(stderr, "kernel_launch: occupancy query says %d\n", per_cu);
        (void)hipGetLastError();
        grid = cus;
    }
    if (grid < 0) return;
    (void)hipMemsetAsync((unsigned char*)d_ws + WS_CTL, 0, 1 * MiB, stream);
    Params p{};
    for (int i = 0; i < N_INPUTS; ++i) p.in[i] = (const float*)d_in[i];
    p.out = (float*)d_out; p.ws = (unsigned char*)d_ws;
#if MK_SPLIT
    for (int ph = 0; ph < NPHASES; ++ph) { p.ph_lo = ph; p.ph_hi = ph + 1; hipLaunchKernelGGL(mega, dim3(grid), dim3(NTHR), LDS_BYTES, stream, p); }
#else
    p.ph_lo = 0; p.ph_hi = NPHASES;
    hipLaunchKernelGGL(mega, dim3(grid), dim3(NTHR), LDS_BYTES, stream, p);
#endif
}
```

```cpp
#include <hip/hip_runtime.h>
#include <cstdio>
#include <cstdint>
namespace pg8 {
#define PG8_LAS __attribute__((address_space(3)))
typedef unsigned short bf16_t;
typedef short bf16x8 __attribute__((ext_vector_type(8)));
typedef float f32x4 __attribute__((ext_vector_type(4)));
typedef unsigned u32x4 __attribute__((ext_vector_type(4)));
constexpr int BM = 256, BK = 64, HALF = 128, HTB = HALF * BK * 2  , STAGE_BYTES = 8 * HTB, NXCD = 8, WGM = 8;

__host__ __device__ __forceinline__ int lds_byte(int r, int c) { const int st = (r >> 4) * 2 + (c >> 5), rr = r & 15, cc = c & 31, ob = rr * 64 + cc * 2; return st * 1024 + (ob ^ (((ob >> 9) & 1) << 5)); }
__host__ __device__ __forceinline__ void stage_rc(int b, int& R, int& C) { const int st = b / 1024, sb = b % 1024, swz = sb ^ (((sb >> 9) & 1) << 5); R = (st >> 1) * 16 + swz / 64; C = (st & 1) * 32 + (swz % 64) / 2; }
__host__ __device__ __forceinline__ int perm32(int rho) { const int n = rho >> 4, i = rho & 15; return 8 * (i >> 2) + 4 * n + (i & 3); }

struct Unit { int pm, pn, ord; };
struct Gemm { const bf16_t* A; const bf16_t* Bt; int M, N, K, pad; };

struct StaticOrder {
    static constexpr bool GATHER = false;
    int nM, nN, nwg, G, c;
    __host__ __device__ __forceinline__ void init(int M, int N, int G_, int c_) { nM = M / BM; nN = N / BM; nwg = nM * nN; G = G_; c = c_; }
    __host__ __device__ __forceinline__ bool next(int i, Unit& u) const {
        const long L = (long)i * G + c; if (L >= nwg) return false;
        int wgid = (int)L; { const int q = nwg / NXCD, r = nwg % NXCD, xcd = wgid % NXCD, off = wgid / NXCD; wgid = (xcd < r ? xcd * (q + 1) : r * (q + 1) + (xcd - r) * q) + off; }
        const int nig = WGM * nN, gid = wgid / nig, fm = gid * WGM, gsz = (nM - fm) < WGM ? (nM - fm) : WGM;
        u.pm = fm + ((wgid % nig) % gsz); u.pn = (wgid % nig) / gsz; return true;
    }
    __device__ __forceinline__ size_t bbase(const Unit& u, size_t tstep) const { return (size_t)u.pn * tstep; }
    __device__ __forceinline__ int arow(const Unit&, int) const { return 0; }
    __device__ __forceinline__ void a_ready(const Unit&) const {}
    __device__ __forceinline__ void done(const Unit&) const {}
};

__device__ __forceinline__ unsigned cvt_pk_bf16(float lo, float hi) { unsigned r; asm volatile("v_cvt_pk_bf16_f32 %0, %1, %2" : "=v"(r) : "v"(lo), "v"(hi)); return r; }
typedef float f32x2 __attribute__((ext_vector_type(2)));
template <class Epi, class Sched, bool ALIGN_EPI = false, bool SP2 = false>
__device__ __forceinline__ void gemm_phase(PG8_LAS unsigned char* lds, const Gemm g, const Sched& S, const Epi& E) {
    int tid_ = threadIdx.x; asm volatile("" : "+v"(tid_));
    const int tid = tid_, wid = __builtin_amdgcn_readfirstlane(tid >> 6), lane = tid & 63, wr = wid >> 2, wc = wid & 3, fr = lane & 15, fq = lane >> 4;
    int K_ = g.K; asm volatile("" : "+s"(K_));
    const int K = K_, nt = K / BK;
    unsigned voffA[2], voffB[2]; int gR[2], gC[2]; unsigned va[2][2], vnx[2][2];
#pragma unroll
    for (int i = 0; i < 2; ++i) { int R, C; stage_rc(tid * 16 + i * 8192, R, C); const int Rb = Epi::PERM ? ((R & ~31) + perm32(R & 31)) : R;
        voffA[i] = (unsigned)(R * K + C) * 2u; voffB[i] = (unsigned)(Rb * K + C) * 2u; gR[i] = R; gC[i] = C; }
    const size_t kstep = (size_t)(BK * 2);
    const size_t hstep = (size_t)HALF * K * 2;
    const size_t tstep = 2 * hstep;
    const unsigned ldsw = (unsigned)wid * 1024u;
    const int aoff = lds_byte(wr * 64 + fr, fq * 8), boff = lds_byte(wc * 32 + fr, fq * 8);
#define PG8_SA(b, h) (((b) * 2 + (h)) * HTB)
#define PG8_SB(b, h) ((4 + (b) * 2 + (h)) * HTB)
#define PG8_STAGE(bufoff, gbase, voff) do { _Pragma("unroll") for (int _i = 0; _i < 2; ++_i) \
        __builtin_amdgcn_global_load_lds((const unsigned*)((const char*)(gbase) + (voff)[_i]), (PG8_LAS unsigned*)(lds + (bufoff) + ldsw + _i * 8192), 16, 0, 0); } while (0)
#define PG8_STAGE_A(bufoff, kptr, h, nx) do { if constexpr (Sched::GATHER) { const unsigned o_[2] = {(nx) ? vnx[h][0] : va[h][0], (nx) ? vnx[h][1] : va[h][1]}; PG8_STAGE(bufoff, kptr, o_); } \
        else { PG8_STAGE(bufoff, (kptr) + (h) * hstep, voffA); } } while (0)
#define PG8_GOFF(dst, u) do { _Pragma("unroll") for (int h_ = 0; h_ < 2; ++h_) _Pragma("unroll") for (int i_ = 0; i_ < 2; ++i_) dst[h_][i_] = (unsigned)S.arow(u, h_ * HALF + gR[i_]) * (unsigned)(K * 2) + (unsigned)(gC[i_] * 2); } while (0)
#define PG8_LDA(dst, b, h) do { _Pragma("unroll") for (int m = 0; m < 4; ++m) _Pragma("unroll") for (int k = 0; k < 2; ++k) dst[m][k] = *(const PG8_LAS bf16x8*)(lds + PG8_SA(b, h) + aoff + m * 2048 + k * 1024); } while (0)
#define PG8_LDB(dst, b, h) do { _Pragma("unroll") for (int n = 0; n < 2; ++n) _Pragma("unroll") for (int k = 0; k < 2; ++k) dst[n][k] = *(const PG8_LAS bf16x8*)(lds + PG8_SB(b, h) + boff + n * 2048 + k * 1024); } while (0)
#define PG8_MMA(ai, bj, At, Bt) do { __builtin_amdgcn_s_setprio(1); _Pragma("unroll") for (int m = 0; m < 4; ++m) _Pragma("unroll") for (int n = 0; n < 2; ++n) _Pragma("unroll") for (int k = 0; k < 2; ++k) \
        acc[ai][bj][m][n] = __builtin_amdgcn_mfma_f32_16x16x32_bf16(Bt[n][k], At[m][k], acc[ai][bj][m][n], 0, 0, 0); __builtin_amdgcn_s_setprio(0); } while (0)
#define PG8_WAIT_V(n) asm volatile("s_waitcnt vmcnt(" #n ")" ::: "memory")
#define PG8_WAIT_L(n) asm volatile("s_waitcnt lgkmcnt(" #n ")" ::: "memory")
#define PG8_BAR __builtin_amdgcn_s_barrier()
#define PG8_SCHED __builtin_amdgcn_sched_barrier(0)
    Unit cur, nxt; int ui = 0;
    if (!S.next(0, cur)) return;
    cur.ord = 0;
    f32x4 acc[2][2][4][2];
#pragma unroll
    for (int a = 0; a < 2; ++a)
#pragma unroll
        for (int b = 0; b < 2; ++b)
#pragma unroll
            for (int m = 0; m < 4; ++m)
#pragma unroll
                for (int n = 0; n < 2; ++n) acc[a][b][m][n] = (f32x4){0.f, 0.f, 0.f, 0.f};
    bf16x8 At[4][2], B0[2][2], B1[2][2];
    static_assert(!Sched::GATHER || SP2, "the gathered A operand is wired into the SP2 loop only");
    const char* cA = (const char*)g.A + (Sched::GATHER ? (size_t)0 : (size_t)cur.pm * tstep); const char* cB = (const char*)g.Bt + S.bbase(cur, tstep);
    if constexpr (Sched::GATHER) { PG8_GOFF(va, cur); _Pragma("unroll") for (int h_ = 0; h_ < 2; ++h_) _Pragma("unroll") for (int i_ = 0; i_ < 2; ++i_) vnx[h_][i_] = va[h_][i_]; }
    S.a_ready(cur);
    if constexpr (SP2) {
        PG8_STAGE(PG8_SB(0, 0), cB, voffB); PG8_STAGE(PG8_SB(0, 1), cB + hstep, voffB); PG8_STAGE_A(PG8_SA(0, 0), cA, 0, false); PG8_STAGE_A(PG8_SA(0, 1), cA, 1, false);
        if (wr == 1) PG8_BAR;
        PG8_WAIT_V(2); PG8_BAR;
        PG8_STAGE(PG8_SB(1, 0), cB + kstep, voffB); PG8_STAGE_A(PG8_SA(1, 0), cA + kstep, 0, false); PG8_STAGE(PG8_SB(1, 1), cB + hstep + kstep, voffB);
        PG8_WAIT_V(6); PG8_BAR;
    } else {
        PG8_STAGE(PG8_SB(0, 0), cB, voffB); PG8_STAGE(PG8_SA(0, 0), cA, voffA); PG8_STAGE(PG8_SB(0, 1), cB + hstep, voffB); PG8_STAGE(PG8_SA(0, 1), cA + hstep, voffA);
        if (wr == 1) PG8_BAR;
        PG8_WAIT_V(4); PG8_BAR;
        PG8_STAGE(PG8_SB(1, 0), cB + kstep, voffB); PG8_STAGE(PG8_SA(1, 0), cA + kstep, voffA); PG8_STAGE(PG8_SB(1, 1), cB + hstep + kstep, voffB);
        PG8_WAIT_V(6); PG8_BAR;
    }
    for (;;) {
        const bool has_next = S.next(ui + 1, nxt); nxt.ord = ui + 1;
        if constexpr (Sched::GATHER) { if (has_next) PG8_GOFF(vnx, nxt); }
        const char* nA = (has_next && !Sched::GATHER) ? (const char*)g.A + (size_t)nxt.pm * tstep : cA; const char* nB = has_next ? (const char*)g.Bt + S.bbase(nxt, tstep) : cB;
        for (int t = 0; t < nt; t += 2) {
            const bool last = (t == nt - 2); const bool lastnx = last && has_next; (void)lastnx;
            const char* a1 = cA + (size_t)(t + 1) * kstep;
            const char* a2 = last ? nA : cA + (size_t)(t + 2) * kstep; const char* b2 = last ? nB : cB + (size_t)(t + 2) * kstep;
            const char* a3 = a2 + kstep; const char* b3 = b2 + kstep;
            if (last && has_next) S.a_ready(nxt);
            if constexpr (SP2) {
            PG8_LDB(B0, 0, 0); PG8_LDB(B1, 0, 1); PG8_SCHED; PG8_LDA(At, 0, 0); PG8_STAGE_A(PG8_SA(1, 1), a1, 1, false);
            PG8_WAIT_V(8); PG8_WAIT_L(0); PG8_BAR; PG8_MMA(0, 0, At, B0); PG8_MMA(0, 1, At, B1); PG8_BAR; PG8_SCHED;
            PG8_LDA(At, 0, 1); PG8_STAGE(PG8_SB(0, 0), b2, voffB); PG8_STAGE(PG8_SB(0, 1), b2 + hstep, voffB); PG8_STAGE_A(PG8_SA(0, 0), a2, 0, lastnx);
            PG8_WAIT_V(8); PG8_WAIT_L(0); PG8_BAR; PG8_MMA(1, 0, At, B0); PG8_MMA(1, 1, At, B1); PG8_BAR; PG8_SCHED;
            PG8_LDB(B0, 1, 0); PG8_LDB(B1, 1, 1); PG8_SCHED; PG8_LDA(At, 1, 0); PG8_STAGE_A(PG8_SA(0, 1), a2, 1, lastnx);
            PG8_WAIT_V(8); PG8_WAIT_L(0); PG8_BAR; PG8_MMA(0, 0, At, B0); PG8_MMA(0, 1, At, B1); PG8_BAR; PG8_SCHED;
            PG8_LDA(At, 1, 1); PG8_STAGE(PG8_SB(1, 0), b3, voffB); PG8_STAGE(PG8_SB(1, 1), b3 + hstep, voffB); PG8_STAGE_A(PG8_SA(1, 0), a3, 0, lastnx);
            PG8_WAIT_V(8); PG8_WAIT_L(0); PG8_BAR; PG8_MMA(1, 0, At, B0); PG8_MMA(1, 1, At, B1); PG8_BAR; PG8_SCHED;
            } else {
            PG8_LDB(B0, 0, 0); PG8_SCHED; PG8_LDA(At, 0, 0); PG8_STAGE(PG8_SA(1, 1), a1 + hstep, voffA);
            PG8_WAIT_L(8); PG8_BAR; PG8_WAIT_L(0); PG8_MMA(0, 0, At, B0); PG8_BAR; PG8_SCHED;
            PG8_LDB(B1, 0, 1); PG8_STAGE(PG8_SB(0, 0), b2, voffB);
            PG8_BAR; PG8_WAIT_L(0); PG8_MMA(0, 1, At, B1); PG8_BAR;
            PG8_LDA(At, 0, 1); PG8_STAGE(PG8_SA(0, 0), a2, voffA);
            PG8_BAR; PG8_WAIT_L(0); PG8_MMA(1, 0, At, B0); PG8_BAR; PG8_SCHED;
            PG8_STAGE(PG8_SB(0, 1), b2 + hstep, voffB);
            PG8_WAIT_V(6); PG8_BAR; PG8_MMA(1, 1, At, B1); PG8_BAR;
            PG8_LDB(B0, 1, 0); PG8_SCHED; PG8_LDA(At, 1, 0); PG8_STAGE(PG8_SA(0, 1), a2 + hstep, voffA);
            PG8_WAIT_L(8); PG8_BAR; PG8_WAIT_L(0); PG8_MMA(0, 0, At, B0); PG8_BAR; PG8_SCHED;
            PG8_LDB(B1, 1, 1); PG8_STAGE(PG8_SB(1, 0), b3, voffB);
            PG8_BAR; PG8_WAIT_L(0); PG8_MMA(0, 1, At, B1); PG8_BAR;
            PG8_LDA(At, 1, 1); PG8_STAGE(PG8_SA(1, 0), a3, voffA);
            PG8_BAR; PG8_WAIT_L(0); PG8_MMA(1, 0, At, B0); PG8_BAR; PG8_SCHED;
            PG8_STAGE(PG8_SB(1, 1), b3 + hstep, voffB);
            PG8_WAIT_V(6); PG8_BAR; PG8_MMA(1, 1, At, B1); PG8_BAR;
            }
        }
        if constexpr (ALIGN_EPI) { if (wr == 0) PG8_BAR; }
        if constexpr (!Epi::AFTER_DRAIN) { E(acc, cur, wr, wc, fr, fq); S.done(cur); }
        if (!has_next) break;
#pragma unroll
        for (int a = 0; a < 2; ++a)
#pragma unroll
            for (int b = 0; b < 2; ++b)
#pragma unroll
                for (int m = 0; m < 4; ++m)
#pragma unroll
                    for (int n = 0; n < 2; ++n) acc[a][b][m][n] = (f32x4){0.f, 0.f, 0.f, 0.f};
        cur = nxt; cA = nA; cB = nB; ++ui;
        if constexpr (Sched::GATHER) { _Pragma("unroll") for (int h_ = 0; h_ < 2; ++h_) _Pragma("unroll") for (int i_ = 0; i_ < 2; ++i_) va[h_][i_] = vnx[h_][i_]; }
        if constexpr (ALIGN_EPI) { if (wr == 1) PG8_BAR; }
    }
    PG8_WAIT_V(0);
    if constexpr (!ALIGN_EPI) { if (wr == 0) PG8_BAR; }
    PG8_BAR;
    if constexpr (Epi::AFTER_DRAIN) { E.fused(acc, cur, wr, wc, fr, fq, lds, wid, lane); S.done(cur); }
#undef PG8_SA
#undef PG8_SB
#undef PG8_STAGE
#undef PG8_STAGE_A
#undef PG8_GOFF
#undef PG8_LDA
#undef PG8_LDB
#undef PG8_MMA
#undef PG8_WAIT_V
#undef PG8_WAIT_L
#undef PG8_BAR
#undef PG8_SCHED
}
}

#define DEVI __device__ __forceinline__
typedef unsigned short bf16_t;
typedef float f32x4 __attribute__((ext_vector_type(4)));
typedef unsigned u32x4 __attribute__((ext_vector_type(4)));
typedef unsigned u32x2 __attribute__((ext_vector_type(2)));

constexpr int T = 65536, D = 1024, SEQ = 2048, NB = 32, DEPTH = 2;
constexpr int NZ = 3328;
constexpr int ZQA = 0, ZKA = 384, ZVA = 768, ZIF = 1152, ZQB = 1280, ZKB = 1664, ZVB = 2048, ZOB = 2432, ZUC = 2816, ZVC = 3072;
constexpr int NEXP = 32, DEXP = 256, PDIM = 256;
constexpr int MAXROWS = 2 * T + NEXP * 256;
constexpr float EPS = 1e-6f;

constexpr size_t MiB = 1u << 20;
constexpr size_t WS_CTL = 0;
constexpr size_t WS_GATES = 1 * MiB;
constexpr size_t WS_SSP = 3 * MiB;
constexpr size_t WS_TOKE = 7 * MiB;
constexpr size_t WS_TOKW = 7 * MiB + 512 * 1024;
constexpr size_t WS_RSTD2 = 8 * MiB;
constexpr size_t WS_RSTD3 = 8 * MiB + 256 * 1024;
constexpr size_t WS_RANK = 8 * MiB + 512 * 1024;
constexpr size_t WS_ROWTS = 9 * MiB;
constexpr size_t WS_ROWW = 10 * MiB;
constexpr size_t WS_ROWRS = 11 * MiB + 64 * 1024;
constexpr size_t WS_TILEE = 11 * MiB;
constexpr size_t WS_PSTART = 11 * MiB + 4096;
constexpr size_t WS_WR = 12 * MiB;
constexpr size_t WS_WSGU = 13 * MiB;
constexpr size_t WS_WTS = 16 * MiB;
constexpr size_t WL_IN = 0, WL_OUT = 6656 * 1024, WL_GU = WL_OUT + 2 * MiB, WL_DN = WL_GU + 32 * MiB, WL_PG = WL_DN + 16 * MiB, WL_PP = WL_PG + 2 * MiB, WL_SIZE = 59 * MiB;
constexpr size_t WS_PB = 134 * MiB;
constexpr size_t WS_HBA = 198 * MiB;
constexpr size_t WS_HBB = 326 * MiB;
constexpr size_t WS_YMIX = 454 * MiB;
constexpr size_t WS_Z = 582 * MiB;
constexpr size_t WS_XS = WS_Z, WS_Y = WS_Z, WS_HID = WS_Z + 272 * MiB;
constexpr size_t WS_SSP2 = 998 * MiB;
constexpr size_t WS_END = 1002 * MiB;
static_assert(WL_PP + 512 * 1024 <= WL_SIZE, "weights map");
static_assert((size_t)MAXROWS * 1024 * 2 <= 272 * MiB && (size_t)MAXROWS * 256 * 2 <= 68 * MiB, "overlay map");
constexpr int CW_COUNT = 0;
constexpr int CW_NTILES = 64;

DEVI float bf2f(unsigned short b) { return __uint_as_float((unsigned)b << 16); }
typedef float f32x2_t __attribute__((ext_vector_type(2))); typedef __bf16 bf16x2_t __attribute__((ext_vector_type(2)));
DEVI unsigned pk2(float lo, float hi) { const f32x2_t v = {lo, hi}; return __builtin_bit_cast(unsigned, __builtin_convertvector(v, bf16x2_t)); }
DEVI unsigned f2bf(float f) { return pk2(f, 0.f) & 0xffffu; }
DEVI float wave_sum(float v) {
#pragma unroll
    for (int o = 1; o < 64; o <<= 1) v += __shfl_xor(v, o);
    return v;
}
DEVI float sigmoidf_(float x) { return 1.0f / (1.0f + __expf(-x)); }
DEVI float siluf_(float x) { return x * sigmoidf_(x); }
DEVI float gelu_tanh(float x) { const float u = 0.7978845608028654f * (x + 0.044715f * x * x * x); return 0.5f * x * (1.0f + tanhf(u)); }
DEVI float softplusf_(float x) { return fmaxf(x, 0.f) + log1pf(__expf(-fabsf(x))); }

using pg8::Unit;
struct EpiZ {
    static constexpr bool PERM = true, AFTER_DRAIN = false;
    bf16_t* Z; const float* rtab; float* gates;
    DEVI void operator()(const f32x4 (&acc)[2][2][4][2], const Unit& u, int wr, int wc, int fr, int fq) const {
        int row0 = u.pm * 256 + wr * 64 + fr, col0 = u.pn * 256 + wc * 32 + 8 * fq; asm volatile("" : "+v"(row0), "+v"(col0));
        const float* rt = rtab + u.ord * 256 + wr * 64 + fr;
#pragma unroll
        for (int ai = 0; ai < 2; ++ai)
#pragma unroll
            for (int m = 0; m < 4; ++m) {
                const int row = row0 + ai * 128 + m * 16;
                const float rs = rt[ai * 128 + m * 16];
                bf16_t* rowp = Z + (size_t)row * NZ + col0;
#pragma unroll
                for (int bj = 0; bj < 2; ++bj) {
                    const float sc = (u.pn == 0 || (u.pn == 1 && bj == 0)) ? rs * (0.125f * 1.4426950408889634f) : rs;
                    const f32x4 v0 = acc[ai][bj][m][0] * sc, v1 = acc[ai][bj][m][1] * sc;
                    u32x4 w; w.x = pk2(v0[0], v0[1]); w.y = pk2(v0[2], v0[3]); w.z = pk2(v1[0], v1[1]); w.w = pk2(v1[2], v1[3]);
                    *(u32x4*)(rowp + bj * 128) = w;
                    if (bj == 1 && u.pn == 4 && wc == 0 && fq == 0) { *(f32x4*)(gates + (size_t)row * 8) = v0; *(f32x4*)(gates + (size_t)row * 8 + 4) = v1; }
                }
            }
    }
};
DEVI void unpack8(const u32x4 w, float (&f)[8]) { f[0] = __uint_as_float(w.x << 16); f[1] = __uint_as_float(w.x & 0xffff0000u); f[2] = __uint_as_float(w.y << 16); f[3] = __uint_as_float(w.y & 0xffff0000u);
    f[4] = __uint_as_float(w.z << 16); f[5] = __uint_as_float(w.z & 0xffff0000u); f[6] = __uint_as_float(w.w << 16); f[7] = __uint_as_float(w.w & 0xffff0000u); }
struct EpiResid {
    static constexpr bool PERM = true, AFTER_DRAIN = false;
    const bf16_t* hin; bf16_t* hout; float* ssp;
    DEVI void operator()(const f32x4 (&acc)[2][2][4][2], const Unit& u, int wr, int wc, int fr, int fq) const {
        int row0 = u.pm * 256 + wr * 64 + fr, col0 = u.pn * 256 + wc * 32 + 8 * fq; asm volatile("" : "+v"(row0), "+v"(col0));
#pragma unroll
        for (int ai = 0; ai < 2; ++ai) {
            u32x4 hv[4][2];
#pragma unroll
            for (int m = 0; m < 4; ++m)
#pragma unroll
                for (int bj = 0; bj < 2; ++bj) hv[m][bj] = *(const u32x4*)(hin + (size_t)(row0 + ai * 128 + m * 16) * D + col0 + bj * 128);
#pragma unroll
            for (int m = 0; m < 4; ++m) {
                const int row = row0 + ai * 128 + m * 16; const size_t off = (size_t)row * D + col0; float sacc = 0.f;
#pragma unroll
                for (int bj = 0; bj < 2; ++bj) {
                    float f[8]; unpack8(hv[m][bj], f);
                    const f32x4 v0 = acc[ai][bj][m][0], v1 = acc[ai][bj][m][1];
                    f[0] += v0[0]; f[1] += v0[1]; f[2] += v0[2]; f[3] += v0[3]; f[4] += v1[0]; f[5] += v1[1]; f[6] += v1[2]; f[7] += v1[3];
                    sacc += ((f[0] * f[0] + f[1] * f[1]) + (f[2] * f[2] + f[3] * f[3])) + ((f[4] * f[4] + f[5] * f[5]) + (f[6] * f[6] + f[7] * f[7]));
                    u32x4 w; w.x = pk2(f[0], f[1]); w.y = pk2(f[2], f[3]); w.z = pk2(f[4], f[5]); w.w = pk2(f[6], f[7]);
                    *(u32x4*)(hout + off + bj * 128) = w;
                }
                sacc += __shfl_xor(sacc, 16); sacc += __shfl_xor(sacc, 32);
                if (fq == 0) ssp[(size_t)row * 16 + u.pn * 4 + wc] = sacc;
            }
        }
    }
};
struct EpiPLE {
    static constexpr bool PERM = true, AFTER_DRAIN = false;
    const float* rstd3; const bf16_t* pp; const bf16_t* hin; bf16_t* hout; float* ssp;
    DEVI void operator()(const f32x4 (&acc)[2][2][4][2], const Unit& u, int wr, int wc, int fr, int fq) const {
        int row0 = u.pm * 256 + wr * 64 + fr, col0 = u.pn * 256 + wc * 32 + 8 * fq; asm volatile("" : "+v"(row0), "+v"(col0));
#pragma unroll
        for (int ai = 0; ai < 2; ++ai) {
            u32x4 hv[4][2], pvv[4][2]; float rsv[4];
#pragma unroll
            for (int m = 0; m < 4; ++m) { const int row = row0 + ai * 128 + m * 16; rsv[m] = rstd3[row];
#pragma unroll
                for (int bj = 0; bj < 2; ++bj) { hv[m][bj] = *(const u32x4*)(hin + (size_t)row * D + col0 + bj * 128); pvv[m][bj] = *(const u32x4*)(pp + (size_t)row * D + col0 + bj * 128); } }
#pragma unroll
            for (int m = 0; m < 4; ++m) {
                const int row = row0 + ai * 128 + m * 16; const size_t off = (size_t)row * D + col0; const float rs = rsv[m];
                float sacc = 0.f;
#pragma unroll
                for (int bj = 0; bj < 2; ++bj) {
                    float hf[8], pf[8]; unpack8(hv[m][bj], hf); unpack8(pvv[m][bj], pf);
                    float o[8];
#pragma unroll
                    for (int i = 0; i < 8; ++i) { const float a = acc[ai][bj][m][i >> 2][i & 3] * rs; o[i] = hf[i] + __builtin_amdgcn_rcpf(1.0f + __expf(-a)) * pf[i]; sacc += o[i] * o[i]; }
                    u32x4 w; w.x = pk2(o[0], o[1]); w.y = pk2(o[2], o[3]); w.z = pk2(o[4], o[5]); w.w = pk2(o[6], o[7]);
                    *(u32x4*)(hout + off + bj * 128) = w;
                }
                sacc += __shfl_xor(sacc, 16); sacc += __shfl_xor(sacc, 32);
                if (fq == 0) ssp[(size_t)row * 16 + u.pn * 4 + wc] = sacc;
            }
        }
    }
};
struct EpiGU {
    static constexpr bool PERM = true, AFTER_DRAIN = false;
    const float* row_rs; bf16_t* hid;
    DEVI void operator()(const f32x4 (&acc)[2][2][4][2], const Unit& u, int wr, int wc, int fr, int fq) const {
        int row0 = u.pm * 256 + wr * 64 + fr; asm volatile("" : "+v"(row0));
        float rsv[2][4];
#pragma unroll
        for (int ai = 0; ai < 2; ++ai)
#pragma unroll
            for (int m = 0; m < 4; ++m) rsv[ai][m] = row_rs[row0 + ai * 128 + m * 16];
#pragma unroll
        for (int ai = 0; ai < 2; ++ai)
#pragma unroll
            for (int m = 0; m < 4; ++m) {
                const int row = row0 + ai * 128 + m * 16;
                const float rs = rsv[ai][m];
                float hv[8];
#pragma unroll
                for (int n = 0; n < 2; ++n)
#pragma unroll
                    for (int i = 0; i < 4; ++i) { const float g = acc[ai][0][m][n][i] * rs, uu = acc[ai][1][m][n][i] * rs; hv[n * 4 + i] = siluf_(g) * uu; }
                u32x4 w; w.x = pk2(hv[0], hv[1]); w.y = pk2(hv[2], hv[3]); w.z = pk2(hv[4], hv[5]); w.w = pk2(hv[6], hv[7]);
                *(u32x4*)(hid + (size_t)row * DEXP + u.pn * 128 + wc * 32 + 8 * fq) = w;
            }
    }
};
struct EpiDown {
    static constexpr bool PERM = true, AFTER_DRAIN = false;
    const float* row_w; bf16_t* Y;
    DEVI void operator()(const f32x4 (&acc)[2][2][4][2], const Unit& u, int wr, int wc, int fr, int fq) const {
        int row0 = u.pm * 256 + wr * 64 + fr, col0 = u.pn * 256 + wc * 32 + 8 * fq; asm volatile("" : "+v"(row0), "+v"(col0));
        float wv[2][4];
#pragma unroll
        for (int ai = 0; ai < 2; ++ai)
#pragma unroll
            for (int m = 0; m < 4; ++m) wv[ai][m] = row_w[row0 + ai * 128 + m * 16];
#pragma unroll
        for (int ai = 0; ai < 2; ++ai)
#pragma unroll
            for (int m = 0; m < 4; ++m) {
                const float wt = wv[ai][m];
                bf16_t* rowp = Y + (size_t)(row0 + ai * 128 + m * 16) * D + col0;
#pragma unroll
                for (int bj = 0; bj < 2; ++bj) {
                    const f32x4 v0 = acc[ai][bj][m][0] * wt, v1 = acc[ai][bj][m][1] * wt;
                    u32x4 w; w.x = pk2(v0[0], v0[1]); w.y = pk2(v0[2], v0[3]); w.z = pk2(v1[0], v1[1]); w.w = pk2(v1[2], v1[3]);
                    __builtin_nontemporal_store(w, (u32x4*)(rowp + bj * 128));
                }
            }
    }
};
struct EpiNull {
    static constexpr bool PERM = true, AFTER_DRAIN = false;
    float* sink;
    DEVI void operator()(const f32x4 (&acc)[2][2][4][2], const Unit& u, int wr, int wc, int fr, int fq) const {
        float s = 0.f;
#pragma unroll
        for (int ai = 0; ai < 2; ++ai)
#pragma unroll
            for (int bj = 0; bj < 2; ++bj)
#pragma unroll
                for (int m = 0; m < 4; ++m)
#pragma unroll
                    for (int n = 0; n < 2; ++n) s += acc[ai][bj][m][n][0];
        if (s == 1.2345e-30f) sink[0] = s;
    }
};
struct EpiRouter {
    static constexpr bool PERM = false, AFTER_DRAIN = true;
    const float* ssp; const float* rgb; const float* reb; int* tokE; float* tokW; float* rstd2; int* rank; unsigned* count;
    DEVI void fused(f32x4 (&acc)[2][2][4][2], const Unit& u, int wr, int wc, int fr, int fq, PG8_LAS unsigned char* lds, int wid, int lane) const {
        PG8_LAS float* lg = (PG8_LAS float*)lds;
        PG8_LAS int* hist = (PG8_LAS int*)(lds + 256 * 97 * 4); PG8_LAS int* wgb = hist + 32; PG8_LAS int* selE = wgb + 32; PG8_LAS int* selR = selE + 512;
        const int tid = wid * 64 + lane;
        if (tid < 32) hist[tid] = 0;
        if (wc < 3) {
#pragma unroll
            for (int ai = 0; ai < 2; ++ai)
#pragma unroll
                for (int m = 0; m < 4; ++m) { const int r = ai * 128 + wr * 64 + m * 16 + fr;
#pragma unroll
                    for (int n = 0; n < 2; ++n)
#pragma unroll
                        for (int i = 0; i < 4; ++i) lg[r * 97 + 32 * wc + 16 * n + 4 * fq + i] = acc[ai][0][m][n][i]; }
        }
        asm volatile("s_waitcnt lgkmcnt(0)" ::: "memory"); __builtin_amdgcn_s_barrier(); asm volatile("" ::: "memory");
        if (tid < 256) {
            const int t = u.pm * 256 + tid; PG8_LAS const float* l0 = lg + tid * 97;
            const f32x4* sp = (const f32x4*)(ssp + (size_t)t * 16); const f32x4 st = (sp[0] + sp[1]) + (sp[2] + sp[3]);
            const float rs = rsqrtf(((st[0] + st[1]) + (st[2] + st[3])) * (1.0f / 1024.0f) + EPS);
            float gl[4]; int gtop = 0; float gmax;
#pragma unroll
            for (int n = 0; n < 4; ++n) gl[n] = (l0[n] + l0[48 + n]) * rs + rgb[n];
            gmax = gl[0];
#pragma unroll
            for (int n = 1; n < 4; ++n) if (gl[n] > gmax) { gmax = gl[n]; gtop = n; }
            float den = 0.f;
#pragma unroll
            for (int n = 0; n < 4; ++n) den += __expf(gl[n] - gmax);
            const float gw = 1.0f / den;
            float el[8];
#pragma unroll
            for (int jj = 0; jj < 8; ++jj) el[jj] = (l0[4 + gtop * 8 + jj] + l0[52 + gtop * 8 + jj]) * rs + reb[gtop * 8 + jj];
            int i1 = 0; float v1 = el[0];
#pragma unroll
            for (int jj = 1; jj < 8; ++jj) if (el[jj] > v1) { v1 = el[jj]; i1 = jj; }
            int i2 = -1; float v2 = -INFINITY;
#pragma unroll
            for (int jj = 0; jj < 8; ++jj) if (jj != i1 && el[jj] > v2) { v2 = el[jj]; i2 = jj; }
            const float ex = __expf(v2 - v1), w1 = 1.0f / (1.0f + ex), w2 = ex * w1;
            const int e1 = gtop * 8 + i1, e2 = gtop * 8 + i2;
            tokE[t * 2] = e1; tokE[t * 2 + 1] = e2; tokW[t * 2] = w1 * gw; tokW[t * 2 + 1] = w2 * gw; rstd2[t] = rs;
            selE[tid * 2] = e1; selE[tid * 2 + 1] = e2; selR[tid * 2] = __hip_atomic_fetch_add(hist + e1, 1, __ATOMIC_RELAXED, __HIP_MEMORY_SCOPE_WORKGROUP); selR[tid * 2 + 1] = __hip_atomic_fetch_add(hist + e2, 1, __ATOMIC_RELAXED, __HIP_MEMORY_SCOPE_WORKGROUP);
        }
        asm volatile("s_waitcnt lgkmcnt(0)" ::: "memory"); __builtin_amdgcn_s_barrier(); asm volatile("" ::: "memory");
        if (tid < 32) wgb[tid] = (int)atomicAdd(count + tid, (unsigned)hist[tid]);
        asm volatile("s_waitcnt vmcnt(0) lgkmcnt(0)" ::: "memory"); __builtin_amdgcn_s_barrier(); asm volatile("" ::: "memory");
        rank[u.pm * 512 + tid] = wgb[selE[tid]] + selR[tid];
        asm volatile("s_waitcnt lgkmcnt(0)" ::: "memory"); __builtin_amdgcn_s_barrier(); asm volatile("" ::: "memory");
    }
};
struct EpiPlain {
    static constexpr bool PERM = true, AFTER_DRAIN = false;
    bf16_t* O; int ldc, pad;
    DEVI void operator()(const f32x4 (&acc)[2][2][4][2], const Unit& u, int wr, int wc, int fr, int fq) const {
        int row0 = u.pm * 256 + wr * 64 + fr, col0 = u.pn * 256 + wc * 32 + 8 * fq; asm volatile("" : "+v"(row0), "+v"(col0));
#pragma unroll
        for (int ai = 0; ai < 2; ++ai)
#pragma unroll
            for (int m = 0; m < 4; ++m) {
                bf16_t* rowp = O + (size_t)(row0 + ai * 128 + m * 16) * ldc + col0;
#pragma unroll
                for (int bj = 0; bj < 2; ++bj) {
                    const f32x4 v0 = acc[ai][bj][m][0], v1 = acc[ai][bj][m][1];
                    u32x4 w; w.x = pk2(v0[0], v0[1]); w.y = pk2(v0[2], v0[3]); w.z = pk2(v1[0], v1[1]); w.w = pk2(v1[2], v1[3]);
                    *(u32x4*)(rowp + bj * 128) = w;
                }
            }
    }
};
struct MoeOrder {
    static constexpr bool GATHER = false;
    int ntot, nN, G, c; const int* tile_e; size_t estride;
    DEVI void bind(const int* n_tiles_ptr, int G_, int c_) { ntot = __builtin_amdgcn_readfirstlane(*n_tiles_ptr) * nN; G = G_; c = c_; }
    DEVI bool next(int i, Unit& u) const { const long L = (long)i * G + c; if (L >= ntot) return false; u.pm = (int)(L / nN); u.pn = (int)(L % nN); return true; }
    DEVI size_t bbase(const Unit& u, size_t tstep) const { return (size_t)__builtin_amdgcn_readfirstlane(tile_e[u.pm]) * estride + (size_t)u.pn * tstep; }
    DEVI int arow(const Unit&, int) const { return 0; }
    DEVI void a_ready(const Unit&) const {}
    DEVI void done(const Unit&) const {}
};
struct MoeGatherOrder : MoeOrder {
    static constexpr bool GATHER = true;
    const int* row_ts;
    DEVI int arow(const Unit& u, int r) const { const int ts = row_ts[u.pm * 256 + r]; return ts >= 0 ? (ts >> 1) : 0; }
};


#ifndef REP_SB
#define REP_SB 1
#endif
#ifndef REP_ML
#define REP_ML 1
#endif
#ifndef REP_SGU
#define REP_SGU 1
#endif
#ifndef REP_Z
#define REP_Z 1
#endif
#ifndef REP_PRO
#define REP_PRO 1
#endif
#ifndef REP_GATHER
#define REP_GATHER 1
#endif
#ifndef REP_GU
#define REP_GU 1
#endif
#ifndef REP_DOWN
#define REP_DOWN 1
#endif
#ifndef REP_PP
#define REP_PP 1
#endif
#ifndef REP_WOUT0
#define REP_WOUT0 1
#endif
#ifndef REP_BAR
#define REP_BAR 1
#endif
#ifndef REP_PLACE
#define REP_PLACE 1
#endif
#ifndef REP_PLE
#define REP_PLE 1
#endif
#ifndef REP_RTR
#define REP_RTR 1
#endif
#ifndef STG_Z
#define STG_Z 0
#endif
#ifndef STG_WOUT
#define STG_WOUT 0
#endif
#ifndef STG_GU
#define STG_GU 0
#endif
#ifndef STG_DOWN
#define STG_DOWN 0
#endif
#ifndef STG_PP
#define STG_PP 0
#endif
#ifndef STG_PLE
#define STG_PLE 0
#endif
#ifndef AL_Z
#define AL_Z true
#endif
#ifndef AL_WOUT
#define AL_WOUT true
#endif
#ifndef AL_GU
#define AL_GU true
#endif
#ifndef AL_DOWN
#define AL_DOWN true
#endif
#ifndef AL_PP
#define AL_PP true
#endif
#ifndef AL_PLE
#define AL_PLE true
#endif
constexpr int NTHR = 512;
constexpr int RING_BYTES = 147456;
constexpr int MISC_OFF = RING_BYTES;
constexpr int LDS_BYTES = RING_BYTES + 4096;
constexpr int CW_BAR = 4096;

#define XB_TMO      128
#define XB_XCNT(j)  (256  + 64 * (j))
#define XB_XSUB(j)  (1280 + 64 * (j))
#define XB_XGEN(j)  (2304 + 64 * (j))
#define XB_TOP      3328
#define XB_TOPGEN   3392
#define XCD_BAR_WORDS 3456
#define XB_SPIN_CAP (1u << 18)
#define LAS __attribute__((address_space(3)))

__device__ __forceinline__ unsigned xb_ld(unsigned* p)              { return __hip_atomic_load(p, __ATOMIC_RELAXED, __HIP_MEMORY_SCOPE_AGENT); }
__device__ __forceinline__ unsigned xb_add(unsigned* p, unsigned v) { return __hip_atomic_fetch_add(p, v, __ATOMIC_RELAXED, __HIP_MEMORY_SCOPE_AGENT); }
__device__ __forceinline__ unsigned xb_xcc_id() { return (unsigned)__builtin_amdgcn_s_getreg((3 << 11) | 20) & 0xFu; }
#define XB_SPIN(cond, bar) do { unsigned _sp = 0; while (cond) { __builtin_amdgcn_s_sleep(1); \
    if ((++_sp & 255u) == 0u) { if (xb_ld(&(bar)[XB_TMO])) break; if (_sp > XB_SPIN_CAP) { atomicAdd(&(bar)[XB_TMO], 1u); break; } } } } while (0)

struct XcdBarrier {
    unsigned* bar; unsigned x;
    volatile LAS unsigned* st;
};

__device__ __forceinline__ XcdBarrier xcd_barrier_post(unsigned* bar, volatile LAS unsigned* st) {
    XcdBarrier b; b.bar = bar; b.x = xb_xcc_id(); b.st = st;
    if (threadIdx.x == 0) (void)xb_add(&bar[XB_XCNT(b.x)], 1u);
    return b;
}
__device__ __forceinline__ void xcd_barrier_complete(unsigned* bar, unsigned x, unsigned& nloc, unsigned& nx) {
    const unsigned G = gridDim.x * gridDim.y * gridDim.z;
    unsigned sum, cnt, mine, sp = 0u;
    for (;;) {
        sum = 0u; cnt = 0u; mine = 0u;
#pragma unroll
        for (unsigned j = 0; j < 16; ++j) { const unsigned c = xb_ld(&bar[XB_XCNT(j)]); sum += c; cnt += (c > 0u) ? 1u : 0u; mine = (j == x) ? c : mine; }
        if (sum == G) break;
        __builtin_amdgcn_s_sleep(1);
        if ((++sp & 255u) == 0u) { if (xb_ld(&bar[XB_TMO])) break; if (sp > XB_SPIN_CAP) { atomicAdd(&bar[XB_TMO], 1u); break; } }
    }
    nloc = mine > 0u ? mine : 1u; nx = cnt > 0u ? cnt : 1u;
}

__device__ __forceinline__ void xcd_barrier(const XcdBarrier& b) {
    asm volatile("s_waitcnt vmcnt(0)" ::: "memory");
    __syncthreads();
    if (threadIdx.x == 0) {
        unsigned* bar = b.bar;
        __builtin_amdgcn_s_waitcnt(0);
        unsigned nloc = b.st[0], nx = b.st[1];
        if (nloc == 0u) { xcd_barrier_complete(bar, b.x, nloc, nx); b.st[0] = nloc; b.st[1] = nx; }
        const unsigned old = xb_add(&bar[XB_XSUB(b.x)], 1u);
        const unsigned gen = old / nloc;
        if (old + 1u == (gen + 1u) * nloc) {
            __builtin_amdgcn_fence(__ATOMIC_RELEASE, "agent");
            asm volatile("s_waitcnt vmcnt(0)" ::: "memory");
            const unsigned og = xb_add(&bar[XB_TOP], 1u);
            const unsigned tg = og / nx;
            if (og + 1u == (tg + 1u) * nx) xb_add(&bar[XB_TOPGEN], 1u);
            else XB_SPIN(xb_ld(&bar[XB_TOPGEN]) == tg, bar);
            __builtin_amdgcn_fence(__ATOMIC_ACQUIRE, "agent");
            xb_add(&bar[XB_XGEN(b.x)], 1u);
            asm volatile("s_waitcnt vmcnt(0)" ::: "memory");
        } else {
            XB_SPIN(xb_ld(&bar[XB_XGEN(b.x)]) == gen, bar);
            __builtin_amdgcn_fence(__ATOMIC_ACQUIRE, "agent");
            asm volatile("s_waitcnt vmcnt(0)" ::: "memory");
        }
    }
    __syncthreads();
}


DEVI int otid() { int t = threadIdx.x; asm volatile("" : "+v"(t)); return t; }
DEVI void stagger(int wg, unsigned ticks) { const unsigned long long t0 = __builtin_amdgcn_s_memrealtime(), d = (unsigned long long)((wg & 3) * ticks); while (__builtin_amdgcn_s_memrealtime() - t0 < d) __builtin_amdgcn_s_sleep(8); }
struct PrepJob { const float* in; const float* in2; const float* gain; bf16_t* out; int ldin, K, Nout, mode, ne, pad; size_t in_es, out_es; };
DEVI void ph_prep_w(const PrepJob& j, unsigned char* sm, int wg, int nwg) {
    const int tid = otid(), lane = tid & 63, wave = tid >> 6;
    float* scr = (float*)sm + wave * (64 * 33);
    const int nb = j.Nout / 32, kb = j.K / 64, per = nb * kb, total = per * j.ne;
    for (int it = wg * 8 + wave; it < total; it += nwg * 8) {
        const int e = it / per, r = it - e * per, k0 = (r / nb) * 64, n0 = (r % nb) * 32;
        const int n = n0 + (lane & 31); const float* src = j.in + (size_t)e * j.in_es; int col = n; bool valid = true;
        if (j.mode == 1) {
            if (n < 1152) col = n; else if (n < 1160) col = 2688 + (n - 1152); else if (n < 1280) valid = false; else if (n < 2816) col = 1152 + (n - 1280); else col = 2696 + (n - 2816);
        } else if (j.mode == 2) { const int pn = n >> 8, bj = (n >> 7) & 1; col = pn * 128 + (n & 127); if (bj) src = j.in2 + (size_t)e * j.in_es; }
        const float* sp = src + (size_t)(k0 + (lane >> 5)) * j.ldin + col; const float* gp = j.gain ? j.gain + k0 + (lane >> 5) : nullptr;
        float vv[32];
#pragma unroll
        for (int i = 0; i < 32; ++i) vv[i] = valid ? sp[(size_t)(2 * i) * j.ldin] : 0.f;
#pragma unroll
        for (int i = 0; i < 32; ++i) { float v = vv[i]; if (gp) v *= gp[2 * i]; scr[(2 * i + (lane >> 5)) * 33 + (lane & 31)] = v; }
        asm volatile("s_waitcnt lgkmcnt(0)" ::: "memory");
        const int c = lane & 7; bf16_t* o = j.out + (size_t)e * j.out_es;
#pragma unroll
        for (int jj = 0; jj < 4; ++jj) { const int nn = (lane >> 3) + 8 * jj; const float* q = scr + (8 * c) * 33 + nn;
            u32x4 w; w.x = pk2(q[0 * 33], q[1 * 33]); w.y = pk2(q[2 * 33], q[3 * 33]); w.z = pk2(q[4 * 33], q[5 * 33]); w.w = pk2(q[6 * 33], q[7 * 33]);
            *(u32x4*)(o + (size_t)(n0 + nn) * j.K + k0 + 8 * c) = w; }
        asm volatile("s_waitcnt lgkmcnt(0)" ::: "memory");
    }
}
DEVI void ph_prep_router(const float* rgw, const float* rew, const float* g, bf16_t* WRt, int wg, int nwg) {
    for (int idx = wg * NTHR + otid(); idx < 256 * 1024; idx += nwg * NTHR) { const int r = idx / 1024, k = idx % 1024, n = r < 48 ? r : r - 48;
        float w = (r < 96 && n < 36) ? g[k] * (n < 4 ? rgw[k * 4 + n] : rew[k * 32 + (n - 4)]) : 0.f;
        const unsigned hb = f2bf(w); WRt[idx] = (bf16_t)(r < 48 ? hb : f2bf(w - __uint_as_float(hb << 16))); }
}
DEVI void ph_prep_x(const float* x, bf16_t* hb, float* ssp, int wg, int nwg) {
    const int tid = otid(), lane = tid & 63, gw = wg * 8 + (tid >> 6), ngw = nwg * 8;
    for (int row = 2 * gw; row < T; row += 2 * ngw) {
        f32x4 v[2][4];
#pragma unroll
        for (int r = 0; r < 2; ++r)
#pragma unroll
            for (int jj = 0; jj < 4; ++jj) v[r][jj] = ((const f32x4*)(x + (size_t)(row + r) * D) + lane)[64 * jj];
#pragma unroll
        for (int r = 0; r < 2; ++r) { float s = 0.f; u32x2* o = (u32x2*)(hb + (size_t)(row + r) * D) + lane;
#pragma unroll
            for (int jj = 0; jj < 4; ++jj) { const f32x4 a = v[r][jj]; s += (a[0] * a[0] + a[1] * a[1]) + (a[2] * a[2] + a[3] * a[3]); u32x2 w; w.x = pk2(a[0], a[1]); w.y = pk2(a[2], a[3]); o[64 * jj] = w; }
            s = wave_sum(s);
            if (lane < 16) ssp[(size_t)(row + r) * 16 + lane] = lane == 0 ? s : 0.f; }
    }
}
DEVI void ph_cvt_bf16(const float* in, bf16_t* out, size_t n4, int wg, int nwg) {
    const size_t stride = (size_t)nwg * NTHR;
    for (size_t i0 = (size_t)wg * NTHR + otid(); i0 < n4; i0 += 8 * stride) {
        f32x4 v[8];
#pragma unroll
        for (int k = 0; k < 8; ++k) { const size_t i = i0 + k * stride; v[k] = i < n4 ? ((const f32x4*)in)[i] : (f32x4){0.f, 0.f, 0.f, 0.f}; }
#pragma unroll
        for (int k = 0; k < 8; ++k) { const size_t i = i0 + k * stride; if (i < n4) { u32x2 w; w.x = pk2(v[k][0], v[k][1]); w.y = pk2(v[k][2], v[k][3]); ((u32x2*)out)[i] = w; } }
    }
}

namespace sb {
typedef short bf16x8 __attribute__((ext_vector_type(8)));
typedef short s16x4 __attribute__((ext_vector_type(4)));
typedef float f32x16 __attribute__((ext_vector_type(16)));
constexpr float QSCALE = 0.125f * 1.4426950408889634f;
constexpr int WAVE_LDS = 12288;
DEVI int crow(int r, int hi) { return (r & 3) + 8 * (r >> 2) + 4 * hi; }
DEVI void glds16(const void* gsrc, unsigned lds_dst) { unsigned keep;
    asm volatile("s_mov_b32 %0, m0\n\ts_mov_b32 m0, %2\n\ts_nop 0\n\tglobal_load_lds_dwordx4 %1, off\n\ts_mov_b32 m0, %0" : "=&s"(keep) : "v"(gsrc), "s"(lds_dst) : "memory"); }
DEVI unsigned cvtpk(float lo, float hi) { unsigned r; asm("v_cvt_pk_bf16_f32 %0, %1, %2" : "=v"(r) : "v"(lo), "v"(hi)); return r; }
DEVI void pv(f32x16* o, int vb, bf16x8 pa0, bf16x8 pa1, bf16x8 pa2, bf16x8 pa3) {
#pragma unroll
    for (int d0 = 0; d0 < 2; ++d0) { s16x4 lo[4], hi[4];
#pragma unroll
        for (int ks = 0; ks < 4; ++ks) {
            asm volatile("ds_read_b64_tr_b16 %0,%1 offset:%c2" : "=&v"(lo[ks]) : "v"(vb), "i"(d0 * 4096 + ks * 1024) : "memory");
            asm volatile("ds_read_b64_tr_b16 %0,%1 offset:%c2" : "=&v"(hi[ks]) : "v"(vb), "i"(d0 * 4096 + ks * 1024 + 512) : "memory"); }
        asm volatile("s_waitcnt lgkmcnt(0)" ::: "memory"); __builtin_amdgcn_sched_barrier(0);
#define SB_PK(k) (bf16x8){lo[k][0], lo[k][1], lo[k][2], lo[k][3], hi[k][0], hi[k][1], hi[k][2], hi[k][3]}
        o[d0] = __builtin_amdgcn_mfma_f32_32x32x16_bf16(pa0, SB_PK(0), o[d0], 0, 0, 0);
        o[d0] = __builtin_amdgcn_mfma_f32_32x32x16_bf16(pa1, SB_PK(1), o[d0], 0, 0, 0);
        o[d0] = __builtin_amdgcn_mfma_f32_32x32x16_bf16(pa2, SB_PK(2), o[d0], 0, 0, 0);
        o[d0] = __builtin_amdgcn_mfma_f32_32x32x16_bf16(pa3, SB_PK(3), o[d0], 0, 0, 0);
#undef SB_PK
    }
}
}
DEVI void ph_sb(const bf16_t* Z, const float* og, bf16_t* Ymix, unsigned char* smb, int wg, int nwg) {
    using namespace sb;
    const int tid = otid(), lane = tid & 63, wave = __builtin_amdgcn_readfirstlane(tid >> 6), r32 = lane & 31, hi = lane >> 5;
    unsigned char* vt = smb + wave * 16384;
    const unsigned vt_lds = (unsigned)(uintptr_t)vt;
    const int vbl = ((lane >> 4) & 1) * 32 + (lane & 3) * 8 + (4 * hi + ((lane & 15) >> 2)) * 64;
    const unsigned vK0 = (unsigned)(r32 * NZ + ZKA + hi * 8) * 2u, vK1 = vK0 + 32u * NZ * 2u, vV = (unsigned)((lane >> 2) * NZ + ZVA + (lane & 3) * 8) * 2u, vQ = (unsigned)(r32 * NZ + ZQA + hi * 8) * 2u;
#define SB_TILE(hh, jj) ((const char*)Z + ((size_t)(bbase + (jj) * 64) * NZ + (hh) * 64) * 2)
#define SB_LOADK(dst, hh, jj) do { const char* kb_ = SB_TILE(hh, jj); _Pragma("unroll") for (int d0 = 0; d0 < 4; ++d0) { dst[2 * d0] = *(const bf16x8*)(kb_ + vK0 + d0 * 32); dst[2 * d0 + 1] = *(const bf16x8*)(kb_ + vK1 + d0 * 32); } } while (0)
#define SB_DMAV(buf, hh, jj) do { const char* kb_ = SB_TILE(hh, jj); _Pragma("unroll") for (int w8 = 0; w8 < 8; ++w8) \
        glds16(kb_ + ((size_t)(16 * (w8 & 3)) * NZ + (w8 >> 2) * 32) * 2 + vV, (unsigned)__builtin_amdgcn_readfirstlane(vt_lds + (buf) * 8192 + w8 * 1024)); } while (0)
#define SB_LOADQ(dst, hh) do { const char* qp_ = (const char*)Z + ((size_t)row0 * NZ + (hh) * 64) * 2 + vQ; _Pragma("unroll") for (int d0 = 0; d0 < 4; ++d0) dst[d0] = *(const bf16x8*)(qp_ + d0 * 32); } while (0)
    for (int wu = wg * 8 + wave; wu < T / 32; wu += nwg * 8) {
        const int row0 = wu * 32, bbase = (row0 / SEQ) * SEQ, t0 = row0 - bbase, tq = t0 + r32, jt0 = t0 >> 6;
        float ssq[4] = {0.f, 0.f, 0.f, 0.f};
        int cb = 0, pf = 0;
        bf16x8 kf[8], qr[4];
        asm volatile("s_waitcnt lgkmcnt(0)" ::: "memory");
        SB_DMAV(0, 0, jt0); SB_LOADK(kf, 0, jt0); SB_LOADQ(qr, 0);
#pragma unroll 1
        for (int h = 0; h < 6; ++h) {
            f32x16 o[2]; o[0] = f32x16{}; o[1] = f32x16{};
            float carry = 1.f; bool diag = true;
#pragma unroll 1
            for (int jt = jt0; ; --jt) {
                const int kv0 = jt * 64;
                f32x16 p0 = __builtin_amdgcn_mfma_f32_32x32x16_bf16(kf[0], qr[0], f32x16{}, 0, 0, 0), p1 = __builtin_amdgcn_mfma_f32_32x32x16_bf16(kf[1], qr[0], f32x16{}, 0, 0, 0);
#pragma unroll
                for (int d0 = 1; d0 < 4; ++d0) { p0 = __builtin_amdgcn_mfma_f32_32x32x16_bf16(kf[2 * d0], qr[d0], p0, 0, 0, 0); p1 = __builtin_amdgcn_mfma_f32_32x32x16_bf16(kf[2 * d0 + 1], qr[d0], p1, 0, 0, 0); }
                if (diag && jt > 0) { SB_DMAV(cb ^ 1, h, jt - 1); SB_LOADK(kf, h, jt - 1); pf = 1; }
                else if (h + 1 < 6) { SB_DMAV(cb ^ 1, h + 1, jt0); SB_LOADK(kf, h + 1, jt0); pf = 2; }
                else pf = 0;
                if (diag) {
#pragma unroll
                    for (int r = 0; r < 16; ++r) { const int kv = kv0 + crow(r, hi); if (kv >= tq) p0[r] = -INFINITY; if (kv + 32 >= tq) p1[r] = -INFINITY; }
                }
                float total = 1.f; u32x4 pw0, pw1, pw2, pw3;
#define SB_HALF(P, PWA, PWB) do { f32x16 R; \
                    _Pragma("unroll") for (int r = 0; r < 16; ++r) { float c_; asm("v_min_f32 %0, %1, %2" : "=v"(c_) : "v"(P[r]), "v"(100.f)); const float e_ = __builtin_amdgcn_exp2f(c_); R[r] = __builtin_amdgcn_rcpf(1.0f + e_); P[r] = e_ * R[r]; } \
                    _Pragma("unroll") for (int g = 3; g >= 0; --g) { const float mine = (R[4 * g] * R[4 * g + 1]) * (R[4 * g + 2] * R[4 * g + 3]); const auto sw_ = __builtin_amdgcn_permlane32_swap(__float_as_uint(mine), __float_as_uint(mine), false, false); const float og_ = __uint_as_float(hi ? sw_[0] : sw_[1]);     \
                        float t = carry * (hi == 0 ? total * og_ : total); total *= mine * og_; \
                        P[4 * g + 3] *= t; t *= R[4 * g + 3]; P[4 * g + 2] *= t; t *= R[4 * g + 2]; P[4 * g + 1] *= t; t *= R[4 * g + 1]; P[4 * g] *= t; } \
                    PWA = (u32x4){cvtpk(P[0], P[1]), cvtpk(P[2], P[3]), cvtpk(P[4], P[5]), cvtpk(P[6], P[7])}; PWB = (u32x4){cvtpk(P[8], P[9]), cvtpk(P[10], P[11]), cvtpk(P[12], P[13]), cvtpk(P[14], P[15])}; } while (0)
                SB_HALF(p1, pw2, pw3);
                SB_HALF(p0, pw0, pw1);
#undef SB_HALF
                carry *= total;
                if (pf) asm volatile("s_waitcnt vmcnt(16)" ::: "memory");
                else asm volatile("s_waitcnt vmcnt(0)" ::: "memory");
                pv(o, (int)vt_lds + cb * 8192 + vbl, __builtin_bit_cast(bf16x8, pw0), __builtin_bit_cast(bf16x8, pw1), __builtin_bit_cast(bf16x8, pw2), __builtin_bit_cast(bf16x8, pw3));
                diag = false;
                if (jt == 0 || !__any(carry > 9.0949470177e-13f)) break;
                if (pf == 1) { cb ^= 1; pf = 0; }
                else { SB_DMAV(cb, h, jt - 1); SB_LOADK(kf, h, jt - 1); pf = 0; }
            }
            const bool hit = (pf == 2);
            pf = 0;
            if (h + 1 < 6) SB_LOADQ(qr, h + 1);
            bf16_t* stg = (bf16_t*)(vt + cb * 8192);
#pragma unroll
            for (int r = 0; r < 16; ++r) { const int orow = crow(r, hi); stg[orow * 64 + r32] = (bf16_t)f2bf(o[0][r]); stg[orow * 64 + 32 + r32] = (bf16_t)f2bf(o[1][r]); }
            asm volatile("s_waitcnt lgkmcnt(0)" ::: "memory");
#pragma unroll
            for (int i = 0; i < 4; ++i) { const int row = i * 8 + (lane >> 3), ch = lane & 7; const u32x4 v = *(const u32x4*)(stg + row * 64 + ch * 8);
                float a[8]; unpack8(v, a);
                ssq[i] += ((a[0] * a[0] + a[1] * a[1]) + (a[2] * a[2] + a[3] * a[3])) + ((a[4] * a[4] + a[5] * a[5]) + (a[6] * a[6] + a[7] * a[7]));
                *(u32x4*)(Ymix + (size_t)(row0 + row) * D + h * 64 + ch * 8) = v; }
            asm volatile("s_waitcnt lgkmcnt(0)" ::: "memory");
            if (h + 1 < 6) {
                if (!hit) { SB_DMAV(cb ^ 1, h + 1, jt0); SB_LOADK(kf, h + 1, jt0); }
                cb ^= 1;
            }
        }
        asm volatile("s_waitcnt vmcnt(0)" ::: "memory");
        float rs[4];
#pragma unroll
        for (int i = 0; i < 4; ++i) { float s = ssq[i]; s += __shfl_xor(s, 1); s += __shfl_xor(s, 2); s += __shfl_xor(s, 4); rs[i] = rsqrtf(s * (1.0f / 384.0f) + EPS); }
#pragma unroll 1
        for (int h = 0; h < 6; ++h) { const int ch = lane & 7; const f32x4 g0 = *(const f32x4*)(og + h * 64 + ch * 8), g1 = *(const f32x4*)(og + h * 64 + ch * 8 + 4);
#pragma unroll
            for (int i = 0; i < 4; ++i) { const int row = i * 8 + (lane >> 3); u32x4* pp = (u32x4*)(Ymix + (size_t)(row0 + row) * D + h * 64 + ch * 8); float a[8]; unpack8(*pp, a); const float r = rs[i];
                u32x4 w; w.x = pk2(a[0] * r * g0[0], a[1] * r * g0[1]); w.y = pk2(a[2] * r * g0[2], a[3] * r * g0[3]); w.z = pk2(a[4] * r * g1[0], a[5] * r * g1[1]); w.w = pk2(a[6] * r * g1[2], a[7] * r * g1[3]);
                *pp = w; } }
    }
#undef SB_TILE
#undef SB_LOADK
#undef SB_DMAV
#undef SB_LOADQ
}

namespace ml {
constexpr int QROW = 208, TROW = 144;
constexpr int O_QN = 0, O_KN = 13312, O_KWT = 26624, O_VT = 40448, O_CT = 54272, CT_BYTES = 96 * QROW, O_NV = O_CT + 2 * CT_BYTES, O_TB = O_NV + 768, O_SC = O_TB + 2 * 1280,
              O_MNG = O_SC + 64, O_CW = O_MNG + 384, O_RAW = O_CW + 5 * 192 * 4, NP_QK = 67 * 24, NP_ALL = NP_QK + 64 * 12, O_RAWV = O_RAW + NP_QK * 16, O_DUMMY = O_RAW + 40 * 1024, O_END = O_DUMMY + 1024;
static_assert(O_END <= 147456 && NP_ALL <= 40 * 64 && O_RAW % 16 == 0, "mLSTM LDS map");
typedef short bf16x8 __attribute__((ext_vector_type(8)));
}
DEVI void ph_mlstm(const bf16_t* Z, const float* gates, const float* conv_w, const float* conv_b, const float* igb, const float* fgb, const float* mng, bf16_t* Ymix,
                   unsigned char* smb, int wg, int nwg) {
    using namespace ml;
    const int tid = otid(), lane = tid & 63, wave = __builtin_amdgcn_readfirstlane(tid >> 6), l16 = lane & 15, quad = lane >> 4;
    float* NV = (float*)(smb + O_NV);
    const unsigned raw_lds = (unsigned)(uintptr_t)(smb + O_RAW);
    for (int unit = wg; unit < NB * 4; unit += nwg) {
        const int b = unit >> 2, h = unit & 3; const size_t rb = (size_t)b * SEQ;
#define ML_DMA(n1) do { const char* zb_ = (const char*)Z + ((long)rb + (long)(n1) * 64 - 3) * (NZ * 2); \
            _Pragma("unroll") for (int ins = 0; ins < 5; ++ins) if ((ins * 8 + wave) * 64 + lane < NP_ALL) sb::glds16(zb_ + doff[ins], (unsigned)__builtin_amdgcn_readfirstlane(raw_lds + (ins * 8 + wave) * 1024)); } while (0)
        unsigned doff[5];
#pragma unroll
        for (int ins = 0; ins < 5; ++ins) { const int pidx = (ins * 8 + wave) * 64 + lane;
            if (pidx < NP_QK) { const int r = pidx / 24, seg = pidx - 24 * r; doff[ins] = (unsigned)(r * NZ + (seg < 12 ? ZQB + h * 96 + 8 * seg : ZKB + h * 96 + 8 * (seg - 12))) * 2u; }
            else { const int j = pidx - NP_QK, l = j / 12, seg = j - 12 * l; doff[ins] = (unsigned)((l + 3) * NZ + ZVB + h * 96 + 8 * seg) * 2u; } }
#define ML_WARM(n2) do { if (wave >= 4) { const unsigned dl_ = (unsigned)__builtin_amdgcn_readfirstlane((unsigned)(uintptr_t)(smb + O_DUMMY)); const int wq_ = wave - 4; \
            if ((n2) < 32) { const char* rp_ = (const char*)Z + ((size_t)rb + (size_t)(n2) * 64 + lane) * (NZ * 2) + (size_t)((wq_ == 0 ? ZQB : wq_ == 1 ? ZKB : wq_ == 2 ? ZVB : ZOB) + h * 96) * 2; \
                sb::glds16(rp_, dl_); sb::glds16(rp_ + 128, dl_); } \
            if (wq_ == 3 && (n2) + 1 < 32) { const char* gp_ = (const char*)gates + ((size_t)rb + (size_t)((n2) + 1) * 64) * 32 + lane * 16; sb::glds16(gp_, dl_); sb::glds16(gp_ + 1024, dl_); } } } while (0)
#define ML_GATES(n1, ip, fp) do { float* TBn = (float*)(smb + O_TB) + ((n1) & 1) * 320; float* SCn = (float*)(smb + O_SC) + ((n1) & 1) * 4; \
            float c = -softplusf_(-(fp)); _Pragma("unroll") for (int o = 1; o < 64; o <<= 1) { const float t_ = __shfl_up(c, o); if (lane >= o) c += t_; } \
            const float btot = __shfl(c, 63), a_ = btot - c + (ip), g_ = (ip) - c; float mloc = a_; \
            _Pragma("unroll") for (int o = 32; o >= 1; o >>= 1) mloc = fmaxf(mloc, __shfl_xor(mloc, o)); \
            float pm = g_; _Pragma("unroll") for (int o = 1; o < 64; o <<= 1) { const float t_ = __shfl_up(pm, o); if (lane >= o) pm = fmaxf(pm, t_); } \
            const float mn = fmaxf(btot + mrun, mloc); \
            TBn[lane] = a_; TBn[64 + lane] = g_; TBn[128 + lane] = pm; TBn[192 + lane] = c; TBn[256 + lane] = __expf(a_ - mn); \
            if (lane == 0) { SCn[0] = mrun; SCn[1] = mn; SCn[2] = __expf(btot + mrun - mn); } mrun = mn; } while (0)
#define ML_CONVERT(n1) do { const float* WLn = (const float*)(smb + O_TB) + ((n1) & 1) * 320 + 256; \
            if (tid < 384) { const unsigned char* rw = smb + O_RAW + cc * 2; const int l0 = 16 * rseg; const bool z0 = ((n1) == 0 && rseg == 0); \
                const f32x2_t* cwp_ = (const f32x2_t*)((const float*)(smb + O_CW) + cc); const f32x2_t cw0 = cwp_[0], cw1 = cwp_[96], cw2 = cwp_[192], cw3 = cwp_[288], cbias = cwp_[384]; \
                f32x2_t x0, x1, x2; { const unsigned u0 = *(const unsigned*)(rw + (l0 + 0) * 384), u1 = *(const unsigned*)(rw + (l0 + 1) * 384), u2 = *(const unsigned*)(rw + (l0 + 2) * 384); \
                    x0 = z0 ? (f32x2_t){0.f, 0.f} : (f32x2_t){__uint_as_float(u0 << 16), __uint_as_float(u0 & 0xffff0000u)}; x1 = z0 ? (f32x2_t){0.f, 0.f} : (f32x2_t){__uint_as_float(u1 << 16), __uint_as_float(u1 & 0xffff0000u)}; \
                    x2 = z0 ? (f32x2_t){0.f, 0.f} : (f32x2_t){__uint_as_float(u2 << 16), __uint_as_float(u2 & 0xffff0000u)}; } \
                unsigned char* qk = smb + (which ? O_KN : O_QN) + cd * 2; unsigned char* kwt = smb + O_KWT + cd * TROW; \
                _Pragma("unroll 2") for (int i = 0; i < 16; i += 2) { const int l = l0 + i; \
                    const unsigned ua = *(const unsigned*)(rw + (l + 3) * 384), ub = *(const unsigned*)(rw + (l + 4) * 384); \
                    const f32x2_t xa = {__uint_as_float(ua << 16), __uint_as_float(ua & 0xffff0000u)}, xb = {__uint_as_float(ub << 16), __uint_as_float(ub & 0xffff0000u)}; \
                    f32x2_t ya = cbias + cw0 * x0 + cw1 * x1 + cw2 * x2 + cw3 * xa, yb = cbias + cw0 * x1 + cw1 * x2 + cw2 * xa + cw3 * xb; x0 = x2; x1 = xa; x2 = xb; \
                    f32x2_t oa, ob_; oa.x = ya.x * __builtin_amdgcn_rcpf(1.0f + __expf(-ya.x)); oa.y = ya.y * __builtin_amdgcn_rcpf(1.0f + __expf(-ya.y)); ob_.x = yb.x * __builtin_amdgcn_rcpf(1.0f + __expf(-yb.x)); ob_.y = yb.y * __builtin_amdgcn_rcpf(1.0f + __expf(-yb.y)); \
                    if (which) { oa = oa * 0.10206207261596575f; ob_ = ob_ * 0.10206207261596575f; const float wa = WLn[l], wb = WLn[l + 1]; \
                        *(unsigned*)(kwt + l * 2) = pk2(oa.x * wa, ob_.x * wb); *(unsigned*)(kwt + TROW + l * 2) = pk2(oa.y * wa, ob_.y * wb); } \
                    *(unsigned*)(qk + l * QROW) = pk2(oa.x, oa.y); *(unsigned*)(qk + (l + 1) * QROW) = pk2(ob_.x, ob_.y); } \
            } else { const int idx = tid - 384, lp = idx >> 2, eq = idx & 3; const u32x4* s0 = (const u32x4*)(smb + O_RAWV + (2 * lp) * 192 + eq * 48); const u32x4* s1 = (const u32x4*)(smb + O_RAWV + (2 * lp + 1) * 192 + eq * 48); \
                unsigned char* vt = smb + O_VT + (eq * 24) * TROW + lp * 4; \
                _Pragma("unroll") for (int i = 0; i < 3; ++i) { const u32x4 a = s0[i], b = s1[i]; \
                    *(unsigned*)(vt + (i * 8 + 0) * TROW) = (a.x & 0xffffu) | (b.x << 16); *(unsigned*)(vt + (i * 8 + 1) * TROW) = (a.x >> 16) | (b.x & 0xffff0000u); \
                    *(unsigned*)(vt + (i * 8 + 2) * TROW) = (a.y & 0xffffu) | (b.y << 16); *(unsigned*)(vt + (i * 8 + 3) * TROW) = (a.y >> 16) | (b.y & 0xffff0000u); \
                    *(unsigned*)(vt + (i * 8 + 4) * TROW) = (a.z & 0xffffu) | (b.z << 16); *(unsigned*)(vt + (i * 8 + 5) * TROW) = (a.z >> 16) | (b.z & 0xffff0000u); \
                    *(unsigned*)(vt + (i * 8 + 6) * TROW) = (a.w & 0xffffu) | (b.w << 16); *(unsigned*)(vt + (i * 8 + 7) * TROW) = (a.w >> 16) | (b.w & 0xffff0000u); } } } while (0)
        const int cc = tid < 384 ? 2 * (tid % 96) : 0, rseg = tid < 384 ? tid / 96 : 0, which = cc >= 96 ? 1 : 0, cd = cc - 96 * which;
        if (tid < 192) { const int w_ = tid >= 96 ? 1 : 0, ch_ = w_ * 384 + h * 96 + (tid - 96 * w_); float* cwt = (float*)(smb + O_CW);
            cwt[tid] = conv_w[ch_]; cwt[192 + tid] = conv_w[768 + ch_]; cwt[384 + tid] = conv_w[2 * 768 + ch_]; cwt[576 + tid] = conv_w[3 * 768 + ch_]; cwt[768 + tid] = conv_b[ch_]; }
        float mrun = 0.f;
        ML_DMA(0);
        for (int i = tid; i < CT_BYTES / 4; i += NTHR) ((unsigned*)(smb + O_CT))[i] = 0u;
        if (tid < 96) { NV[tid] = 0.f; ((float*)(smb + O_MNG))[tid] = mng[h * 96 + tid]; }
        if (wave == 7) { const size_t row = rb + lane; const float ip = gates[row * 8 + h] + igb[h], fp = gates[row * 8 + 4 + h] + fgb[h]; ML_GATES(0, ip, fp); }
        asm volatile("s_waitcnt vmcnt(0)" ::: "memory");
        __syncthreads();
        ML_CONVERT(0);
        __syncthreads();
        f32x4 Cst[9];
#pragma unroll
        for (int k = 0; k < 9; ++k) Cst[k] = (f32x4){0.f, 0.f, 0.f, 0.f};
#pragma unroll 1
        for (int n = 0; n < 32; ++n) {
            const int cur = n & 1, nxt = cur ^ 1; const float* SCc = (const float*)(smb + O_SC) + cur * 4; const float m_in = SCc[0], dec = SCc[2];
            const float* TBc = (const float*)(smb + O_TB) + cur * 320;
            const size_t r0 = rb + n * 64;
            if (n + 1 < 32) ML_DMA(n + 1);
            if (wave < 4) {
                const int tt = wave, t = 16 * tt + l16; const size_t row = r0 + t;
                const unsigned char* qn = smb + O_QN; const unsigned char* kn = smb + O_KN; const unsigned char* vtb = smb + O_VT; const unsigned char* ct = smb + O_CT + cur * CT_BYTES;
                bf16x8 bq[3];
#pragma unroll
                for (int ks = 0; ks < 3; ++ks) bq[ks] = *(const bf16x8*)(qn + t * QROW + (32 * ks + 8 * quad) * 2);
                const float Mt = fmaxf(m_in, TBc[128 + t]), inter = __expf(m_in - Mt), flr = __expf(-(TBc[192 + t] + Mt));
                f32x4 P[4]; float psum = 0.f;
#pragma unroll
                for (int st = 0; st < 4; ++st) { P[st] = (f32x4){0.f, 0.f, 0.f, 0.f};
                    if (st <= tt) {
#pragma unroll
                        for (int ks = 0; ks < 3; ++ks) P[st] = __builtin_amdgcn_mfma_f32_16x16x32_bf16(*(const bf16x8*)(kn + (16 * st + l16) * QROW + (32 * ks + 8 * quad) * 2), bq[ks], P[st], 0, 0, 0);
                        const f32x4 gs = *(const f32x4*)(TBc + 64 + 16 * st + 4 * quad);
#pragma unroll
                        for (int j = 0; j < 4; ++j) { const int s_ = 16 * st + 4 * quad + j; const float w = s_ <= t ? __expf(gs[j] - Mt) : 0.f; P[st][j] *= w; psum += P[st][j]; }
                    } }
                psum += __shfl_xor(psum, 16); psum += __shfl_xor(psum, 32);
                float qn_ = 0.f; { const float* nv = NV + cur * 96 + quad * 24; const unsigned char* qp = qn + t * QROW + quad * 48;
#pragma unroll
                    for (int i = 0; i < 3; ++i) { const u32x4 w = *(const u32x4*)(qp + i * 16);
                        qn_ += __uint_as_float(w.x << 16) * nv[i * 8 + 0] + __uint_as_float(w.x & 0xffff0000u) * nv[i * 8 + 1] + __uint_as_float(w.y << 16) * nv[i * 8 + 2] + __uint_as_float(w.y & 0xffff0000u) * nv[i * 8 + 3]
                             + __uint_as_float(w.z << 16) * nv[i * 8 + 4] + __uint_as_float(w.z & 0xffff0000u) * nv[i * 8 + 5] + __uint_as_float(w.w << 16) * nv[i * 8 + 6] + __uint_as_float(w.w & 0xffff0000u) * nv[i * 8 + 7]; } }
                qn_ += __shfl_xor(qn_, 16); qn_ += __shfl_xor(qn_, 32);
                float den = psum + inter * qn_; den = fmaxf(fabsf(den), flr); const float rden = 1.0f / den;
                bf16x8 pk[2];
#pragma unroll
                for (int i = 0; i < 2; ++i) { u32x4 w; w.x = pk2(P[2 * i][0], P[2 * i][1]); w.y = pk2(P[2 * i][2], P[2 * i][3]); w.z = pk2(P[2 * i + 1][0], P[2 * i + 1][1]); w.w = pk2(P[2 * i + 1][2], P[2 * i + 1][3]); pk[i] = __builtin_bit_cast(bf16x8, w); }
                float hv[6][4]; float ss = 0.f;
#pragma unroll
                for (int et = 0; et < 6; ++et) {
                    f32x4 n1 = (f32x4){0.f, 0.f, 0.f, 0.f}, n2 = (f32x4){0.f, 0.f, 0.f, 0.f};
#pragma unroll
                    for (int i = 0; i < 2; ++i) if (2 * i <= tt) { const unsigned char* vp = vtb + (16 * et + l16) * TROW + (32 * i + 4 * quad) * 2;
                        const u32x2 lo = *(const u32x2*)vp, hi2 = *(const u32x2*)(vp + 32); const u32x4 a = {lo.x, lo.y, hi2.x, hi2.y};
                        n1 = __builtin_amdgcn_mfma_f32_16x16x32_bf16(__builtin_bit_cast(bf16x8, a), pk[i], n1, 0, 0, 0); }
#pragma unroll
                    for (int ks = 0; ks < 3; ++ks) n2 = __builtin_amdgcn_mfma_f32_16x16x32_bf16(*(const bf16x8*)(ct + (16 * et + l16) * QROW + (32 * ks + 8 * quad) * 2), bq[ks], n2, 0, 0, 0);
#pragma unroll
                    for (int j = 0; j < 4; ++j) { const float v = (n1[j] + inter * n2[j]) * rden; hv[et][j] = v; ss += v * v; }
                    __builtin_amdgcn_sched_barrier(0);
                }
                u32x2 obv[6];
#pragma unroll
                for (int et = 0; et < 6; ++et) obv[et] = *(const u32x2*)(Z + row * NZ + ZOB + h * 96 + 16 * et + 4 * quad);
                ss += __shfl_xor(ss, 16); ss += __shfl_xor(ss, 32);
                const float rs = rsqrtf(ss * (1.0f / 96.0f) + EPS);
#pragma unroll
                for (int et = 0; et < 6; ++et) { const int e = 16 * et + 4 * quad; const u32x2 ob = obv[et]; const f32x4 mg = *(const f32x4*)((const float*)(smb + O_MNG) + e);
                    u32x2 w; w.x = pk2(hv[et][0] * rs * mg[0] * sigmoidf_(__uint_as_float(ob.x << 16)), hv[et][1] * rs * mg[1] * sigmoidf_(__uint_as_float(ob.x & 0xffff0000u)));
                    w.y = pk2(hv[et][2] * rs * mg[2] * sigmoidf_(__uint_as_float(ob.y << 16)), hv[et][3] * rs * mg[3] * sigmoidf_(__uint_as_float(ob.y & 0xffff0000u)));
                    *(u32x2*)(Ymix + row * D + 384 + h * 96 + e) = w; }
            } else {
                const int wq = wave - 4; const unsigned char* kwt = smb + O_KWT; const unsigned char* vtb = smb + O_VT; unsigned char* ctn = smb + O_CT + nxt * CT_BYTES;
                float gip = 0.f, gfp = 0.f;
                if (wq == 3 && n + 1 < 32) { const size_t row = r0 + 64 + lane; gip = gates[row * 8 + h] + igb[h]; gfp = gates[row * 8 + 4 + h] + fgb[h]; }
#pragma unroll
                for (int k = 0; k < 9; ++k) { const int idx = wq + 4 * k, dt = idx / 6, et = idx - 6 * dt; f32x4 U = (f32x4){0.f, 0.f, 0.f, 0.f};
#pragma unroll
                    for (int ks = 0; ks < 2; ++ks) U = __builtin_amdgcn_mfma_f32_16x16x32_bf16(*(const bf16x8*)(kwt + (16 * dt + l16) * TROW + (32 * ks + 8 * quad) * 2), *(const bf16x8*)(vtb + (16 * et + l16) * TROW + (32 * ks + 8 * quad) * 2), U, 0, 0, 0);
                    Cst[k] = Cst[k] * dec + U;
                    u32x2 w; w.x = pk2(Cst[k][0], Cst[k][1]); w.y = pk2(Cst[k][2], Cst[k][3]);
                    *(u32x2*)(ctn + (16 * et + l16) * QROW + (16 * dt + 4 * quad) * 2) = w; }
                if (wq == 0 || (wq == 1 && lane < 32)) { const int d = wq * 64 + lane; const u32x4* kp = (const u32x4*)(kwt + d * TROW); float sacc = 0.f;
#pragma unroll
                    for (int i = 0; i < 8; ++i) { const u32x4 w = kp[i];
                        sacc += (__uint_as_float(w.x << 16) + __uint_as_float(w.x & 0xffff0000u)) + (__uint_as_float(w.y << 16) + __uint_as_float(w.y & 0xffff0000u))
                              + (__uint_as_float(w.z << 16) + __uint_as_float(w.z & 0xffff0000u)) + (__uint_as_float(w.w << 16) + __uint_as_float(w.w & 0xffff0000u)); }
                    NV[nxt * 96 + d] = dec * NV[cur * 96 + d] + sacc; }
                if (wq == 3 && n + 1 < 32) ML_GATES(n + 1, gip, gfp);
            }
            asm volatile("s_waitcnt vmcnt(0)" ::: "memory");
            __syncthreads();
            ML_WARM(n + 2);
            if (n + 1 < 32) ML_CONVERT(n + 1);
            __syncthreads();
        }
#undef ML_DMA
#undef ML_WARM
#undef ML_GATES
#undef ML_CONVERT
    }
}

namespace sgu {
constexpr int VROW = 272, VGRP = 64 * VROW + 32, MROW = 528, MST_OFF = 71680;
static_assert(4 * VGRP <= MST_OFF && MST_OFF + 128 * MROW <= 147456, "SGU LDS map");
DEVI float gelu_fast(float x) { const float u = 1.5957691216057308f * (x + 0.044715f * x * x * x); return x * __builtin_amdgcn_rcpf(1.0f + __expf(-u)); }
}
DEVI void ph_sgu(const bf16_t* Z, const float* ln_g, const float* ln_b, const bf16_t* Wm, const float* bs, const float* og, bf16_t* Ymix, unsigned char* smb, int wg, int nwg) {
    using namespace sgu; typedef short bf16x8 __attribute__((ext_vector_type(8))); typedef float f32x16 __attribute__((ext_vector_type(16)));
    const int tid = otid(), lane = tid & 63, wave = __builtin_amdgcn_readfirstlane(tid >> 6), r32 = lane & 31, hi = lane >> 5;
    for (int blk = wg; blk < T / 128; blk += nwg) {
        const size_t row0 = (size_t)blk * 128;
        u32x4 uv[8]; { const u32x4* up = (const u32x4*)(Z + (row0 + (tid >> 2)) * NZ + ZUC + (tid & 3) * 64);
#pragma unroll
            for (int i = 0; i < 8; ++i) uv[i] = up[i]; }
        {
            const int tp = tid >> 3, g = (tid >> 1) & 3, hf = tid & 1, c0 = g * 64 + hf * 32;
            u32x4 raw[2][4];
#pragma unroll
            for (int k = 0; k < 2; ++k) { const u32x4* src = (const u32x4*)(Z + (row0 + 2 * tp + k) * NZ + ZVC + c0);
#pragma unroll
                for (int i = 0; i < 4; ++i) raw[k][i] = src[i]; }
            float v[2][32];
#pragma unroll
            for (int k = 0; k < 2; ++k)
#pragma unroll
                for (int i = 0; i < 4; ++i) { float f[8]; unpack8(raw[k][i], f);
#pragma unroll
                    for (int j = 0; j < 8; ++j) v[k][i * 8 + j] = gelu_fast(f[j]); }
            float mu[2], rstd[2];
#pragma unroll
            for (int k = 0; k < 2; ++k) { float s1 = 0.f;
#pragma unroll
                for (int c = 0; c < 32; ++c) s1 += v[k][c];
                s1 += __shfl_xor(s1, 1); mu[k] = s1 * (1.0f / 64.0f); float s2 = 0.f;
#pragma unroll
                for (int c = 0; c < 32; ++c) { const float dd = v[k][c] - mu[k]; s2 += dd * dd; }
                s2 += __shfl_xor(s2, 1); rstd[k] = rsqrtf(s2 * (1.0f / 64.0f) + EPS); }
            unsigned char* dst = smb + g * VGRP + (hf * 32) * VROW + tp * 4;
#pragma unroll
            for (int c = 0; c < 32; ++c) { const float gg = ln_g[c0 + c], bb = ln_b[c0 + c];
                *(unsigned*)(dst + c * VROW) = pk2((v[0][c] - mu[0]) * rstd[0] * gg + bb, (v[1][c] - mu[1]) * rstd[1] * gg + bb); }
        }
        const int g2 = wave >> 1, mh = wave & 1;
        bf16x8 af[2][8];
        { const bf16_t* wa = Wm + ((size_t)g2 * 128 + 64 * mh + r32) * 128 + 8 * hi;
#pragma unroll
            for (int ks = 0; ks < 8; ++ks) if (ks < 4 || mh) { af[0][ks] = *(const bf16x8*)(wa + ks * 16); af[1][ks] = *(const bf16x8*)(wa + 32 * 128 + ks * 16); } }
        asm volatile("s_waitcnt lgkmcnt(0)" ::: "memory"); __builtin_amdgcn_s_barrier(); asm volatile("" ::: "memory");
        {
            f32x16 acc[2][2];
#pragma unroll
            for (int i = 0; i < 2; ++i)
#pragma unroll
                for (int j = 0; j < 2; ++j) acc[i][j] = f32x16{};
            const unsigned char* vb = smb + g2 * VGRP + r32 * VROW + 16 * hi;
#pragma unroll
            for (int ks = 0; ks < 8; ++ks) if (ks < 4 || mh) {
                const bf16x8 b0 = *(const bf16x8*)(vb + ks * 32), b1 = *(const bf16x8*)(vb + 32 * VROW + ks * 32);
                acc[0][0] = __builtin_amdgcn_mfma_f32_32x32x16_bf16(af[0][ks], b0, acc[0][0], 0, 0, 0); acc[0][1] = __builtin_amdgcn_mfma_f32_32x32x16_bf16(af[0][ks], b1, acc[0][1], 0, 0, 0);
                acc[1][0] = __builtin_amdgcn_mfma_f32_32x32x16_bf16(af[1][ks], b0, acc[1][0], 0, 0, 0); acc[1][1] = __builtin_amdgcn_mfma_f32_32x32x16_bf16(af[1][ks], b1, acc[1][1], 0, 0, 0);
            }
            bf16_t* mst = (bf16_t*)(smb + MST_OFF);
#pragma unroll
            for (int mt = 0; mt < 2; ++mt)
#pragma unroll
                for (int r = 0; r < 16; ++r) { const int t = 64 * mh + 32 * mt + (r & 3) + 8 * (r >> 2) + 4 * hi; const float bias = bs[g2 * 128 + t];
                    bf16_t* mp = mst + t * (MROW / 2) + g2 * 64 + r32;
                    mp[0] = (bf16_t)f2bf(acc[mt][0][r] + bias); mp[32] = (bf16_t)f2bf(acc[mt][1][r] + bias); }
        }
        asm volatile("s_waitcnt lgkmcnt(0)" ::: "memory"); __builtin_amdgcn_s_barrier(); asm volatile("" ::: "memory");
        {
            const int t = tid >> 2, g = tid & 3; const size_t row = row0 + t;
            const u32x4* mp = (const u32x4*)(smb + MST_OFF + t * MROW + g * 128);
            float y[64]; float ss = 0.f;
#pragma unroll
            for (int i = 0; i < 8; ++i) { float uf[8], mf[8]; unpack8(uv[i], uf); unpack8(mp[i], mf);
#pragma unroll
                for (int j = 0; j < 8; ++j) { y[i * 8 + j] = gelu_fast(uf[j]) * mf[j]; ss += y[i * 8 + j] * y[i * 8 + j]; } }
            ss += __shfl_xor(ss, 1); ss += __shfl_xor(ss, 2);
            const float rs = rsqrtf(ss * (1.0f / 256.0f) + EPS);
            u32x4* yp = (u32x4*)(Ymix + row * D + 768 + g * 64); const f32x4* gp = (const f32x4*)(og + g * 64);
#pragma unroll
            for (int i = 0; i < 8; ++i) { const f32x4 g0 = gp[2 * i], g1 = gp[2 * i + 1];
                u32x4 w; w.x = pk2(y[i * 8 + 0] * rs * g0[0], y[i * 8 + 1] * rs * g0[1]); w.y = pk2(y[i * 8 + 2] * rs * g0[2], y[i * 8 + 3] * rs * g0[3]);
                w.z = pk2(y[i * 8 + 4] * rs * g1[0], y[i * 8 + 5] * rs * g1[1]); w.w = pk2(y[i * 8 + 6] * rs * g1[2], y[i * 8 + 7] * rs * g1[3]); yp[i] = w; }
        }
        asm volatile("s_waitcnt lgkmcnt(0)" ::: "memory"); __builtin_amdgcn_s_barrier(); asm volatile("" ::: "memory");
    }
}
DEVI void ph_prep_sgu(const float* w, bf16_t* Wm, int wg, int nwg) {
    for (int idx = wg * NTHR + otid(); idx < 4 * 128 * 128; idx += nwg * NTHR) { const int t = (idx >> 7) & 127, s = idx & 127; Wm[idx] = (bf16_t)f2bf(((s >> 6) <= (t >> 6)) ? w[idx] : 0.f); }
}

DEVI void ph_place_all(const unsigned* count, const int* tokE, const float* tokW, int* rank, const float* rstd2, int* row_ts, float* row_w, float* row_rs, int* tile_e, int* n_tiles, unsigned char* smb, int wg, int nwg) {
    int* ps = (int*)smb; int* cnt = ps + 40;
    const int tid = otid(), lane = tid & 63;
    if (tid < 64) { const int c = lane < 32 ? (int)__hip_atomic_load(count + lane, __ATOMIC_RELAXED, __HIP_MEMORY_SCOPE_AGENT) : 0; const int pad = (c + 255) & ~255;
        int incl = pad;
#pragma unroll
        for (int o = 1; o < 32; o <<= 1) { const int t_ = __shfl_up(incl, o); if (lane >= o) incl += t_; }
        if (lane < 32) { cnt[lane] = c; ps[lane] = incl - pad; if (lane == 31) ps[32] = incl; } }
    __syncthreads();
    if (wg == 0) {
        const int nt = ps[32] >> 8;
        if (tid == 0) *n_tiles = nt;
        for (int i = tid; i < nt; i += NTHR) { int e = 0;
#pragma unroll 1
            for (int k = 1; k < 32; ++k) if ((ps[k] >> 8) <= i) e = k;
            tile_e[i] = e; }
        for (int e = 0; e < 32; ++e) for (int r = cnt[e] + tid; r < ps[e + 1] - ps[e]; r += NTHR) { row_ts[ps[e] + r] = -1; row_rs[ps[e] + r] = 0.f; }
    }
    for (int idx = wg * NTHR + tid; idx < 2 * T; idx += nwg * NTHR) { const int pos = ps[tokE[idx]] + rank[idx]; row_ts[pos] = idx; row_w[pos] = tokW[idx]; row_rs[pos] = rstd2[idx >> 1]; rank[idx] = pos; }
    __syncthreads();
}
DEVI void ph_combine(bf16_t* h, const bf16_t* Y, const int* tokpos, float* rstd3, int wg, int nwg) {
    const int tid = otid(), lane = tid & 63, gw = wg * 8 + (tid >> 6), ngw = nwg * 8;
    for (int base = 2 * gw; base < T; base += 32 * ngw) {
        const int myrow = base + 2 * ngw * (lane >> 2) + ((lane >> 1) & 1);
        const int tp = myrow < T ? tokpos[myrow * 2 + (lane & 1)] : 0;
#pragma unroll 1
        for (int k = 0; k < 16; ++k) {
            const int row = base + 2 * ngw * k; if (row >= T) break;
            u32x4 hv[2][2], y0[2][2], y1[2][2];
#pragma unroll
            for (int r = 0; r < 2; ++r) { const int p0 = __builtin_amdgcn_readfirstlane(__shfl(tp, 4 * k + 2 * r)), p1 = __builtin_amdgcn_readfirstlane(__shfl(tp, 4 * k + 2 * r + 1));
#pragma unroll
                for (int jj = 0; jj < 2; ++jj) { hv[r][jj] = ((const u32x4*)(h + (size_t)(row + r) * D) + lane)[64 * jj];
                    y0[r][jj] = __builtin_nontemporal_load((const u32x4*)(Y + (size_t)p0 * D) + lane + 64 * jj); y1[r][jj] = __builtin_nontemporal_load((const u32x4*)(Y + (size_t)p1 * D) + lane + 64 * jj); } }
#pragma unroll
            for (int r = 0; r < 2; ++r) { float s = 0.f;
#pragma unroll
                for (int jj = 0; jj < 2; ++jj) { float a[8], b0[8], b1[8]; unpack8(hv[r][jj], a); unpack8(y0[r][jj], b0); unpack8(y1[r][jj], b1);
#pragma unroll
                    for (int i = 0; i < 8; ++i) { a[i] += b0[i] + b1[i]; s += a[i] * a[i]; }
                    u32x4 w; w.x = pk2(a[0], a[1]); w.y = pk2(a[2], a[3]); w.z = pk2(a[4], a[5]); w.w = pk2(a[6], a[7]); ((u32x4*)(h + (size_t)(row + r) * D) + lane)[64 * jj] = w; }
                s = wave_sum(s);
                if (lane == 0) rstd3[row + r] = rsqrtf(s * (1.0f / 1024.0f) + EPS); }
        }
    }
}
DEVI void ph_final(const bf16_t* h, float* out, const float* ssp, const float* g, int wg, int nwg) {
    const int tid = otid(), lane = tid & 63, gw = wg * 8 + (tid >> 6), ngw = nwg * 8;
    const f32x4* gp = (const f32x4*)g + 2 * lane; const f32x4 g00 = gp[0], g01 = gp[1], g10 = gp[128], g11 = gp[129];
    for (int row = 2 * gw; row < T; row += 2 * ngw) {
        u32x4 hv[2][2]; float sp[2];
#pragma unroll
        for (int r = 0; r < 2; ++r) { sp[r] = lane < 16 ? ssp[(size_t)(row + r) * 16 + lane] : 0.f;
#pragma unroll
            for (int jj = 0; jj < 2; ++jj) hv[r][jj] = ((const u32x4*)(h + (size_t)(row + r) * D) + lane)[64 * jj]; }
#pragma unroll
        for (int r = 0; r < 2; ++r) { const float rs = rsqrtf(wave_sum(sp[r]) * (1.0f / 1024.0f) + EPS); f32x4* op = (f32x4*)(out + (size_t)(row + r) * D) + 2 * lane;
#pragma unroll
            for (int jj = 0; jj < 2; ++jj) { float a[8]; unpack8(hv[r][jj], a); const f32x4 g0 = jj ? g10 : g00, g1 = jj ? g11 : g01;
                op[128 * jj] = (f32x4){a[0] * rs * g0[0], a[1] * rs * g0[1], a[2] * rs * g0[2], a[3] * rs * g0[3]}; op[128 * jj + 1] = (f32x4){a[4] * rs * g1[0], a[5] * rs * g1[1], a[6] * rs * g1[2], a[7] * rs * g1[3]}; } }
    }
}

enum { IN_X = 0, IN_P, IN_NORM1G, IN_WIN, IN_CONVW, IN_CONVB, IN_IGB, IN_FGB, IN_MNG, IN_SBOG, IN_SGULNG, IN_SGULNB, IN_SGUW, IN_SGUB, IN_SGUOG, IN_WOUT, IN_NORM2G,
       IN_RGW, IN_RGB, IN_REW, IN_REB, IN_WGATE, IN_WUP, IN_WDOWN, IN_PLENG, IN_PLEGW, IN_PLEPW, IN_FINALG, N_INPUTS };
constexpr int NPH_LAYER = 9, NPHASES = 1 + DEPTH * NPH_LAYER + 1;
struct Params { const float* in[N_INPUTS]; float* out; unsigned char* ws; int ph_lo, ph_hi; };
static_assert(sizeof(Params) == N_INPUTS * 8 + 8 + 8 + 8, "Params has no padding");

__global__ void __launch_bounds__(NTHR, 2) mega(Params p) {
    extern __shared__ __attribute__((aligned(16))) unsigned char lds[];
    const int tid = threadIdx.x, wg = blockIdx.x, nwg = gridDim.x;
    for (int u = tid; u < (LDS_BYTES - MISC_OFF) / 4; u += NTHR) ((LAS unsigned*)(lds + MISC_OFF))[u] = 0u;
    __syncthreads();
    unsigned char* const ws0 = p.ws;
    const bool fused = (p.ph_hi - p.ph_lo) > 1;
    XcdBarrier bar; bar.bar = (unsigned*)(ws0 + WS_CTL) + CW_BAR; bar.x = 0; bar.st = nullptr;
    if (fused) bar = xcd_barrier_post((unsigned*)(ws0 + WS_CTL) + CW_BAR, (volatile LAS unsigned*)(lds + MISC_OFF));
    PG8_LAS unsigned char* ring = (PG8_LAS unsigned char*)lds;
#define WSP(type, off) ((type)(ws + (off)))
#define PH_LOCALS size_t zo_ = 0; asm volatile("" : "+s"(zo_)); unsigned char* ws = ws0 + zo_; float* out = p.out + zo_;   \
        unsigned char* wl = ws + WS_WTS + (size_t)l * WL_SIZE; (void)wl; (void)out; \
        bf16_t* const HIN = (bf16_t*)(ws + ((l & 1) ? WS_HBB : WS_HBA)); bf16_t* const HOUT = (bf16_t*)(ws + ((l & 1) ? WS_HBA : WS_HBB)); (void)HIN; (void)HOUT;

    int gp = 0;
#define PH_ON (p.ph_lo <= gp && gp < p.ph_hi)
#define PH_END do { if (fused && gp + 1 < p.ph_hi) for (int rb_ = 0; rb_ < REP_BAR; ++rb_) xcd_barrier(bar); ++gp; } while (0)

    if (PH_ON) for (int rep = 0; rep < REP_PRO; ++rep) {
#pragma unroll 1
        for (int l = 0; l < DEPTH; ++l) {
            PH_LOCALS
            { const PrepJob j{p.in[IN_WIN] + (size_t)l * D * 3208, nullptr, p.in[IN_NORM1G] + l * D, (bf16_t*)(wl + WL_IN), 3208, D, NZ, 1, 1, 0, 0, 0}; ph_prep_w(j, lds, wg, nwg); }
            { const PrepJob j{p.in[IN_WOUT] + (size_t)l * D * D, nullptr, nullptr, (bf16_t*)(wl + WL_OUT), D, D, D, 0, 1, 0, 0, 0}; ph_prep_w(j, lds, wg, nwg); }
            { const PrepJob j{p.in[IN_WGATE] + (size_t)l * NEXP * D * DEXP, p.in[IN_WUP] + (size_t)l * NEXP * D * DEXP, p.in[IN_NORM2G] + l * D, (bf16_t*)(wl + WL_GU), DEXP, D, 512, 2, NEXP, 0, (size_t)D * DEXP, (size_t)512 * D};
              ph_prep_w(j, lds, wg, nwg); }
            { const PrepJob j{p.in[IN_WDOWN] + (size_t)l * NEXP * DEXP * D, nullptr, nullptr, (bf16_t*)(wl + WL_DN), D, DEXP, D, 0, NEXP, 0, (size_t)DEXP * D, (size_t)D * DEXP}; ph_prep_w(j, lds, wg, nwg); }
            { const PrepJob j{p.in[IN_PLEGW] + (size_t)l * D * D, nullptr, p.in[IN_PLENG] + l * D, (bf16_t*)(wl + WL_PG), D, D, D, 0, 1, 0, 0, 0}; ph_prep_w(j, lds, wg, nwg); }
            { const PrepJob j{p.in[IN_PLEPW] + (size_t)l * PDIM * D, nullptr, nullptr, (bf16_t*)(wl + WL_PP), D, PDIM, D, 0, 1, 0, 0, 0}; ph_prep_w(j, lds, wg, nwg); }
            ph_prep_sgu(p.in[IN_SGUW] + (size_t)l * 4 * 128 * 128, WSP(bf16_t*, WS_WSGU) + (size_t)l * 4 * 128 * 128, wg, nwg);
            ph_prep_router(p.in[IN_RGW] + l * D * 4, p.in[IN_REW] + l * D * 32, p.in[IN_NORM2G] + l * D, WSP(bf16_t*, WS_WR) + (size_t)l * 256 * D, wg, nwg);
        }
        { const int l = 0; PH_LOCALS
          ph_prep_x(p.in[IN_X], WSP(bf16_t*, WS_HBA), WSP(float*, WS_SSP), wg, nwg);
          ph_cvt_bf16(p.in[IN_P], WSP(bf16_t*, WS_PB), (size_t)DEPTH * T * PDIM / 4, wg, nwg); }
    }
    PH_END;

#pragma clang loop unroll(full)
    for (int l = 0; l < DEPTH; ++l) {
        if (PH_ON) { PH_LOCALS
            pg8::Gemm g{HIN, (const bf16_t*)(wl + WL_IN), T, NZ, D, 0}; pg8::StaticOrder S; S.init(T, NZ, nwg, wg); const float* rtab = (const float*)(lds + 131072);
            { const int tid_ = otid(); const float* ssp_ = WSP(const float*, WS_SSP);
              for (int i = tid_ >> 8; ; i += 2) { pg8::Unit u_; if (!S.next(i & ~1, u_)) break; if (S.next(i, u_)) { const f32x4* sp = (const f32x4*)(ssp_ + (size_t)(u_.pm * 256 + (tid_ & 255)) * 16);
                  const f32x4 st = (sp[0] + sp[1]) + (sp[2] + sp[3]); ((float*)(lds + 131072))[i * 256 + (tid_ & 255)] = rsqrtf(((st[0] + st[1]) + (st[2] + st[3])) * (1.0f / 1024.0f) + EPS); } }
              __syncthreads(); }
            EpiZ E{WSP(bf16_t*, WS_Z), rtab, WSP(float*, WS_GATES)};
            if (STG_Z) stagger(wg, STG_Z);
            for (int rep = 0; rep < REP_Z; ++rep) pg8::gemm_phase<EpiZ, pg8::StaticOrder, AL_Z, true>(ring, g, S, E); }
        PH_END;
        if (PH_ON) { PH_LOCALS
            const int nh = nwg >> 1;
            if (wg < nh) {
                for (int rep = 0; rep < REP_ML; ++rep) ph_mlstm(WSP(const bf16_t*, WS_Z), WSP(const float*, WS_GATES), p.in[IN_CONVW] + l * 4 * 768, p.in[IN_CONVB] + l * 768, p.in[IN_IGB] + l * 4, p.in[IN_FGB] + l * 4, p.in[IN_MNG] + l * 384, WSP(bf16_t*, WS_YMIX), lds, wg, nh);
            } else {
                for (int rep = 0; rep < REP_SB; ++rep) { ph_sb(WSP(const bf16_t*, WS_Z), p.in[IN_SBOG] + l * 384, WSP(bf16_t*, WS_YMIX), lds, wg - nh, nwg - nh); __syncthreads(); }
                for (int rep = 0; rep < REP_SGU; ++rep) ph_sgu(WSP(const bf16_t*, WS_Z), p.in[IN_SGULNG] + l * 256, p.in[IN_SGULNB] + l * 256, WSP(const bf16_t*, WS_WSGU) + (size_t)l * 4 * 128 * 128, p.in[IN_SGUB] + l * 4 * 128, p.in[IN_SGUOG] + l * 256, WSP(bf16_t*, WS_YMIX), lds, wg - nh, nwg - nh);
            }
        }
        PH_END;
        if (PH_ON) { PH_LOCALS
            pg8::Gemm g{WSP(const bf16_t*, WS_YMIX), (const bf16_t*)(wl + WL_OUT), T, D, D, 0}; pg8::StaticOrder S; S.init(T, D, nwg, wg); EpiResid E{HIN, HIN, WSP(float*, WS_SSP2)};
            if (REP_WOUT0 > 1) { EpiResid E2{HIN, WSP(bf16_t*, WS_Z), WSP(float*, WS_Z + 400 * MiB)}; for (int rep = 1; rep < REP_WOUT0; ++rep) pg8::gemm_phase<EpiResid, pg8::StaticOrder, AL_WOUT, true>(ring, g, S, E2); }
            if (STG_WOUT) stagger(wg, STG_WOUT);
            pg8::gemm_phase<EpiResid, pg8::StaticOrder, AL_WOUT, true>(ring, g, S, E); }
        PH_END;
        if (PH_ON) { PH_LOCALS
            pg8::Gemm g{HIN, WSP(const bf16_t*, WS_WR) + (size_t)l * 256 * D, T, 256, D, 0}; pg8::StaticOrder S; S.init(T, 256, nwg, wg);
            EpiRouter E{WSP(const float*, WS_SSP2), p.in[IN_RGB] + l * 4, p.in[IN_REB] + l * 32, WSP(int*, WS_TOKE), WSP(float*, WS_TOKW), WSP(float*, WS_RSTD2), WSP(int*, WS_RANK), WSP(unsigned*, WS_CTL) + CW_COUNT + 32 * l};
            pg8::gemm_phase<EpiRouter, pg8::StaticOrder, false, true>(ring, g, S, E); }
        PH_END;
        if (PH_ON) { PH_LOCALS
            for (int rep = 0; rep < REP_PLACE; ++rep) ph_place_all(WSP(const unsigned*, WS_CTL) + CW_COUNT + 32 * l, WSP(const int*, WS_TOKE), WSP(const float*, WS_TOKW), WSP(int*, WS_RANK), WSP(const float*, WS_RSTD2), WSP(int*, WS_ROWTS), WSP(float*, WS_ROWW), WSP(float*, WS_ROWRS),
                         WSP(int*, WS_TILEE), WSP(int*, WS_CTL) + CW_NTILES + l, lds, wg, nwg); }
        PH_END;
        if (PH_ON) { PH_LOCALS
            pg8::Gemm g{HIN, (const bf16_t*)(wl + WL_GU), MAXROWS, 512, D, 0}; MoeGatherOrder S; S.ntot = 0; S.nN = 2; S.G = 0; S.c = 0; S.tile_e = (const int*)(lds + 131072); S.estride = (size_t)512 * D * 2; S.row_ts = WSP(const int*, WS_ROWTS);
            { const int tid_ = otid(); const int nt_ = *(WSP(const int*, WS_CTL) + CW_NTILES + l); for (int i = tid_; i < nt_; i += NTHR) ((int*)(lds + 131072))[i] = WSP(const int*, WS_TILEE)[i]; __syncthreads(); }
            S.bind(WSP(const int*, WS_CTL) + CW_NTILES + l, nwg, wg);
            EpiGU E{WSP(const float*, WS_ROWRS), WSP(bf16_t*, WS_HID)};
            if (STG_GU) stagger(wg, STG_GU);
            for (int rep = 0; rep < REP_GU; ++rep) pg8::gemm_phase<EpiGU, MoeGatherOrder, AL_GU, true>(ring, g, S, E); }
        PH_END;
        if (PH_ON) { PH_LOCALS
            pg8::Gemm g{WSP(const bf16_t*, WS_HID), (const bf16_t*)(wl + WL_DN), MAXROWS, D, DEXP, 0}; MoeOrder S{0, 4, 0, 0, (const int*)(lds + 131072), (size_t)D * DEXP * 2};
            { const int tid_ = otid(); const int nt_ = *(WSP(const int*, WS_CTL) + CW_NTILES + l); for (int i = tid_; i < nt_; i += NTHR) ((int*)(lds + 131072))[i] = WSP(const int*, WS_TILEE)[i]; __syncthreads(); }
            S.bind(WSP(const int*, WS_CTL) + CW_NTILES + l, nwg, wg);
            EpiDown E{WSP(const float*, WS_ROWW), WSP(bf16_t*, WS_Y)};
            if (STG_DOWN) stagger(wg, STG_DOWN);
            for (int rep = 0; rep < REP_DOWN; ++rep) pg8::gemm_phase<EpiDown, MoeOrder, AL_DOWN, true>(ring, g, S, E); }
        PH_END;
        if (PH_ON) { PH_LOCALS
            ph_combine(HIN, WSP(const bf16_t*, WS_Y), WSP(const int*, WS_RANK), WSP(float*, WS_RSTD3), wg, nwg);
            __syncthreads();
            pg8::Gemm g{WSP(const bf16_t*, WS_PB) + (size_t)l * T * PDIM, (const bf16_t*)(wl + WL_PP), T, D, PDIM, 0}; pg8::StaticOrder S; S.init(T, D, nwg, wg); EpiPlain E{WSP(bf16_t*, WS_YMIX), D, 0};
            for (int rep = 0; rep < REP_PP; ++rep) pg8::gemm_phase<EpiPlain, pg8::StaticOrder, AL_PP, true>(ring, g, S, E);
        }
        PH_END;
        if (PH_ON) { PH_LOCALS
            pg8::Gemm g{HIN, (const bf16_t*)(wl + WL_PG), T, D, D, 0}; pg8::StaticOrder S; S.init(T, D, nwg, wg); EpiPLE E{WSP(const float*, WS_RSTD3), WSP(const bf16_t*, WS_YMIX), HIN, HOUT, WSP(float*, WS_SSP)};
            if (STG_PLE) stagger(wg, STG_PLE);
            if (REP_PLE > 1) { EpiPLE E2{WSP(const float*, WS_RSTD3), WSP(const bf16_t*, WS_YMIX), HIN, WSP(bf16_t*, WS_Z), WSP(float*, WS_Z + 400 * MiB)}; for (int rep = 1; rep < REP_PLE; ++rep) pg8::gemm_phase<EpiPLE, pg8::StaticOrder, AL_PLE, true>(ring, g, S, E2); }
            pg8::gemm_phase<EpiPLE, pg8::StaticOrder, AL_PLE, true>(ring, g, S, E); }
        PH_END;
    }
    if (PH_ON) { const int l = 0; PH_LOCALS
        ph_final(WSP(const bf16_t*, (DEPTH & 1) ? WS_HBB : WS_HBA), out, WSP(const float*, WS_SSP), p.in[IN_FINALG], wg, nwg); }
#undef PH_ON
#undef PH_END
}

#ifndef REP_SB
#define REP_SB 1
#endif
#ifndef REP_ML
#define REP_ML 1
#endif
#ifndef REP_SGU
#define REP_SGU 1
#endif
#ifndef MK_SPLIT
#define MK_SPLIT 0
#endif
extern "C" void kernel_launch(void* const* d_in, const int* in_sizes, int n_in, void* d_out, int out_size, void* d_ws, size_t ws_size, hipStream_t stream) {
    static int grid = 0;
    if (grid == 0) {
        if (n_in != N_INPUTS || in_sizes[0] != T * D || out_size != T * D || ws_size < WS_END) { fprintf(stderr, "kernel_launch: unexpected shapes / workspace (%d inputs, ws %zu)\n", n_in, ws_size); grid = -1; return; }
        int dev = 0, cus = 0;
        if (hipGetDevice(&dev) != hipSuccess || hipDeviceGetAttribute(&cus, hipDeviceAttributeMultiprocessorCount, dev) != hipSuccess) { grid = -1; return; }
        if (hipFuncSetAttribute((const void*)mega, hipFuncAttributeMaxDynamicSharedMemorySize, LDS_BYTES) != hipSuccess) { grid = -1; return; }
        int per_cu = 0;
        if (hipOccupancyMaxActiveBlocksPerMultiprocessor(&per_cu, (const void*)mega, NTHR, LDS_BYTES) != hipSuccess || per_cu < 1) fprintf(stderr, "kernel_launch: occupancy query says %d\n", per_cu);
        (void)hipGetLastError();
        grid = cus;
        if (grid != 256) { fprintf(stderr, "kernel_launch: built for 256 CUs (one router unit per workgroup)\n"); grid = -1; return; }
        if (grid < 208) { fprintf(stderr, "kernel_launch: built for >= 208 CUs (LDS table of 16 units per workgroup in the input projection)\n"); grid = -1; return; }
    }
    if (grid < 0) return;
    (void)hipMemsetAsync((unsigned char*)d_ws + WS_CTL, 0, 1 * MiB, stream);
    Params p{};
    for (int i = 0; i < N_INPUTS; ++i) p.in[i] = (const float*)d_in[i];
    p.out = (float*)d_out; p.ws = (unsigned char*)d_ws;
#if MK_SPLIT
    for (int ph = 0; ph < NPHASES; ++ph) { p.ph_lo = ph; p.ph_hi = ph + 1; hipLaunchKernelGGL(mega, dim3(grid), dim3(NTHR), LDS_BYTES, stream, p); }
#else
    p.ph_lo = 0; p.ph_hi = NPHASES;
    hipLaunchKernelGGL(mega, dim3(grid), dim3(NTHR), LDS_BYTES, stream, p);
#endif
}
```

```cpp
#include <hip/hip_runtime.h>
#include <cstdio>
#include <cstdint>
namespace pg8 {
#define PG8_LAS __attribute__((address_space(3)))
typedef unsigned short bf16_t;
typedef short bf16x8 __attribute__((ext_vector_type(8)));
typedef float f32x4 __attribute__((ext_vector_type(4)));
typedef unsigned u32x4 __attribute__((ext_vector_type(4)));
constexpr int BM = 256, BK = 64, HALF = 128, HTB = HALF * BK * 2  , STAGE_BYTES = 8 * HTB, NXCD = 8, WGM = 8;

__host__ __device__ __forceinline__ int lds_byte(int r, int c) { const int st = (r >> 4) * 2 + (c >> 5), rr = r & 15, cc = c & 31, ob = rr * 64 + cc * 2; return st * 1024 + (ob ^ (((ob >> 9) & 1) << 5)); }
__host__ __device__ __forceinline__ void stage_rc(int b, int& R, int& C) { const int st = b / 1024, sb = b % 1024, swz = sb ^ (((sb >> 9) & 1) << 5); R = (st >> 1) * 16 + swz / 64; C = (st & 1) * 32 + (swz % 64) / 2; }
__host__ __device__ __forceinline__ int perm32(int rho) { const int n = rho >> 4, i = rho & 15; return 8 * (i >> 2) + 4 * n + (i & 3); }

struct Unit { int pm, pn, ord; };
struct Gemm { const bf16_t* A; const bf16_t* Bt; int M, N, K, pad; };

struct StaticOrder {
    static constexpr bool GATHER = false;
    int nM, nN, nwg, G, c;
    __host__ __device__ __forceinline__ void init(int M, int N, int G_, int c_) { nM = M / BM; nN = N / BM; nwg = nM * nN; G = G_; c = c_; }
    __host__ __device__ __forceinline__ bool next(int i, Unit& u) const {
        const long L = (long)i * G + c; if (L >= nwg) return false;
        int wgid = (int)L; { const int q = nwg / NXCD, r = nwg % NXCD, xcd = wgid % NXCD, off = wgid / NXCD; wgid = (xcd < r ? xcd * (q + 1) : r * (q + 1) + (xcd - r) * q) + off; }
        const int nig = WGM * nN, gid = wgid / nig, fm = gid * WGM, gsz = (nM - fm) < WGM ? (nM - fm) : WGM;
        u.pm = fm + ((wgid % nig) % gsz); u.pn = (wgid % nig) / gsz; return true;
    }
    __device__ __forceinline__ size_t bbase(const Unit& u, size_t tstep) const { return (size_t)u.pn * tstep; }
    __device__ __forceinline__ int arow(const Unit&, int) const { return 0; }
    __device__ __forceinline__ void a_ready(const Unit&) const {}
    __device__ __forceinline__ void done(const Unit&) const {}
};

__device__ __forceinline__ unsigned cvt_pk_bf16(float lo, float hi) { unsigned r; asm volatile("v_cvt_pk_bf16_f32 %0, %1, %2" : "=v"(r) : "v"(lo), "v"(hi)); return r; }
typedef float f32x2 __attribute__((ext_vector_type(2)));
template <class Epi, class Sched, bool ALIGN_EPI = false, bool SP2 = false>
__device__ __forceinline__ void gemm_phase(PG8_LAS unsigned char* lds, const Gemm g, const Sched& S, const Epi& E) {
    int tid_ = threadIdx.x; asm volatile("" : "+v"(tid_));
    const int tid = tid_, wid = __builtin_amdgcn_readfirstlane(tid >> 6), lane = tid & 63, wr = wid >> 2, wc = wid & 3, fr = lane & 15, fq = lane >> 4;
    int K_ = g.K; asm volatile("" : "+s"(K_));
    const int K = K_, nt = K / BK;
    unsigned voffA[2], voffB[2]; int gR[2], gC[2]; unsigned va[2][2], vnx[2][2];
#pragma unroll
    for (int i = 0; i < 2; ++i) { int R, C; stage_rc(tid * 16 + i * 8192, R, C); const int Rb = Epi::PERM ? ((R & ~31) + perm32(R & 31)) : R;
        voffA[i] = (unsigned)(R * K + C) * 2u; voffB[i] = (unsigned)(Rb * K + C) * 2u; gR[i] = R; gC[i] = C; }
    const size_t kstep = (size_t)(BK * 2);
    const size_t hstep = (size_t)HALF * K * 2;
    const size_t tstep = 2 * hstep;
    const unsigned ldsw = (unsigned)wid * 1024u;
    const int aoff = lds_byte(wr * 64 + fr, fq * 8), boff = lds_byte(wc * 32 + fr, fq * 8);
#define PG8_SA(b, h) (((b) * 2 + (h)) * HTB)
#define PG8_SB(b, h) ((4 + (b) * 2 + (h)) * HTB)
#define PG8_STAGE(bufoff, gbase, voff) do { _Pragma("unroll") for (int _i = 0; _i < 2; ++_i) \
        __builtin_amdgcn_global_load_lds((const unsigned*)((const char*)(gbase) + (voff)[_i]), (PG8_LAS unsigned*)(lds + (bufoff) + ldsw + _i * 8192), 16, 0, 0); } while (0)
#define PG8_STAGE_A(bufoff, kptr, h, nx) do { if constexpr (Sched::GATHER) { const unsigned o_[2] = {(nx) ? vnx[h][0] : va[h][0], (nx) ? vnx[h][1] : va[h][1]}; PG8_STAGE(bufoff, kptr, o_); } \
        else { PG8_STAGE(bufoff, (kptr) + (h) * hstep, voffA); } } while (0)
#define PG8_GOFF(dst, u) do { _Pragma("unroll") for (int h_ = 0; h_ < 2; ++h_) _Pragma("unroll") for (int i_ = 0; i_ < 2; ++i_) dst[h_][i_] = (unsigned)S.arow(u, h_ * HALF + gR[i_]) * (unsigned)(K * 2) + (unsigned)(gC[i_] * 2); } while (0)
#define PG8_LDA(dst, b, h) do { _Pragma("unroll") for (int m = 0; m < 4; ++m) _Pragma("unroll") for (int k = 0; k < 2; ++k) dst[m][k] = *(const PG8_LAS bf16x8*)(lds + PG8_SA(b, h) + aoff + m * 2048 + k * 1024); } while (0)
#define PG8_LDB(dst, b, h) do { _Pragma("unroll") for (int n = 0; n < 2; ++n) _Pragma("unroll") for (int k = 0; k < 2; ++k) dst[n][k] = *(const PG8_LAS bf16x8*)(lds + PG8_SB(b, h) + boff + n * 2048 + k * 1024); } while (0)
#define PG8_MMA(ai, bj, At, Bt) do { __builtin_amdgcn_s_setprio(1); _Pragma("unroll") for (int m = 0; m < 4; ++m) _Pragma("unroll") for (int n = 0; n < 2; ++n) _Pragma("unroll") for (int k = 0; k < 2; ++k) \
        acc[ai][bj][m][n] = __builtin_amdgcn_mfma_f32_16x16x32_bf16(Bt[n][k], At[m][k], acc[ai][bj][m][n], 0, 0, 0); __builtin_amdgcn_s_setprio(0); } while (0)
#define PG8_WAIT_V(n) asm volatile("s_waitcnt vmcnt(" #n ")" ::: "memory")
#define PG8_WAIT_L(n) asm volatile("s_waitcnt lgkmcnt(" #n ")" ::: "memory")
#define PG8_BAR __builtin_amdgcn_s_barrier()
#define PG8_SCHED __builtin_amdgcn_sched_barrier(0)
    Unit cur, nxt; int ui = 0;
    if (!S.next(0, cur)) return;
    cur.ord = 0;
    f32x4 acc[2][2][4][2];
#pragma unroll
    for (int a = 0; a < 2; ++a)
#pragma unroll
        for (int b = 0; b < 2; ++b)
#pragma unroll
            for (int m = 0; m < 4; ++m)
#pragma unroll
                for (int n = 0; n < 2; ++n) acc[a][b][m][n] = (f32x4){0.f, 0.f, 0.f, 0.f};
    bf16x8 At[4][2], B0[2][2], B1[2][2];
    static_assert(!Sched::GATHER || SP2, "the gathered A operand is wired into the SP2 loop only");
    const char* cA = (const char*)g.A + (Sched::GATHER ? (size_t)0 : (size_t)cur.pm * tstep); const char* cB = (const char*)g.Bt + S.bbase(cur, tstep);
    if constexpr (Sched::GATHER) { PG8_GOFF(va, cur); _Pragma("unroll") for (int h_ = 0; h_ < 2; ++h_) _Pragma("unroll") for (int i_ = 0; i_ < 2; ++i_) vnx[h_][i_] = va[h_][i_]; }
    S.a_ready(cur);
    if constexpr (SP2) {
        PG8_STAGE(PG8_SB(0, 0), cB, voffB); PG8_STAGE(PG8_SB(0, 1), cB + hstep, voffB); PG8_STAGE_A(PG8_SA(0, 0), cA, 0, false); PG8_STAGE_A(PG8_SA(0, 1), cA, 1, false);
        if (wr == 1) PG8_BAR;
        PG8_WAIT_V(2); PG8_BAR;
        PG8_STAGE(PG8_SB(1, 0), cB + kstep, voffB); PG8_STAGE_A(PG8_SA(1, 0), cA + kstep, 0, false); PG8_STAGE(PG8_SB(1, 1), cB + hstep + kstep, voffB);
        PG8_WAIT_V(6); PG8_BAR;
    } else {
        PG8_STAGE(PG8_SB(0, 0), cB, voffB); PG8_STAGE(PG8_SA(0, 0), cA, voffA); PG8_STAGE(PG8_SB(0, 1), cB + hstep, voffB); PG8_STAGE(PG8_SA(0, 1), cA + hstep, voffA);
        if (wr == 1) PG8_BAR;
        PG8_WAIT_V(4); PG8_BAR;
        PG8_STAGE(PG8_SB(1, 0), cB + kstep, voffB); PG8_STAGE(PG8_SA(1, 0), cA + kstep, voffA); PG8_STAGE(PG8_SB(1, 1), cB + hstep + kstep, voffB);
        PG8_WAIT_V(6); PG8_BAR;
    }
    for (;;) {
        const bool has_next = S.next(ui + 1, nxt); nxt.ord = ui + 1;
        if constexpr (Sched::GATHER) { if (has_next) PG8_GOFF(vnx, nxt); }
        const char* nA = (has_next && !Sched::GATHER) ? (const char*)g.A + (size_t)nxt.pm * tstep : cA; const char* nB = has_next ? (const char*)g.Bt + S.bbase(nxt, tstep) : cB;
        for (int t = 0; t < nt; t += 2) {
            const bool last = (t == nt - 2); const bool lastnx = last && has_next; (void)lastnx;
            const char* a1 = cA + (size_t)(t + 1) * kstep;
            const char* a2 = last ? nA : cA + (size_t)(t + 2) * kstep; const char* b2 = last ? nB : cB + (size_t)(t + 2) * kstep;
            const char* a3 = a2 + kstep; const char* b3 = b2 + kstep;
            if (last && has_next) S.a_ready(nxt);
            if constexpr (SP2) {
            PG8_LDB(B0, 0, 0); PG8_LDB(B1, 0, 1); PG8_SCHED; PG8_LDA(At, 0, 0); PG8_STAGE_A(PG8_SA(1, 1), a1, 1, false);
            PG8_WAIT_V(8); PG8_WAIT_L(0); PG8_BAR; PG8_MMA(0, 0, At, B0); PG8_MMA(0, 1, At, B1); PG8_BAR; PG8_SCHED;
            PG8_LDA(At, 0, 1); PG8_STAGE(PG8_SB(0, 0), b2, voffB); PG8_STAGE(PG8_SB(0, 1), b2 + hstep, voffB); PG8_STAGE_A(PG8_SA(0, 0), a2, 0, lastnx);
            PG8_WAIT_V(8); PG8_WAIT_L(0); PG8_BAR; PG8_MMA(1, 0, At, B0); PG8_MMA(1, 1, At, B1); PG8_BAR; PG8_SCHED;
            PG8_LDB(B0, 1, 0); PG8_LDB(B1, 1, 1); PG8_SCHED; PG8_LDA(At, 1, 0); PG8_STAGE_A(PG8_SA(0, 1), a2, 1, lastnx);
            PG8_WAIT_V(8); PG8_WAIT_L(0); PG8_BAR; PG8_MMA(0, 0, At, B0); PG8_MMA(0, 1, At, B1); PG8_BAR; PG8_SCHED;
            PG8_LDA(At, 1, 1); PG8_STAGE(PG8_SB(1, 0), b3, voffB); PG8_STAGE(PG8_SB(1, 1), b3 + hstep, voffB); PG8_STAGE_A(PG8_SA(1, 0), a3, 0, lastnx);
            PG8_WAIT_V(8); PG8_WAIT_L(0); PG8_BAR; PG8_MMA(1, 0, At, B0); PG8_MMA(1, 1, At, B1); PG8_BAR; PG8_SCHED;
            } else {
            PG8_LDB(B0, 0, 0); PG8_SCHED; PG8_LDA(At, 0, 0); PG8_STAGE(PG8_SA(1, 1), a1 + hstep, voffA);
            PG8_WAIT_L(8); PG8_BAR; PG8_WAIT_L(0); PG8_MMA(0, 0, At, B0); PG8_BAR; PG8_SCHED;
            PG8_LDB(B1, 0, 1); PG8_STAGE(PG8_SB(0, 0), b2, voffB);
            PG8_BAR; PG8_WAIT_L(0); PG8_MMA(0, 1, At, B1); PG8_BAR;
            PG8_LDA(At, 0, 1); PG8_STAGE(PG8_SA(0, 0), a2, voffA);
            PG8_BAR; PG8_WAIT_L(0); PG8_MMA(1, 0, At, B0); PG8_BAR; PG8_SCHED;
            PG8_STAGE(PG8_SB(0, 1), b2 + hstep, voffB);
            PG8_WAIT_V(6); PG8_BAR; PG8_MMA(1, 1, At, B1); PG8_BAR;
            PG8_LDB(B0, 1, 0); PG8_SCHED; PG8_LDA(At, 1, 0); PG8_STAGE(PG8_SA(0, 1), a2 + hstep, voffA);
            PG8_WAIT_L(8); PG8_BAR; PG8_WAIT_L(0); PG8_MMA(0, 0, At, B0); PG8_BAR; PG8_SCHED;
            PG8_LDB(B1, 1, 1); PG8_STAGE(PG8_SB(1, 0), b3, voffB);
            PG8_BAR; PG8_WAIT_L(0); PG8_MMA(0, 1, At, B1); PG8_BAR;
            PG8_LDA(At, 1, 1); PG8_STAGE(PG8_SA(1, 0), a3, voffA);
            PG8_BAR; PG8_WAIT_L(0); PG8_MMA(1, 0, At, B0); PG8_BAR; PG8_SCHED;
            PG8_STAGE(PG8_SB(1, 1), b3 + hstep, voffB);
            PG8_WAIT_V(6); PG8_BAR; PG8_MMA(1, 1, At, B1); PG8_BAR;
            }
        }
        if constexpr (ALIGN_EPI) { if (wr == 0) PG8_BAR; }
        if constexpr (!Epi::AFTER_DRAIN) { E(acc, cur, wr, wc, fr, fq); S.done(cur); }
        if (!has_next) break;
#pragma unroll
        for (int a = 0; a < 2; ++a)
#pragma unroll
            for (int b = 0; b < 2; ++b)
#pragma unroll
                for (int m = 0; m < 4; ++m)
#pragma unroll
                    for (int n = 0; n < 2; ++n) acc[a][b][m][n] = (f32x4){0.f, 0.f, 0.f, 0.f};
        cur = nxt; cA = nA; cB = nB; ++ui;
        if constexpr (Sched::GATHER) { _Pragma("unroll") for (int h_ = 0; h_ < 2; ++h_) _Pragma("unroll") for (int i_ = 0; i_ < 2; ++i_) va[h_][i_] = vnx[h_][i_]; }
        if constexpr (ALIGN_EPI) { if (wr == 1) PG8_BAR; }
    }
    PG8_WAIT_V(0);
    if constexpr (!ALIGN_EPI) { if (wr == 0) PG8_BAR; }
    PG8_BAR;
    if constexpr (Epi::AFTER_DRAIN) { E.fused(acc, cur, wr, wc, fr, fq, lds, wid, lane); S.done(cur); }
#undef PG8_SA
#undef PG8_SB
#undef PG8_STAGE
#undef PG8_STAGE_A
#undef PG8_GOFF
#undef PG8_LDA
#undef PG8_LDB
#undef PG8_MMA
#undef PG8_WAIT_V
#undef PG8_WAIT_L
#undef PG8_BAR
#undef PG8_SCHED
}
}

#define DEVI __device__ __forceinline__
typedef unsigned short bf16_t;
typedef float f32x4 __attribute__((ext_vector_type(4)));
typedef unsigned u32x4 __attribute__((ext_vector_type(4)));
typedef unsigned u32x2 __attribute__((ext_vector_type(2)));

constexpr int T = 65536, D = 1024, SEQ = 2048, NB = 32, DEPTH = 2;
constexpr int NZ = 3328;
constexpr int ZQA = 0, ZKA = 384, ZVA = 768, ZIF = 1152, ZQB = 1280, ZKB = 1664, ZVB = 2048, ZOB = 2432, ZUC = 2816, ZVC = 3072;
constexpr int NEXP = 32, DEXP = 256, PDIM = 256;
constexpr int MAXROWS = 2 * T + NEXP * 256;
constexpr float EPS = 1e-6f;

constexpr size_t MiB = 1u << 20;
constexpr size_t WS_CTL = 0;
constexpr size_t WS_GATES = 1 * MiB;
constexpr size_t WS_SSP = 3 * MiB;
constexpr size_t WS_TOKE = 7 * MiB;
constexpr size_t WS_TOKW = 7 * MiB + 512 * 1024;
constexpr size_t WS_RSTD2 = 8 * MiB;
constexpr size_t WS_RSTD3 = 8 * MiB + 256 * 1024;
constexpr size_t WS_RANK = 8 * MiB + 512 * 1024;
constexpr size_t WS_ROWTS = 9 * MiB;
constexpr size_t WS_ROWW = 10 * MiB;
constexpr size_t WS_ROWRS = 11 * MiB + 64 * 1024;
constexpr size_t WS_TILEE = 11 * MiB;
constexpr size_t WS_PSTART = 11 * MiB + 4096;
constexpr size_t WS_WR = 12 * MiB;
constexpr size_t WS_WSGU = 13 * MiB;
constexpr size_t WS_WTS = 16 * MiB;
constexpr size_t WL_IN = 0, WL_OUT = 6656 * 1024, WL_GU = WL_OUT + 2 * MiB, WL_DN = WL_GU + 32 * MiB, WL_PG = WL_DN + 16 * MiB, WL_PP = WL_PG + 2 * MiB, WL_SIZE = 59 * MiB;
constexpr size_t WS_PB = 134 * MiB;
constexpr size_t WS_HBA = 198 * MiB;
constexpr size_t WS_HBB = 326 * MiB;
constexpr size_t WS_YMIX = 454 * MiB;
constexpr size_t WS_Z = 582 * MiB;
constexpr size_t WS_XS = WS_Z, WS_Y = WS_Z, WS_HID = WS_Z + 272 * MiB;
constexpr size_t WS_SSP2 = 998 * MiB;
constexpr size_t WS_END = 1002 * MiB;
static_assert(WL_PP + 512 * 1024 <= WL_SIZE, "weights map");
static_assert((size_t)MAXROWS * 1024 * 2 <= 272 * MiB && (size_t)MAXROWS * 256 * 2 <= 68 * MiB, "overlay map");
constexpr int CW_COUNT = 0;
constexpr int CW_NTILES = 64;

DEVI float bf2f(unsigned short b) { return __uint_as_float((unsigned)b << 16); }
typedef float f32x2_t __attribute__((ext_vector_type(2))); typedef __bf16 bf16x2_t __attribute__((ext_vector_type(2)));
DEVI unsigned pk2(float lo, float hi) { const f32x2_t v = {lo, hi}; return __builtin_bit_cast(unsigned, __builtin_convertvector(v, bf16x2_t)); }
DEVI unsigned f2bf(float f) { return pk2(f, 0.f) & 0xffffu; }
DEVI float wave_sum(float v) {
#pragma unroll
    for (int o = 1; o < 64; o <<= 1) v += __shfl_xor(v, o);
    return v;
}
DEVI float sigmoidf_(float x) { return 1.0f / (1.0f + __expf(-x)); }
DEVI float siluf_(float x) { return x * sigmoidf_(x); }
DEVI float gelu_tanh(float x) { const float u = 0.7978845608028654f * (x + 0.044715f * x * x * x); return 0.5f * x * (1.0f + tanhf(u)); }
DEVI float softplusf_(float x) { return fmaxf(x, 0.f) + log1pf(__expf(-fabsf(x))); }

using pg8::Unit;
struct EpiZ {
    static constexpr bool PERM = true, AFTER_DRAIN = false;
    bf16_t* Z; const float* rtab; float* gates;
    DEVI void operator()(const f32x4 (&acc)[2][2][4][2], const Unit& u, int wr, int wc, int fr, int fq) const {
        int row0 = u.pm * 256 + wr * 64 + fr, col0 = u.pn * 256 + wc * 32 + 8 * fq; asm volatile("" : "+v"(row0), "+v"(col0));
        const float* rt = rtab + u.ord * 256 + wr * 64 + fr;
#pragma unroll
        for (int ai = 0; ai < 2; ++ai)
#pragma unroll
            for (int m = 0; m < 4; ++m) {
                const int row = row0 + ai * 128 + m * 16;
                const float rs = rt[ai * 128 + m * 16];
                bf16_t* rowp = Z + (size_t)row * NZ + col0;
#pragma unroll
                for (int bj = 0; bj < 2; ++bj) {
                    const float sc = (u.pn == 0 || (u.pn == 1 && bj == 0)) ? rs * (0.125f * 1.4426950408889634f) : rs;
                    const f32x4 v0 = acc[ai][bj][m][0] * sc, v1 = acc[ai][bj][m][1] * sc;
                    u32x4 w; w.x = pk2(v0[0], v0[1]); w.y = pk2(v0[2], v0[3]); w.z = pk2(v1[0], v1[1]); w.w = pk2(v1[2], v1[3]);
                    *(u32x4*)(rowp + bj * 128) = w;
                    if (bj == 1 && u.pn == 4 && wc == 0 && fq == 0) { *(f32x4*)(gates + (size_t)row * 8) = v0; *(f32x4*)(gates + (size_t)row * 8 + 4) = v1; }
                }
            }
    }
};
DEVI void unpack8(const u32x4 w, float (&f)[8]) { f[0] = __uint_as_float(w.x << 16); f[1] = __uint_as_float(w.x & 0xffff0000u); f[2] = __uint_as_float(w.y << 16); f[3] = __uint_as_float(w.y & 0xffff0000u);
    f[4] = __uint_as_float(w.z << 16); f[5] = __uint_as_float(w.z & 0xffff0000u); f[6] = __uint_as_float(w.w << 16); f[7] = __uint_as_float(w.w & 0xffff0000u); }
struct EpiResid {
    static constexpr bool PERM = true, AFTER_DRAIN = false;
    const bf16_t* hin; bf16_t* hout; float* ssp;
    DEVI void operator()(const f32x4 (&acc)[2][2][4][2], const Unit& u, int wr, int wc, int fr, int fq) const {
        int row0 = u.pm * 256 + wr * 64 + fr, col0 = u.pn * 256 + wc * 32 + 8 * fq; asm volatile("" : "+v"(row0), "+v"(col0));
#pragma unroll
        for (int ai = 0; ai < 2; ++ai) {
            u32x4 hv[4][2];
#pragma unroll
            for (int m = 0; m < 4; ++m)
#pragma unroll
                for (int bj = 0; bj < 2; ++bj) hv[m][bj] = *(const u32x4*)(hin + (size_t)(row0 + ai * 128 + m * 16) * D + col0 + bj * 128);
#pragma unroll
            for (int m = 0; m < 4; ++m) {
                const int row = row0 + ai * 128 + m * 16; const size_t off = (size_t)row * D + col0; float sacc = 0.f;
#pragma unroll
                for (int bj = 0; bj < 2; ++bj) {
                    float f[8]; unpack8(hv[m][bj], f);
                    const f32x4 v0 = acc[ai][bj][m][0], v1 = acc[ai][bj][m][1];
                    f[0] += v0[0]; f[1] += v0[1]; f[2] += v0[2]; f[3] += v0[3]; f[4] += v1[0]; f[5] += v1[1]; f[6] += v1[2]; f[7] += v1[3];
                    sacc += ((f[0] * f[0] + f[1] * f[1]) + (f[2] * f[2] + f[3] * f[3])) + ((f[4] * f[4] + f[5] * f[5]) + (f[6] * f[6] + f[7] * f[7]));
                    u32x4 w; w.x = pk2(f[0], f[1]); w.y = pk2(f[2], f[3]); w.z = pk2(f[4], f[5]); w.w = pk2(f[6], f[7]);
                    *(u32x4*)(hout + off + bj * 128) = w;
                }
                sacc += __shfl_xor(sacc, 16); sacc += __shfl_xor(sacc, 32);
                if (fq == 0) ssp[(size_t)row * 16 + u.pn * 4 + wc] = sacc;
            }
        }
    }
};
struct EpiPLE {
    static constexpr bool PERM = true, AFTER_DRAIN = false;
    const float* rstd3; const bf16_t* pp; const bf16_t* hin; bf16_t* hout; float* ssp;
    DEVI void operator()(const f32x4 (&acc)[2][2][4][2], const Unit& u, int wr, int wc, int fr, int fq) const {
        int row0 = u.pm * 256 + wr * 64 + fr, col0 = u.pn * 256 + wc * 32 + 8 * fq; asm volatile("" : "+v"(row0), "+v"(col0));
#pragma unroll
        for (int ai = 0; ai < 2; ++ai) {
            u32x4 hv[4][2], pvv[4][2]; float rsv[4];
#pragma unroll
            for (int m = 0; m < 4; ++m) { const int row = row0 + ai * 128 + m * 16; rsv[m] = rstd3[row];
#pragma unroll
                for (int bj = 0; bj < 2; ++bj) { hv[m][bj] = *(const u32x4*)(hin + (size_t)row * D + col0 + bj * 128); pvv[m][bj] = *(const u32x4*)(pp + (size_t)row * D + col0 + bj * 128); } }
#pragma unroll
            for (int m = 0; m < 4; ++m) {
                const int row = row0 + ai * 128 + m * 16; const size_t off = (size_t)row * D + col0; const float rs = rsv[m];
                float sacc = 0.f;
#pragma unroll
                for (int bj = 0; bj < 2; ++bj) {
                    float hf[8], pf[8]; unpack8(hv[m][bj], hf); unpack8(pvv[m][bj], pf);
                    float o[8];
#pragma unroll
                    for (int i = 0; i < 8; ++i) { const float a = acc[ai][bj][m][i >> 2][i & 3] * rs; o[i] = hf[i] + __builtin_amdgcn_rcpf(1.0f + __expf(-a)) * pf[i]; sacc += o[i] * o[i]; }
                    u32x4 w; w.x = pk2(o[0], o[1]); w.y = pk2(o[2], o[3]); w.z = pk2(o[4], o[5]); w.w = pk2(o[6], o[7]);
                    *(u32x4*)(hout + off + bj * 128) = w;
                }
                sacc += __shfl_xor(sacc, 16); sacc += __shfl_xor(sacc, 32);
                if (fq == 0) ssp[(size_t)row * 16 + u.pn * 4 + wc] = sacc;
            }
        }
    }
};
struct EpiGU {
    static constexpr bool PERM = true, AFTER_DRAIN = false;
    const float* row_rs; bf16_t* hid;
    DEVI void operator()(const f32x4 (&acc)[2][2][4][2], const Unit& u, int wr, int wc, int fr, int fq) const {
        int row0 = u.pm * 256 + wr * 64 + fr; asm volatile("" : "+v"(row0));
        float rsv[2][4];
#pragma unroll
        for (int ai = 0; ai < 2; ++ai)
#pragma unroll
            for (int m = 0; m < 4; ++m) rsv[ai][m] = row_rs[row0 + ai * 128 + m * 16];
#pragma unroll
        for (int ai = 0; ai < 2; ++ai)
#pragma unroll
            for (int m = 0; m < 4; ++m) {
                const int row = row0 + ai * 128 + m * 16;
                const float rs = rsv[ai][m];
                float hv[8];
#pragma unroll
                for (int n = 0; n < 2; ++n)
#pragma unroll
                    for (int i = 0; i < 4; ++i) { const float g = acc[ai][0][m][n][i] * rs, uu = acc[ai][1][m][n][i] * rs; hv[n * 4 + i] = siluf_(g) * uu; }
                u32x4 w; w.x = pk2(hv[0], hv[1]); w.y = pk2(hv[2], hv[3]); w.z = pk2(hv[4], hv[5]); w.w = pk2(hv[6], hv[7]);
                *(u32x4*)(hid + (size_t)row * DEXP + u.pn * 128 + wc * 32 + 8 * fq) = w;
            }
    }
};
struct EpiDown {
    static constexpr bool PERM = true, AFTER_DRAIN = false;
    const float* row_w; bf16_t* Y;
    DEVI void operator()(const f32x4 (&acc)[2][2][4][2], const Unit& u, int wr, int wc, int fr, int fq) const {
        int row0 = u.pm * 256 + wr * 64 + fr, col0 = u.pn * 256 + wc * 32 + 8 * fq; asm volatile("" : "+v"(row0), "+v"(col0));
        float wv[2][4];
#pragma unroll
        for (int ai = 0; ai < 2; ++ai)
#pragma unroll
            for (int m = 0; m < 4; ++m) wv[ai][m] = row_w[row0 + ai * 128 + m * 16];
#pragma unroll
        for (int ai = 0; ai < 2; ++ai)
#pragma unroll
            for (int m = 0; m < 4; ++m) {
                const float wt = wv[ai][m];
                bf16_t* rowp = Y + (size_t)(row0 + ai * 128 + m * 16) * D + col0;
#pragma unroll
                for (int bj = 0; bj < 2; ++bj) {
                    const f32x4 v0 = acc[ai][bj][m][0] * wt, v1 = acc[ai][bj][m][1] * wt;
                    u32x4 w; w.x = pk2(v0[0], v0[1]); w.y = pk2(v0[2], v0[3]); w.z = pk2(v1[0], v1[1]); w.w = pk2(v1[2], v1[3]);
                    __builtin_nontemporal_store(w, (u32x4*)(rowp + bj * 128));
                }
            }
    }
};
struct EpiNull {
    static constexpr bool PERM = true, AFTER_DRAIN = false;
    float* sink;
    DEVI void operator()(const f32x4 (&acc)[2][2][4][2], const Unit& u, int wr, int wc, int fr, int fq) const {
        float s = 0.f;
#pragma unroll
        for (int ai = 0; ai < 2; ++ai)
#pragma unroll
            for (int bj = 0; bj < 2; ++bj)
#pragma unroll
                for (int m = 0; m < 4; ++m)
#pragma unroll
                    for (int n = 0; n < 2; ++n) s += acc[ai][bj][m][n][0];
        if (s == 1.2345e-30f) sink[0] = s;
    }
};
struct EpiRouter {
    static constexpr bool PERM = false, AFTER_DRAIN = true;
    const float* ssp; const float* rgb; const float* reb; int* tokE; float* tokW; float* rstd2; int* rank; unsigned* count;
    DEVI void fused(f32x4 (&acc)[2][2][4][2], const Unit& u, int wr, int wc, int fr, int fq, PG8_LAS unsigned char* lds, int wid, int lane) const {
        PG8_LAS float* lg = (PG8_LAS float*)lds;
        PG8_LAS int* hist = (PG8_LAS int*)(lds + 256 * 97 * 4); PG8_LAS int* wgb = hist + 32; PG8_LAS int* selE = wgb + 32; PG8_LAS int* selR = selE + 512;
        const int tid = wid * 64 + lane;
        if (tid < 32) hist[tid] = 0;
        if (wc < 3) {
#pragma unroll
            for (int ai = 0; ai < 2; ++ai)
#pragma unroll
                for (int m = 0; m < 4; ++m) { const int r = ai * 128 + wr * 64 + m * 16 + fr;
#pragma unroll
                    for (int n = 0; n < 2; ++n)
#pragma unroll
                        for (int i = 0; i < 4; ++i) lg[r * 97 + 32 * wc + 16 * n + 4 * fq + i] = acc[ai][0][m][n][i]; }
        }
        asm volatile("s_waitcnt lgkmcnt(0)" ::: "memory"); __builtin_amdgcn_s_barrier(); asm volatile("" ::: "memory");
        if (tid < 256) {
            const int t = u.pm * 256 + tid; PG8_LAS const float* l0 = lg + tid * 97;
            const f32x4* sp = (const f32x4*)(ssp + (size_t)t * 16); const f32x4 st = (sp[0] + sp[1]) + (sp[2] + sp[3]);
            const float rs = rsqrtf(((st[0] + st[1]) + (st[2] + st[3])) * (1.0f / 1024.0f) + EPS);
            float gl[4]; int gtop = 0; float gmax;
#pragma unroll
            for (int n = 0; n < 4; ++n) gl[n] = (l0[n] + l0[48 + n]) * rs + rgb[n];
            gmax = gl[0];
#pragma unroll
            for (int n = 1; n < 4; ++n) if (gl[n] > gmax) { gmax = gl[n]; gtop = n; }
            float den = 0.f;
#pragma unroll
            for (int n = 0; n < 4; ++n) den += __expf(gl[n] - gmax);
            const float gw = 1.0f / den;
            float el[8];
#pragma unroll
            for (int jj = 0; jj < 8; ++jj) el[jj] = (l0[4 + gtop * 8 + jj] + l0[52 + gtop * 8 + jj]) * rs + reb[gtop * 8 + jj];
            int i1 = 0; float v1 = el[0];
#pragma unroll
            for (int jj = 1; jj < 8; ++jj) if (el[jj] > v1) { v1 = el[jj]; i1 = jj; }
            int i2 = -1; float v2 = -INFINITY;
#pragma unroll
            for (int jj = 0; jj < 8; ++jj) if (jj != i1 && el[jj] > v2) { v2 = el[jj]; i2 = jj; }
            const float ex = __expf(v2 - v1), w1 = 1.0f / (1.0f + ex), w2 = ex * w1;
            const int e1 = gtop * 8 + i1, e2 = gtop * 8 + i2;
            tokE[t * 2] = e1; tokE[t * 2 + 1] = e2; tokW[t * 2] = w1 * gw; tokW[t * 2 + 1] = w2 * gw; rstd2[t] = rs;
            selE[tid * 2] = e1; selE[tid * 2 + 1] = e2; selR[tid * 2] = __hip_atomic_fetch_add(hist + e1, 1, __ATOMIC_RELAXED, __HIP_MEMORY_SCOPE_WORKGROUP); selR[tid * 2 + 1] = __hip_atomic_fetch_add(hist + e2, 1, __ATOMIC_RELAXED, __HIP_MEMORY_SCOPE_WORKGROUP);
        }
        asm volatile("s_waitcnt lgkmcnt(0)" ::: "memory"); __builtin_amdgcn_s_barrier(); asm volatile("" ::: "memory");
        if (tid < 32) wgb[tid] = (int)atomicAdd(count + tid, (unsigned)hist[tid]);
        asm volatile("s_waitcnt vmcnt(0) lgkmcnt(0)" ::: "memory"); __builtin_amdgcn_s_barrier(); asm volatile("" ::: "memory");
        rank[u.pm * 512 + tid] = wgb[selE[tid]] + selR[tid];
        asm volatile("s_waitcnt lgkmcnt(0)" ::: "memory"); __builtin_amdgcn_s_barrier(); asm volatile("" ::: "memory");
    }
};
struct EpiPlain {
    static constexpr bool PERM = true, AFTER_DRAIN = false;
    bf16_t* O; int ldc, pad;
    DEVI void operator()(const f32x4 (&acc)[2][2][4][2], const Unit& u, int wr, int wc, int fr, int fq) const {
        int row0 = u.pm * 256 + wr * 64 + fr, col0 = u.pn * 256 + wc * 32 + 8 * fq; asm volatile("" : "+v"(row0), "+v"(col0));
#pragma unroll
        for (int ai = 0; ai < 2; ++ai)
#pragma unroll
            for (int m = 0; m < 4; ++m) {
                bf16_t* rowp = O + (size_t)(row0 + ai * 128 + m * 16) * ldc + col0;
#pragma unroll
                for (int bj = 0; bj < 2; ++bj) {
                    const f32x4 v0 = acc[ai][bj][m][0], v1 = acc[ai][bj][m][1];
                    u32x4 w; w.x = pk2(v0[0], v0[1]); w.y = pk2(v0[2], v0[3]); w.z = pk2(v1[0], v1[1]); w.w = pk2(v1[2], v1[3]);
                    *(u32x4*)(rowp + bj * 128) = w;
                }
            }
    }
};
struct MoeOrder {
    static constexpr bool GATHER = false;
    int ntot, nN, G, c; const int* tile_e; size_t estride;
    DEVI void bind(const int* n_tiles_ptr, int G_, int c_) { ntot = __builtin_amdgcn_readfirstlane(*n_tiles_ptr) * nN; G = G_; c = c_; }
    DEVI bool next(int i, Unit& u) const { const long L = (long)i * G + c; if (L >= ntot) return false; u.pm = (int)(L / nN); u.pn = (int)(L % nN); return true; }
    DEVI size_t bbase(const Unit& u, size_t tstep) const { return (size_t)__builtin_amdgcn_readfirstlane(tile_e[u.pm]) * estride + (size_t)u.pn * tstep; }
    DEVI int arow(const Unit&, int) const { return 0; }
    DEVI void a_ready(const Unit&) const {}
    DEVI void done(const Unit&) const {}
};
struct MoeGatherOrder : MoeOrder {
    static constexpr bool GATHER = true;
    const int* row_ts;
    DEVI int arow(const Unit& u, int r) const { const int ts = row_ts[u.pm * 256 + r]; return ts >= 0 ? (ts >> 1) : 0; }
};
struct MoeDealOrder : MoeOrder {
    static constexpr int H = 8;
    int mt0, ntail, nD;
    DEVI bool next(int i, Unit& u) const {
        const int w = c;
        if (w < ntail) { if (i < 4) { u.pm = mt0 + w; u.pn = i; return true; } i -= 4; }
        const int nf = G - ntail; int d;
        if (w >= ntail && i < H) d = (w - ntail) + i * nf;
        else { const int ii = (w >= ntail) ? i - H : i, j = (w >= ntail) ? (w - ntail) : (w - ntail + G); d = H * nf + j + G * ii; }
        if (d >= nD) return false;
        u.pm = d >> 2; u.pn = d & 3; return true;
    }
};


#ifndef REP_SB
#define REP_SB 1
#endif
#ifndef REP_ML
#define REP_ML 1
#endif
#ifndef REP_SGU
#define REP_SGU 1
#endif
#ifndef REP_Z
#define REP_Z 1
#endif
#ifndef REP_PRO
#define REP_PRO 1
#endif
#ifndef REP_GATHER
#define REP_GATHER 1
#endif
#ifndef REP_GU
#define REP_GU 1
#endif
#ifndef REP_DOWN
#define REP_DOWN 1
#endif
#ifndef REP_PP
#define REP_PP 1
#endif
#ifndef REP_WOUT0
#define REP_WOUT0 1
#endif
#ifndef REP_BAR
#define REP_BAR 1
#endif
#ifndef REP_PLACE
#define REP_PLACE 1
#endif
#ifndef REP_PLE
#define REP_PLE 1
#endif
#ifndef REP_RTR
#define REP_RTR 1
#endif
#ifndef STG_Z
#define STG_Z 0
#endif
#ifndef STG_WOUT
#define STG_WOUT 0
#endif
#ifndef STG_GU
#define STG_GU 0
#endif
#ifndef STG_DOWN
#define STG_DOWN 0
#endif
#ifndef STG_PP
#define STG_PP 0
#endif
#ifndef STG_PLE
#define STG_PLE 0
#endif
#ifndef AL_Z
#define AL_Z true
#endif
#ifndef AL_WOUT
#define AL_WOUT true
#endif
#ifndef AL_GU
#define AL_GU true
#endif
#ifndef AL_DOWN
#define AL_DOWN true
#endif
#ifndef AL_PP
#define AL_PP true
#endif
#ifndef AL_PLE
#define AL_PLE true
#endif
constexpr int NTHR = 512;
constexpr int RING_BYTES = 147456;
constexpr int MISC_OFF = RING_BYTES;
constexpr int LDS_BYTES = RING_BYTES + 4096;
constexpr int CW_BAR = 4096;

#define XB_TMO      128
#define XB_XCNT(j)  (256  + 64 * (j))
#define XB_XSUB(j)  (1280 + 64 * (j))
#define XB_XGEN(j)  (2304 + 64 * (j))
#define XB_TOP      3328
#define XB_TOPGEN   3392
#define XCD_BAR_WORDS 3456
#define XB_SPIN_CAP (1u << 18)
#define LAS __attribute__((address_space(3)))

__device__ __forceinline__ unsigned xb_ld(unsigned* p)              { return __hip_atomic_load(p, __ATOMIC_RELAXED, __HIP_MEMORY_SCOPE_AGENT); }
__device__ __forceinline__ unsigned xb_add(unsigned* p, unsigned v) { return __hip_atomic_fetch_add(p, v, __ATOMIC_RELAXED, __HIP_MEMORY_SCOPE_AGENT); }
__device__ __forceinline__ unsigned xb_xcc_id() { return (unsigned)__builtin_amdgcn_s_getreg((3 << 11) | 20) & 0xFu; }
#define XB_SPIN(cond, bar) do { unsigned _sp = 0; while (cond) { __builtin_amdgcn_s_sleep(1); \
    if ((++_sp & 255u) == 0u) { if (xb_ld(&(bar)[XB_TMO])) break; if (_sp > XB_SPIN_CAP) { atomicAdd(&(bar)[XB_TMO], 1u); break; } } } } while (0)

struct XcdBarrier {
    unsigned* bar; unsigned x;
    volatile LAS unsigned* st;
};

__device__ __forceinline__ XcdBarrier xcd_barrier_post(unsigned* bar, volatile LAS unsigned* st) {
    XcdBarrier b; b.bar = bar; b.x = xb_xcc_id(); b.st = st;
    if (threadIdx.x == 0) (void)xb_add(&bar[XB_XCNT(b.x)], 1u);
    return b;
}
__device__ __forceinline__ void xcd_barrier_complete(unsigned* bar, unsigned x, unsigned& nloc, unsigned& nx) {
    const unsigned G = gridDim.x * gridDim.y * gridDim.z;
    unsigned sum, cnt, mine, sp = 0u;
    for (;;) {
        sum = 0u; cnt = 0u; mine = 0u;
#pragma unroll
        for (unsigned j = 0; j < 16; ++j) { const unsigned c = xb_ld(&bar[XB_XCNT(j)]); sum += c; cnt += (c > 0u) ? 1u : 0u; mine = (j == x) ? c : mine; }
        if (sum == G) break;
        __builtin_amdgcn_s_sleep(1);
        if ((++sp & 255u) == 0u) { if (xb_ld(&bar[XB_TMO])) break; if (sp > XB_SPIN_CAP) { atomicAdd(&bar[XB_TMO], 1u); break; } }
    }
    nloc = mine > 0u ? mine : 1u; nx = cnt > 0u ? cnt : 1u;
}

__device__ __forceinline__ void xcd_barrier(const XcdBarrier& b) {
    asm volatile("s_waitcnt vmcnt(0)" ::: "memory");
    __syncthreads();
    if (threadIdx.x == 0) {
        unsigned* bar = b.bar;
        __builtin_amdgcn_s_waitcnt(0);
        unsigned nloc = b.st[0], nx = b.st[1];
        if (nloc == 0u) { xcd_barrier_complete(bar, b.x, nloc, nx); b.st[0] = nloc; b.st[1] = nx; }
        const unsigned old = xb_add(&bar[XB_XSUB(b.x)], 1u);
        const unsigned gen = old / nloc;
        if (old + 1u == (gen + 1u) * nloc) {
            __builtin_amdgcn_fence(__ATOMIC_RELEASE, "agent");
            asm volatile("s_waitcnt vmcnt(0)" ::: "memory");
            const unsigned og = xb_add(&bar[XB_TOP], 1u);
            const unsigned tg = og / nx;
            if (og + 1u == (tg + 1u) * nx) xb_add(&bar[XB_TOPGEN], 1u);
            else XB_SPIN(xb_ld(&bar[XB_TOPGEN]) == tg, bar);
            __builtin_amdgcn_fence(__ATOMIC_ACQUIRE, "agent");
            xb_add(&bar[XB_XGEN(b.x)], 1u);
            asm volatile("s_waitcnt vmcnt(0)" ::: "memory");
        } else {
            XB_SPIN(xb_ld(&bar[XB_XGEN(b.x)]) == gen, bar);
            __builtin_amdgcn_fence(__ATOMIC_ACQUIRE, "agent");
            asm volatile("s_waitcnt vmcnt(0)" ::: "memory");
        }
    }
    __syncthreads();
}


DEVI int otid() { int t = threadIdx.x; asm volatile("" : "+v"(t)); return t; }
DEVI void stagger(int wg, unsigned ticks) { const unsigned long long t0 = __builtin_amdgcn_s_memrealtime(), d = (unsigned long long)((wg & 3) * ticks); while (__builtin_amdgcn_s_memrealtime() - t0 < d) __builtin_amdgcn_s_sleep(8); }
struct PrepJob { const float* in; const float* in2; const float* gain; bf16_t* out; int ldin, K, Nout, mode, ne, pad; size_t in_es, out_es; };
DEVI void ph_prep_w(const PrepJob& j, unsigned char* sm, int wg, int nwg) {
    const int tid = otid(), lane = tid & 63, wave = tid >> 6;
    float* scr = (float*)sm + wave * (64 * 33);
    const int nb = j.Nout / 32, kb = j.K / 64, per = nb * kb, total = per * j.ne;
    for (int it = wg * 8 + wave; it < total; it += nwg * 8) {
        const int e = it / per, r = it - e * per, k0 = (r / nb) * 64, n0 = (r % nb) * 32;
        const int n = n0 + (lane & 31); const float* src = j.in + (size_t)e * j.in_es; int col = n; bool valid = true;
        if (j.mode == 1) {
            if (n < 1152) col = n; else if (n < 1160) col = 2688 + (n - 1152); else if (n < 1280) valid = false; else if (n < 2816) col = 1152 + (n - 1280); else col = 2696 + (n - 2816);
        } else if (j.mode == 2) { const int pn = n >> 8, bj = (n >> 7) & 1; col = pn * 128 + (n & 127); if (bj) src = j.in2 + (size_t)e * j.in_es; }
        const float* sp = src + (size_t)(k0 + (lane >> 5)) * j.ldin + col; const float* gp = j.gain ? j.gain + k0 + (lane >> 5) : nullptr;
        float vv[32];
#pragma unroll
        for (int i = 0; i < 32; ++i) vv[i] = valid ? sp[(size_t)(2 * i) * j.ldin] : 0.f;
#pragma unroll
        for (int i = 0; i < 32; ++i) { float v = vv[i]; if (gp) v *= gp[2 * i]; scr[(2 * i + (lane >> 5)) * 33 + (lane & 31)] = v; }
        asm volatile("s_waitcnt lgkmcnt(0)" ::: "memory");
        const int c = lane & 7; bf16_t* o = j.out + (size_t)e * j.out_es;
#pragma unroll
        for (int jj = 0; jj < 4; ++jj) { const int nn = (lane >> 3) + 8 * jj; const float* q = scr + (8 * c) * 33 + nn;
            u32x4 w; w.x = pk2(q[0 * 33], q[1 * 33]); w.y = pk2(q[2 * 33], q[3 * 33]); w.z = pk2(q[4 * 33], q[5 * 33]); w.w = pk2(q[6 * 33], q[7 * 33]);
            *(u32x4*)(o + (size_t)(n0 + nn) * j.K + k0 + 8 * c) = w; }
        asm volatile("s_waitcnt lgkmcnt(0)" ::: "memory");
    }
}
DEVI void ph_prep_router(const float* rgw, const float* rew, const float* g, bf16_t* WRt, int wg, int nwg) {
    for (int idx = wg * NTHR + otid(); idx < 256 * 1024; idx += nwg * NTHR) { const int r = idx / 1024, k = idx % 1024, n = r < 48 ? r : r - 48;
        float w = (r < 96 && n < 36) ? g[k] * (n < 4 ? rgw[k * 4 + n] : rew[k * 32 + (n - 4)]) : 0.f;
        const unsigned hb = f2bf(w); WRt[idx] = (bf16_t)(r < 48 ? hb : f2bf(w - __uint_as_float(hb << 16))); }
}
DEVI void ph_prep_x(const float* x, bf16_t* hb, float* ssp, int wg, int nwg) {
    const int tid = otid(), lane = tid & 63, gw = wg * 8 + (tid >> 6), ngw = nwg * 8;
    for (int row = 2 * gw; row < T; row += 2 * ngw) {
        f32x4 v[2][4];
#pragma unroll
        for (int r = 0; r < 2; ++r)
#pragma unroll
            for (int jj = 0; jj < 4; ++jj) v[r][jj] = ((const f32x4*)(x + (size_t)(row + r) * D) + lane)[64 * jj];
#pragma unroll
        for (int r = 0; r < 2; ++r) { float s = 0.f; u32x2* o = (u32x2*)(hb + (size_t)(row + r) * D) + lane;
#pragma unroll
            for (int jj = 0; jj < 4; ++jj) { const f32x4 a = v[r][jj]; s += (a[0] * a[0] + a[1] * a[1]) + (a[2] * a[2] + a[3] * a[3]); u32x2 w; w.x = pk2(a[0], a[1]); w.y = pk2(a[2], a[3]); o[64 * jj] = w; }
            s = wave_sum(s);
            if (lane < 16) ssp[(size_t)(row + r) * 16 + lane] = lane == 0 ? s : 0.f; }
    }
}
DEVI void ph_cvt_bf16(const float* in, bf16_t* out, size_t n4, int wg, int nwg) {
    const size_t stride = (size_t)nwg * NTHR;
    for (size_t i0 = (size_t)wg * NTHR + otid(); i0 < n4; i0 += 8 * stride) {
        f32x4 v[8];
#pragma unroll
        for (int k = 0; k < 8; ++k) { const size_t i = i0 + k * stride; v[k] = i < n4 ? ((const f32x4*)in)[i] : (f32x4){0.f, 0.f, 0.f, 0.f}; }
#pragma unroll
        for (int k = 0; k < 8; ++k) { const size_t i = i0 + k * stride; if (i < n4) { u32x2 w; w.x = pk2(v[k][0], v[k][1]); w.y = pk2(v[k][2], v[k][3]); ((u32x2*)out)[i] = w; } }
    }
}

namespace sb {
typedef short bf16x8 __attribute__((ext_vector_type(8)));
typedef short s16x4 __attribute__((ext_vector_type(4)));
typedef float f32x16 __attribute__((ext_vector_type(16)));
constexpr float QSCALE = 0.125f * 1.4426950408889634f;
constexpr int WAVE_LDS = 12288;
DEVI int crow(int r, int hi) { return (r & 3) + 8 * (r >> 2) + 4 * hi; }
DEVI void glds16(const void* gsrc, unsigned lds_dst) { unsigned keep;
    asm volatile("s_mov_b32 %0, m0\n\ts_mov_b32 m0, %2\n\ts_nop 0\n\tglobal_load_lds_dwordx4 %1, off\n\ts_mov_b32 m0, %0" : "=&s"(keep) : "v"(gsrc), "s"(lds_dst) : "memory"); }
DEVI unsigned cvtpk(float lo, float hi) { unsigned r; asm("v_cvt_pk_bf16_f32 %0, %1, %2" : "=v"(r) : "v"(lo), "v"(hi)); return r; }
DEVI void pv(f32x16* o, int vb, bf16x8 pa0, bf16x8 pa1, bf16x8 pa2, bf16x8 pa3) {
#pragma unroll
    for (int d0 = 0; d0 < 2; ++d0) { s16x4 lo[4], hi[4];
#pragma unroll
        for (int ks = 0; ks < 4; ++ks) {
            asm volatile("ds_read_b64_tr_b16 %0,%1 offset:%c2" : "=&v"(lo[ks]) : "v"(vb), "i"(d0 * 4096 + ks * 1024) : "memory");
            asm volatile("ds_read_b64_tr_b16 %0,%1 offset:%c2" : "=&v"(hi[ks]) : "v"(vb), "i"(d0 * 4096 + ks * 1024 + 512) : "memory"); }
        asm volatile("s_waitcnt lgkmcnt(0)" ::: "memory"); __builtin_amdgcn_sched_barrier(0);
#define SB_PK(k) (bf16x8){lo[k][0], lo[k][1], lo[k][2], lo[k][3], hi[k][0], hi[k][1], hi[k][2], hi[k][3]}
        o[d0] = __builtin_amdgcn_mfma_f32_32x32x16_bf16(pa0, SB_PK(0), o[d0], 0, 0, 0);
        o[d0] = __builtin_amdgcn_mfma_f32_32x32x16_bf16(pa1, SB_PK(1), o[d0], 0, 0, 0);
        o[d0] = __builtin_amdgcn_mfma_f32_32x32x16_bf16(pa2, SB_PK(2), o[d0], 0, 0, 0);
        o[d0] = __builtin_amdgcn_mfma_f32_32x32x16_bf16(pa3, SB_PK(3), o[d0], 0, 0, 0);
#undef SB_PK
    }
}
}
DEVI void ph_sb(const bf16_t* Z, const float* og, bf16_t* Ymix, unsigned char* smb, int wg, int nwg) {
    using namespace sb;
    const int tid = otid(), lane = tid & 63, wave = __builtin_amdgcn_readfirstlane(tid >> 6), r32 = lane & 31, hi = lane >> 5;
    unsigned char* vt = smb + wave * 16384;
    const unsigned vt_lds = (unsigned)(uintptr_t)vt;
    const int vbl = ((lane >> 4) & 1) * 32 + (lane & 3) * 8 + (4 * hi + ((lane & 15) >> 2)) * 64;
    const unsigned vK0 = (unsigned)(r32 * NZ + ZKA + hi * 8) * 2u, vK1 = vK0 + 32u * NZ * 2u, vV = (unsigned)((lane >> 2) * NZ + ZVA + (lane & 3) * 8) * 2u, vQ = (unsigned)(r32 * NZ + ZQA + hi * 8) * 2u;
#define SB_TILE(hh, jj) ((const char*)Z + ((size_t)(bbase + (jj) * 64) * NZ + (hh) * 64) * 2)
#define SB_LOADK(dst, hh, jj) do { const char* kb_ = SB_TILE(hh, jj); _Pragma("unroll") for (int d0 = 0; d0 < 4; ++d0) { dst[2 * d0] = *(const bf16x8*)(kb_ + vK0 + d0 * 32); dst[2 * d0 + 1] = *(const bf16x8*)(kb_ + vK1 + d0 * 32); } } while (0)
#define SB_DMAV(buf, hh, jj) do { const char* kb_ = SB_TILE(hh, jj); _Pragma("unroll") for (int w8 = 0; w8 < 8; ++w8) \
        glds16(kb_ + ((size_t)(16 * (w8 & 3)) * NZ + (w8 >> 2) * 32) * 2 + vV, (unsigned)__builtin_amdgcn_readfirstlane(vt_lds + (buf) * 8192 + w8 * 1024)); } while (0)
#define SB_LOADQ(dst, hh) do { const char* qp_ = (const char*)Z + ((size_t)row0 * NZ + (hh) * 64) * 2 + vQ; _Pragma("unroll") for (int d0 = 0; d0 < 4; ++d0) dst[d0] = *(const bf16x8*)(qp_ + d0 * 32); } while (0)
    for (int wu = wg * 8 + wave; wu < T / 32; wu += nwg * 8) {
        const int row0 = wu * 32, bbase = (row0 / SEQ) * SEQ, t0 = row0 - bbase, tq = t0 + r32, jt0 = t0 >> 6;
        float ssq[4] = {0.f, 0.f, 0.f, 0.f};
        int cb = 0, pf = 0;
        bf16x8 kf[8], qr[4];
        asm volatile("s_waitcnt lgkmcnt(0)" ::: "memory");
        SB_DMAV(0, 0, jt0); SB_LOADK(kf, 0, jt0); SB_LOADQ(qr, 0);
#pragma unroll 1
        for (int h = 0; h < 6; ++h) {
            f32x16 o[2]; o[0] = f32x16{}; o[1] = f32x16{};
            float carry = 1.f; bool diag = true;
#pragma unroll 1
            for (int jt = jt0; ; --jt) {
                const int kv0 = jt * 64;
                f32x16 p0 = __builtin_amdgcn_mfma_f32_32x32x16_bf16(kf[0], qr[0], f32x16{}, 0, 0, 0), p1 = __builtin_amdgcn_mfma_f32_32x32x16_bf16(kf[1], qr[0], f32x16{}, 0, 0, 0);
#pragma unroll
                for (int d0 = 1; d0 < 4; ++d0) { p0 = __builtin_amdgcn_mfma_f32_32x32x16_bf16(kf[2 * d0], qr[d0], p0, 0, 0, 0); p1 = __builtin_amdgcn_mfma_f32_32x32x16_bf16(kf[2 * d0 + 1], qr[d0], p1, 0, 0, 0); }
                if (diag && jt > 0) { SB_DMAV(cb ^ 1, h, jt - 1); SB_LOADK(kf, h, jt - 1); pf = 1; }
                else if (h + 1 < 6) { SB_DMAV(cb ^ 1, h + 1, jt0); SB_LOADK(kf, h + 1, jt0); pf = 2; }
                else pf = 0;
                if (diag) {
#pragma unroll
                    for (int r = 0; r < 16; ++r) { const int kv = kv0 + crow(r, hi); if (kv >= tq) p0[r] = -INFINITY; if (kv + 32 >= tq) p1[r] = -INFINITY; }
                }
                float total = 1.f; u32x4 pw0, pw1, pw2, pw3;
#define SB_HALF(P, PWA, PWB) do { f32x16 R; \
                    _Pragma("unroll") for (int r = 0; r < 16; ++r) { float c_; asm("v_min_f32 %0, %1, %2" : "=v"(c_) : "v"(P[r]), "v"(100.f)); const float e_ = __builtin_amdgcn_exp2f(c_); R[r] = __builtin_amdgcn_rcpf(1.0f + e_); P[r] = e_ * R[r]; } \
                    _Pragma("unroll") for (int g = 3; g >= 0; --g) { const float mine = (R[4 * g] * R[4 * g + 1]) * (R[4 * g + 2] * R[4 * g + 3]); const auto sw_ = __builtin_amdgcn_permlane32_swap(__float_as_uint(mine), __float_as_uint(mine), false, false); const float og_ = __uint_as_float(hi ? sw_[0] : sw_[1]);     \
                        float t = carry * (hi == 0 ? total * og_ : total); total *= mine * og_; \
                        P[4 * g + 3] *= t; t *= R[4 * g + 3]; P[4 * g + 2] *= t; t *= R[4 * g + 2]; P[4 * g + 1] *= t; t *= R[4 * g + 1]; P[4 * g] *= t; } \
                    PWA = (u32x4){cvtpk(P[0], P[1]), cvtpk(P[2], P[3]), cvtpk(P[4], P[5]), cvtpk(P[6], P[7])}; PWB = (u32x4){cvtpk(P[8], P[9]), cvtpk(P[10], P[11]), cvtpk(P[12], P[13]), cvtpk(P[14], P[15])}; } while (0)
                SB_HALF(p1, pw2, pw3);
                SB_HALF(p0, pw0, pw1);
#undef SB_HALF
                carry *= total;
                if (pf) asm volatile("s_waitcnt vmcnt(16)" ::: "memory");
                else asm volatile("s_waitcnt vmcnt(0)" ::: "memory");
                pv(o, (int)vt_lds + cb * 8192 + vbl, __builtin_bit_cast(bf16x8, pw0), __builtin_bit_cast(bf16x8, pw1), __builtin_bit_cast(bf16x8, pw2), __builtin_bit_cast(bf16x8, pw3));
                diag = false;
                if (jt == 0 || !__any(carry > 9.0949470177e-13f)) break;
                if (pf == 1) { cb ^= 1; pf = 0; }
                else { SB_DMAV(cb, h, jt - 1); SB_LOADK(kf, h, jt - 1); pf = 0; }
            }
            const bool hit = (pf == 2);
            pf = 0;
            if (h + 1 < 6) SB_LOADQ(qr, h + 1);
            bf16_t* stg = (bf16_t*)(vt + cb * 8192);
#pragma unroll
            for (int r = 0; r < 16; ++r) { const int orow = crow(r, hi); stg[orow * 64 + r32] = (bf16_t)f2bf(o[0][r]); stg[orow * 64 + 32 + r32] = (bf16_t)f2bf(o[1][r]); }
            asm volatile("s_waitcnt lgkmcnt(0)" ::: "memory");
#pragma unroll
            for (int i = 0; i < 4; ++i) { const int row = i * 8 + (lane >> 3), ch = lane & 7; const u32x4 v = *(const u32x4*)(stg + row * 64 + ch * 8);
                float a[8]; unpack8(v, a);
                ssq[i] += ((a[0] * a[0] + a[1] * a[1]) + (a[2] * a[2] + a[3] * a[3])) + ((a[4] * a[4] + a[5] * a[5]) + (a[6] * a[6] + a[7] * a[7]));
                *(u32x4*)(Ymix + (size_t)(row0 + row) * D + h * 64 + ch * 8) = v; }
            asm volatile("s_waitcnt lgkmcnt(0)" ::: "memory");
            if (h + 1 < 6) {
                if (!hit) { SB_DMAV(cb ^ 1, h + 1, jt0); SB_LOADK(kf, h + 1, jt0); }
                cb ^= 1;
            }
        }
        asm volatile("s_waitcnt vmcnt(0)" ::: "memory");
        float rs[4];
#pragma unroll
        for (int i = 0; i < 4; ++i) { float s = ssq[i]; s += __shfl_xor(s, 1); s += __shfl_xor(s, 2); s += __shfl_xor(s, 4); rs[i] = rsqrtf(s * (1.0f / 384.0f) + EPS); }
#pragma unroll 1
        for (int h = 0; h < 6; ++h) { const int ch = lane & 7; const f32x4 g0 = *(const f32x4*)(og + h * 64 + ch * 8), g1 = *(const f32x4*)(og + h * 64 + ch * 8 + 4);
#pragma unroll
            for (int i = 0; i < 4; ++i) { const int row = i * 8 + (lane >> 3); u32x4* pp = (u32x4*)(Ymix + (size_t)(row0 + row) * D + h * 64 + ch * 8); float a[8]; unpack8(*pp, a); const float r = rs[i];
                u32x4 w; w.x = pk2(a[0] * r * g0[0], a[1] * r * g0[1]); w.y = pk2(a[2] * r * g0[2], a[3] * r * g0[3]); w.z = pk2(a[4] * r * g1[0], a[5] * r * g1[1]); w.w = pk2(a[6] * r * g1[2], a[7] * r * g1[3]);
                *pp = w; } }
    }
#undef SB_TILE
#undef SB_LOADK
#undef SB_DMAV
#undef SB_LOADQ
}

namespace ml {
constexpr int QROW = 208, TROW = 144;
constexpr int O_QN = 0, O_KN = 13312, O_KWT = 26624, O_VT = 40448, O_CT = 54272, CT_BYTES = 96 * QROW, O_NV = O_CT + 2 * CT_BYTES, O_TB = O_NV + 768, O_SC = O_TB + 2 * 1280,
              O_MNG = O_SC + 64, O_CW = O_MNG + 384, O_RAW = O_CW + 5 * 192 * 4, NP_QK = 67 * 24, NP_ALL = NP_QK + 64 * 12, O_RAWV = O_RAW + NP_QK * 16, O_DUMMY = O_RAW + 40 * 1024, O_END = O_DUMMY + 1024;
static_assert(O_END <= 147456 && NP_ALL <= 40 * 64 && O_RAW % 16 == 0, "mLSTM LDS map");
typedef short bf16x8 __attribute__((ext_vector_type(8)));
}
DEVI void ph_mlstm(const bf16_t* Z, const float* gates, const float* conv_w, const float* conv_b, const float* igb, const float* fgb, const float* mng, bf16_t* Ymix,
                   unsigned char* smb, int wg, int nwg) {
    using namespace ml;
    const int tid = otid(), lane = tid & 63, wave = __builtin_amdgcn_readfirstlane(tid >> 6), l16 = lane & 15, quad = lane >> 4;
    float* NV = (float*)(smb + O_NV);
    const unsigned raw_lds = (unsigned)(uintptr_t)(smb + O_RAW);
    for (int unit = wg; unit < NB * 4; unit += nwg) {
        const int b = unit >> 2, h = unit & 3; const size_t rb = (size_t)b * SEQ;
#define ML_DMA(n1) do { const char* zb_ = (const char*)Z + ((long)rb + (long)(n1) * 64 - 3) * (NZ * 2); \
            _Pragma("unroll") for (int ins = 0; ins < 5; ++ins) if ((ins * 8 + wave) * 64 + lane < NP_ALL) sb::glds16(zb_ + doff[ins], (unsigned)__builtin_amdgcn_readfirstlane(raw_lds + (ins * 8 + wave) * 1024)); } while (0)
        unsigned doff[5];
#pragma unroll
        for (int ins = 0; ins < 5; ++ins) { const int pidx = (ins * 8 + wave) * 64 + lane;
            if (pidx < NP_QK) { const int r = pidx / 24, seg = pidx - 24 * r; doff[ins] = (unsigned)(r * NZ + (seg < 12 ? ZQB + h * 96 + 8 * seg : ZKB + h * 96 + 8 * (seg - 12))) * 2u; }
            else { const int j = pidx - NP_QK, l = j / 12, seg = j - 12 * l; doff[ins] = (unsigned)((l + 3) * NZ + ZVB + h * 96 + 8 * seg) * 2u; } }
#define ML_WARM(n2) do { if (wave >= 4) { const unsigned dl_ = (unsigned)__builtin_amdgcn_readfirstlane((unsigned)(uintptr_t)(smb + O_DUMMY)); const int wq_ = wave - 4; \
            if ((n2) < 32) { const char* rp_ = (const char*)Z + ((size_t)rb + (size_t)(n2) * 64 + lane) * (NZ * 2) + (size_t)((wq_ == 0 ? ZQB : wq_ == 1 ? ZKB : wq_ == 2 ? ZVB : ZOB) + h * 96) * 2; \
                sb::glds16(rp_, dl_); sb::glds16(rp_ + 128, dl_); } \
            if (wq_ == 3 && (n2) + 1 < 32) { const char* gp_ = (const char*)gates + ((size_t)rb + (size_t)((n2) + 1) * 64) * 32 + lane * 16; sb::glds16(gp_, dl_); sb::glds16(gp_ + 1024, dl_); } } } while (0)
#define ML_GATES(n1, ip, fp) do { float* TBn = (float*)(smb + O_TB) + ((n1) & 1) * 320; float* SCn = (float*)(smb + O_SC) + ((n1) & 1) * 4; \
            float c = -softplusf_(-(fp)); _Pragma("unroll") for (int o = 1; o < 64; o <<= 1) { const float t_ = __shfl_up(c, o); if (lane >= o) c += t_; } \
            const float btot = __shfl(c, 63), a_ = btot - c + (ip), g_ = (ip) - c; float mloc = a_; \
            _Pragma("unroll") for (int o = 32; o >= 1; o >>= 1) mloc = fmaxf(mloc, __shfl_xor(mloc, o)); \
            float pm = g_; _Pragma("unroll") for (int o = 1; o < 64; o <<= 1) { const float t_ = __shfl_up(pm, o); if (lane >= o) pm = fmaxf(pm, t_); } \
            const float mn = fmaxf(btot + mrun, mloc); \
            TBn[lane] = a_; TBn[64 + lane] = g_; TBn[128 + lane] = pm; TBn[192 + lane] = c; TBn[256 + lane] = __expf(a_ - mn); \
            if (lane == 0) { SCn[0] = mrun; SCn[1] = mn; SCn[2] = __expf(btot + mrun - mn); } mrun = mn; } while (0)
#define ML_CONVERT(n1) do { const float* WLn = (const float*)(smb + O_TB) + ((n1) & 1) * 320 + 256; \
            if (tid < 384) { const unsigned char* rw = smb + O_RAW + cc * 2; const int l0 = 16 * rseg; const bool z0 = ((n1) == 0 && rseg == 0); \
                const f32x2_t* cwp_ = (const f32x2_t*)((const float*)(smb + O_CW) + cc); const f32x2_t cw0 = cwp_[0], cw1 = cwp_[96], cw2 = cwp_[192], cw3 = cwp_[288], cbias = cwp_[384]; \
                f32x2_t x0, x1, x2; { const unsigned u0 = *(const unsigned*)(rw + (l0 + 0) * 384), u1 = *(const unsigned*)(rw + (l0 + 1) * 384), u2 = *(const unsigned*)(rw + (l0 + 2) * 384); \
                    x0 = z0 ? (f32x2_t){0.f, 0.f} : (f32x2_t){__uint_as_float(u0 << 16), __uint_as_float(u0 & 0xffff0000u)}; x1 = z0 ? (f32x2_t){0.f, 0.f} : (f32x2_t){__uint_as_float(u1 << 16), __uint_as_float(u1 & 0xffff0000u)}; \
                    x2 = z0 ? (f32x2_t){0.f, 0.f} : (f32x2_t){__uint_as_float(u2 << 16), __uint_as_float(u2 & 0xffff0000u)}; } \
                unsigned char* qk = smb + (which ? O_KN : O_QN) + cd * 2; unsigned char* kwt = smb + O_KWT + cd * TROW; \
                _Pragma("unroll 2") for (int i = 0; i < 16; i += 2) { const int l = l0 + i; \
                    const unsigned ua = *(const unsigned*)(rw + (l + 3) * 384), ub = *(const unsigned*)(rw + (l + 4) * 384); \
                    const f32x2_t xa = {__uint_as_float(ua << 16), __uint_as_float(ua & 0xffff0000u)}, xb = {__uint_as_float(ub << 16), __uint_as_float(ub & 0xffff0000u)}; \
                    f32x2_t ya = cbias + cw0 * x0 + cw1 * x1 + cw2 * x2 + cw3 * xa, yb = cbias + cw0 * x1 + cw1 * x2 + cw2 * xa + cw3 * xb; x0 = x2; x1 = xa; x2 = xb; \
                    f32x2_t oa, ob_; oa.x = ya.x * __builtin_amdgcn_rcpf(1.0f + __expf(-ya.x)); oa.y = ya.y * __builtin_amdgcn_rcpf(1.0f + __expf(-ya.y)); ob_.x = yb.x * __builtin_amdgcn_rcpf(1.0f + __expf(-yb.x)); ob_.y = yb.y * __builtin_amdgcn_rcpf(1.0f + __expf(-yb.y)); \
                    if (which) { oa = oa * 0.10206207261596575f; ob_ = ob_ * 0.10206207261596575f; const float wa = WLn[l], wb = WLn[l + 1]; \
                        *(unsigned*)(kwt + l * 2) = pk2(oa.x * wa, ob_.x * wb); *(unsigned*)(kwt + TROW + l * 2) = pk2(oa.y * wa, ob_.y * wb); } \
                    *(unsigned*)(qk + l * QROW) = pk2(oa.x, oa.y); *(unsigned*)(qk + (l + 1) * QROW) = pk2(ob_.x, ob_.y); } \
            } else { const int idx = tid - 384, lp = idx >> 2, eq = idx & 3; const u32x4* s0 = (const u32x4*)(smb + O_RAWV + (2 * lp) * 192 + eq * 48); const u32x4* s1 = (const u32x4*)(smb + O_RAWV + (2 * lp + 1) * 192 + eq * 48); \
                unsigned char* vt = smb + O_VT + (eq * 24) * TROW + lp * 4; \
                _Pragma("unroll") for (int i = 0; i < 3; ++i) { const u32x4 a = s0[i], b = s1[i]; \
                    *(unsigned*)(vt + (i * 8 + 0) * TROW) = (a.x & 0xffffu) | (b.x << 16); *(unsigned*)(vt + (i * 8 + 1) * TROW) = (a.x >> 16) | (b.x & 0xffff0000u); \
                    *(unsigned*)(vt + (i * 8 + 2) * TROW) = (a.y & 0xffffu) | (b.y << 16); *(unsigned*)(vt + (i * 8 + 3) * TROW) = (a.y >> 16) | (b.y & 0xffff0000u); \
                    *(unsigned*)(vt + (i * 8 + 4) * TROW) = (a.z & 0xffffu) | (b.z << 16); *(unsigned*)(vt + (i * 8 + 5) * TROW) = (a.z >> 16) | (b.z & 0xffff0000u); \
                    *(unsigned*)(vt + (i * 8 + 6) * TROW) = (a.w & 0xffffu) | (b.w << 16); *(unsigned*)(vt + (i * 8 + 7) * TROW) = (a.w >> 16) | (b.w & 0xffff0000u); } } } while (0)
        const int cc = tid < 384 ? 2 * (tid % 96) : 0, rseg = tid < 384 ? tid / 96 : 0, which = cc >= 96 ? 1 : 0, cd = cc - 96 * which;
        if (tid < 192) { const int w_ = tid >= 96 ? 1 : 0, ch_ = w_ * 384 + h * 96 + (tid - 96 * w_); float* cwt = (float*)(smb + O_CW);
            cwt[tid] = conv_w[ch_]; cwt[192 + tid] = conv_w[768 + ch_]; cwt[384 + tid] = conv_w[2 * 768 + ch_]; cwt[576 + tid] = conv_w[3 * 768 + ch_]; cwt[768 + tid] = conv_b[ch_]; }
        float mrun = 0.f;
        ML_DMA(0);
        for (int i = tid; i < CT_BYTES / 4; i += NTHR) ((unsigned*)(smb + O_CT))[i] = 0u;
        if (tid < 96) { NV[tid] = 0.f; ((float*)(smb + O_MNG))[tid] = mng[h * 96 + tid]; }
        if (wave == 7) { const size_t row = rb + lane; const float ip = gates[row * 8 + h] + igb[h], fp = gates[row * 8 + 4 + h] + fgb[h]; ML_GATES(0, ip, fp); }
        asm volatile("s_waitcnt vmcnt(0)" ::: "memory");
        __syncthreads();
        ML_CONVERT(0);
        __syncthreads();
        f32x4 Cst[9];
#pragma unroll
        for (int k = 0; k < 9; ++k) Cst[k] = (f32x4){0.f, 0.f, 0.f, 0.f};
#pragma unroll 1
        for (int n = 0; n < 32; ++n) {
            const int cur = n & 1, nxt = cur ^ 1; const float* SCc = (const float*)(smb + O_SC) + cur * 4; const float m_in = SCc[0], dec = SCc[2];
            const float* TBc = (const float*)(smb + O_TB) + cur * 320;
            const size_t r0 = rb + n * 64;
            if (n + 1 < 32) ML_DMA(n + 1);
            if (wave < 4) {
                const int tt = wave, t = 16 * tt + l16; const size_t row = r0 + t;
                const unsigned char* qn = smb + O_QN; const unsigned char* kn = smb + O_KN; const unsigned char* vtb = smb + O_VT; const unsigned char* ct = smb + O_CT + cur * CT_BYTES;
                bf16x8 bq[3];
#pragma unroll
                for (int ks = 0; ks < 3; ++ks) bq[ks] = *(const bf16x8*)(qn + t * QROW + (32 * ks + 8 * quad) * 2);
                const float Mt = fmaxf(m_in, TBc[128 + t]), inter = __expf(m_in - Mt), flr = __expf(-(TBc[192 + t] + Mt));
                f32x4 P[4]; float psum = 0.f;
#pragma unroll
                for (int st = 0; st < 4; ++st) { P[st] = (f32x4){0.f, 0.f, 0.f, 0.f};
                    if (st <= tt) {
#pragma unroll
                        for (int ks = 0; ks < 3; ++ks) P[st] = __builtin_amdgcn_mfma_f32_16x16x32_bf16(*(const bf16x8*)(kn + (16 * st + l16) * QROW + (32 * ks + 8 * quad) * 2), bq[ks], P[st], 0, 0, 0);
                        const f32x4 gs = *(const f32x4*)(TBc + 64 + 16 * st + 4 * quad);
#pragma unroll
                        for (int j = 0; j < 4; ++j) { const int s_ = 16 * st + 4 * quad + j; const float w = s_ <= t ? __expf(gs[j] - Mt) : 0.f; P[st][j] *= w; psum += P[st][j]; }
                    } }
                psum += __shfl_xor(psum, 16); psum += __shfl_xor(psum, 32);
                float qn_ = 0.f; { const float* nv = NV + cur * 96 + quad * 24; const unsigned char* qp = qn + t * QROW + quad * 48;
#pragma unroll
                    for (int i = 0; i < 3; ++i) { const u32x4 w = *(const u32x4*)(qp + i * 16);
                        qn_ += __uint_as_float(w.x << 16) * nv[i * 8 + 0] + __uint_as_float(w.x & 0xffff0000u) * nv[i * 8 + 1] + __uint_as_float(w.y << 16) * nv[i * 8 + 2] + __uint_as_float(w.y & 0xffff0000u) * nv[i * 8 + 3]
                             + __uint_as_float(w.z << 16) * nv[i * 8 + 4] + __uint_as_float(w.z & 0xffff0000u) * nv[i * 8 + 5] + __uint_as_float(w.w << 16) * nv[i * 8 + 6] + __uint_as_float(w.w & 0xffff0000u) * nv[i * 8 + 7]; } }
                qn_ += __shfl_xor(qn_, 16); qn_ += __shfl_xor(qn_, 32);
                float den = psum + inter * qn_; den = fmaxf(fabsf(den), flr); const float rden = 1.0f / den;
                bf16x8 pk[2];
#pragma unroll
                for (int i = 0; i < 2; ++i) { u32x4 w; w.x = pk2(P[2 * i][0], P[2 * i][1]); w.y = pk2(P[2 * i][2], P[2 * i][3]); w.z = pk2(P[2 * i + 1][0], P[2 * i + 1][1]); w.w = pk2(P[2 * i + 1][2], P[2 * i + 1][3]); pk[i] = __builtin_bit_cast(bf16x8, w); }
                float hv[6][4]; float ss = 0.f;
#pragma unroll
                for (int et = 0; et < 6; ++et) {
                    f32x4 n1 = (f32x4){0.f, 0.f, 0.f, 0.f}, n2 = (f32x4){0.f, 0.f, 0.f, 0.f};
#pragma unroll
                    for (int i = 0; i < 2; ++i) if (2 * i <= tt) { const unsigned char* vp = vtb + (16 * et + l16) * TROW + (32 * i + 4 * quad) * 2;
                        const u32x2 lo = *(const u32x2*)vp, hi2 = *(const u32x2*)(vp + 32); const u32x4 a = {lo.x, lo.y, hi2.x, hi2.y};
                        n1 = __builtin_amdgcn_mfma_f32_16x16x32_bf16(__builtin_bit_cast(bf16x8, a), pk[i], n1, 0, 0, 0); }
#pragma unroll
                    for (int ks = 0; ks < 3; ++ks) n2 = __builtin_amdgcn_mfma_f32_16x16x32_bf16(*(const bf16x8*)(ct + (16 * et + l16) * QROW + (32 * ks + 8 * quad) * 2), bq[ks], n2, 0, 0, 0);
#pragma unroll
                    for (int j = 0; j < 4; ++j) { const float v = (n1[j] + inter * n2[j]) * rden; hv[et][j] = v; ss += v * v; }
                    __builtin_amdgcn_sched_barrier(0);
                }
                u32x2 obv[6];
#pragma unroll
                for (int et = 0; et < 6; ++et) obv[et] = *(const u32x2*)(Z + row * NZ + ZOB + h * 96 + 16 * et + 4 * quad);
                ss += __shfl_xor(ss, 16); ss += __shfl_xor(ss, 32);
                const float rs = rsqrtf(ss * (1.0f / 96.0f) + EPS);
#pragma unroll
                for (int et = 0; et < 6; ++et) { const int e = 16 * et + 4 * quad; const u32x2 ob = obv[et]; const f32x4 mg = *(const f32x4*)((const float*)(smb + O_MNG) + e);
                    u32x2 w; w.x = pk2(hv[et][0] * rs * mg[0] * sigmoidf_(__uint_as_float(ob.x << 16)), hv[et][1] * rs * mg[1] * sigmoidf_(__uint_as_float(ob.x & 0xffff0000u)));
                    w.y = pk2(hv[et][2] * rs * mg[2] * sigmoidf_(__uint_as_float(ob.y << 16)), hv[et][3] * rs * mg[3] * sigmoidf_(__uint_as_float(ob.y & 0xffff0000u)));
                    *(u32x2*)(Ymix + row * D + 384 + h * 96 + e) = w; }
            } else {
                const int wq = wave - 4; const unsigned char* kwt = smb + O_KWT; const unsigned char* vtb = smb + O_VT; unsigned char* ctn = smb + O_CT + nxt * CT_BYTES;
                float gip = 0.f, gfp = 0.f;
                if (wq == 3 && n + 1 < 32) { const size_t row = r0 + 64 + lane; gip = gates[row * 8 + h] + igb[h]; gfp = gates[row * 8 + 4 + h] + fgb[h]; }
#pragma unroll
                for (int k = 0; k < 9; ++k) { const int idx = wq + 4 * k, dt = idx / 6, et = idx - 6 * dt; f32x4 U = (f32x4){0.f, 0.f, 0.f, 0.f};
#pragma unroll
                    for (int ks = 0; ks < 2; ++ks) U = __builtin_amdgcn_mfma_f32_16x16x32_bf16(*(const bf16x8*)(kwt + (16 * dt + l16) * TROW + (32 * ks + 8 * quad) * 2), *(const bf16x8*)(vtb + (16 * et + l16) * TROW + (32 * ks + 8 * quad) * 2), U, 0, 0, 0);
                    Cst[k] = Cst[k] * dec + U;
                    u32x2 w; w.x = pk2(Cst[k][0], Cst[k][1]); w.y = pk2(Cst[k][2], Cst[k][3]);
                    *(u32x2*)(ctn + (16 * et + l16) * QROW + (16 * dt + 4 * quad) * 2) = w; __builtin_amdgcn_sched_barrier(0); }
                if (wq == 0 || (wq == 1 && lane < 32)) { const int d = wq * 64 + lane; const u32x4* kp = (const u32x4*)(kwt + d * TROW); float sacc = 0.f;
#pragma unroll
                    for (int i = 0; i < 8; ++i) { const u32x4 w = kp[i];
                        sacc += (__uint_as_float(w.x << 16) + __uint_as_float(w.x & 0xffff0000u)) + (__uint_as_float(w.y << 16) + __uint_as_float(w.y & 0xffff0000u))
                              + (__uint_as_float(w.z << 16) + __uint_as_float(w.z & 0xffff0000u)) + (__uint_as_float(w.w << 16) + __uint_as_float(w.w & 0xffff0000u)); }
                    NV[nxt * 96 + d] = dec * NV[cur * 96 + d] + sacc; }
                if (wq == 3 && n + 1 < 32) ML_GATES(n + 1, gip, gfp);
            }
            asm volatile("s_waitcnt vmcnt(0)" ::: "memory");
            __syncthreads();
            ML_WARM(n + 2);
            if (n + 1 < 32) ML_CONVERT(n + 1);
            __syncthreads();
        }
#undef ML_DMA
#undef ML_WARM
#undef ML_GATES
#undef ML_CONVERT
    }
}

namespace sgu {
constexpr int VROW = 272, VGRP = 64 * VROW + 32, MROW = 528, MST_OFF = 71680;
static_assert(4 * VGRP <= MST_OFF && MST_OFF + 128 * MROW <= 147456, "SGU LDS map");
DEVI float gelu_fast(float x) { const float u = 1.5957691216057308f * (x + 0.044715f * x * x * x); return x * __builtin_amdgcn_rcpf(1.0f + __expf(-u)); }
}
DEVI void ph_sgu(const bf16_t* Z, const float* ln_g, const float* ln_b, const bf16_t* Wm, const float* bs, const float* og, bf16_t* Ymix, unsigned char* smb, int wg, int nwg) {
    using namespace sgu; typedef short bf16x8 __attribute__((ext_vector_type(8))); typedef float f32x16 __attribute__((ext_vector_type(16)));
    const int tid = otid(), lane = tid & 63, wave = __builtin_amdgcn_readfirstlane(tid >> 6), r32 = lane & 31, hi = lane >> 5;
    for (int blk = wg; blk < T / 128; blk += nwg) {
        const size_t row0 = (size_t)blk * 128;
        u32x4 uv[8]; { const u32x4* up = (const u32x4*)(Z + (row0 + (tid >> 2)) * NZ + ZUC + (tid & 3) * 64);
#pragma unroll
            for (int i = 0; i < 8; ++i) uv[i] = up[i]; }
        {
            const int tp = tid >> 3, g = (tid >> 1) & 3, hf = tid & 1, c0 = g * 64 + hf * 32;
            u32x4 raw[2][4];
#pragma unroll
            for (int k = 0; k < 2; ++k) { const u32x4* src = (const u32x4*)(Z + (row0 + 2 * tp + k) * NZ + ZVC + c0);
#pragma unroll
                for (int i = 0; i < 4; ++i) raw[k][i] = src[i]; }
            float v[2][32];
#pragma unroll
            for (int k = 0; k < 2; ++k)
#pragma unroll
                for (int i = 0; i < 4; ++i) { float f[8]; unpack8(raw[k][i], f);
#pragma unroll
                    for (int j = 0; j < 8; ++j) v[k][i * 8 + j] = gelu_fast(f[j]); }
            float mu[2], rstd[2];
#pragma unroll
            for (int k = 0; k < 2; ++k) { float s1 = 0.f;
#pragma unroll
                for (int c = 0; c < 32; ++c) s1 += v[k][c];
                s1 += __shfl_xor(s1, 1); mu[k] = s1 * (1.0f / 64.0f); float s2 = 0.f;
#pragma unroll
                for (int c = 0; c < 32; ++c) { const float dd = v[k][c] - mu[k]; s2 += dd * dd; }
                s2 += __shfl_xor(s2, 1); rstd[k] = rsqrtf(s2 * (1.0f / 64.0f) + EPS); }
            unsigned char* dst = smb + g * VGRP + (hf * 32) * VROW + tp * 4;
#pragma unroll
            for (int c = 0; c < 32; ++c) { const float gg = ln_g[c0 + c], bb = ln_b[c0 + c];
                *(unsigned*)(dst + c * VROW) = pk2((v[0][c] - mu[0]) * rstd[0] * gg + bb, (v[1][c] - mu[1]) * rstd[1] * gg + bb); }
        }
        const int g2 = wave >> 1, mh = wave & 1;
        bf16x8 af[2][8];
        { const bf16_t* wa = Wm + ((size_t)g2 * 128 + 64 * mh + r32) * 128 + 8 * hi;
#pragma unroll
            for (int ks = 0; ks < 8; ++ks) if (ks < 4 || mh) { af[0][ks] = *(const bf16x8*)(wa + ks * 16); af[1][ks] = *(const bf16x8*)(wa + 32 * 128 + ks * 16); } }
        asm volatile("s_waitcnt lgkmcnt(0)" ::: "memory"); __builtin_amdgcn_s_barrier(); asm volatile("" ::: "memory");
        {
            f32x16 acc[2][2];
#pragma unroll
            for (int i = 0; i < 2; ++i)
#pragma unroll
                for (int j = 0; j < 2; ++j) acc[i][j] = f32x16{};
            const unsigned char* vb = smb + g2 * VGRP + r32 * VROW + 16 * hi;
#pragma unroll
            for (int ks = 0; ks < 8; ++ks) if (ks < 4 || mh) {
                const bf16x8 b0 = *(const bf16x8*)(vb + ks * 32), b1 = *(const bf16x8*)(vb + 32 * VROW + ks * 32);
                acc[0][0] = __builtin_amdgcn_mfma_f32_32x32x16_bf16(af[0][ks], b0, acc[0][0], 0, 0, 0); acc[0][1] = __builtin_amdgcn_mfma_f32_32x32x16_bf16(af[0][ks], b1, acc[0][1], 0, 0, 0);
                acc[1][0] = __builtin_amdgcn_mfma_f32_32x32x16_bf16(af[1][ks], b0, acc[1][0], 0, 0, 0); acc[1][1] = __builtin_amdgcn_mfma_f32_32x32x16_bf16(af[1][ks], b1, acc[1][1], 0, 0, 0);
            }
            bf16_t* mst = (bf16_t*)(smb + MST_OFF);
#pragma unroll
            for (int mt = 0; mt < 2; ++mt)
#pragma unroll
                for (int r = 0; r < 16; ++r) { const int t = 64 * mh + 32 * mt + (r & 3) + 8 * (r >> 2) + 4 * hi; const float bias = bs[g2 * 128 + t];
                    bf16_t* mp = mst + t * (MROW / 2) + g2 * 64 + r32;
                    mp[0] = (bf16_t)f2bf(acc[mt][0][r] + bias); mp[32] = (bf16_t)f2bf(acc[mt][1][r] + bias); }
        }
        asm volatile("s_waitcnt lgkmcnt(0)" ::: "memory"); __builtin_amdgcn_s_barrier(); asm volatile("" ::: "memory");
        {
            const int t = tid >> 2, g = tid & 3; const size_t row = row0 + t;
            const u32x4* mp = (const u32x4*)(smb + MST_OFF + t * MROW + g * 128);
            float y[64]; float ss = 0.f;
#pragma unroll
            for (int i = 0; i < 8; ++i) { float uf[8], mf[8]; unpack8(uv[i], uf); unpack8(mp[i], mf);
#pragma unroll
                for (int j = 0; j < 8; ++j) { y[i * 8 + j] = gelu_fast(uf[j]) * mf[j]; ss += y[i * 8 + j] * y[i * 8 + j]; } }
            ss += __shfl_xor(ss, 1); ss += __shfl_xor(ss, 2);
            const float rs = rsqrtf(ss * (1.0f / 256.0f) + EPS);
            u32x4* yp = (u32x4*)(Ymix + row * D + 768 + g * 64); const f32x4* gp = (const f32x4*)(og + g * 64);
#pragma unroll
            for (int i = 0; i < 8; ++i) { const f32x4 g0 = gp[2 * i], g1 = gp[2 * i + 1];
                u32x4 w; w.x = pk2(y[i * 8 + 0] * rs * g0[0], y[i * 8 + 1] * rs * g0[1]); w.y = pk2(y[i * 8 + 2] * rs * g0[2], y[i * 8 + 3] * rs * g0[3]);
                w.z = pk2(y[i * 8 + 4] * rs * g1[0], y[i * 8 + 5] * rs * g1[1]); w.w = pk2(y[i * 8 + 6] * rs * g1[2], y[i * 8 + 7] * rs * g1[3]); yp[i] = w; }
        }
        asm volatile("s_waitcnt lgkmcnt(0)" ::: "memory"); __builtin_amdgcn_s_barrier(); asm volatile("" ::: "memory");
    }
}
DEVI void ph_prep_sgu(const float* w, bf16_t* Wm, int wg, int nwg) {
    for (int idx = wg * NTHR + otid(); idx < 4 * 128 * 128; idx += nwg * NTHR) { const int t = (idx >> 7) & 127, s = idx & 127; Wm[idx] = (bf16_t)f2bf(((s >> 6) <= (t >> 6)) ? w[idx] : 0.f); }
}

DEVI void ph_place_all(const unsigned* count, const int* tokE, const float* tokW, int* rank, const float* rstd2, int* row_ts, float* row_w, float* row_rs, int* tile_e, int* n_tiles, unsigned char* smb, int wg, int nwg) {
    int* ps = (int*)smb; int* cnt = ps + 40;
    const int tid = otid(), lane = tid & 63;
    if (tid < 64) { const int c = lane < 32 ? (int)__hip_atomic_load(count + lane, __ATOMIC_RELAXED, __HIP_MEMORY_SCOPE_AGENT) : 0; const int pad = (c + 255) & ~255;
        int incl = pad;
#pragma unroll
        for (int o = 1; o < 32; o <<= 1) { const int t_ = __shfl_up(incl, o); if (lane >= o) incl += t_; }
        if (lane < 32) { cnt[lane] = c; ps[lane] = incl - pad; if (lane == 31) ps[32] = incl; } }
    __syncthreads();
    if (wg == 0) {
        const int nt = ps[32] >> 8;
        if (tid == 0) *n_tiles = nt;
        for (int i = tid; i < nt; i += NTHR) { int e = 0;
#pragma unroll 1
            for (int k = 1; k < 32; ++k) if ((ps[k] >> 8) <= i) e = k;
            tile_e[i] = e; }
        for (int e = 0; e < 32; ++e) for (int r = cnt[e] + tid; r < ps[e + 1] - ps[e]; r += NTHR) { row_ts[ps[e] + r] = -1; row_rs[ps[e] + r] = 0.f; }
    }
    for (int idx = wg * NTHR + tid; idx < 2 * T; idx += nwg * NTHR) { const int pos = ps[tokE[idx]] + rank[idx]; row_ts[pos] = idx; row_w[pos] = tokW[idx]; row_rs[pos] = rstd2[idx >> 1]; rank[idx] = pos; }
    __syncthreads();
}
DEVI void ph_combine(bf16_t* h, const bf16_t* Y, const int* tokpos, float* rstd3, int wg, int nwg) {
    const int tid = otid(), lane = tid & 63, gw = wg * 8 + (tid >> 6), ngw = nwg * 8;
    for (int base = 2 * gw; base < T; base += 32 * ngw) {
        const int myrow = base + 2 * ngw * (lane >> 2) + ((lane >> 1) & 1);
        const int tp = myrow < T ? tokpos[myrow * 2 + (lane & 1)] : 0;
#pragma unroll 1
        for (int k = 0; k < 16; ++k) {
            const int row = base + 2 * ngw * k; if (row >= T) break;
            u32x4 hv[2][2], y0[2][2], y1[2][2];
#pragma unroll
            for (int r = 0; r < 2; ++r) { const int p0 = __builtin_amdgcn_readfirstlane(__shfl(tp, 4 * k + 2 * r)), p1 = __builtin_amdgcn_readfirstlane(__shfl(tp, 4 * k + 2 * r + 1));
#pragma unroll
                for (int jj = 0; jj < 2; ++jj) { hv[r][jj] = ((const u32x4*)(h + (size_t)(row + r) * D) + lane)[64 * jj];
                    y0[r][jj] = __builtin_nontemporal_load((const u32x4*)(Y + (size_t)p0 * D) + lane + 64 * jj); y1[r][jj] = __builtin_nontemporal_load((const u32x4*)(Y + (size_t)p1 * D) + lane + 64 * jj); } }
#pragma unroll
            for (int r = 0; r < 2; ++r) { float s = 0.f;
#pragma unroll
                for (int jj = 0; jj < 2; ++jj) { float a[8], b0[8], b1[8]; unpack8(hv[r][jj], a); unpack8(y0[r][jj], b0); unpack8(y1[r][jj], b1);
#pragma unroll
                    for (int i = 0; i < 8; ++i) { a[i] += b0[i] + b1[i]; s += a[i] * a[i]; }
                    u32x4 w; w.x = pk2(a[0], a[1]); w.y = pk2(a[2], a[3]); w.z = pk2(a[4], a[5]); w.w = pk2(a[6], a[7]); ((u32x4*)(h + (size_t)(row + r) * D) + lane)[64 * jj] = w; }
                s = wave_sum(s);
                if (lane == 0) rstd3[row + r] = rsqrtf(s * (1.0f / 1024.0f) + EPS); }
        }
    }
}
DEVI void ph_final(const bf16_t* h, float* out, const float* ssp, const float* g, int wg, int nwg) {
    const int tid = otid(), lane = tid & 63, gw = wg * 8 + (tid >> 6), ngw = nwg * 8;
    const f32x4* gp = (const f32x4*)g + 2 * lane; const f32x4 g00 = gp[0], g01 = gp[1], g10 = gp[128], g11 = gp[129];
    for (int row = 2 * gw; row < T; row += 2 * ngw) {
        u32x4 hv[2][2]; float sp[2];
#pragma unroll
        for (int r = 0; r < 2; ++r) { sp[r] = lane < 16 ? ssp[(size_t)(row + r) * 16 + lane] : 0.f;
#pragma unroll
            for (int jj = 0; jj < 2; ++jj) hv[r][jj] = ((const u32x4*)(h + (size_t)(row + r) * D) + lane)[64 * jj]; }
#pragma unroll
        for (int r = 0; r < 2; ++r) { const float rs = rsqrtf(wave_sum(sp[r]) * (1.0f / 1024.0f) + EPS); f32x4* op = (f32x4*)(out + (size_t)(row + r) * D) + 2 * lane;
#pragma unroll
            for (int jj = 0; jj < 2; ++jj) { float a[8]; unpack8(hv[r][jj], a); const f32x4 g0 = jj ? g10 : g00, g1 = jj ? g11 : g01;
                op[128 * jj] = (f32x4){a[0] * rs * g0[0], a[1] * rs * g0[1], a[2] * rs * g0[2], a[3] * rs * g0[3]}; op[128 * jj + 1] = (f32x4){a[4] * rs * g1[0], a[5] * rs * g1[1], a[6] * rs * g1[2], a[7] * rs * g1[3]}; } }
    }
}

enum { IN_X = 0, IN_P, IN_NORM1G, IN_WIN, IN_CONVW, IN_CONVB, IN_IGB, IN_FGB, IN_MNG, IN_SBOG, IN_SGULNG, IN_SGULNB, IN_SGUW, IN_SGUB, IN_SGUOG, IN_WOUT, IN_NORM2G,
       IN_RGW, IN_RGB, IN_REW, IN_REB, IN_WGATE, IN_WUP, IN_WDOWN, IN_PLENG, IN_PLEGW, IN_PLEPW, IN_FINALG, N_INPUTS };
constexpr int NPH_LAYER = 9, NPHASES = 1 + DEPTH * NPH_LAYER + 1;
struct Params { const float* in[N_INPUTS]; float* out; unsigned char* ws; int ph_lo, ph_hi; };
static_assert(sizeof(Params) == N_INPUTS * 8 + 8 + 8 + 8, "Params has no padding");

__global__ void __launch_bounds__(NTHR, 2) mega(Params p) {
    extern __shared__ __attribute__((aligned(16))) unsigned char lds[];
    const int tid = threadIdx.x, wg = blockIdx.x, nwg = gridDim.x;
    for (int u = tid; u < (LDS_BYTES - MISC_OFF) / 4; u += NTHR) ((LAS unsigned*)(lds + MISC_OFF))[u] = 0u;
    __syncthreads();
    unsigned char* const ws0 = p.ws;
    const bool fused = (p.ph_hi - p.ph_lo) > 1;
    XcdBarrier bar; bar.bar = (unsigned*)(ws0 + WS_CTL) + CW_BAR; bar.x = 0; bar.st = nullptr;
    if (fused) bar = xcd_barrier_post((unsigned*)(ws0 + WS_CTL) + CW_BAR, (volatile LAS unsigned*)(lds + MISC_OFF));
    PG8_LAS unsigned char* ring = (PG8_LAS unsigned char*)lds;
#define WSP(type, off) ((type)(ws + (off)))
#define PH_LOCALS size_t zo_ = 0; asm volatile("" : "+s"(zo_)); unsigned char* ws = ws0 + zo_; float* out = p.out + zo_;   \
        unsigned char* wl = ws + WS_WTS + (size_t)l * WL_SIZE; (void)wl; (void)out; \
        bf16_t* const HIN = (bf16_t*)(ws + ((l & 1) ? WS_HBB : WS_HBA)); bf16_t* const HOUT = (bf16_t*)(ws + ((l & 1) ? WS_HBA : WS_HBB)); (void)HIN; (void)HOUT;

    int gp = 0;
#define PH_ON (p.ph_lo <= gp && gp < p.ph_hi)
#define PH_END do { if (fused && gp + 1 < p.ph_hi) for (int rb_ = 0; rb_ < REP_BAR; ++rb_) xcd_barrier(bar); ++gp; } while (0)

    if (PH_ON) for (int rep = 0; rep < REP_PRO; ++rep) {
#pragma unroll 1
        for (int l = 0; l < DEPTH; ++l) {
            PH_LOCALS
            { const PrepJob j{p.in[IN_WIN] + (size_t)l * D * 3208, nullptr, p.in[IN_NORM1G] + l * D, (bf16_t*)(wl + WL_IN), 3208, D, NZ, 1, 1, 0, 0, 0}; ph_prep_w(j, lds, wg, nwg); }
            { const PrepJob j{p.in[IN_WOUT] + (size_t)l * D * D, nullptr, nullptr, (bf16_t*)(wl + WL_OUT), D, D, D, 0, 1, 0, 0, 0}; ph_prep_w(j, lds, wg, nwg); }
            { const PrepJob j{p.in[IN_WGATE] + (size_t)l * NEXP * D * DEXP, p.in[IN_WUP] + (size_t)l * NEXP * D * DEXP, p.in[IN_NORM2G] + l * D, (bf16_t*)(wl + WL_GU), DEXP, D, 512, 2, NEXP, 0, (size_t)D * DEXP, (size_t)512 * D};
              ph_prep_w(j, lds, wg, nwg); }
            { const PrepJob j{p.in[IN_WDOWN] + (size_t)l * NEXP * DEXP * D, nullptr, nullptr, (bf16_t*)(wl + WL_DN), D, DEXP, D, 0, NEXP, 0, (size_t)DEXP * D, (size_t)D * DEXP}; ph_prep_w(j, lds, wg, nwg); }
            { const PrepJob j{p.in[IN_PLEGW] + (size_t)l * D * D, nullptr, p.in[IN_PLENG] + l * D, (bf16_t*)(wl + WL_PG), D, D, D, 0, 1, 0, 0, 0}; ph_prep_w(j, lds, wg, nwg); }
            { const PrepJob j{p.in[IN_PLEPW] + (size_t)l * PDIM * D, nullptr, nullptr, (bf16_t*)(wl + WL_PP), D, PDIM, D, 0, 1, 0, 0, 0}; ph_prep_w(j, lds, wg, nwg); }
            ph_prep_sgu(p.in[IN_SGUW] + (size_t)l * 4 * 128 * 128, WSP(bf16_t*, WS_WSGU) + (size_t)l * 4 * 128 * 128, wg, nwg);
            ph_prep_router(p.in[IN_RGW] + l * D * 4, p.in[IN_REW] + l * D * 32, p.in[IN_NORM2G] + l * D, WSP(bf16_t*, WS_WR) + (size_t)l * 256 * D, wg, nwg);
        }
        { const int l = 0; PH_LOCALS
          ph_prep_x(p.in[IN_X], WSP(bf16_t*, WS_HBA), WSP(float*, WS_SSP), wg, nwg);
          ph_cvt_bf16(p.in[IN_P], WSP(bf16_t*, WS_PB), (size_t)DEPTH * T * PDIM / 4, wg, nwg); }
    }
    PH_END;

#pragma clang loop unroll(full)
    for (int l = 0; l < DEPTH; ++l) {
        if (PH_ON) { PH_LOCALS
            pg8::Gemm g{HIN, (const bf16_t*)(wl + WL_IN), T, NZ, D, 0}; pg8::StaticOrder S; S.init(T, NZ, nwg, wg); const float* rtab = (const float*)(lds + 131072);
            { const int tid_ = otid(); const float* ssp_ = WSP(const float*, WS_SSP);
              for (int i = tid_ >> 8; ; i += 2) { pg8::Unit u_; if (!S.next(i & ~1, u_)) break; if (S.next(i, u_)) { const f32x4* sp = (const f32x4*)(ssp_ + (size_t)(u_.pm * 256 + (tid_ & 255)) * 16);
                  const f32x4 st = (sp[0] + sp[1]) + (sp[2] + sp[3]); ((float*)(lds + 131072))[i * 256 + (tid_ & 255)] = rsqrtf(((st[0] + st[1]) + (st[2] + st[3])) * (1.0f / 1024.0f) + EPS); } }
              __syncthreads(); }
            EpiZ E{WSP(bf16_t*, WS_Z), rtab, WSP(float*, WS_GATES)};
            if (STG_Z) stagger(wg, STG_Z);
            for (int rep = 0; rep < REP_Z; ++rep) pg8::gemm_phase<EpiZ, pg8::StaticOrder, AL_Z, true>(ring, g, S, E); }
        PH_END;
        if (PH_ON) { PH_LOCALS
            const int nh = nwg >> 1;
            if (wg < nh) {
                for (int rep = 0; rep < REP_ML; ++rep) ph_mlstm(WSP(const bf16_t*, WS_Z), WSP(const float*, WS_GATES), p.in[IN_CONVW] + l * 4 * 768, p.in[IN_CONVB] + l * 768, p.in[IN_IGB] + l * 4, p.in[IN_FGB] + l * 4, p.in[IN_MNG] + l * 384, WSP(bf16_t*, WS_YMIX), lds, wg, nh);
            } else {
                for (int rep = 0; rep < REP_SB; ++rep) { ph_sb(WSP(const bf16_t*, WS_Z), p.in[IN_SBOG] + l * 384, WSP(bf16_t*, WS_YMIX), lds, wg - nh, nwg - nh); __syncthreads(); }
                for (int rep = 0; rep < REP_SGU; ++rep) ph_sgu(WSP(const bf16_t*, WS_Z), p.in[IN_SGULNG] + l * 256, p.in[IN_SGULNB] + l * 256, WSP(const bf16_t*, WS_WSGU) + (size_t)l * 4 * 128 * 128, p.in[IN_SGUB] + l * 4 * 128, p.in[IN_SGUOG] + l * 256, WSP(bf16_t*, WS_YMIX), lds, wg - nh, nwg - nh);
            }
        }
        PH_END;
        if (PH_ON) { PH_LOCALS
            pg8::Gemm g{WSP(const bf16_t*, WS_YMIX), (const bf16_t*)(wl + WL_OUT), T, D, D, 0}; pg8::StaticOrder S; S.init(T, D, nwg, wg); EpiResid E{HIN, HIN, WSP(float*, WS_SSP2)};
            if (REP_WOUT0 > 1) { EpiResid E2{HIN, WSP(bf16_t*, WS_Z), WSP(float*, WS_Z + 400 * MiB)}; for (int rep = 1; rep < REP_WOUT0; ++rep) pg8::gemm_phase<EpiResid, pg8::StaticOrder, AL_WOUT, true>(ring, g, S, E2); }
            if (STG_WOUT) stagger(wg, STG_WOUT);
            pg8::gemm_phase<EpiResid, pg8::StaticOrder, AL_WOUT, true>(ring, g, S, E); }
        PH_END;
        if (PH_ON) { PH_LOCALS
            pg8::Gemm g{HIN, WSP(const bf16_t*, WS_WR) + (size_t)l * 256 * D, T, 256, D, 0}; pg8::StaticOrder S; S.init(T, 256, nwg, wg);
            EpiRouter E{WSP(const float*, WS_SSP2), p.in[IN_RGB] + l * 4, p.in[IN_REB] + l * 32, WSP(int*, WS_TOKE), WSP(float*, WS_TOKW), WSP(float*, WS_RSTD2), WSP(int*, WS_RANK), WSP(unsigned*, WS_CTL) + CW_COUNT + 32 * l};
            pg8::gemm_phase<EpiRouter, pg8::StaticOrder, false, true>(ring, g, S, E); }
        PH_END;
        if (PH_ON) { PH_LOCALS
            for (int rep = 0; rep < REP_PLACE; ++rep) ph_place_all(WSP(const unsigned*, WS_CTL) + CW_COUNT + 32 * l, WSP(const int*, WS_TOKE), WSP(const float*, WS_TOKW), WSP(int*, WS_RANK), WSP(const float*, WS_RSTD2), WSP(int*, WS_ROWTS), WSP(float*, WS_ROWW), WSP(float*, WS_ROWRS),
                         WSP(int*, WS_TILEE), WSP(int*, WS_CTL) + CW_NTILES + l, lds, wg, nwg); }
        PH_END;
        if (PH_ON) { PH_LOCALS
            pg8::Gemm g{HIN, (const bf16_t*)(wl + WL_GU), MAXROWS, 512, D, 0}; MoeGatherOrder S; S.ntot = 0; S.nN = 2; S.G = 0; S.c = 0; S.tile_e = (const int*)(lds + 131072); S.estride = (size_t)512 * D * 2; S.row_ts = WSP(const int*, WS_ROWTS);
            { const int tid_ = otid(); const int nt_ = *(WSP(const int*, WS_CTL) + CW_NTILES + l); for (int i = tid_; i < nt_; i += NTHR) ((int*)(lds + 131072))[i] = WSP(const int*, WS_TILEE)[i]; __syncthreads(); }
            S.bind(WSP(const int*, WS_CTL) + CW_NTILES + l, nwg, wg);
            S.ntot = (S.ntot / nwg) * nwg;
            EpiGU E{WSP(const float*, WS_ROWRS), WSP(bf16_t*, WS_HID)};
            if (STG_GU) stagger(wg, STG_GU);
            for (int rep = 0; rep < REP_GU; ++rep) pg8::gemm_phase<EpiGU, MoeGatherOrder, AL_GU, true>(ring, g, S, E); }
        PH_END;
        if (PH_ON) { PH_LOCALS
            { const int tid_ = otid(); const int nt_ = *(WSP(const int*, WS_CTL) + CW_NTILES + l); for (int i = tid_; i < nt_; i += NTHR) ((int*)(lds + 131072))[i] = WSP(const int*, WS_TILEE)[i]; __syncthreads(); }
            const int ntl = __builtin_amdgcn_readfirstlane(*(WSP(const int*, WS_CTL) + CW_NTILES + l)), mt0 = ((ntl * 2) / nwg) * (nwg / 2), ntail = ntl - mt0;
            if (wg < ntail) {
                pg8::Gemm g{HIN, (const bf16_t*)(wl + WL_GU), MAXROWS, 512, D, 0}; MoeGatherOrder S; S.nN = 2; S.G = 1; S.c = (mt0 + wg) * 2; S.ntot = S.c + 2; S.tile_e = (const int*)(lds + 131072); S.estride = (size_t)512 * D * 2; S.row_ts = WSP(const int*, WS_ROWTS);
                EpiGU E{WSP(const float*, WS_ROWRS), WSP(bf16_t*, WS_HID)};
                pg8::gemm_phase<EpiGU, MoeGatherOrder, AL_GU, true>(ring, g, S, E);
                __syncthreads();
            }
            pg8::Gemm g{WSP(const bf16_t*, WS_HID), (const bf16_t*)(wl + WL_DN), MAXROWS, D, DEXP, 0}; MoeDealOrder S; S.ntot = 0; S.nN = 4; S.G = nwg; S.c = wg; S.tile_e = (const int*)(lds + 131072); S.estride = (size_t)D * DEXP * 2; S.mt0 = mt0; S.ntail = ntail; S.nD = mt0 * 4;
            EpiDown E{WSP(const float*, WS_ROWW), WSP(bf16_t*, WS_Y)};
            if (STG_DOWN) stagger(wg, STG_DOWN);
            for (int rep = 0; rep < REP_DOWN; ++rep) pg8::gemm_phase<EpiDown, MoeDealOrder, AL_DOWN, true>(ring, g, S, E); }
        PH_END;
        if (PH_ON) { PH_LOCALS
            ph_combine(HIN, WSP(const bf16_t*, WS_Y), WSP(const int*, WS_RANK), WSP(float*, WS_RSTD3), wg, nwg);
            __syncthreads();
            pg8::Gemm g{WSP(const bf16_t*, WS_PB) + (size_t)l * T * PDIM, (const bf16_t*)(wl + WL_PP), T, D, PDIM, 0}; pg8::StaticOrder S; S.init(T, D, nwg, wg); EpiPlain E{WSP(bf16_t*, WS_YMIX), D, 0};
            for (int rep = 0; rep < REP_PP; ++rep) pg8::gemm_phase<EpiPlain, pg8::StaticOrder, AL_PP, true>(ring, g, S, E);
        }
        PH_END;
        if (PH_ON) { PH_LOCALS
            pg8::Gemm g{HIN, (const bf16_t*)(wl + WL_PG), T, D, D, 0}; pg8::StaticOrder S; S.init(T, D, nwg, wg); EpiPLE E{WSP(const float*, WS_RSTD3), WSP(const bf16_t*, WS_YMIX), HIN, HOUT, WSP(float*, WS_SSP)};
            if (STG_PLE) stagger(wg, STG_PLE);
            if (REP_PLE > 1) { EpiPLE E2{WSP(const float*, WS_RSTD3), WSP(const bf16_t*, WS_YMIX), HIN, WSP(bf16_t*, WS_Z), WSP(float*, WS_Z + 400 * MiB)}; for (int rep = 1; rep < REP_PLE; ++rep) pg8::gemm_phase<EpiPLE, pg8::StaticOrder, AL_PLE, true>(ring, g, S, E2); }
            pg8::gemm_phase<EpiPLE, pg8::StaticOrder, AL_PLE, true>(ring, g, S, E); }
        PH_END;
    }
    if (PH_ON) { const int l = 0; PH_LOCALS
        ph_final(WSP(const bf16_t*, (DEPTH & 1) ? WS_HBB : WS_HBA), out, WSP(const float*, WS_SSP), p.in[IN_FINALG], wg, nwg); }
#undef PH_ON
#undef PH_END
}

#ifndef REP_SB
#define REP_SB 1
#endif
#ifndef REP_ML
#define REP_ML 1
#endif
#ifndef REP_SGU
#define REP_SGU 1
#endif
#ifndef MK_SPLIT
#define MK_SPLIT 0
#endif
extern "C" void kernel_launch(void* const* d_in, const int* in_sizes, int n_in, void* d_out, int out_size, void* d_ws, size_t ws_size, hipStream_t stream) {
    static int grid = 0;
    if (grid == 0) {
        if (n_in != N_INPUTS || in_sizes[0] != T * D || out_size != T * D || ws_size < WS_END) { fprintf(stderr, "kernel_launch: unexpected shapes / workspace (%d inputs, ws %zu)\n", n_in, ws_size); grid = -1; return; }
        int dev = 0, cus = 0;
        if (hipGetDevice(&dev) != hipSuccess || hipDeviceGetAttribute(&cus, hipDeviceAttributeMultiprocessorCount, dev) != hipSuccess) { grid = -1; return; }
        if (hipFuncSetAttribute((const void*)mega, hipFuncAttributeMaxDynamicSharedMemorySize, LDS_BYTES) != hipSuccess) { grid = -1; return; }
        int per_cu = 0;
        if (hipOccupancyMaxActiveBlocksPerMultiprocessor(&per_cu, (const void*)mega, NTHR, LDS_BYTES) != hipSuccess || per_cu < 1) fprintf(stderr, "kernel_launch: occupancy query says %d\n", per_cu);
        (void)hipGetLastError();
        grid = cus;
        if (grid != 256) { fprintf(stderr, "kernel_launch: built for 256 CUs (one router unit per workgroup)\n"); grid = -1; return; }
        if (grid < 208) { fprintf(stderr, "kernel_launch: built for >= 208 CUs (LDS table of 16 units per workgroup in the input projection)\n"); grid = -1; return; }
    }
    if (grid < 0) return;
    (void)hipMemsetAsync((unsigned char*)d_ws + WS_CTL, 0, 1 * MiB, stream);
    Params p{};
    for (int i = 0; i < N_INPUTS; ++i) p.in[i] = (const float*)d_in[i];
    p.out = (float*)d_out; p.ws = (unsigned char*)d_ws;
#if MK_SPLIT
    for (int ph = 0; ph < NPHASES; ++ph) { p.ph_lo = ph; p.ph_hi = ph + 1; hipLaunchKernelGGL(mega, dim3(grid), dim3(NTHR), LDS_BYTES, stream, p); }
#else
    p.ph_lo = 0; p.ph_hi = NPHASES;
    hipLaunchKernelGGL(mega, dim3(grid), dim3(NTHR), LDS_BYTES, stream, p);
#endif
}
```

```cpp
#include <hip/hip_runtime.h>
#include <cstdio>
#include <cstdint>
namespace pg8 {
#define PG8_LAS __attribute__((address_space(3)))
typedef unsigned short bf16_t;
typedef short bf16x8 __attribute__((ext_vector_type(8)));
typedef float f32x4 __attribute__((ext_vector_type(4)));
typedef unsigned u32x4 __attribute__((ext_vector_type(4)));
constexpr int BM = 256, BK = 64, HALF = 128, HTB = HALF * BK * 2  , STAGE_BYTES = 8 * HTB, NXCD = 8, WGM = 8;

__host__ __device__ __forceinline__ int lds_byte(int r, int c) { const int st = (r >> 4) * 2 + (c >> 5), rr = r & 15, cc = c & 31, ob = rr * 64 + cc * 2; return st * 1024 + (ob ^ (((ob >> 9) & 1) << 5)); }
__host__ __device__ __forceinline__ void stage_rc(int b, int& R, int& C) { const int st = b / 1024, sb = b % 1024, swz = sb ^ (((sb >> 9) & 1) << 5); R = (st >> 1) * 16 + swz / 64; C = (st & 1) * 32 + (swz % 64) / 2; }
__host__ __device__ __forceinline__ int perm32(int rho) { const int n = rho >> 4, i = rho & 15; return 8 * (i >> 2) + 4 * n + (i & 3); }

struct Unit { int pm, pn, ord; };
struct Gemm { const bf16_t* A; const bf16_t* Bt; int M, N, K, pad; };

struct StaticOrder {
    static constexpr bool GATHER = false;
    int nM, nN, nwg, G, c;
    __host__ __device__ __forceinline__ void init(int M, int N, int G_, int c_) { nM = M / BM; nN = N / BM; nwg = nM * nN; G = G_; c = c_; }
    __host__ __device__ __forceinline__ bool next(int i, Unit& u) const {
        const long L = (long)i * G + c; if (L >= nwg) return false;
        int wgid = (int)L; { const int q = nwg / NXCD, r = nwg % NXCD, xcd = wgid % NXCD, off = wgid / NXCD; wgid = (xcd < r ? xcd * (q + 1) : r * (q + 1) + (xcd - r) * q) + off; }
        const int nig = WGM * nN, gid = wgid / nig, fm = gid * WGM, gsz = (nM - fm) < WGM ? (nM - fm) : WGM;
        u.pm = fm + ((wgid % nig) % gsz); u.pn = (wgid % nig) / gsz; return true;
    }
    __device__ __forceinline__ size_t bbase(const Unit& u, size_t tstep) const { return (size_t)u.pn * tstep; }
    __device__ __forceinline__ int arow(const Unit&, int) const { return 0; }
    __device__ __forceinline__ void a_ready(const Unit&) const {}
    __device__ __forceinline__ void done(const Unit&) const {}
};

__device__ __forceinline__ unsigned cvt_pk_bf16(float lo, float hi) { unsigned r; asm volatile("v_cvt_pk_bf16_f32 %0, %1, %2" : "=v"(r) : "v"(lo), "v"(hi)); return r; }
typedef float f32x2 __attribute__((ext_vector_type(2)));
template <class Epi, class Sched, bool ALIGN_EPI = false, bool SP2 = false>
__device__ __forceinline__ void gemm_phase(PG8_LAS unsigned char* lds, const Gemm g, const Sched& S, const Epi& E) {
    int tid_ = threadIdx.x; asm volatile("" : "+v"(tid_));
    const int tid = tid_, wid = __builtin_amdgcn_readfirstlane(tid >> 6), lane = tid & 63, wr = wid >> 2, wc = wid & 3, fr = lane & 15, fq = lane >> 4;
    int K_ = g.K; asm volatile("" : "+s"(K_));
    const int K = K_, nt = K / BK;
    unsigned voffA[2], voffB[2]; int gR[2], gC[2]; unsigned va[2][2], vnx[2][2];
#pragma unroll
    for (int i = 0; i < 2; ++i) { int R, C; stage_rc(tid * 16 + i * 8192, R, C); const int Rb = Epi::PERM ? ((R & ~31) + perm32(R & 31)) : R;
        voffA[i] = (unsigned)(R * K + C) * 2u; voffB[i] = (unsigned)(Rb * K + C) * 2u; gR[i] = R; gC[i] = C; }
    const size_t kstep = (size_t)(BK * 2);
    const size_t hstep = (size_t)HALF * K * 2;
    const size_t tstep = 2 * hstep;
    const unsigned ldsw = (unsigned)wid * 1024u;
    const int aoff = lds_byte(wr * 64 + fr, fq * 8), boff = lds_byte(wc * 32 + fr, fq * 8);
#define PG8_SA(b, h) (((b) * 2 + (h)) * HTB)
#define PG8_SB(b, h) ((4 + (b) * 2 + (h)) * HTB)
#define PG8_STAGE(bufoff, gbase, voff) do { _Pragma("unroll") for (int _i = 0; _i < 2; ++_i) \
        __builtin_amdgcn_global_load_lds((const unsigned*)((const char*)(gbase) + (voff)[_i]), (PG8_LAS unsigned*)(lds + (bufoff) + ldsw + _i * 8192), 16, 0, 0); } while (0)
#define PG8_STAGE_A(bufoff, kptr, h, nx) do { if constexpr (Sched::GATHER) { const unsigned o_[2] = {(nx) ? vnx[h][0] : va[h][0], (nx) ? vnx[h][1] : va[h][1]}; PG8_STAGE(bufoff, kptr, o_); } \
        else { PG8_STAGE(bufoff, (kptr) + (h) * hstep, voffA); } } while (0)
#define PG8_GOFF(dst, u) do { _Pragma("unroll") for (int h_ = 0; h_ < 2; ++h_) _Pragma("unroll") for (int i_ = 0; i_ < 2; ++i_) dst[h_][i_] = (unsigned)S.arow(u, h_ * HALF + gR[i_]) * (unsigned)(K * 2) + (unsigned)(gC[i_] * 2); } while (0)
#define PG8_LDA(dst, b, h) do { _Pragma("unroll") for (int m = 0; m < 4; ++m) _Pragma("unroll") for (int k = 0; k < 2; ++k) dst[m][k] = *(const PG8_LAS bf16x8*)(lds + PG8_SA(b, h) + aoff + m * 2048 + k * 1024); } while (0)
#define PG8_LDB(dst, b, h) do { _Pragma("unroll") for (int n = 0; n < 2; ++n) _Pragma("unroll") for (int k = 0; k < 2; ++k) dst[n][k] = *(const PG8_LAS bf16x8*)(lds + PG8_SB(b, h) + boff + n * 2048 + k * 1024); } while (0)
#define PG8_MMA(ai, bj, At, Bt) do { __builtin_amdgcn_s_setprio(1); _Pragma("unroll") for (int m = 0; m < 4; ++m) _Pragma("unroll") for (int n = 0; n < 2; ++n) _Pragma("unroll") for (int k = 0; k < 2; ++k) \
        acc[ai][bj][m][n] = __builtin_amdgcn_mfma_f32_16x16x32_bf16(Bt[n][k], At[m][k], acc[ai][bj][m][n], 0, 0, 0); __builtin_amdgcn_s_setprio(0); } while (0)
#define PG8_WAIT_V(n) asm volatile("s_waitcnt vmcnt(" #n ")" ::: "memory")
#define PG8_WAIT_L(n) asm volatile("s_waitcnt lgkmcnt(" #n ")" ::: "memory")
#define PG8_BAR __builtin_amdgcn_s_barrier()
#define PG8_SCHED __builtin_amdgcn_sched_barrier(0)
    Unit cur, nxt; int ui = 0;
    if (!S.next(0, cur)) return;
    cur.ord = 0;
    f32x4 acc[2][2][4][2];
#pragma unroll
    for (int a = 0; a < 2; ++a)
#pragma unroll
        for (int b = 0; b < 2; ++b)
#pragma unroll
            for (int m = 0; m < 4; ++m)
#pragma unroll
                for (int n = 0; n < 2; ++n) acc[a][b][m][n] = (f32x4){0.f, 0.f, 0.f, 0.f};
    bf16x8 At[4][2], B0[2][2], B1[2][2];
    static_assert(!Sched::GATHER || SP2, "the gathered A operand is wired into the SP2 loop only");
    const char* cA = (const char*)g.A + (Sched::GATHER ? (size_t)0 : (size_t)cur.pm * tstep); const char* cB = (const char*)g.Bt + S.bbase(cur, tstep);
    if constexpr (Sched::GATHER) { PG8_GOFF(va, cur); _Pragma("unroll") for (int h_ = 0; h_ < 2; ++h_) _Pragma("unroll") for (int i_ = 0; i_ < 2; ++i_) vnx[h_][i_] = va[h_][i_]; }
    S.a_ready(cur);
    if constexpr (SP2) {
        PG8_STAGE(PG8_SB(0, 0), cB, voffB); PG8_STAGE(PG8_SB(0, 1), cB + hstep, voffB); PG8_STAGE_A(PG8_SA(0, 0), cA, 0, false); PG8_STAGE_A(PG8_SA(0, 1), cA, 1, false);
        if (wr == 1) PG8_BAR;
        PG8_WAIT_V(2); PG8_BAR;
        PG8_STAGE(PG8_SB(1, 0), cB + kstep, voffB); PG8_STAGE_A(PG8_SA(1, 0), cA + kstep, 0, false); PG8_STAGE(PG8_SB(1, 1), cB + hstep + kstep, voffB);
        PG8_WAIT_V(6); PG8_BAR;
    } else {
        PG8_STAGE(PG8_SB(0, 0), cB, voffB); PG8_STAGE(PG8_SA(0, 0), cA, voffA); PG8_STAGE(PG8_SB(0, 1), cB + hstep, voffB); PG8_STAGE(PG8_SA(0, 1), cA + hstep, voffA);
        if (wr == 1) PG8_BAR;
        PG8_WAIT_V(4); PG8_BAR;
        PG8_STAGE(PG8_SB(1, 0), cB + kstep, voffB); PG8_STAGE(PG8_SA(1, 0), cA + kstep, voffA); PG8_STAGE(PG8_SB(1, 1), cB + hstep + kstep, voffB);
        PG8_WAIT_V(6); PG8_BAR;
    }
    for (;;) {
        const bool has_next = S.next(ui + 1, nxt); nxt.ord = ui + 1;
        if constexpr (Sched::GATHER) { if (has_next) PG8_GOFF(vnx, nxt); }
        const char* nA = (has_next && !Sched::GATHER) ? (const char*)g.A + (size_t)nxt.pm * tstep : cA; const char* nB = has_next ? (const char*)g.Bt + S.bbase(nxt, tstep) : cB;
        for (int t = 0; t < nt; t += 2) {
            const bool last = (t == nt - 2); const bool lastnx = last && has_next; (void)lastnx;
            const char* a1 = cA + (size_t)(t + 1) * kstep;
            const char* a2 = last ? nA : cA + (size_t)(t + 2) * kstep; const char* b2 = last ? nB : cB + (size_t)(t + 2) * kstep;
            const char* a3 = a2 + kstep; const char* b3 = b2 + kstep;
            if (last && has_next) S.a_ready(nxt);
            if constexpr (SP2) {
            PG8_LDB(B0, 0, 0); PG8_LDB(B1, 0, 1); PG8_SCHED; PG8_LDA(At, 0, 0); PG8_STAGE_A(PG8_SA(1, 1), a1, 1, false);
            PG8_WAIT_V(8); PG8_WAIT_L(0); PG8_BAR; PG8_MMA(0, 0, At, B0); PG8_MMA(0, 1, At, B1); PG8_BAR; PG8_SCHED;
            PG8_LDA(At, 0, 1); PG8_STAGE(PG8_SB(0, 0), b2, voffB); PG8_STAGE(PG8_SB(0, 1), b2 + hstep, voffB); PG8_STAGE_A(PG8_SA(0, 0), a2, 0, lastnx);
            PG8_WAIT_V(8); PG8_WAIT_L(0); PG8_BAR; PG8_MMA(1, 0, At, B0); PG8_MMA(1, 1, At, B1); PG8_BAR; PG8_SCHED;
            PG8_LDB(B0, 1, 0); PG8_LDB(B1, 1, 1); PG8_SCHED; PG8_LDA(At, 1, 0); PG8_STAGE_A(PG8_SA(0, 1), a2, 1, lastnx);
            PG8_WAIT_V(8); PG8_WAIT_L(0); PG8_BAR; PG8_MMA(0, 0, At, B0); PG8_MMA(0, 1, At, B1); PG8_BAR; PG8_SCHED;
            PG8_LDA(At, 1, 1); PG8_STAGE(PG8_SB(1, 0), b3, voffB); PG8_STAGE(PG8_SB(1, 1), b3 + hstep, voffB); PG8_STAGE_A(PG8_SA(1, 0), a3, 0, lastnx);
            PG8_WAIT_V(8); PG8_WAIT_L(0); PG8_BAR; PG8_MMA(1, 0, At, B0); PG8_MMA(1, 1, At, B1); PG8_BAR; PG8_SCHED;
            } else {
            PG8_LDB(B0, 0, 0); PG8_SCHED; PG8_LDA(At, 0, 0); PG8_STAGE(PG8_SA(1, 1), a1 + hstep, voffA);
            PG8_WAIT_L(8); PG8_BAR; PG8_WAIT_L(0); PG8_MMA(0, 0, At, B0); PG8_BAR; PG8_SCHED;
            PG8_LDB(B1, 0, 1); PG8_STAGE(PG8_SB(0, 0), b2, voffB);
            PG8_BAR; PG8_WAIT_L(0); PG8_MMA(0, 1, At, B1); PG8_BAR;
            PG8_LDA(At, 0, 1); PG8_STAGE(PG8_SA(0, 0), a2, voffA);
            PG8_BAR; PG8_WAIT_L(0); PG8_MMA(1, 0, At, B0); PG8_BAR; PG8_SCHED;
            PG8_STAGE(PG8_SB(0, 1), b2 + hstep, voffB);
            PG8_WAIT_V(6); PG8_BAR; PG8_MMA(1, 1, At, B1); PG8_BAR;
            PG8_LDB(B0, 1, 0); PG8_SCHED; PG8_LDA(At, 1, 0); PG8_STAGE(PG8_SA(0, 1), a2 + hstep, voffA);
            PG8_WAIT_L(8); PG8_BAR; PG8_WAIT_L(0); PG8_MMA(0, 0, At, B0); PG8_BAR; PG8_SCHED;
            PG8_LDB(B1, 1, 1); PG8_STAGE(PG8_SB(1, 0), b3, voffB);
            PG8_BAR; PG8_WAIT_L(0); PG8_MMA(0, 1, At, B1); PG8_BAR;
            PG8_LDA(At, 1, 1); PG8_STAGE(PG8_SA(1, 0), a3, voffA);
            PG8_BAR; PG8_WAIT_L(0); PG8_MMA(1, 0, At, B0); PG8_BAR; PG8_SCHED;
            PG8_STAGE(PG8_SB(1, 1), b3 + hstep, voffB);
            PG8_WAIT_V(6); PG8_BAR; PG8_MMA(1, 1, At, B1); PG8_BAR;
            }
        }
        if constexpr (ALIGN_EPI) { if (wr == 0) PG8_BAR; }
        if constexpr (!Epi::AFTER_DRAIN) { E(acc, cur, wr, wc, fr, fq); S.done(cur); }
        if (!has_next) break;
#pragma unroll
        for (int a = 0; a < 2; ++a)
#pragma unroll
            for (int b = 0; b < 2; ++b)
#pragma unroll
                for (int m = 0; m < 4; ++m)
#pragma unroll
                    for (int n = 0; n < 2; ++n) acc[a][b][m][n] = (f32x4){0.f, 0.f, 0.f, 0.f};
        cur = nxt; cA = nA; cB = nB; ++ui;
        if constexpr (Sched::GATHER) { _Pragma("unroll") for (int h_ = 0; h_ < 2; ++h_) _Pragma("unroll") for (int i_ = 0; i_ < 2; ++i_) va[h_][i_] = vnx[h_][i_]; }
        if constexpr (ALIGN_EPI) { if (wr == 1) PG8_BAR; }
    }
    PG8_WAIT_V(0);
    if constexpr (!ALIGN_EPI) { if (wr == 0) PG8_BAR; }
    PG8_BAR;
    if constexpr (Epi::AFTER_DRAIN) { E.fused(acc, cur, wr, wc, fr, fq, lds, wid, lane); S.done(cur); }
#undef PG8_SA
#undef PG8_SB
#undef PG8_STAGE
#undef PG8_STAGE_A
#undef PG8_GOFF
#undef PG8_LDA
#undef PG8_LDB
#undef PG8_MMA
#undef PG8_WAIT_V
#undef PG8_WAIT_L
#undef PG8_BAR
#undef PG8_SCHED
}
}

#define DEVI __device__ __forceinline__
typedef unsigned short bf16_t;
typedef float f32x4 __attribute__((ext_vector_type(4)));
typedef unsigned u32x4 __attribute__((ext_vector_type(4)));
typedef unsigned u32x2 __attribute__((ext_vector_type(2)));

constexpr int T = 65536, D = 1024, SEQ = 2048, NB = 32, DEPTH = 2;
constexpr int NZ = 3328;
constexpr int ZQA = 0, ZKA = 384, ZVA = 768, ZIF = 1152, ZQB = 1280, ZKB = 1664, ZVB = 2048, ZOB = 2432, ZUC = 2816, ZVC = 3072;
constexpr int NEXP = 32, DEXP = 256, PDIM = 256;
constexpr int MAXROWS = 2 * T + NEXP * 256;
constexpr float EPS = 1e-6f;

constexpr size_t MiB = 1u << 20;
constexpr size_t WS_CTL = 0;
constexpr size_t WS_GATES = 1 * MiB;
constexpr size_t WS_SSP = 3 * MiB;
constexpr size_t WS_TOKE = 7 * MiB;
constexpr size_t WS_TOKW = 7 * MiB + 512 * 1024;
constexpr size_t WS_RSTD2 = 8 * MiB;
constexpr size_t WS_RSTD3 = 8 * MiB + 256 * 1024;
constexpr size_t WS_RANK = 8 * MiB + 512 * 1024;
constexpr size_t WS_ROWTS = 9 * MiB;
constexpr size_t WS_ROWW = 10 * MiB;
constexpr size_t WS_ROWRS = 11 * MiB + 64 * 1024;
constexpr size_t WS_TILEE = 11 * MiB;
constexpr size_t WS_PSTART = 11 * MiB + 4096;
constexpr size_t WS_WR = 12 * MiB;
constexpr size_t WS_WSGU = 13 * MiB;
constexpr size_t WS_WTS = 16 * MiB;
constexpr size_t WL_IN = 0, WL_OUT = 6656 * 1024, WL_GU = WL_OUT + 2 * MiB, WL_DN = WL_GU + 32 * MiB, WL_PG = WL_DN + 16 * MiB, WL_PP = WL_PG + 2 * MiB, WL_SIZE = 59 * MiB;
constexpr size_t WS_PB = 134 * MiB;
constexpr size_t WS_HBA = 198 * MiB;
constexpr size_t WS_HBB = 326 * MiB;
constexpr size_t WS_YMIX = 454 * MiB;
constexpr size_t WS_Z = 582 * MiB;
constexpr size_t WS_XS = WS_Z, WS_Y = WS_Z, WS_HID = WS_Z + 272 * MiB;
constexpr size_t WS_SSP2 = 998 * MiB;
constexpr size_t WS_END = 1002 * MiB;
static_assert(WL_PP + 512 * 1024 <= WL_SIZE, "weights map");
static_assert((size_t)MAXROWS * 1024 * 2 <= 272 * MiB && (size_t)MAXROWS * 256 * 2 <= 68 * MiB, "overlay map");
constexpr int CW_COUNT = 0;
constexpr int CW_NTILES = 64;

DEVI float bf2f(unsigned short b) { return __uint_as_float((unsigned)b << 16); }
typedef float f32x2_t __attribute__((ext_vector_type(2))); typedef __bf16 bf16x2_t __attribute__((ext_vector_type(2)));
DEVI unsigned pk2(float lo, float hi) { const f32x2_t v = {lo, hi}; return __builtin_bit_cast(unsigned, __builtin_convertvector(v, bf16x2_t)); }
DEVI unsigned f2bf(float f) { return pk2(f, 0.f) & 0xffffu; }
DEVI float wave_sum(float v) {
#pragma unroll
    for (int o = 1; o < 64; o <<= 1) v += __shfl_xor(v, o);
    return v;
}
DEVI float sigmoidf_(float x) { return 1.0f / (1.0f + __expf(-x)); }
DEVI float siluf_(float x) { return x * sigmoidf_(x); }
DEVI float gelu_tanh(float x) { const float u = 0.7978845608028654f * (x + 0.044715f * x * x * x); return 0.5f * x * (1.0f + tanhf(u)); }
DEVI float softplusf_(float x) { return fmaxf(x, 0.f) + log1pf(__expf(-fabsf(x))); }

using pg8::Unit;
struct EpiZ {
    static constexpr bool PERM = true, AFTER_DRAIN = false;
    bf16_t* Z; const float* rtab; float* gates;
    const float* cin; bf16_t* cout; int G, c;
    static constexpr int CVT_NCH = DEPTH * T * PDIM / 8, CVT_CPU = (CVT_NCH + 13 * 256 - 1) / (13 * 256);
    DEVI void operator()(const f32x4 (&acc)[2][2][4][2], const Unit& u, int wr, int wc, int fr, int fq) const {
        int row0 = u.pm * 256 + wr * 64 + fr, col0 = u.pn * 256 + wc * 32 + 8 * fq; asm volatile("" : "+v"(row0), "+v"(col0));
        const float* rt = rtab + u.ord * 256 + wr * 64 + fr;
        f32x4 cv[3][2]; int cch[3];
        if (cin != nullptr) { int t_ = (wr * 4 + wc) * 64 + fq * 16 + fr; asm volatile("" : "+v"(t_)); const int ch0 = (u.ord * G + c) * CVT_CPU;
#pragma unroll
            for (int k = 0; k < 3; ++k) { const int o_ = t_ + 512 * k; cch[k] = (o_ < CVT_CPU && ch0 + o_ < CVT_NCH) ? ch0 + o_ : -1;
                if (cch[k] >= 0) { cv[k][0] = ((const f32x4*)cin)[2 * (size_t)cch[k]]; cv[k][1] = ((const f32x4*)cin)[2 * (size_t)cch[k] + 1]; } } }
#pragma unroll
        for (int ai = 0; ai < 2; ++ai)
#pragma unroll
            for (int m = 0; m < 4; ++m) {
                const int row = row0 + ai * 128 + m * 16;
                const float rs = rt[ai * 128 + m * 16];
                bf16_t* rowp = Z + (size_t)row * NZ + col0;
#pragma unroll
                for (int bj = 0; bj < 2; ++bj) {
                    const float sc = (u.pn == 0 || (u.pn == 1 && bj == 0)) ? rs * (0.125f * 1.4426950408889634f) : rs;
                    const f32x4 v0 = acc[ai][bj][m][0] * sc, v1 = acc[ai][bj][m][1] * sc;
                    u32x4 w; w.x = pk2(v0[0], v0[1]); w.y = pk2(v0[2], v0[3]); w.z = pk2(v1[0], v1[1]); w.w = pk2(v1[2], v1[3]);
                    *(u32x4*)(rowp + bj * 128) = w;
                    if (bj == 1 && u.pn == 4 && wc == 0 && fq == 0) { *(f32x4*)(gates + (size_t)row * 8) = v0; *(f32x4*)(gates + (size_t)row * 8 + 4) = v1; }
                }
            }
        if (cin != nullptr) {
#pragma unroll
            for (int k = 0; k < 3; ++k) if (cch[k] >= 0) { u32x4 w; w.x = pk2(cv[k][0][0], cv[k][0][1]); w.y = pk2(cv[k][0][2], cv[k][0][3]); w.z = pk2(cv[k][1][0], cv[k][1][1]); w.w = pk2(cv[k][1][2], cv[k][1][3]); ((u32x4*)cout)[cch[k]] = w; } }
    }
};
DEVI void unpack8(const u32x4 w, float (&f)[8]) { f[0] = __uint_as_float(w.x << 16); f[1] = __uint_as_float(w.x & 0xffff0000u); f[2] = __uint_as_float(w.y << 16); f[3] = __uint_as_float(w.y & 0xffff0000u);
    f[4] = __uint_as_float(w.z << 16); f[5] = __uint_as_float(w.z & 0xffff0000u); f[6] = __uint_as_float(w.w << 16); f[7] = __uint_as_float(w.w & 0xffff0000u); }
struct EpiResid {
    static constexpr bool PERM = true, AFTER_DRAIN = false;
    const bf16_t* hin; bf16_t* hout; float* ssp;
    DEVI void operator()(const f32x4 (&acc)[2][2][4][2], const Unit& u, int wr, int wc, int fr, int fq) const {
        int row0 = u.pm * 256 + wr * 64 + fr, col0 = u.pn * 256 + wc * 32 + 8 * fq; asm volatile("" : "+v"(row0), "+v"(col0));
#pragma unroll
        for (int ai = 0; ai < 2; ++ai) {
            u32x4 hv[4][2];
#pragma unroll
            for (int m = 0; m < 4; ++m)
#pragma unroll
                for (int bj = 0; bj < 2; ++bj) hv[m][bj] = *(const u32x4*)(hin + (size_t)(row0 + ai * 128 + m * 16) * D + col0 + bj * 128);
#pragma unroll
            for (int m = 0; m < 4; ++m) {
                const int row = row0 + ai * 128 + m * 16; const size_t off = (size_t)row * D + col0; float sacc = 0.f;
#pragma unroll
                for (int bj = 0; bj < 2; ++bj) {
                    float f[8]; unpack8(hv[m][bj], f);
                    const f32x4 v0 = acc[ai][bj][m][0], v1 = acc[ai][bj][m][1];
                    f[0] += v0[0]; f[1] += v0[1]; f[2] += v0[2]; f[3] += v0[3]; f[4] += v1[0]; f[5] += v1[1]; f[6] += v1[2]; f[7] += v1[3];
                    sacc += ((f[0] * f[0] + f[1] * f[1]) + (f[2] * f[2] + f[3] * f[3])) + ((f[4] * f[4] + f[5] * f[5]) + (f[6] * f[6] + f[7] * f[7]));
                    u32x4 w; w.x = pk2(f[0], f[1]); w.y = pk2(f[2], f[3]); w.z = pk2(f[4], f[5]); w.w = pk2(f[6], f[7]);
                    *(u32x4*)(hout + off + bj * 128) = w;
                }
                sacc += __shfl_xor(sacc, 16); sacc += __shfl_xor(sacc, 32);
                if (fq == 0) ssp[(size_t)row * 16 + u.pn * 4 + wc] = sacc;
            }
        }
    }
};
struct EpiPLE {
    static constexpr bool PERM = true, AFTER_DRAIN = false;
    const float* rstd3; const bf16_t* pp; const bf16_t* hin; bf16_t* hout; float* ssp;
    DEVI void operator()(const f32x4 (&acc)[2][2][4][2], const Unit& u, int wr, int wc, int fr, int fq) const {
        int row0 = u.pm * 256 + wr * 64 + fr, col0 = u.pn * 256 + wc * 32 + 8 * fq; asm volatile("" : "+v"(row0), "+v"(col0));
#pragma unroll
        for (int ai = 0; ai < 2; ++ai) {
            u32x4 hv[4][2], pvv[4][2]; float rsv[4];
#pragma unroll
            for (int m = 0; m < 4; ++m) { const int row = row0 + ai * 128 + m * 16; rsv[m] = rstd3[row];
#pragma unroll
                for (int bj = 0; bj < 2; ++bj) { hv[m][bj] = *(const u32x4*)(hin + (size_t)row * D + col0 + bj * 128); pvv[m][bj] = *(const u32x4*)(pp + (size_t)row * D + col0 + bj * 128); } }
#pragma unroll
            for (int m = 0; m < 4; ++m) {
                const int row = row0 + ai * 128 + m * 16; const size_t off = (size_t)row * D + col0; const float rs = rsv[m];
                float sacc = 0.f;
#pragma unroll
                for (int bj = 0; bj < 2; ++bj) {
                    float hf[8], pf[8]; unpack8(hv[m][bj], hf); unpack8(pvv[m][bj], pf);
                    float o[8];
#pragma unroll
                    for (int i = 0; i < 8; ++i) { const float a = acc[ai][bj][m][i >> 2][i & 3] * rs; o[i] = hf[i] + __builtin_amdgcn_rcpf(1.0f + __expf(-a)) * pf[i]; sacc += o[i] * o[i]; }
                    u32x4 w; w.x = pk2(o[0], o[1]); w.y = pk2(o[2], o[3]); w.z = pk2(o[4], o[5]); w.w = pk2(o[6], o[7]);
                    *(u32x4*)(hout + off + bj * 128) = w;
                }
                sacc += __shfl_xor(sacc, 16); sacc += __shfl_xor(sacc, 32);
                if (fq == 0) ssp[(size_t)row * 16 + u.pn * 4 + wc] = sacc;
            }
        }
    }
};
struct EpiGU {
    static constexpr bool PERM = true, AFTER_DRAIN = false;
    const float* row_rs; bf16_t* hid;
    DEVI void operator()(const f32x4 (&acc)[2][2][4][2], const Unit& u, int wr, int wc, int fr, int fq) const {
        int row0 = u.pm * 256 + wr * 64 + fr; asm volatile("" : "+v"(row0));
        float rsv[2][4];
#pragma unroll
        for (int ai = 0; ai < 2; ++ai)
#pragma unroll
            for (int m = 0; m < 4; ++m) rsv[ai][m] = row_rs[row0 + ai * 128 + m * 16];
#pragma unroll
        for (int ai = 0; ai < 2; ++ai)
#pragma unroll
            for (int m = 0; m < 4; ++m) {
                const int row = row0 + ai * 128 + m * 16;
                const float rs = rsv[ai][m];
                float hv[8];
#pragma unroll
                for (int n = 0; n < 2; ++n)
#pragma unroll
                    for (int i = 0; i < 4; ++i) { const float g = acc[ai][0][m][n][i] * rs, uu = acc[ai][1][m][n][i] * rs; hv[n * 4 + i] = siluf_(g) * uu; }
                u32x4 w; w.x = pk2(hv[0], hv[1]); w.y = pk2(hv[2], hv[3]); w.z = pk2(hv[4], hv[5]); w.w = pk2(hv[6], hv[7]);
                *(u32x4*)(hid + (size_t)row * DEXP + u.pn * 128 + wc * 32 + 8 * fq) = w;
            }
    }
};
struct EpiDown {
    static constexpr bool PERM = true, AFTER_DRAIN = false;
    const float* row_w; bf16_t* Y;
    DEVI void operator()(const f32x4 (&acc)[2][2][4][2], const Unit& u, int wr, int wc, int fr, int fq) const {
        int row0 = u.pm * 256 + wr * 64 + fr, col0 = u.pn * 256 + wc * 32 + 8 * fq; asm volatile("" : "+v"(row0), "+v"(col0));
        float wv[2][4];
#pragma unroll
        for (int ai = 0; ai < 2; ++ai)
#pragma unroll
            for (int m = 0; m < 4; ++m) wv[ai][m] = row_w[row0 + ai * 128 + m * 16];
#pragma unroll
        for (int ai = 0; ai < 2; ++ai)
#pragma unroll
            for (int m = 0; m < 4; ++m) {
                const float wt = wv[ai][m];
                bf16_t* rowp = Y + (size_t)(row0 + ai * 128 + m * 16) * D + col0;
#pragma unroll
                for (int bj = 0; bj < 2; ++bj) {
                    const f32x4 v0 = acc[ai][bj][m][0] * wt, v1 = acc[ai][bj][m][1] * wt;
                    u32x4 w; w.x = pk2(v0[0], v0[1]); w.y = pk2(v0[2], v0[3]); w.z = pk2(v1[0], v1[1]); w.w = pk2(v1[2], v1[3]);
                    __builtin_nontemporal_store(w, (u32x4*)(rowp + bj * 128));
                }
            }
    }
};
struct EpiNull {
    static constexpr bool PERM = true, AFTER_DRAIN = false;
    float* sink;
    DEVI void operator()(const f32x4 (&acc)[2][2][4][2], const Unit& u, int wr, int wc, int fr, int fq) const {
        float s = 0.f;
#pragma unroll
        for (int ai = 0; ai < 2; ++ai)
#pragma unroll
            for (int bj = 0; bj < 2; ++bj)
#pragma unroll
                for (int m = 0; m < 4; ++m)
#pragma unroll
                    for (int n = 0; n < 2; ++n) s += acc[ai][bj][m][n][0];
        if (s == 1.2345e-30f) sink[0] = s;
    }
};
struct EpiRouter {
    static constexpr bool PERM = false, AFTER_DRAIN = true;
    const float* ssp; const float* rgb; const float* reb; int* tokE; float* tokW; float* rstd2; int* rank; unsigned* count;
    DEVI void fused(f32x4 (&acc)[2][2][4][2], const Unit& u, int wr, int wc, int fr, int fq, PG8_LAS unsigned char* lds, int wid, int lane) const {
        PG8_LAS float* lg = (PG8_LAS float*)lds;
        PG8_LAS int* hist = (PG8_LAS int*)(lds + 256 * 97 * 4); PG8_LAS int* wgb = hist + 32; PG8_LAS int* selE = wgb + 32; PG8_LAS int* selR = selE + 512;
        const int tid = wid * 64 + lane;
        if (tid < 32) hist[tid] = 0;
        if (wc < 3) {
#pragma unroll
            for (int ai = 0; ai < 2; ++ai)
#pragma unroll
                for (int m = 0; m < 4; ++m) { const int r = ai * 128 + wr * 64 + m * 16 + fr;
#pragma unroll
                    for (int n = 0; n < 2; ++n)
#pragma unroll
                        for (int i = 0; i < 4; ++i) lg[r * 97 + 32 * wc + 16 * n + 4 * fq + i] = acc[ai][0][m][n][i]; }
        }
        asm volatile("s_waitcnt lgkmcnt(0)" ::: "memory"); __builtin_amdgcn_s_barrier(); asm volatile("" ::: "memory");
        if (tid < 256) {
            const int t = u.pm * 256 + tid; PG8_LAS const float* l0 = lg + tid * 97;
            const f32x4* sp = (const f32x4*)(ssp + (size_t)t * 16); const f32x4 st = (sp[0] + sp[1]) + (sp[2] + sp[3]);
            const float rs = rsqrtf(((st[0] + st[1]) + (st[2] + st[3])) * (1.0f / 1024.0f) + EPS);
            float gl[4]; int gtop = 0; float gmax;
#pragma unroll
            for (int n = 0; n < 4; ++n) gl[n] = (l0[n] + l0[48 + n]) * rs + rgb[n];
            gmax = gl[0];
#pragma unroll
            for (int n = 1; n < 4; ++n) if (gl[n] > gmax) { gmax = gl[n]; gtop = n; }
            float den = 0.f;
#pragma unroll
            for (int n = 0; n < 4; ++n) den += __expf(gl[n] - gmax);
            const float gw = 1.0f / den;
            float el[8];
#pragma unroll
            for (int jj = 0; jj < 8; ++jj) el[jj] = (l0[4 + gtop * 8 + jj] + l0[52 + gtop * 8 + jj]) * rs + reb[gtop * 8 + jj];
            int i1 = 0; float v1 = el[0];
#pragma unroll
            for (int jj = 1; jj < 8; ++jj) if (el[jj] > v1) { v1 = el[jj]; i1 = jj; }
            int i2 = -1; float v2 = -INFINITY;
#pragma unroll
            for (int jj = 0; jj < 8; ++jj) if (jj != i1 && el[jj] > v2) { v2 = el[jj]; i2 = jj; }
            const float ex = __expf(v2 - v1), w1 = 1.0f / (1.0f + ex), w2 = ex * w1;
            const int e1 = gtop * 8 + i1, e2 = gtop * 8 + i2;
            tokE[t * 2] = e1; tokE[t * 2 + 1] = e2; tokW[t * 2] = w1 * gw; tokW[t * 2 + 1] = w2 * gw; rstd2[t] = rs;
            selE[tid * 2] = e1; selE[tid * 2 + 1] = e2; selR[tid * 2] = __hip_atomic_fetch_add(hist + e1, 1, __ATOMIC_RELAXED, __HIP_MEMORY_SCOPE_WORKGROUP); selR[tid * 2 + 1] = __hip_atomic_fetch_add(hist + e2, 1, __ATOMIC_RELAXED, __HIP_MEMORY_SCOPE_WORKGROUP);
        }
        asm volatile("s_waitcnt lgkmcnt(0)" ::: "memory"); __builtin_amdgcn_s_barrier(); asm volatile("" ::: "memory");
        if (tid < 32) wgb[tid] = (int)atomicAdd(count + tid, (unsigned)hist[tid]);
        asm volatile("s_waitcnt vmcnt(0) lgkmcnt(0)" ::: "memory"); __builtin_amdgcn_s_barrier(); asm volatile("" ::: "memory");
        rank[u.pm * 512 + tid] = wgb[selE[tid]] + selR[tid];
        asm volatile("s_waitcnt lgkmcnt(0)" ::: "memory"); __builtin_amdgcn_s_barrier(); asm volatile("" ::: "memory");
    }
};
struct EpiPlain {
    static constexpr bool PERM = true, AFTER_DRAIN = false;
    bf16_t* O; int ldc, pad;
    DEVI void operator()(const f32x4 (&acc)[2][2][4][2], const Unit& u, int wr, int wc, int fr, int fq) const {
        int row0 = u.pm * 256 + wr * 64 + fr, col0 = u.pn * 256 + wc * 32 + 8 * fq; asm volatile("" : "+v"(row0), "+v"(col0));
#pragma unroll
        for (int ai = 0; ai < 2; ++ai)
#pragma unroll
            for (int m = 0; m < 4; ++m) {
                bf16_t* rowp = O + (size_t)(row0 + ai * 128 + m * 16) * ldc + col0;
#pragma unroll
                for (int bj = 0; bj < 2; ++bj) {
                    const f32x4 v0 = acc[ai][bj][m][0], v1 = acc[ai][bj][m][1];
                    u32x4 w; w.x = pk2(v0[0], v0[1]); w.y = pk2(v0[2], v0[3]); w.z = pk2(v1[0], v1[1]); w.w = pk2(v1[2], v1[3]);
                    *(u32x4*)(rowp + bj * 128) = w;
                }
            }
    }
};
struct MoeOrder {
    static constexpr bool GATHER = false;
    int ntot, nN, G, c; const int* tile_e; size_t estride;
    DEVI void bind(const int* n_tiles_ptr, int G_, int c_) { ntot = __builtin_amdgcn_readfirstlane(*n_tiles_ptr) * nN; G = G_; c = c_; }
    DEVI bool next(int i, Unit& u) const { const long L = (long)i * G + c; if (L >= ntot) return false; u.pm = (int)(L / nN); u.pn = (int)(L % nN); return true; }
    DEVI size_t bbase(const Unit& u, size_t tstep) const { return (size_t)__builtin_amdgcn_readfirstlane(tile_e[u.pm]) * estride + (size_t)u.pn * tstep; }
    DEVI int arow(const Unit&, int) const { return 0; }
    DEVI void a_ready(const Unit&) const {}
    DEVI void done(const Unit&) const {}
};
struct MoeGatherOrder : MoeOrder {
    static constexpr bool GATHER = true;
    const int* row_ts;
    DEVI int arow(const Unit& u, int r) const { const int ts = row_ts[u.pm * 256 + r]; return ts >= 0 ? (ts >> 1) : 0; }
};
struct MoeDealOrder : MoeOrder {
    static constexpr int H = 8;
    int mt0, ntail, nD;
    DEVI bool next(int i, Unit& u) const {
        const int w = c;
        if (w < ntail) { if (i < 4) { u.pm = mt0 + w; u.pn = i; return true; } i -= 4; }
        const int nf = G - ntail; int d;
        if (w >= ntail && i < H) d = (w - ntail) + i * nf;
        else { const int ii = (w >= ntail) ? i - H : i, j = (w >= ntail) ? (w - ntail) : (w - ntail + G); d = H * nf + j + G * ii; }
        if (d >= nD) return false;
        u.pm = d >> 2; u.pn = d & 3; return true;
    }
};


#ifndef REP_SB
#define REP_SB 1
#endif
#ifndef REP_ML
#define REP_ML 1
#endif
#ifndef REP_SGU
#define REP_SGU 1
#endif
#ifndef REP_Z
#define REP_Z 1
#endif
#ifndef REP_PRO
#define REP_PRO 1
#endif
#ifndef REP_GATHER
#define REP_GATHER 1
#endif
#ifndef REP_GU
#define REP_GU 1
#endif
#ifndef REP_DOWN
#define REP_DOWN 1
#endif
#ifndef REP_PP
#define REP_PP 1
#endif
#ifndef REP_WOUT0
#define REP_WOUT0 1
#endif
#ifndef REP_BAR
#define REP_BAR 1
#endif
#ifndef REP_PLACE
#define REP_PLACE 1
#endif
#ifndef REP_PLE
#define REP_PLE 1
#endif
#ifndef REP_RTR
#define REP_RTR 1
#endif
#ifndef STG_Z
#define STG_Z 0
#endif
#ifndef STG_WOUT
#define STG_WOUT 0
#endif
#ifndef STG_GU
#define STG_GU 0
#endif
#ifndef STG_DOWN
#define STG_DOWN 0
#endif
#ifndef STG_PP
#define STG_PP 0
#endif
#ifndef STG_PLE
#define STG_PLE 0
#endif
#ifndef AL_Z
#define AL_Z true
#endif
#ifndef AL_WOUT
#define AL_WOUT true
#endif
#ifndef AL_GU
#define AL_GU true
#endif
#ifndef AL_DOWN
#define AL_DOWN true
#endif
#ifndef AL_PP
#define AL_PP true
#endif
#ifndef AL_PLE
#define AL_PLE true
#endif
constexpr int NTHR = 512;
constexpr int RING_BYTES = 147456;
constexpr int MISC_OFF = RING_BYTES;
constexpr int LDS_BYTES = RING_BYTES + 4096;
constexpr int CW_BAR = 4096;

#define XB_TMO      128
#define XB_XCNT(j)  (256  + 64 * (j))
#define XB_XSUB(j)  (1280 + 64 * (j))
#define XB_XGEN(j)  (2304 + 64 * (j))
#define XB_TOP      3328
#define XB_TOPGEN   3392
#define XCD_BAR_WORDS 3456
#define XB_SPIN_CAP (1u << 18)
#define LAS __attribute__((address_space(3)))

__device__ __forceinline__ unsigned xb_ld(unsigned* p)              { return __hip_atomic_load(p, __ATOMIC_RELAXED, __HIP_MEMORY_SCOPE_AGENT); }
__device__ __forceinline__ unsigned xb_add(unsigned* p, unsigned v) { return __hip_atomic_fetch_add(p, v, __ATOMIC_RELAXED, __HIP_MEMORY_SCOPE_AGENT); }
__device__ __forceinline__ unsigned xb_xcc_id() { return (unsigned)__builtin_amdgcn_s_getreg((3 << 11) | 20) & 0xFu; }
#define XB_SPIN(cond, bar) do { unsigned _sp = 0; while (cond) { __builtin_amdgcn_s_sleep(1); \
    if ((++_sp & 255u) == 0u) { if (xb_ld(&(bar)[XB_TMO])) break; if (_sp > XB_SPIN_CAP) { atomicAdd(&(bar)[XB_TMO], 1u); break; } } } } while (0)

struct XcdBarrier {
    unsigned* bar; unsigned x;
    volatile LAS unsigned* st;
};

__device__ __forceinline__ XcdBarrier xcd_barrier_post(unsigned* bar, volatile LAS unsigned* st) {
    XcdBarrier b; b.bar = bar; b.x = xb_xcc_id(); b.st = st;
    if (threadIdx.x == 0) (void)xb_add(&bar[XB_XCNT(b.x)], 1u);
    return b;
}
__device__ __forceinline__ void xcd_barrier_complete(unsigned* bar, unsigned x, unsigned& nloc, unsigned& nx) {
    const unsigned G = gridDim.x * gridDim.y * gridDim.z;
    unsigned sum, cnt, mine, sp = 0u;
    for (;;) {
        sum = 0u; cnt = 0u; mine = 0u;
#pragma unroll
        for (unsigned j = 0; j < 16; ++j) { const unsigned c = xb_ld(&bar[XB_XCNT(j)]); sum += c; cnt += (c > 0u) ? 1u : 0u; mine = (j == x) ? c : mine; }
        if (sum == G) break;
        __builtin_amdgcn_s_sleep(1);
        if ((++sp & 255u) == 0u) { if (xb_ld(&bar[XB_TMO])) break; if (sp > XB_SPIN_CAP) { atomicAdd(&bar[XB_TMO], 1u); break; } }
    }
    nloc = mine > 0u ? mine : 1u; nx = cnt > 0u ? cnt : 1u;
}

__device__ __forceinline__ void xcd_barrier(const XcdBarrier& b) {
    asm volatile("s_waitcnt vmcnt(0)" ::: "memory");
    __syncthreads();
    if (threadIdx.x == 0) {
        unsigned* bar = b.bar;
        __builtin_amdgcn_s_waitcnt(0);
        unsigned nloc = b.st[0], nx = b.st[1];
        if (nloc == 0u) { xcd_barrier_complete(bar, b.x, nloc, nx); b.st[0] = nloc; b.st[1] = nx; }
        const unsigned old = xb_add(&bar[XB_XSUB(b.x)], 1u);
        const unsigned gen = old / nloc;
        if (old + 1u == (gen + 1u) * nloc) {
            __builtin_amdgcn_fence(__ATOMIC_RELEASE, "agent");
            asm volatile("s_waitcnt vmcnt(0)" ::: "memory");
            const unsigned og = xb_add(&bar[XB_TOP], 1u);
            const unsigned tg = og / nx;
            if (og + 1u == (tg + 1u) * nx) xb_add(&bar[XB_TOPGEN], 1u);
            else XB_SPIN(xb_ld(&bar[XB_TOPGEN]) == tg, bar);
            __builtin_amdgcn_fence(__ATOMIC_ACQUIRE, "agent");
            xb_add(&bar[XB_XGEN(b.x)], 1u);
            asm volatile("s_waitcnt vmcnt(0)" ::: "memory");
        } else {
            XB_SPIN(xb_ld(&bar[XB_XGEN(b.x)]) == gen, bar);
            __builtin_amdgcn_fence(__ATOMIC_ACQUIRE, "agent");
            asm volatile("s_waitcnt vmcnt(0)" ::: "memory");
        }
    }
    __syncthreads();
}


DEVI int otid() { int t = threadIdx.x; asm volatile("" : "+v"(t)); return t; }
DEVI void stagger(int wg, unsigned ticks) { const unsigned long long t0 = __builtin_amdgcn_s_memrealtime(), d = (unsigned long long)((wg & 3) * ticks); while (__builtin_amdgcn_s_memrealtime() - t0 < d) __builtin_amdgcn_s_sleep(8); }
struct PrepJob { const float* in; const float* in2; const float* gain; bf16_t* out; int ldin, K, Nout, mode, ne, pad; size_t in_es, out_es; };
DEVI void ph_prep_w(const PrepJob& j, unsigned char* sm, int wg, int nwg) {
    const int tid = otid(), lane = tid & 63, wave = tid >> 6;
    float* scr = (float*)sm + wave * (64 * 33);
    const int nb = j.Nout / 32, kb = j.K / 64, per = nb * kb, total = per * j.ne;
    for (int it = wg * 8 + wave; it < total; it += nwg * 8) {
        const int e = it / per, r = it - e * per, k0 = (r / nb) * 64, n0 = (r % nb) * 32;
        const int n = n0 + (lane & 31); const float* src = j.in + (size_t)e * j.in_es; int col = n; bool valid = true;
        if (j.mode == 1) {
            if (n < 1152) col = n; else if (n < 1160) col = 2688 + (n - 1152); else if (n < 1280) valid = false; else if (n < 2816) col = 1152 + (n - 1280); else col = 2696 + (n - 2816);
        } else if (j.mode == 2) { const int pn = n >> 8, bj = (n >> 7) & 1; col = pn * 128 + (n & 127); if (bj) src = j.in2 + (size_t)e * j.in_es; }
        const float* sp = src + (size_t)(k0 + (lane >> 5)) * j.ldin + col; const float* gp = j.gain ? j.gain + k0 + (lane >> 5) : nullptr;
        float vv[32];
#pragma unroll
        for (int i = 0; i < 32; ++i) vv[i] = valid ? sp[(size_t)(2 * i) * j.ldin] : 0.f;
#pragma unroll
        for (int i = 0; i < 32; ++i) { float v = vv[i]; if (gp) v *= gp[2 * i]; scr[(2 * i + (lane >> 5)) * 33 + (lane & 31)] = v; }
        asm volatile("s_waitcnt lgkmcnt(0)" ::: "memory");
        const int c = lane & 7; bf16_t* o = j.out + (size_t)e * j.out_es;
#pragma unroll
        for (int jj = 0; jj < 4; ++jj) { const int nn = (lane >> 3) + 8 * jj; const float* q = scr + (8 * c) * 33 + nn;
            u32x4 w; w.x = pk2(q[0 * 33], q[1 * 33]); w.y = pk2(q[2 * 33], q[3 * 33]); w.z = pk2(q[4 * 33], q[5 * 33]); w.w = pk2(q[6 * 33], q[7 * 33]);
            *(u32x4*)(o + (size_t)(n0 + nn) * j.K + k0 + 8 * c) = w; }
        asm volatile("s_waitcnt lgkmcnt(0)" ::: "memory");
    }
}
DEVI void ph_prep_router(const float* rgw, const float* rew, const float* g, bf16_t* WRt, int wg, int nwg) {
    for (int idx = wg * NTHR + otid(); idx < 256 * 1024; idx += nwg * NTHR) { const int r = idx / 1024, k = idx % 1024, n = r < 48 ? r : r - 48;
        float w = (r < 96 && n < 36) ? g[k] * (n < 4 ? rgw[k * 4 + n] : rew[k * 32 + (n - 4)]) : 0.f;
        const unsigned hb = f2bf(w); WRt[idx] = (bf16_t)(r < 48 ? hb : f2bf(w - __uint_as_float(hb << 16))); }
}
DEVI void ph_prep_x(const float* x, bf16_t* hb, float* ssp, int wg, int nwg) {
    const int tid = otid(), lane = tid & 63, gw = wg * 8 + (tid >> 6), ngw = nwg * 8;
    for (int row = 2 * gw; row < T; row += 2 * ngw) {
        f32x4 v[2][4];
#pragma unroll
        for (int r = 0; r < 2; ++r)
#pragma unroll
            for (int jj = 0; jj < 4; ++jj) v[r][jj] = ((const f32x4*)(x + (size_t)(row + r) * D) + lane)[64 * jj];
#pragma unroll
        for (int r = 0; r < 2; ++r) { float s = 0.f; u32x2* o = (u32x2*)(hb + (size_t)(row + r) * D) + lane;
#pragma unroll
            for (int jj = 0; jj < 4; ++jj) { const f32x4 a = v[r][jj]; s += (a[0] * a[0] + a[1] * a[1]) + (a[2] * a[2] + a[3] * a[3]); u32x2 w; w.x = pk2(a[0], a[1]); w.y = pk2(a[2], a[3]); o[64 * jj] = w; }
            s = wave_sum(s);
            if (lane < 16) ssp[(size_t)(row + r) * 16 + lane] = lane == 0 ? s : 0.f; }
    }
}
DEVI void ph_cvt_bf16(const float* in, bf16_t* out, size_t n4, int wg, int nwg) {
    const size_t stride = (size_t)nwg * NTHR;
    for (size_t i0 = (size_t)wg * NTHR + otid(); i0 < n4; i0 += 8 * stride) {
        f32x4 v[8];
#pragma unroll
        for (int k = 0; k < 8; ++k) { const size_t i = i0 + k * stride; v[k] = i < n4 ? ((const f32x4*)in)[i] : (f32x4){0.f, 0.f, 0.f, 0.f}; }
#pragma unroll
        for (int k = 0; k < 8; ++k) { const size_t i = i0 + k * stride; if (i < n4) { u32x2 w; w.x = pk2(v[k][0], v[k][1]); w.y = pk2(v[k][2], v[k][3]); ((u32x2*)out)[i] = w; } }
    }
}

namespace sb {
typedef short bf16x8 __attribute__((ext_vector_type(8)));
typedef short s16x4 __attribute__((ext_vector_type(4)));
typedef float f32x16 __attribute__((ext_vector_type(16)));
constexpr float QSCALE = 0.125f * 1.4426950408889634f;
constexpr int WAVE_LDS = 12288;
DEVI int crow(int r, int hi) { return (r & 3) + 8 * (r >> 2) + 4 * hi; }
DEVI void glds16(const void* gsrc, unsigned lds_dst) { unsigned keep;
    asm volatile("s_mov_b32 %0, m0\n\ts_mov_b32 m0, %2\n\ts_nop 0\n\tglobal_load_lds_dwordx4 %1, off\n\ts_mov_b32 m0, %0" : "=&s"(keep) : "v"(gsrc), "s"(lds_dst) : "memory"); }
DEVI unsigned cvtpk(float lo, float hi) { unsigned r; asm("v_cvt_pk_bf16_f32 %0, %1, %2" : "=v"(r) : "v"(lo), "v"(hi)); return r; }
DEVI void pv(f32x16* o, int vb, bf16x8 pa0, bf16x8 pa1, bf16x8 pa2, bf16x8 pa3) {
#pragma unroll
    for (int d0 = 0; d0 < 2; ++d0) { s16x4 lo[4], hi[4];
#pragma unroll
        for (int ks = 0; ks < 4; ++ks) {
            asm volatile("ds_read_b64_tr_b16 %0,%1 offset:%c2" : "=&v"(lo[ks]) : "v"(vb), "i"(d0 * 4096 + ks * 1024) : "memory");
            asm volatile("ds_read_b64_tr_b16 %0,%1 offset:%c2" : "=&v"(hi[ks]) : "v"(vb), "i"(d0 * 4096 + ks * 1024 + 512) : "memory"); }
        asm volatile("s_waitcnt lgkmcnt(0)" ::: "memory"); __builtin_amdgcn_sched_barrier(0);
#define SB_PK(k) (bf16x8){lo[k][0], lo[k][1], lo[k][2], lo[k][3], hi[k][0], hi[k][1], hi[k][2], hi[k][3]}
        o[d0] = __builtin_amdgcn_mfma_f32_32x32x16_bf16(pa0, SB_PK(0), o[d0], 0, 0, 0);
        o[d0] = __builtin_amdgcn_mfma_f32_32x32x16_bf16(pa1, SB_PK(1), o[d0], 0, 0, 0);
        o[d0] = __builtin_amdgcn_mfma_f32_32x32x16_bf16(pa2, SB_PK(2), o[d0], 0, 0, 0);
        o[d0] = __builtin_amdgcn_mfma_f32_32x32x16_bf16(pa3, SB_PK(3), o[d0], 0, 0, 0);
#undef SB_PK
    }
}
}
DEVI void ph_sb(const bf16_t* Z, const float* og, bf16_t* Ymix, unsigned char* smb, int wg, int nwg) {
    using namespace sb;
    const int tid = otid(), lane = tid & 63, wave = __builtin_amdgcn_readfirstlane(tid >> 6), r32 = lane & 31, hi = lane >> 5;
    unsigned char* vt = smb + wave * 16384;
    const unsigned vt_lds = (unsigned)(uintptr_t)vt;
    const int vbl = ((lane >> 4) & 1) * 32 + (lane & 3) * 8 + (4 * hi + ((lane & 15) >> 2)) * 64;
    const unsigned vK0 = (unsigned)(r32 * NZ + ZKA + hi * 8) * 2u, vK1 = vK0 + 32u * NZ * 2u, vV = (unsigned)((lane >> 2) * NZ + ZVA + (lane & 3) * 8) * 2u, vQ = (unsigned)(r32 * NZ + ZQA + hi * 8) * 2u;
#define SB_TILE(hh, jj) ((const char*)Z + ((size_t)(bbase + (jj) * 64) * NZ + (hh) * 64) * 2)
#define SB_LOADK(dst, hh, jj) do { const char* kb_ = SB_TILE(hh, jj); _Pragma("unroll") for (int d0 = 0; d0 < 4; ++d0) { dst[2 * d0] = *(const bf16x8*)(kb_ + vK0 + d0 * 32); dst[2 * d0 + 1] = *(const bf16x8*)(kb_ + vK1 + d0 * 32); } } while (0)
#define SB_DMAV(buf, hh, jj) do { const char* kb_ = SB_TILE(hh, jj); _Pragma("unroll") for (int w8 = 0; w8 < 8; ++w8) \
        glds16(kb_ + ((size_t)(16 * (w8 & 3)) * NZ + (w8 >> 2) * 32) * 2 + vV, (unsigned)__builtin_amdgcn_readfirstlane(vt_lds + (buf) * 8192 + w8 * 1024)); } while (0)
#define SB_LOADQ(dst, hh) do { const char* qp_ = (const char*)Z + ((size_t)row0 * NZ + (hh) * 64) * 2 + vQ; _Pragma("unroll") for (int d0 = 0; d0 < 4; ++d0) dst[d0] = *(const bf16x8*)(qp_ + d0 * 32); } while (0)
    for (int wu = wg * 8 + wave; wu < T / 32; wu += nwg * 8) {
        const int row0 = wu * 32, bbase = (row0 / SEQ) * SEQ, t0 = row0 - bbase, tq = t0 + r32, jt0 = t0 >> 6;
        float ssq[4] = {0.f, 0.f, 0.f, 0.f};
        int cb = 0, pf = 0;
        bf16x8 kf[8], qr[4];
        asm volatile("s_waitcnt lgkmcnt(0)" ::: "memory");
        SB_DMAV(0, 0, jt0); SB_LOADK(kf, 0, jt0); SB_LOADQ(qr, 0);
#pragma unroll 1
        for (int h = 0; h < 6; ++h) {
            f32x16 o[2]; o[0] = f32x16{}; o[1] = f32x16{};
            float carry = 1.f; bool diag = true;
#pragma unroll 1
            for (int jt = jt0; ; --jt) {
                const int kv0 = jt * 64;
                f32x16 p0 = __builtin_amdgcn_mfma_f32_32x32x16_bf16(kf[0], qr[0], f32x16{}, 0, 0, 0), p1 = __builtin_amdgcn_mfma_f32_32x32x16_bf16(kf[1], qr[0], f32x16{}, 0, 0, 0);
#pragma unroll
                for (int d0 = 1; d0 < 4; ++d0) { p0 = __builtin_amdgcn_mfma_f32_32x32x16_bf16(kf[2 * d0], qr[d0], p0, 0, 0, 0); p1 = __builtin_amdgcn_mfma_f32_32x32x16_bf16(kf[2 * d0 + 1], qr[d0], p1, 0, 0, 0); }
                if (diag && jt > 0) { SB_DMAV(cb ^ 1, h, jt - 1); SB_LOADK(kf, h, jt - 1); pf = 1; }
                else if (h + 1 < 6) { SB_DMAV(cb ^ 1, h + 1, jt0); SB_LOADK(kf, h + 1, jt0); pf = 2; }
                else pf = 0;
                if (diag) {
#pragma unroll
                    for (int r = 0; r < 16; ++r) { const int kv = kv0 + crow(r, hi); if (kv >= tq) p0[r] = -INFINITY; if (kv + 32 >= tq) p1[r] = -INFINITY; }
                }
                float total = 1.f; u32x4 pw0, pw1, pw2, pw3;
#define SB_HALF(P, PWA, PWB) do { f32x16 R; \
                    _Pragma("unroll") for (int r = 0; r < 16; ++r) { float c_; asm("v_min_f32 %0, %1, %2" : "=v"(c_) : "v"(P[r]), "v"(100.f)); const float e_ = __builtin_amdgcn_exp2f(c_); R[r] = __builtin_amdgcn_rcpf(1.0f + e_); P[r] = e_ * R[r]; } \
                    _Pragma("unroll") for (int g = 3; g >= 0; --g) { const float mine = (R[4 * g] * R[4 * g + 1]) * (R[4 * g + 2] * R[4 * g + 3]); const auto sw_ = __builtin_amdgcn_permlane32_swap(__float_as_uint(mine), __float_as_uint(mine), false, false); const float og_ = __uint_as_float(hi ? sw_[0] : sw_[1]);     \
                        float t = carry * (hi == 0 ? total * og_ : total); total *= mine * og_; \
                        P[4 * g + 3] *= t; t *= R[4 * g + 3]; P[4 * g + 2] *= t; t *= R[4 * g + 2]; P[4 * g + 1] *= t; t *= R[4 * g + 1]; P[4 * g] *= t; } \
                    PWA = (u32x4){cvtpk(P[0], P[1]), cvtpk(P[2], P[3]), cvtpk(P[4], P[5]), cvtpk(P[6], P[7])}; PWB = (u32x4){cvtpk(P[8], P[9]), cvtpk(P[10], P[11]), cvtpk(P[12], P[13]), cvtpk(P[14], P[15])}; } while (0)
                SB_HALF(p1, pw2, pw3);
                SB_HALF(p0, pw0, pw1);
#undef SB_HALF
                carry *= total;
                if (pf) asm volatile("s_waitcnt vmcnt(16)" ::: "memory");
                else asm volatile("s_waitcnt vmcnt(0)" ::: "memory");
                pv(o, (int)vt_lds + cb * 8192 + vbl, __builtin_bit_cast(bf16x8, pw0), __builtin_bit_cast(bf16x8, pw1), __builtin_bit_cast(bf16x8, pw2), __builtin_bit_cast(bf16x8, pw3));
                diag = false;
                if (jt == 0 || !__any(carry > 9.0949470177e-13f)) break;
                if (pf == 1) { cb ^= 1; pf = 0; }
                else { SB_DMAV(cb, h, jt - 1); SB_LOADK(kf, h, jt - 1); pf = 0; }
            }
            const bool hit = (pf == 2);
            pf = 0;
            if (h + 1 < 6) SB_LOADQ(qr, h + 1);
            bf16_t* stg = (bf16_t*)(vt + cb * 8192);
#pragma unroll
            for (int r = 0; r < 16; ++r) { const int orow = crow(r, hi); stg[orow * 64 + r32] = (bf16_t)f2bf(o[0][r]); stg[orow * 64 + 32 + r32] = (bf16_t)f2bf(o[1][r]); }
            asm volatile("s_waitcnt lgkmcnt(0)" ::: "memory");
#pragma unroll
            for (int i = 0; i < 4; ++i) { const int row = i * 8 + (lane >> 3), ch = lane & 7; const u32x4 v = *(const u32x4*)(stg + row * 64 + ch * 8);
                float a[8]; unpack8(v, a);
                ssq[i] += ((a[0] * a[0] + a[1] * a[1]) + (a[2] * a[2] + a[3] * a[3])) + ((a[4] * a[4] + a[5] * a[5]) + (a[6] * a[6] + a[7] * a[7]));
                *(u32x4*)(Ymix + (size_t)(row0 + row) * D + h * 64 + ch * 8) = v; }
            asm volatile("s_waitcnt lgkmcnt(0)" ::: "memory");
            if (h + 1 < 6) {
                if (!hit) { SB_DMAV(cb ^ 1, h + 1, jt0); SB_LOADK(kf, h + 1, jt0); }
                cb ^= 1;
            }
        }
        asm volatile("s_waitcnt vmcnt(0)" ::: "memory");
        float rs[4];
#pragma unroll
        for (int i = 0; i < 4; ++i) { float s = ssq[i]; s += __shfl_xor(s, 1); s += __shfl_xor(s, 2); s += __shfl_xor(s, 4); rs[i] = rsqrtf(s * (1.0f / 384.0f) + EPS); }
#pragma unroll 1
        for (int h = 0; h < 6; ++h) { const int ch = lane & 7; const f32x4 g0 = *(const f32x4*)(og + h * 64 + ch * 8), g1 = *(const f32x4*)(og + h * 64 + ch * 8 + 4);
#pragma unroll
            for (int i = 0; i < 4; ++i) { const int row = i * 8 + (lane >> 3); u32x4* pp = (u32x4*)(Ymix + (size_t)(row0 + row) * D + h * 64 + ch * 8); float a[8]; unpack8(*pp, a); const float r = rs[i];
                u32x4 w; w.x = pk2(a[0] * r * g0[0], a[1] * r * g0[1]); w.y = pk2(a[2] * r * g0[2], a[3] * r * g0[3]); w.z = pk2(a[4] * r * g1[0], a[5] * r * g1[1]); w.w = pk2(a[6] * r * g1[2], a[7] * r * g1[3]);
                *pp = w; } }
    }
#undef SB_TILE
#undef SB_LOADK
#undef SB_DMAV
#undef SB_LOADQ
}

namespace ml {
constexpr int QROW = 208, TROW = 144;
constexpr int O_QN = 0, O_KN = 13312, O_KWT = 26624, O_VT = 40448, O_CT = 54272, CT_BYTES = 96 * QROW, O_NV = O_CT + 2 * CT_BYTES, O_TB = O_NV + 768, O_SC = O_TB + 2 * 1280,
              O_MNG = O_SC + 64, O_CW = O_MNG + 384, O_RAW = O_CW + 5 * 192 * 4, NP_QK = 67 * 24, NP_ALL = NP_QK + 64 * 12, O_RAWV = O_RAW + NP_QK * 16, O_DUMMY = O_RAW + 40 * 1024, O_END = O_DUMMY + 1024;
static_assert(O_END <= 147456 && NP_ALL <= 40 * 64 && O_RAW % 16 == 0, "mLSTM LDS map");
typedef short bf16x8 __attribute__((ext_vector_type(8)));
}
DEVI void ph_mlstm(const bf16_t* Z, const float* gates, const float* conv_w, const float* conv_b, const float* igb, const float* fgb, const float* mng, bf16_t* Ymix,
                   unsigned char* smb, int wg, int nwg) {
    using namespace ml;
    const int tid = otid(), lane = tid & 63, wave = __builtin_amdgcn_readfirstlane(tid >> 6), l16 = lane & 15, quad = lane >> 4;
    float* NV = (float*)(smb + O_NV);
    const unsigned raw_lds = (unsigned)(uintptr_t)(smb + O_RAW);
    for (int unit = wg; unit < NB * 4; unit += nwg) {
        const int b = unit >> 2, h = unit & 3; const size_t rb = (size_t)b * SEQ;
#define ML_DMA(n1) do { const char* zb_ = (const char*)Z + ((long)rb + (long)(n1) * 64 - 3) * (NZ * 2); \
            _Pragma("unroll") for (int ins = 0; ins < 5; ++ins) if ((ins * 8 + wave) * 64 + lane < NP_ALL) sb::glds16(zb_ + doff[ins], (unsigned)__builtin_amdgcn_readfirstlane(raw_lds + (ins * 8 + wave) * 1024)); } while (0)
        unsigned doff[5];
#pragma unroll
        for (int ins = 0; ins < 5; ++ins) { const int pidx = (ins * 8 + wave) * 64 + lane;
            if (pidx < NP_QK) { const int r = pidx / 24, seg = pidx - 24 * r; doff[ins] = (unsigned)(r * NZ + (seg < 12 ? ZQB + h * 96 + 8 * seg : ZKB + h * 96 + 8 * (seg - 12))) * 2u; }
            else { const int j = pidx - NP_QK, l = j / 12, seg = j - 12 * l; doff[ins] = (unsigned)((l + 3) * NZ + ZVB + h * 96 + 8 * seg) * 2u; } }
#define ML_WARM(n2) do { if (wave >= 4) { const unsigned dl_ = (unsigned)__builtin_amdgcn_readfirstlane((unsigned)(uintptr_t)(smb + O_DUMMY)); const int wq_ = wave - 4; \
            if ((n2) < 32) { const char* rp_ = (const char*)Z + ((size_t)rb + (size_t)(n2) * 64 + lane) * (NZ * 2) + (size_t)((wq_ == 0 ? ZQB : wq_ == 1 ? ZKB : wq_ == 2 ? ZVB : ZOB) + h * 96) * 2; \
                sb::glds16(rp_, dl_); sb::glds16(rp_ + 128, dl_); } \
            if (wq_ == 3 && (n2) + 1 < 32) { const char* gp_ = (const char*)gates + ((size_t)rb + (size_t)((n2) + 1) * 64) * 32 + lane * 16; sb::glds16(gp_, dl_); sb::glds16(gp_ + 1024, dl_); } } } while (0)
#define ML_GATES(n1, ip, fp) do { float* TBn = (float*)(smb + O_TB) + ((n1) & 1) * 320; float* SCn = (float*)(smb + O_SC) + ((n1) & 1) * 4; \
            float c = -softplusf_(-(fp)); _Pragma("unroll") for (int o = 1; o < 64; o <<= 1) { const float t_ = __shfl_up(c, o); if (lane >= o) c += t_; } \
            const float btot = __shfl(c, 63), a_ = btot - c + (ip), g_ = (ip) - c; float mloc = a_; \
            _Pragma("unroll") for (int o = 32; o >= 1; o >>= 1) mloc = fmaxf(mloc, __shfl_xor(mloc, o)); \
            float pm = g_; _Pragma("unroll") for (int o = 1; o < 64; o <<= 1) { const float t_ = __shfl_up(pm, o); if (lane >= o) pm = fmaxf(pm, t_); } \
            const float mn = fmaxf(btot + mrun, mloc); \
            TBn[lane] = a_; TBn[64 + lane] = g_; TBn[128 + lane] = pm; TBn[192 + lane] = c; TBn[256 + lane] = __expf(a_ - mn); \
            if (lane == 0) { SCn[0] = mrun; SCn[1] = mn; SCn[2] = __expf(btot + mrun - mn); } mrun = mn; } while (0)
#define ML_CONVERT(n1) do { const float* WLn = (const float*)(smb + O_TB) + ((n1) & 1) * 320 + 256; \
            if (tid < 384) { const unsigned char* rw = smb + O_RAW + cc * 2; const int l0 = 16 * rseg; const bool z0 = ((n1) == 0 && rseg == 0); \
                const f32x2_t* cwp_ = (const f32x2_t*)((const float*)(smb + O_CW) + cc); const f32x2_t cw0 = cwp_[0], cw1 = cwp_[96], cw2 = cwp_[192], cw3 = cwp_[288], cbias = cwp_[384]; \
                f32x2_t x0, x1, x2; { const unsigned u0 = *(const unsigned*)(rw + (l0 + 0) * 384), u1 = *(const unsigned*)(rw + (l0 + 1) * 384), u2 = *(const unsigned*)(rw + (l0 + 2) * 384); \
                    x0 = z0 ? (f32x2_t){0.f, 0.f} : (f32x2_t){__uint_as_float(u0 << 16), __uint_as_float(u0 & 0xffff0000u)}; x1 = z0 ? (f32x2_t){0.f, 0.f} : (f32x2_t){__uint_as_float(u1 << 16), __uint_as_float(u1 & 0xffff0000u)}; \
                    x2 = z0 ? (f32x2_t){0.f, 0.f} : (f32x2_t){__uint_as_float(u2 << 16), __uint_as_float(u2 & 0xffff0000u)}; } \
                unsigned char* qk = smb + (which ? O_KN : O_QN) + cd * 2; unsigned char* kwt = smb + O_KWT + cd * TROW; \
                _Pragma("unroll 2") for (int i = 0; i < 16; i += 2) { const int l = l0 + i; \
                    const unsigned ua = *(const unsigned*)(rw + (l + 3) * 384), ub = *(const unsigned*)(rw + (l + 4) * 384); \
                    const f32x2_t xa = {__uint_as_float(ua << 16), __uint_as_float(ua & 0xffff0000u)}, xb = {__uint_as_float(ub << 16), __uint_as_float(ub & 0xffff0000u)}; \
                    f32x2_t ya = cbias + cw0 * x0 + cw1 * x1 + cw2 * x2 + cw3 * xa, yb = cbias + cw0 * x1 + cw1 * x2 + cw2 * xa + cw3 * xb; x0 = x2; x1 = xa; x2 = xb; \
                    f32x2_t oa, ob_; oa.x = ya.x * __builtin_amdgcn_rcpf(1.0f + __expf(-ya.x)); oa.y = ya.y * __builtin_amdgcn_rcpf(1.0f + __expf(-ya.y)); ob_.x = yb.x * __builtin_amdgcn_rcpf(1.0f + __expf(-yb.x)); ob_.y = yb.y * __builtin_amdgcn_rcpf(1.0f + __expf(-yb.y)); \
                    if (which) { oa = oa * 0.10206207261596575f; ob_ = ob_ * 0.10206207261596575f; const float wa = WLn[l], wb = WLn[l + 1]; \
                        *(unsigned*)(kwt + l * 2) = pk2(oa.x * wa, ob_.x * wb); *(unsigned*)(kwt + TROW + l * 2) = pk2(oa.y * wa, ob_.y * wb); } \
                    *(unsigned*)(qk + l * QROW) = pk2(oa.x, oa.y); *(unsigned*)(qk + (l + 1) * QROW) = pk2(ob_.x, ob_.y); } \
            } else { const int idx = tid - 384, lp = idx >> 2, eq = idx & 3; const u32x4* s0 = (const u32x4*)(smb + O_RAWV + (2 * lp) * 192 + eq * 48); const u32x4* s1 = (const u32x4*)(smb + O_RAWV + (2 * lp + 1) * 192 + eq * 48); \
                unsigned char* vt = smb + O_VT + (eq * 24) * TROW + lp * 4; \
                _Pragma("unroll") for (int i = 0; i < 3; ++i) { const u32x4 a = s0[i], b = s1[i]; \
                    *(unsigned*)(vt + (i * 8 + 0) * TROW) = (a.x & 0xffffu) | (b.x << 16); *(unsigned*)(vt + (i * 8 + 1) * TROW) = (a.x >> 16) | (b.x & 0xffff0000u); \
                    *(unsigned*)(vt + (i * 8 + 2) * TROW) = (a.y & 0xffffu) | (b.y << 16); *(unsigned*)(vt + (i * 8 + 3) * TROW) = (a.y >> 16) | (b.y & 0xffff0000u); \
                    *(unsigned*)(vt + (i * 8 + 4) * TROW) = (a.z & 0xffffu) | (b.z << 16); *(unsigned*)(vt + (i * 8 + 5) * TROW) = (a.z >> 16) | (b.z & 0xffff0000u); \
                    *(unsigned*)(vt + (i * 8 + 6) * TROW) = (a.w & 0xffffu) | (b.w << 16); *(unsigned*)(vt + (i * 8 + 7) * TROW) = (a.w >> 16) | (b.w & 0xffff0000u); } } } while (0)
        const int cc = tid < 384 ? 2 * (tid % 96) : 0, rseg = tid < 384 ? tid / 96 : 0, which = cc >= 96 ? 1 : 0, cd = cc - 96 * which;
        if (tid < 192) { const int w_ = tid >= 96 ? 1 : 0, ch_ = w_ * 384 + h * 96 + (tid - 96 * w_); float* cwt = (float*)(smb + O_CW);
            cwt[tid] = conv_w[ch_]; cwt[192 + tid] = conv_w[768 + ch_]; cwt[384 + tid] = conv_w[2 * 768 + ch_]; cwt[576 + tid] = conv_w[3 * 768 + ch_]; cwt[768 + tid] = conv_b[ch_]; }
        float mrun = 0.f;
        ML_DMA(0);
        for (int i = tid; i < CT_BYTES / 4; i += NTHR) ((unsigned*)(smb + O_CT))[i] = 0u;
        if (tid < 96) { NV[tid] = 0.f; ((float*)(smb + O_MNG))[tid] = mng[h * 96 + tid]; }
        if (wave == 7) { const size_t row = rb + lane; const float ip = gates[row * 8 + h] + igb[h], fp = gates[row * 8 + 4 + h] + fgb[h]; ML_GATES(0, ip, fp); }
        asm volatile("s_waitcnt vmcnt(0)" ::: "memory");
        __syncthreads();
        ML_CONVERT(0);
        __syncthreads();
        f32x4 Cst[9];
#pragma unroll
        for (int k = 0; k < 9; ++k) Cst[k] = (f32x4){0.f, 0.f, 0.f, 0.f};
#pragma unroll 1
        for (int n = 0; n < 32; ++n) {
            const int cur = n & 1, nxt = cur ^ 1; const float* SCc = (const float*)(smb + O_SC) + cur * 4; const float m_in = SCc[0], dec = SCc[2];
            const float* TBc = (const float*)(smb + O_TB) + cur * 320;
            const size_t r0 = rb + n * 64;
            if (n + 1 < 32) ML_DMA(n + 1);
            if (wave < 4) {
                const int tt = wave, t = 16 * tt + l16; const size_t row = r0 + t;
                const unsigned char* qn = smb + O_QN; const unsigned char* kn = smb + O_KN; const unsigned char* vtb = smb + O_VT; const unsigned char* ct = smb + O_CT + cur * CT_BYTES;
                bf16x8 bq[3];
#pragma unroll
                for (int ks = 0; ks < 3; ++ks) bq[ks] = *(const bf16x8*)(qn + t * QROW + (32 * ks + 8 * quad) * 2);
                const float Mt = fmaxf(m_in, TBc[128 + t]), inter = __expf(m_in - Mt), flr = __expf(-(TBc[192 + t] + Mt));
                f32x4 P[4]; float psum = 0.f;
#pragma unroll
                for (int st = 0; st < 4; ++st) { P[st] = (f32x4){0.f, 0.f, 0.f, 0.f};
                    if (st <= tt) {
#pragma unroll
                        for (int ks = 0; ks < 3; ++ks) P[st] = __builtin_amdgcn_mfma_f32_16x16x32_bf16(*(const bf16x8*)(kn + (16 * st + l16) * QROW + (32 * ks + 8 * quad) * 2), bq[ks], P[st], 0, 0, 0);
                        const f32x4 gs = *(const f32x4*)(TBc + 64 + 16 * st + 4 * quad);
#pragma unroll
                        for (int j = 0; j < 4; ++j) { const int s_ = 16 * st + 4 * quad + j; const float w = s_ <= t ? __expf(gs[j] - Mt) : 0.f; P[st][j] *= w; psum += P[st][j]; }
                    } }
                psum += __shfl_xor(psum, 16); psum += __shfl_xor(psum, 32);
                float qn_ = 0.f; { const float* nv = NV + cur * 96 + quad * 24; const unsigned char* qp = qn + t * QROW + quad * 48;
#pragma unroll
                    for (int i = 0; i < 3; ++i) { const u32x4 w = *(const u32x4*)(qp + i * 16);
                        qn_ += __uint_as_float(w.x << 16) * nv[i * 8 + 0] + __uint_as_float(w.x & 0xffff0000u) * nv[i * 8 + 1] + __uint_as_float(w.y << 16) * nv[i * 8 + 2] + __uint_as_float(w.y & 0xffff0000u) * nv[i * 8 + 3]
                             + __uint_as_float(w.z << 16) * nv[i * 8 + 4] + __uint_as_float(w.z & 0xffff0000u) * nv[i * 8 + 5] + __uint_as_float(w.w << 16) * nv[i * 8 + 6] + __uint_as_float(w.w & 0xffff0000u) * nv[i * 8 + 7]; } }
                qn_ += __shfl_xor(qn_, 16); qn_ += __shfl_xor(qn_, 32);
                float den = psum + inter * qn_; den = fmaxf(fabsf(den), flr); const float rden = 1.0f / den;
                bf16x8 pk[2];
#pragma unroll
                for (int i = 0; i < 2; ++i) { u32x4 w; w.x = pk2(P[2 * i][0], P[2 * i][1]); w.y = pk2(P[2 * i][2], P[2 * i][3]); w.z = pk2(P[2 * i + 1][0], P[2 * i + 1][1]); w.w = pk2(P[2 * i + 1][2], P[2 * i + 1][3]); pk[i] = __builtin_bit_cast(bf16x8, w); }
                float hv[6][4]; float ss = 0.f;
#pragma unroll
                for (int et = 0; et < 6; ++et) {
                    f32x4 n1 = (f32x4){0.f, 0.f, 0.f, 0.f}, n2 = (f32x4){0.f, 0.f, 0.f, 0.f};
#pragma unroll
                    for (int i = 0; i < 2; ++i) if (2 * i <= tt) { const unsigned char* vp = vtb + (16 * et + l16) * TROW + (32 * i + 4 * quad) * 2;
                        const u32x2 lo = *(const u32x2*)vp, hi2 = *(const u32x2*)(vp + 32); const u32x4 a = {lo.x, lo.y, hi2.x, hi2.y};
                        n1 = __builtin_amdgcn_mfma_f32_16x16x32_bf16(__builtin_bit_cast(bf16x8, a), pk[i], n1, 0, 0, 0); }
#pragma unroll
                    for (int ks = 0; ks < 3; ++ks) n2 = __builtin_amdgcn_mfma_f32_16x16x32_bf16(*(const bf16x8*)(ct + (16 * et + l16) * QROW + (32 * ks + 8 * quad) * 2), bq[ks], n2, 0, 0, 0);
#pragma unroll
                    for (int j = 0; j < 4; ++j) { const float v = (n1[j] + inter * n2[j]) * rden; hv[et][j] = v; ss += v * v; }
                    __builtin_amdgcn_sched_barrier(0);
                }
                u32x2 obv[6];
#pragma unroll
                for (int et = 0; et < 6; ++et) obv[et] = *(const u32x2*)(Z + row * NZ + ZOB + h * 96 + 16 * et + 4 * quad);
                ss += __shfl_xor(ss, 16); ss += __shfl_xor(ss, 32);
                const float rs = rsqrtf(ss * (1.0f / 96.0f) + EPS);
#pragma unroll
                for (int et = 0; et < 6; ++et) { const int e = 16 * et + 4 * quad; const u32x2 ob = obv[et]; const f32x4 mg = *(const f32x4*)((const float*)(smb + O_MNG) + e);
                    u32x2 w; w.x = pk2(hv[et][0] * rs * mg[0] * sigmoidf_(__uint_as_float(ob.x << 16)), hv[et][1] * rs * mg[1] * sigmoidf_(__uint_as_float(ob.x & 0xffff0000u)));
                    w.y = pk2(hv[et][2] * rs * mg[2] * sigmoidf_(__uint_as_float(ob.y << 16)), hv[et][3] * rs * mg[3] * sigmoidf_(__uint_as_float(ob.y & 0xffff0000u)));
                    *(u32x2*)(Ymix + row * D + 384 + h * 96 + e) = w; }
            } else {
                const int wq = wave - 4; const unsigned char* kwt = smb + O_KWT; const unsigned char* vtb = smb + O_VT; unsigned char* ctn = smb + O_CT + nxt * CT_BYTES;
                float gip = 0.f, gfp = 0.f;
                if (wq == 3 && n + 1 < 32) { const size_t row = r0 + 64 + lane; gip = gates[row * 8 + h] + igb[h]; gfp = gates[row * 8 + 4 + h] + fgb[h]; }
#pragma unroll
                for (int k = 0; k < 9; ++k) { const int idx = wq + 4 * k, dt = idx / 6, et = idx - 6 * dt; f32x4 U = (f32x4){0.f, 0.f, 0.f, 0.f};
#pragma unroll
                    for (int ks = 0; ks < 2; ++ks) U = __builtin_amdgcn_mfma_f32_16x16x32_bf16(*(const bf16x8*)(kwt + (16 * dt + l16) * TROW + (32 * ks + 8 * quad) * 2), *(const bf16x8*)(vtb + (16 * et + l16) * TROW + (32 * ks + 8 * quad) * 2), U, 0, 0, 0);
                    Cst[k] = Cst[k] * dec + U;
                    u32x2 w; w.x = pk2(Cst[k][0], Cst[k][1]); w.y = pk2(Cst[k][2], Cst[k][3]);
                    *(u32x2*)(ctn + (16 * et + l16) * QROW + (16 * dt + 4 * quad) * 2) = w; __builtin_amdgcn_sched_barrier(0); }
                if (wq == 0 || (wq == 1 && lane < 32)) { const int d = wq * 64 + lane; const u32x4* kp = (const u32x4*)(kwt + d * TROW); float sacc = 0.f;
#pragma unroll
                    for (int i = 0; i < 8; ++i) { const u32x4 w = kp[i];
                        sacc += (__uint_as_float(w.x << 16) + __uint_as_float(w.x & 0xffff0000u)) + (__uint_as_float(w.y << 16) + __uint_as_float(w.y & 0xffff0000u))
                              + (__uint_as_float(w.z << 16) + __uint_as_float(w.z & 0xffff0000u)) + (__uint_as_float(w.w << 16) + __uint_as_float(w.w & 0xffff0000u)); }
                    NV[nxt * 96 + d] = dec * NV[cur * 96 + d] + sacc; }
                if (wq == 3 && n + 1 < 32) ML_GATES(n + 1, gip, gfp);
            }
            asm volatile("s_waitcnt vmcnt(0)" ::: "memory");
            __syncthreads();
            ML_WARM(n + 2);
            if (n + 1 < 32) ML_CONVERT(n + 1);
            __syncthreads();
        }
#undef ML_DMA
#undef ML_WARM
#undef ML_GATES
#undef ML_CONVERT
    }
}

namespace sgu {
constexpr int VROW = 272, VGRP = 64 * VROW + 32, MROW = 528, MST_OFF = 71680;
static_assert(4 * VGRP <= MST_OFF && MST_OFF + 128 * MROW <= 147456, "SGU LDS map");
DEVI float gelu_fast(float x) { const float u = 1.5957691216057308f * (x + 0.044715f * x * x * x); return x * __builtin_amdgcn_rcpf(1.0f + __expf(-u)); }
}
DEVI void ph_sgu(const bf16_t* Z, const float* ln_g, const float* ln_b, const bf16_t* Wm, const float* bs, const float* og, bf16_t* Ymix, unsigned char* smb, int wg, int nwg) {
    using namespace sgu; typedef short bf16x8 __attribute__((ext_vector_type(8))); typedef float f32x16 __attribute__((ext_vector_type(16)));
    const int tid = otid(), lane = tid & 63, wave = __builtin_amdgcn_readfirstlane(tid >> 6), r32 = lane & 31, hi = lane >> 5;
    for (int blk = wg; blk < T / 128; blk += nwg) {
        const size_t row0 = (size_t)blk * 128;
        u32x4 uv[8]; { const u32x4* up = (const u32x4*)(Z + (row0 + (tid >> 2)) * NZ + ZUC + (tid & 3) * 64);
#pragma unroll
            for (int i = 0; i < 8; ++i) uv[i] = up[i]; }
        {
            const int tp = tid >> 3, g = (tid >> 1) & 3, hf = tid & 1, c0 = g * 64 + hf * 32;
            u32x4 raw[2][4];
#pragma unroll
            for (int k = 0; k < 2; ++k) { const u32x4* src = (const u32x4*)(Z + (row0 + 2 * tp + k) * NZ + ZVC + c0);
#pragma unroll
                for (int i = 0; i < 4; ++i) raw[k][i] = src[i]; }
            float v[2][32];
#pragma unroll
            for (int k = 0; k < 2; ++k)
#pragma unroll
                for (int i = 0; i < 4; ++i) { float f[8]; unpack8(raw[k][i], f);
#pragma unroll
                    for (int j = 0; j < 8; ++j) v[k][i * 8 + j] = gelu_fast(f[j]); }
            float mu[2], rstd[2];
#pragma unroll
            for (int k = 0; k < 2; ++k) { float s1 = 0.f;
#pragma unroll
                for (int c = 0; c < 32; ++c) s1 += v[k][c];
                s1 += __shfl_xor(s1, 1); mu[k] = s1 * (1.0f / 64.0f); float s2 = 0.f;
#pragma unroll
                for (int c = 0; c < 32; ++c) { const float dd = v[k][c] - mu[k]; s2 += dd * dd; }
                s2 += __shfl_xor(s2, 1); rstd[k] = rsqrtf(s2 * (1.0f / 64.0f) + EPS); }
            unsigned char* dst = smb + g * VGRP + (hf * 32) * VROW + tp * 4;
#pragma unroll
            for (int c = 0; c < 32; ++c) { const float gg = ln_g[c0 + c], bb = ln_b[c0 + c];
                *(unsigned*)(dst + c * VROW) = pk2((v[0][c] - mu[0]) * rstd[0] * gg + bb, (v[1][c] - mu[1]) * rstd[1] * gg + bb); }
        }
        const int g2 = wave >> 1, mh = wave & 1;
        bf16x8 af[2][8];
        { const bf16_t* wa = Wm + ((size_t)g2 * 128 + 64 * mh + r32) * 128 + 8 * hi;
#pragma unroll
            for (int ks = 0; ks < 8; ++ks) if (ks < 4 || mh) { af[0][ks] = *(const bf16x8*)(wa + ks * 16); af[1][ks] = *(const bf16x8*)(wa + 32 * 128 + ks * 16); } }
        asm volatile("s_waitcnt lgkmcnt(0)" ::: "memory"); __builtin_amdgcn_s_barrier(); asm volatile("" ::: "memory");
        {
            f32x16 acc[2][2];
#pragma unroll
            for (int i = 0; i < 2; ++i)
#pragma unroll
                for (int j = 0; j < 2; ++j) acc[i][j] = f32x16{};
            const unsigned char* vb = smb + g2 * VGRP + r32 * VROW + 16 * hi;
#pragma unroll
            for (int ks = 0; ks < 8; ++ks) if (ks < 4 || mh) {
                const bf16x8 b0 = *(const bf16x8*)(vb + ks * 32), b1 = *(const bf16x8*)(vb + 32 * VROW + ks * 32);
                acc[0][0] = __builtin_amdgcn_mfma_f32_32x32x16_bf16(af[0][ks], b0, acc[0][0], 0, 0, 0); acc[0][1] = __builtin_amdgcn_mfma_f32_32x32x16_bf16(af[0][ks], b1, acc[0][1], 0, 0, 0);
                acc[1][0] = __builtin_amdgcn_mfma_f32_32x32x16_bf16(af[1][ks], b0, acc[1][0], 0, 0, 0); acc[1][1] = __builtin_amdgcn_mfma_f32_32x32x16_bf16(af[1][ks], b1, acc[1][1], 0, 0, 0);
            }
            bf16_t* mst = (bf16_t*)(smb + MST_OFF);
#pragma unroll
            for (int mt = 0; mt < 2; ++mt)
#pragma unroll
                for (int r = 0; r < 16; ++r) { const int t = 64 * mh + 32 * mt + (r & 3) + 8 * (r >> 2) + 4 * hi; const float bias = bs[g2 * 128 + t];
                    bf16_t* mp = mst + t * (MROW / 2) + g2 * 64 + r32;
                    mp[0] = (bf16_t)f2bf(acc[mt][0][r] + bias); mp[32] = (bf16_t)f2bf(acc[mt][1][r] + bias); }
        }
        asm volatile("s_waitcnt lgkmcnt(0)" ::: "memory"); __builtin_amdgcn_s_barrier(); asm volatile("" ::: "memory");
        {
            const int t = tid >> 2, g = tid & 3; const size_t row = row0 + t;
            const u32x4* mp = (const u32x4*)(smb + MST_OFF + t * MROW + g * 128);
            float y[64]; float ss = 0.f;
#pragma unroll
            for (int i = 0; i < 8; ++i) { float uf[8], mf[8]; unpack8(uv[i], uf); unpack8(mp[i], mf);
#pragma unroll
                for (int j = 0; j < 8; ++j) { y[i * 8 + j] = gelu_fast(uf[j]) * mf[j]; ss += y[i * 8 + j] * y[i * 8 + j]; } }
            ss += __shfl_xor(ss, 1); ss += __shfl_xor(ss, 2);
            const float rs = rsqrtf(ss * (1.0f / 256.0f) + EPS);
            u32x4* yp = (u32x4*)(Ymix + row * D + 768 + g * 64); const f32x4* gp = (const f32x4*)(og + g * 64);
#pragma unroll
            for (int i = 0; i < 8; ++i) { const f32x4 g0 = gp[2 * i], g1 = gp[2 * i + 1];
                u32x4 w; w.x = pk2(y[i * 8 + 0] * rs * g0[0], y[i * 8 + 1] * rs * g0[1]); w.y = pk2(y[i * 8 + 2] * rs * g0[2], y[i * 8 + 3] * rs * g0[3]);
                w.z = pk2(y[i * 8 + 4] * rs * g1[0], y[i * 8 + 5] * rs * g1[1]); w.w = pk2(y[i * 8 + 6] * rs * g1[2], y[i * 8 + 7] * rs * g1[3]); yp[i] = w; }
        }
        asm volatile("s_waitcnt lgkmcnt(0)" ::: "memory"); __builtin_amdgcn_s_barrier(); asm volatile("" ::: "memory");
    }
}
DEVI void ph_prep_sgu(const float* w, bf16_t* Wm, int wg, int nwg) {
    for (int idx = wg * NTHR + otid(); idx < 4 * 128 * 128; idx += nwg * NTHR) { const int t = (idx >> 7) & 127, s = idx & 127; Wm[idx] = (bf16_t)f2bf(((s >> 6) <= (t >> 6)) ? w[idx] : 0.f); }
}

DEVI void ph_place_all(const unsigned* count, const int* tokE, const float* tokW, int* rank, const float* rstd2, int* row_ts, float* row_w, float* row_rs, int* tile_e, int* n_tiles, unsigned char* smb, int wg, int nwg) {
    int* ps = (int*)smb; int* cnt = ps + 40;
    const int tid = otid(), lane = tid & 63;
    if (tid < 64) { const int c = lane < 32 ? (int)__hip_atomic_load(count + lane, __ATOMIC_RELAXED, __HIP_MEMORY_SCOPE_AGENT) : 0; const int pad = (c + 255) & ~255;
        int incl = pad;
#pragma unroll
        for (int o = 1; o < 32; o <<= 1) { const int t_ = __shfl_up(incl, o); if (lane >= o) incl += t_; }
        if (lane < 32) { cnt[lane] = c; ps[lane] = incl - pad; if (lane == 31) ps[32] = incl; } }
    __syncthreads();
    if (wg == 0) {
        const int nt = ps[32] >> 8;
        if (tid == 0) *n_tiles = nt;
        for (int i = tid; i < nt; i += NTHR) { int e = 0;
#pragma unroll 1
            for (int k = 1; k < 32; ++k) if ((ps[k] >> 8) <= i) e = k;
            tile_e[i] = e; }
        for (int e = 0; e < 32; ++e) for (int r = cnt[e] + tid; r < ps[e + 1] - ps[e]; r += NTHR) { row_ts[ps[e] + r] = -1; row_rs[ps[e] + r] = 0.f; }
    }
    for (int idx = wg * NTHR + tid; idx < 2 * T; idx += nwg * NTHR) { const int pos = ps[tokE[idx]] + rank[idx]; row_ts[pos] = idx; row_w[pos] = tokW[idx]; row_rs[pos] = rstd2[idx >> 1]; rank[idx] = pos; }
    __syncthreads();
}
DEVI void ph_combine(bf16_t* h, const bf16_t* Y, const int* tokpos, float* rstd3, int wg, int nwg) {
    const int tid = otid(), lane = tid & 63, gw = wg * 8 + (tid >> 6), ngw = nwg * 8;
    for (int base = 2 * gw; base < T; base += 32 * ngw) {
        const int myrow = base + 2 * ngw * (lane >> 2) + ((lane >> 1) & 1);
        const int tp = myrow < T ? tokpos[myrow * 2 + (lane & 1)] : 0;
#pragma unroll 1
        for (int k = 0; k < 16; ++k) {
            const int row = base + 2 * ngw * k; if (row >= T) break;
            u32x4 hv[2][2], y0[2][2], y1[2][2];
#pragma unroll
            for (int r = 0; r < 2; ++r) { const int p0 = __builtin_amdgcn_readfirstlane(__shfl(tp, 4 * k + 2 * r)), p1 = __builtin_amdgcn_readfirstlane(__shfl(tp, 4 * k + 2 * r + 1));
#pragma unroll
                for (int jj = 0; jj < 2; ++jj) { hv[r][jj] = ((const u32x4*)(h + (size_t)(row + r) * D) + lane)[64 * jj];
                    y0[r][jj] = __builtin_nontemporal_load((const u32x4*)(Y + (size_t)p0 * D) + lane + 64 * jj); y1[r][jj] = __builtin_nontemporal_load((const u32x4*)(Y + (size_t)p1 * D) + lane + 64 * jj); } }
#pragma unroll
            for (int r = 0; r < 2; ++r) { float s = 0.f;
#pragma unroll
                for (int jj = 0; jj < 2; ++jj) { float a[8], b0[8], b1[8]; unpack8(hv[r][jj], a); unpack8(y0[r][jj], b0); unpack8(y1[r][jj], b1);
#pragma unroll
                    for (int i = 0; i < 8; ++i) { a[i] += b0[i] + b1[i]; s += a[i] * a[i]; }
                    u32x4 w; w.x = pk2(a[0], a[1]); w.y = pk2(a[2], a[3]); w.z = pk2(a[4], a[5]); w.w = pk2(a[6], a[7]); ((u32x4*)(h + (size_t)(row + r) * D) + lane)[64 * jj] = w; }
                s = wave_sum(s);
                if (lane == 0) rstd3[row + r] = rsqrtf(s * (1.0f / 1024.0f) + EPS); }
        }
    }
}
DEVI void ph_final(const bf16_t* h, float* out, const float* ssp, const float* g, int wg, int nwg) {
    const int tid = otid(), lane = tid & 63, gw = wg * 8 + (tid >> 6), ngw = nwg * 8;
    const f32x4* gp = (const f32x4*)g + 2 * lane; const f32x4 g00 = gp[0], g01 = gp[1], g10 = gp[128], g11 = gp[129];
    for (int row = 2 * gw; row < T; row += 2 * ngw) {
        u32x4 hv[2][2]; float sp[2];
#pragma unroll
        for (int r = 0; r < 2; ++r) { sp[r] = lane < 16 ? ssp[(size_t)(row + r) * 16 + lane] : 0.f;
#pragma unroll
            for (int jj = 0; jj < 2; ++jj) hv[r][jj] = ((const u32x4*)(h + (size_t)(row + r) * D) + lane)[64 * jj]; }
#pragma unroll
        for (int r = 0; r < 2; ++r) { const float rs = rsqrtf(wave_sum(sp[r]) * (1.0f / 1024.0f) + EPS); f32x4* op = (f32x4*)(out + (size_t)(row + r) * D) + 2 * lane;
#pragma unroll
            for (int jj = 0; jj < 2; ++jj) { float a[8]; unpack8(hv[r][jj], a); const f32x4 g0 = jj ? g10 : g00, g1 = jj ? g11 : g01;
                op[128 * jj] = (f32x4){a[0] * rs * g0[0], a[1] * rs * g0[1], a[2] * rs * g0[2], a[3] * rs * g0[3]}; op[128 * jj + 1] = (f32x4){a[4] * rs * g1[0], a[5] * rs * g1[1], a[6] * rs * g1[2], a[7] * rs * g1[3]}; } }
    }
}

enum { IN_X = 0, IN_P, IN_NORM1G, IN_WIN, IN_CONVW, IN_CONVB, IN_IGB, IN_FGB, IN_MNG, IN_SBOG, IN_SGULNG, IN_SGULNB, IN_SGUW, IN_SGUB, IN_SGUOG, IN_WOUT, IN_NORM2G,
       IN_RGW, IN_RGB, IN_REW, IN_REB, IN_WGATE, IN_WUP, IN_WDOWN, IN_PLENG, IN_PLEGW, IN_PLEPW, IN_FINALG, N_INPUTS };
constexpr int NPH_LAYER = 9, NPHASES = 1 + DEPTH * NPH_LAYER + 1;
struct Params { const float* in[N_INPUTS]; float* out; unsigned char* ws; int ph_lo, ph_hi; };
static_assert(sizeof(Params) == N_INPUTS * 8 + 8 + 8 + 8, "Params has no padding");

__global__ void __launch_bounds__(NTHR, 2) mega(Params p) {
    extern __shared__ __attribute__((aligned(16))) unsigned char lds[];
    const int tid = threadIdx.x, wg = blockIdx.x, nwg = gridDim.x;
    for (int u = tid; u < (LDS_BYTES - MISC_OFF) / 4; u += NTHR) ((LAS unsigned*)(lds + MISC_OFF))[u] = 0u;
    __syncthreads();
    unsigned char* const ws0 = p.ws;
    const bool fused = (p.ph_hi - p.ph_lo) > 1;
    XcdBarrier bar; bar.bar = (unsigned*)(ws0 + WS_CTL) + CW_BAR; bar.x = 0; bar.st = nullptr;
    if (fused) bar = xcd_barrier_post((unsigned*)(ws0 + WS_CTL) + CW_BAR, (volatile LAS unsigned*)(lds + MISC_OFF));
    PG8_LAS unsigned char* ring = (PG8_LAS unsigned char*)lds;
#define WSP(type, off) ((type)(ws + (off)))
#define PH_LOCALS size_t zo_ = 0; asm volatile("" : "+s"(zo_)); unsigned char* ws = ws0 + zo_; float* out = p.out + zo_;   \
        unsigned char* wl = ws + WS_WTS + (size_t)l * WL_SIZE; (void)wl; (void)out; \
        bf16_t* const HIN = (bf16_t*)(ws + ((l & 1) ? WS_HBB : WS_HBA)); bf16_t* const HOUT = (bf16_t*)(ws + ((l & 1) ? WS_HBA : WS_HBB)); (void)HIN; (void)HOUT;

    int gp = 0;
#define PH_ON (p.ph_lo <= gp && gp < p.ph_hi)
#define PH_END do { if (fused && gp + 1 < p.ph_hi) for (int rb_ = 0; rb_ < REP_BAR; ++rb_) xcd_barrier(bar); ++gp; } while (0)

    if (PH_ON) for (int rep = 0; rep < REP_PRO; ++rep) {
#pragma unroll 1
        for (int l = 0; l < DEPTH; ++l) {
            PH_LOCALS
            { const PrepJob j{p.in[IN_WIN] + (size_t)l * D * 3208, nullptr, p.in[IN_NORM1G] + l * D, (bf16_t*)(wl + WL_IN), 3208, D, NZ, 1, 1, 0, 0, 0}; ph_prep_w(j, lds, wg, nwg); }
            { const PrepJob j{p.in[IN_WOUT] + (size_t)l * D * D, nullptr, nullptr, (bf16_t*)(wl + WL_OUT), D, D, D, 0, 1, 0, 0, 0}; ph_prep_w(j, lds, wg, nwg); }
            { const PrepJob j{p.in[IN_WGATE] + (size_t)l * NEXP * D * DEXP, p.in[IN_WUP] + (size_t)l * NEXP * D * DEXP, p.in[IN_NORM2G] + l * D, (bf16_t*)(wl + WL_GU), DEXP, D, 512, 2, NEXP, 0, (size_t)D * DEXP, (size_t)512 * D};
              ph_prep_w(j, lds, wg, nwg); }
            { const PrepJob j{p.in[IN_WDOWN] + (size_t)l * NEXP * DEXP * D, nullptr, nullptr, (bf16_t*)(wl + WL_DN), D, DEXP, D, 0, NEXP, 0, (size_t)DEXP * D, (size_t)D * DEXP}; ph_prep_w(j, lds, wg, nwg); }
            { const PrepJob j{p.in[IN_PLEGW] + (size_t)l * D * D, nullptr, p.in[IN_PLENG] + l * D, (bf16_t*)(wl + WL_PG), D, D, D, 0, 1, 0, 0, 0}; ph_prep_w(j, lds, wg, nwg); }
            { const PrepJob j{p.in[IN_PLEPW] + (size_t)l * PDIM * D, nullptr, nullptr, (bf16_t*)(wl + WL_PP), D, PDIM, D, 0, 1, 0, 0, 0}; ph_prep_w(j, lds, wg, nwg); }
            ph_prep_sgu(p.in[IN_SGUW] + (size_t)l * 4 * 128 * 128, WSP(bf16_t*, WS_WSGU) + (size_t)l * 4 * 128 * 128, wg, nwg);
            ph_prep_router(p.in[IN_RGW] + l * D * 4, p.in[IN_REW] + l * D * 32, p.in[IN_NORM2G] + l * D, WSP(bf16_t*, WS_WR) + (size_t)l * 256 * D, wg, nwg);
        }
        { const int l = 0; PH_LOCALS
          ph_prep_x(p.in[IN_X], WSP(bf16_t*, WS_HBA), WSP(float*, WS_SSP), wg, nwg);
            }
    }
    PH_END;

#pragma clang loop unroll(full)
    for (int l = 0; l < DEPTH; ++l) {
        if (PH_ON) { PH_LOCALS
            pg8::Gemm g{HIN, (const bf16_t*)(wl + WL_IN), T, NZ, D, 0}; pg8::StaticOrder S; S.init(T, NZ, nwg, wg); const float* rtab = (const float*)(lds + 131072);
            { const int tid_ = otid(); const float* ssp_ = WSP(const float*, WS_SSP);
              for (int i = tid_ >> 8; ; i += 2) { pg8::Unit u_; if (!S.next(i & ~1, u_)) break; if (S.next(i, u_)) { const f32x4* sp = (const f32x4*)(ssp_ + (size_t)(u_.pm * 256 + (tid_ & 255)) * 16);
                  const f32x4 st = (sp[0] + sp[1]) + (sp[2] + sp[3]); ((float*)(lds + 131072))[i * 256 + (tid_ & 255)] = rsqrtf(((st[0] + st[1]) + (st[2] + st[3])) * (1.0f / 1024.0f) + EPS); } }
              __syncthreads(); }
            EpiZ E{WSP(bf16_t*, WS_Z), rtab, WSP(float*, WS_GATES), l == 0 ? p.in[IN_P] : nullptr, WSP(bf16_t*, WS_PB), nwg, wg};
            if (STG_Z) stagger(wg, STG_Z);
            for (int rep = 0; rep < REP_Z; ++rep) pg8::gemm_phase<EpiZ, pg8::StaticOrder, AL_Z, true>(ring, g, S, E); }
        PH_END;
        if (PH_ON) { PH_LOCALS
            const int nh = nwg >> 1;
            if (wg < nh) {
                for (int rep = 0; rep < REP_ML; ++rep) ph_mlstm(WSP(const bf16_t*, WS_Z), WSP(const float*, WS_GATES), p.in[IN_CONVW] + l * 4 * 768, p.in[IN_CONVB] + l * 768, p.in[IN_IGB] + l * 4, p.in[IN_FGB] + l * 4, p.in[IN_MNG] + l * 384, WSP(bf16_t*, WS_YMIX), lds, wg, nh);
            } else {
                for (int rep = 0; rep < REP_SB; ++rep) { ph_sb(WSP(const bf16_t*, WS_Z), p.in[IN_SBOG] + l * 384, WSP(bf16_t*, WS_YMIX), lds, wg - nh, nwg - nh); __syncthreads(); }
                for (int rep = 0; rep < REP_SGU; ++rep) ph_sgu(WSP(const bf16_t*, WS_Z), p.in[IN_SGULNG] + l * 256, p.in[IN_SGULNB] + l * 256, WSP(const bf16_t*, WS_WSGU) + (size_t)l * 4 * 128 * 128, p.in[IN_SGUB] + l * 4 * 128, p.in[IN_SGUOG] + l * 256, WSP(bf16_t*, WS_YMIX), lds, wg - nh, nwg - nh);
            }
        }
        PH_END;
        if (PH_ON) { PH_LOCALS
            pg8::Gemm g{WSP(const bf16_t*, WS_YMIX), (const bf16_t*)(wl + WL_OUT), T, D, D, 0}; pg8::StaticOrder S; S.init(T, D, nwg, wg); EpiResid E{HIN, HIN, WSP(float*, WS_SSP2)};
            if (REP_WOUT0 > 1) { EpiResid E2{HIN, WSP(bf16_t*, WS_Z), WSP(float*, WS_Z + 400 * MiB)}; for (int rep = 1; rep < REP_WOUT0; ++rep) pg8::gemm_phase<EpiResid, pg8::StaticOrder, AL_WOUT, true>(ring, g, S, E2); }
            if (STG_WOUT) stagger(wg, STG_WOUT);
            pg8::gemm_phase<EpiResid, pg8::StaticOrder, AL_WOUT, true>(ring, g, S, E); }
        PH_END;
        if (PH_ON) { PH_LOCALS
            pg8::Gemm g{HIN, WSP(const bf16_t*, WS_WR) + (size_t)l * 256 * D, T, 256, D, 0}; pg8::StaticOrder S; S.init(T, 256, nwg, wg);
            EpiRouter E{WSP(const float*, WS_SSP2), p.in[IN_RGB] + l * 4, p.in[IN_REB] + l * 32, WSP(int*, WS_TOKE), WSP(float*, WS_TOKW), WSP(float*, WS_RSTD2), WSP(int*, WS_RANK), WSP(unsigned*, WS_CTL) + CW_COUNT + 32 * l};
            pg8::gemm_phase<EpiRouter, pg8::StaticOrder, false, true>(ring, g, S, E); }
        PH_END;
        if (PH_ON) { PH_LOCALS
            for (int rep = 0; rep < REP_PLACE; ++rep) ph_place_all(WSP(const unsigned*, WS_CTL) + CW_COUNT + 32 * l, WSP(const int*, WS_TOKE), WSP(const float*, WS_TOKW), WSP(int*, WS_RANK), WSP(const float*, WS_RSTD2), WSP(int*, WS_ROWTS), WSP(float*, WS_ROWW), WSP(float*, WS_ROWRS),
                         WSP(int*, WS_TILEE), WSP(int*, WS_CTL) + CW_NTILES + l, lds, wg, nwg); }
        PH_END;
        if (PH_ON) { PH_LOCALS
            pg8::Gemm g{HIN, (const bf16_t*)(wl + WL_GU), MAXROWS, 512, D, 0}; MoeGatherOrder S; S.ntot = 0; S.nN = 2; S.G = 0; S.c = 0; S.tile_e = (const int*)(lds + 131072); S.estride = (size_t)512 * D * 2; S.row_ts = WSP(const int*, WS_ROWTS);
            { const int tid_ = otid(); const int nt_ = *(WSP(const int*, WS_CTL) + CW_NTILES + l); for (int i = tid_; i < nt_; i += NTHR) ((int*)(lds + 131072))[i] = WSP(const int*, WS_TILEE)[i]; __syncthreads(); }
            S.bind(WSP(const int*, WS_CTL) + CW_NTILES + l, nwg, wg);
            S.ntot = (S.ntot / nwg) * nwg;
            EpiGU E{WSP(const float*, WS_ROWRS), WSP(bf16_t*, WS_HID)};
            if (STG_GU) stagger(wg, STG_GU);
            for (int rep = 0; rep < REP_GU; ++rep) pg8::gemm_phase<EpiGU, MoeGatherOrder, AL_GU, true>(ring, g, S, E); }
        PH_END;
        if (PH_ON) { PH_LOCALS
            { const int tid_ = otid(); const int nt_ = *(WSP(const int*, WS_CTL) + CW_NTILES + l); for (int i = tid_; i < nt_; i += NTHR) ((int*)(lds + 131072))[i] = WSP(const int*, WS_TILEE)[i]; __syncthreads(); }
            const int ntl = __builtin_amdgcn_readfirstlane(*(WSP(const int*, WS_CTL) + CW_NTILES + l)), mt0 = ((ntl * 2) / nwg) * (nwg / 2), ntail = ntl - mt0;
            if (wg < ntail) {
                pg8::Gemm g{HIN, (const bf16_t*)(wl + WL_GU), MAXROWS, 512, D, 0}; MoeGatherOrder S; S.nN = 2; S.G = 1; S.c = (mt0 + wg) * 2; S.ntot = S.c + 2; S.tile_e = (const int*)(lds + 131072); S.estride = (size_t)512 * D * 2; S.row_ts = WSP(const int*, WS_ROWTS);
                EpiGU E{WSP(const float*, WS_ROWRS), WSP(bf16_t*, WS_HID)};
                pg8::gemm_phase<EpiGU, MoeGatherOrder, AL_GU, true>(ring, g, S, E);
                __syncthreads();
            }
            pg8::Gemm g{WSP(const bf16_t*, WS_HID), (const bf16_t*)(wl + WL_DN), MAXROWS, D, DEXP, 0}; MoeDealOrder S; S.ntot = 0; S.nN = 4; S.G = nwg; S.c = wg; S.tile_e = (const int*)(lds + 131072); S.estride = (size_t)D * DEXP * 2; S.mt0 = mt0; S.ntail = ntail; S.nD = mt0 * 4;
            EpiDown E{WSP(const float*, WS_ROWW), WSP(bf16_t*, WS_Y)};
            if (STG_DOWN) stagger(wg, STG_DOWN);
            for (int rep = 0; rep < REP_DOWN; ++rep) pg8::gemm_phase<EpiDown, MoeDealOrder, AL_DOWN, true>(ring, g, S, E); }
        PH_END;
        if (PH_ON) { PH_LOCALS
            ph_combine(HIN, WSP(const bf16_t*, WS_Y), WSP(const int*, WS_RANK), WSP(float*, WS_RSTD3), wg, nwg);
            __syncthreads();
            pg8::Gemm g{WSP(const bf16_t*, WS_PB) + (size_t)l * T * PDIM, (const bf16_t*)(wl + WL_PP), T, D, PDIM, 0}; pg8::StaticOrder S; S.init(T, D, nwg, wg); EpiPlain E{WSP(bf16_t*, WS_YMIX), D, 0};
            for (int rep = 0; rep < REP_PP; ++rep) pg8::gemm_phase<EpiPlain, pg8::StaticOrder, AL_PP, true>(ring, g, S, E);
        }
        PH_END;
        if (PH_ON) { PH_LOCALS
            pg8::Gemm g{HIN, (const bf16_t*)(wl + WL_PG), T, D, D, 0}; pg8::StaticOrder S; S.init(T, D, nwg, wg); EpiPLE E{WSP(const float*, WS_RSTD3), WSP(const bf16_t*, WS_YMIX), HIN, HOUT, WSP(float*, WS_SSP)};
            if (STG_PLE) stagger(wg, STG_PLE);
            if (REP_PLE > 1) { EpiPLE E2{WSP(const float*, WS_RSTD3), WSP(const bf16_t*, WS_YMIX), HIN, WSP(bf16_t*, WS_Z), WSP(float*, WS_Z + 400 * MiB)}; for (int rep = 1; rep < REP_PLE; ++rep) pg8::gemm_phase<EpiPLE, pg8::StaticOrder, AL_PLE, true>(ring, g, S, E2); }
            pg8::gemm_phase<EpiPLE, pg8::StaticOrder, AL_PLE, true>(ring, g, S, E); }
        PH_END;
    }
    if (PH_ON) { const int l = 0; PH_LOCALS
        ph_final(WSP(const bf16_t*, (DEPTH & 1) ? WS_HBB : WS_HBA), out, WSP(const float*, WS_SSP), p.in[IN_FINALG], wg, nwg); }
#undef PH_ON
#undef PH_END
}

#ifndef REP_SB
#define REP_SB 1
#endif
#ifndef REP_ML
#define REP_ML 1
#endif
#ifndef REP_SGU
#define REP_SGU 1
#endif
#ifndef MK_SPLIT
#define MK_SPLIT 0
#endif
extern "C" void kernel_launch(void* const* d_in, const int* in_sizes, int n_in, void* d_out, int out_size, void* d_ws, size_t ws_size, hipStream_t stream) {
    static int grid = 0;
    if (grid == 0) {
        if (n_in != N_INPUTS || in_sizes[0] != T * D || out_size != T * D || ws_size < WS_END) { fprintf(stderr, "kernel_launch: unexpected shapes / workspace (%d inputs, ws %zu)\n", n_in, ws_size); grid = -1; return; }
        int dev = 0, cus = 0;
        if (hipGetDevice(&dev) != hipSuccess || hipDeviceGetAttribute(&cus, hipDeviceAttributeMultiprocessorCount, dev) != hipSuccess) { grid = -1; return; }
        if (hipFuncSetAttribute((const void*)mega, hipFuncAttributeMaxDynamicSharedMemorySize, LDS_BYTES) != hipSuccess) { grid = -1; return; }
        int per_cu = 0;
        if (hipOccupancyMaxActiveBlocksPerMultiprocessor(&per_cu, (const void*)mega, NTHR, LDS_BYTES) != hipSuccess || per_cu < 1) fprintf(stderr, "kernel_launch: occupancy query says %d\n", per_cu);
        (void)hipGetLastError();
        grid = cus;
        if (grid != 256) { fprintf(stderr, "kernel_launch: built for 256 CUs (one router unit per workgroup)\n"); grid = -1; return; }
        if (grid < 208) { fprintf(stderr, "kernel_launch: built for >= 208 CUs (LDS table of 16 units per workgroup in the input projection)\n"); grid = -1; return; }
    }
    if (grid < 0) return;
    (void)hipMemsetAsync((unsigned char*)d_ws + WS_CTL, 0, 1 * MiB, stream);
    Params p{};
    for (int i = 0; i < N_INPUTS; ++i) p.in[i] = (const float*)d_in[i];
    p.out = (float*)d_out; p.ws = (unsigned char*)d_ws;
#if MK_SPLIT
    for (int ph = 0; ph < NPHASES; ++ph) { p.ph_lo = ph; p.ph_hi = ph + 1; hipLaunchKernelGGL(mega, dim3(grid), dim3(NTHR), LDS_BYTES, stream, p); }
#else
    p.ph_lo = 0; p.ph_hi = NPHASES;
    hipLaunchKernelGGL(mega, dim3(grid), dim3(NTHR), LDS_BYTES, stream, p);
#endif
}
```

```cpp
#include <hip/hip_runtime.h>
#include <cstdio>
#include <cstdint>
namespace pg8 {
#define PG8_LAS __attribute__((address_space(3)))
typedef unsigned short bf16_t;
typedef short bf16x8 __attribute__((ext_vector_type(8)));
typedef float f32x4 __attribute__((ext_vector_type(4)));
typedef unsigned u32x4 __attribute__((ext_vector_type(4)));
constexpr int BM = 256, BK = 64, HALF = 128, HTB = HALF * BK * 2  , STAGE_BYTES = 8 * HTB, NXCD = 8, WGM = 8;

__host__ __device__ __forceinline__ int lds_byte(int r, int c) { const int st = (r >> 4) * 2 + (c >> 5), rr = r & 15, cc = c & 31, ob = rr * 64 + cc * 2; return st * 1024 + (ob ^ (((ob >> 9) & 1) << 5)); }
__host__ __device__ __forceinline__ void stage_rc(int b, int& R, int& C) { const int st = b / 1024, sb = b % 1024, swz = sb ^ (((sb >> 9) & 1) << 5); R = (st >> 1) * 16 + swz / 64; C = (st & 1) * 32 + (swz % 64) / 2; }
__host__ __device__ __forceinline__ int perm32(int rho) { const int n = rho >> 4, i = rho & 15; return 8 * (i >> 2) + 4 * n + (i & 3); }

struct Unit { int pm, pn, ord; };
struct Gemm { const bf16_t* A; const bf16_t* Bt; int M, N, K, pad; };

struct StaticOrder {
    static constexpr bool GATHER = false;
    int nM, nN, nwg, G, c;
    __host__ __device__ __forceinline__ void init(int M, int N, int G_, int c_) { nM = M / BM; nN = N / BM; nwg = nM * nN; G = G_; c = c_; }
    __host__ __device__ __forceinline__ bool next(int i, Unit& u) const {
        const long L = (long)i * G + c; if (L >= nwg) return false;
        int wgid = (int)L; { const int q = nwg / NXCD, r = nwg % NXCD, xcd = wgid % NXCD, off = wgid / NXCD; wgid = (xcd < r ? xcd * (q + 1) : r * (q + 1) + (xcd - r) * q) + off; }
        const int nig = WGM * nN, gid = wgid / nig, fm = gid * WGM, gsz = (nM - fm) < WGM ? (nM - fm) : WGM;
        u.pm = fm + ((wgid % nig) % gsz); u.pn = (wgid % nig) / gsz; return true;
    }
    __device__ __forceinline__ size_t bbase(const Unit& u, size_t tstep) const { return (size_t)u.pn * tstep; }
    __device__ __forceinline__ int arow(const Unit&, int) const { return 0; }
    __device__ __forceinline__ void a_ready(const Unit&) const {}
    __device__ __forceinline__ void done(const Unit&) const {}
};

__device__ __forceinline__ unsigned cvt_pk_bf16(float lo, float hi) { unsigned r; asm volatile("v_cvt_pk_bf16_f32 %0, %1, %2" : "=v"(r) : "v"(lo), "v"(hi)); return r; }
typedef float f32x2 __attribute__((ext_vector_type(2)));
template <class Epi, class Sched, bool ALIGN_EPI = false, bool SP2 = false>
__device__ __forceinline__ void gemm_phase(PG8_LAS unsigned char* lds, const Gemm g, const Sched& S, const Epi& E) {
    int tid_ = threadIdx.x; asm volatile("" : "+v"(tid_));
    const int tid = tid_, wid = __builtin_amdgcn_readfirstlane(tid >> 6), lane = tid & 63, wr = wid >> 2, wc = wid & 3, fr = lane & 15, fq = lane >> 4;
    int K_ = g.K; asm volatile("" : "+s"(K_));
    const int K = K_, nt = K / BK;
    unsigned voffA[2], voffB[2]; int gR[2], gC[2]; unsigned va[2][2], vnx[2][2];
#pragma unroll
    for (int i = 0; i < 2; ++i) { int R, C; stage_rc(tid * 16 + i * 8192, R, C); const int Rb = Epi::PERM ? ((R & ~31) + perm32(R & 31)) : R;
        voffA[i] = (unsigned)(R * K + C) * 2u; voffB[i] = (unsigned)(Rb * K + C) * 2u; gR[i] = R; gC[i] = C; }
    const size_t kstep = (size_t)(BK * 2);
    const size_t hstep = (size_t)HALF * K * 2;
    const size_t tstep = 2 * hstep;
    const unsigned ldsw = (unsigned)wid * 1024u;
    const int aoff = lds_byte(wr * 64 + fr, fq * 8), boff = lds_byte(wc * 32 + fr, fq * 8);
#define PG8_SA(b, h) (((b) * 2 + (h)) * HTB)
#define PG8_SB(b, h) ((4 + (b) * 2 + (h)) * HTB)
#define PG8_STAGE(bufoff, gbase, voff) do { _Pragma("unroll") for (int _i = 0; _i < 2; ++_i) \
        __builtin_amdgcn_global_load_lds((const unsigned*)((const char*)(gbase) + (voff)[_i]), (PG8_LAS unsigned*)(lds + (bufoff) + ldsw + _i * 8192), 16, 0, 0); } while (0)
#define PG8_STAGE_A(bufoff, kptr, h, nx) do { if constexpr (Sched::GATHER) { const unsigned o_[2] = {(nx) ? vnx[h][0] : va[h][0], (nx) ? vnx[h][1] : va[h][1]}; PG8_STAGE(bufoff, kptr, o_); } \
        else { PG8_STAGE(bufoff, (kptr) + (h) * hstep, voffA); } } while (0)
#define PG8_GOFF(dst, u) do { _Pragma("unroll") for (int h_ = 0; h_ < 2; ++h_) _Pragma("unroll") for (int i_ = 0; i_ < 2; ++i_) dst[h_][i_] = (unsigned)S.arow(u, h_ * HALF + gR[i_]) * (unsigned)(K * 2) + (unsigned)(gC[i_] * 2); } while (0)
#define PG8_LDA(dst, b, h) do { _Pragma("unroll") for (int m = 0; m < 4; ++m) _Pragma("unroll") for (int k = 0; k < 2; ++k) dst[m][k] = *(const PG8_LAS bf16x8*)(lds + PG8_SA(b, h) + aoff + m * 2048 + k * 1024); } while (0)
#define PG8_LDB(dst, b, h) do { _Pragma("unroll") for (int n = 0; n < 2; ++n) _Pragma("unroll") for (int k = 0; k < 2; ++k) dst[n][k] = *(const PG8_LAS bf16x8*)(lds + PG8_SB(b, h) + boff + n * 2048 + k * 1024); } while (0)
#define PG8_MMA(ai, bj, At, Bt) do { __builtin_amdgcn_s_setprio(1); _Pragma("unroll") for (int m = 0; m < 4; ++m) _Pragma("unroll") for (int n = 0; n < 2; ++n) _Pragma("unroll") for (int k = 0; k < 2; ++k) \
        acc[ai][bj][m][n] = __builtin_amdgcn_mfma_f32_16x16x32_bf16(Bt[n][k], At[m][k], acc[ai][bj][m][n], 0, 0, 0); __builtin_amdgcn_s_setprio(0); } while (0)
#define PG8_WAIT_V(n) asm volatile("s_waitcnt vmcnt(" #n ")" ::: "memory")
#define PG8_WAIT_L(n) asm volatile("s_waitcnt lgkmcnt(" #n ")" ::: "memory")
#define PG8_BAR __builtin_amdgcn_s_barrier()
#define PG8_SCHED __builtin_amdgcn_sched_barrier(0)
    Unit cur, nxt; int ui = 0;
    if (!S.next(0, cur)) return;
    cur.ord = 0;
    f32x4 acc[2][2][4][2];
#pragma unroll
    for (int a = 0; a < 2; ++a)
#pragma unroll
        for (int b = 0; b < 2; ++b)
#pragma unroll
            for (int m = 0; m < 4; ++m)
#pragma unroll
                for (int n = 0; n < 2; ++n) acc[a][b][m][n] = (f32x4){0.f, 0.f, 0.f, 0.f};
    bf16x8 At[4][2], B0[2][2], B1[2][2];
    static_assert(!Sched::GATHER || SP2, "the gathered A operand is wired into the SP2 loop only");
    const char* cA = (const char*)g.A + (Sched::GATHER ? (size_t)0 : (size_t)cur.pm * tstep); const char* cB = (const char*)g.Bt + S.bbase(cur, tstep);
    if constexpr (Sched::GATHER) { PG8_GOFF(va, cur); _Pragma("unroll") for (int h_ = 0; h_ < 2; ++h_) _Pragma("unroll") for (int i_ = 0; i_ < 2; ++i_) vnx[h_][i_] = va[h_][i_]; }
    S.a_ready(cur);
    if constexpr (SP2) {
        PG8_STAGE(PG8_SB(0, 0), cB, voffB); PG8_STAGE(PG8_SB(0, 1), cB + hstep, voffB); PG8_STAGE_A(PG8_SA(0, 0), cA, 0, false); PG8_STAGE_A(PG8_SA(0, 1), cA, 1, false);
        if (wr == 1) PG8_BAR;
        PG8_WAIT_V(2); PG8_BAR;
        PG8_STAGE(PG8_SB(1, 0), cB + kstep, voffB); PG8_STAGE_A(PG8_SA(1, 0), cA + kstep, 0, false); PG8_STAGE(PG8_SB(1, 1), cB + hstep + kstep, voffB);
        PG8_WAIT_V(6); PG8_BAR;
    } else {
        PG8_STAGE(PG8_SB(0, 0), cB, voffB); PG8_STAGE(PG8_SA(0, 0), cA, voffA); PG8_STAGE(PG8_SB(0, 1), cB + hstep, voffB); PG8_STAGE(PG8_SA(0, 1), cA + hstep, voffA);
        if (wr == 1) PG8_BAR;
        PG8_WAIT_V(4); PG8_BAR;
        PG8_STAGE(PG8_SB(1, 0), cB + kstep, voffB); PG8_STAGE(PG8_SA(1, 0), cA + kstep, voffA); PG8_STAGE(PG8_SB(1, 1), cB + hstep + kstep, voffB);
        PG8_WAIT_V(6); PG8_BAR;
    }
    for (;;) {
        const bool has_next = S.next(ui + 1, nxt); nxt.ord = ui + 1;
        if constexpr (Sched::GATHER) { if (has_next) PG8_GOFF(vnx, nxt); }
        const char* nA = (has_next && !Sched::GATHER) ? (const char*)g.A + (size_t)nxt.pm * tstep : cA; const char* nB = has_next ? (const char*)g.Bt + S.bbase(nxt, tstep) : cB;
        for (int t = 0; t < nt; t += 2) {
            const bool last = (t == nt - 2); const bool lastnx = last && has_next; (void)lastnx;
            const char* a1 = cA + (size_t)(t + 1) * kstep;
            const char* a2 = last ? nA : cA + (size_t)(t + 2) * kstep; const char* b2 = last ? nB : cB + (size_t)(t + 2) * kstep;
            const char* a3 = a2 + kstep; const char* b3 = b2 + kstep;
            if (last && has_next) S.a_ready(nxt);
            if constexpr (SP2) {
            PG8_LDB(B0, 0, 0); PG8_LDB(B1, 0, 1); PG8_SCHED; PG8_LDA(At, 0, 0); PG8_STAGE_A(PG8_SA(1, 1), a1, 1, false);
            PG8_WAIT_V(8); PG8_WAIT_L(0); PG8_BAR; PG8_MMA(0, 0, At, B0); PG8_MMA(0, 1, At, B1); PG8_BAR; PG8_SCHED;
            PG8_LDA(At, 0, 1); PG8_STAGE(PG8_SB(0, 0), b2, voffB); PG8_STAGE(PG8_SB(0, 1), b2 + hstep, voffB); PG8_STAGE_A(PG8_SA(0, 0), a2, 0, lastnx);
            PG8_WAIT_V(8); PG8_WAIT_L(0); PG8_BAR; PG8_MMA(1, 0, At, B0); PG8_MMA(1, 1, At, B1); PG8_BAR; PG8_SCHED;
            PG8_LDB(B0, 1, 0); PG8_LDB(B1, 1, 1); PG8_SCHED; PG8_LDA(At, 1, 0); PG8_STAGE_A(PG8_SA(0, 1), a2, 1, lastnx);
            PG8_WAIT_V(8); PG8_WAIT_L(0); PG8_BAR; PG8_MMA(0, 0, At, B0); PG8_MMA(0, 1, At, B1); PG8_BAR; PG8_SCHED;
            PG8_LDA(At, 1, 1); PG8_STAGE(PG8_SB(1, 0), b3, voffB); PG8_STAGE(PG8_SB(1, 1), b3 + hstep, voffB); PG8_STAGE_A(PG8_SA(1, 0), a3, 0, lastnx);
            PG8_WAIT_V(8); PG8_WAIT_L(0); PG8_BAR; PG8_MMA(1, 0, At, B0); PG8_MMA(1, 1, At, B1); PG8_BAR; PG8_SCHED;
            } else {
            PG8_LDB(B0, 0, 0); PG8_SCHED; PG8_LDA(At, 0, 0); PG8_STAGE(PG8_SA(1, 1), a1 + hstep, voffA);
            PG8_WAIT_L(8); PG8_BAR; PG8_WAIT_L(0); PG8_MMA(0, 0, At, B0); PG8_BAR; PG8_SCHED;
            PG8_LDB(B1, 0, 1); PG8_STAGE(PG8_SB(0, 0), b2, voffB);
            PG8_BAR; PG8_WAIT_L(0); PG8_MMA(0, 1, At, B1); PG8_BAR;
            PG8_LDA(At, 0, 1); PG8_STAGE(PG8_SA(0, 0), a2, voffA);
            PG8_BAR; PG8_WAIT_L(0); PG8_MMA(1, 0, At, B0); PG8_BAR; PG8_SCHED;
            PG8_STAGE(PG8_SB(0, 1), b2 + hstep, voffB);
            PG8_WAIT_V(6); PG8_BAR; PG8_MMA(1, 1, At, B1); PG8_BAR;
            PG8_LDB(B0, 1, 0); PG8_SCHED; PG8_LDA(At, 1, 0); PG8_STAGE(PG8_SA(0, 1), a2 + hstep, voffA);
            PG8_WAIT_L(8); PG8_BAR; PG8_WAIT_L(0); PG8_MMA(0, 0, At, B0); PG8_BAR; PG8_SCHED;
            PG8_LDB(B1, 1, 1); PG8_STAGE(PG8_SB(1, 0), b3, voffB);
            PG8_BAR; PG8_WAIT_L(0); PG8_MMA(0, 1, At, B1); PG8_BAR;
            PG8_LDA(At, 1, 1); PG8_STAGE(PG8_SA(1, 0), a3, voffA);
            PG8_BAR; PG8_WAIT_L(0); PG8_MMA(1, 0, At, B0); PG8_BAR; PG8_SCHED;
            PG8_STAGE(PG8_SB(1, 1), b3 + hstep, voffB);
            PG8_WAIT_V(6); PG8_BAR; PG8_MMA(1, 1, At, B1); PG8_BAR;
            }
        }
        if constexpr (ALIGN_EPI) { if (wr == 0) PG8_BAR; }
        if constexpr (!Epi::AFTER_DRAIN) { E(acc, cur, wr, wc, fr, fq); S.done(cur); }
        if (!has_next) break;
#pragma unroll
        for (int a = 0; a < 2; ++a)
#pragma unroll
            for (int b = 0; b < 2; ++b)
#pragma unroll
                for (int m = 0; m < 4; ++m)
#pragma unroll
                    for (int n = 0; n < 2; ++n) acc[a][b][m][n] = (f32x4){0.f, 0.f, 0.f, 0.f};
        cur = nxt; cA = nA; cB = nB; ++ui;
        if constexpr (Sched::GATHER) { _Pragma("unroll") for (int h_ = 0; h_ < 2; ++h_) _Pragma("unroll") for (int i_ = 0; i_ < 2; ++i_) va[h_][i_] = vnx[h_][i_]; }
        if constexpr (ALIGN_EPI) { if (wr == 1) PG8_BAR; }
    }
    PG8_WAIT_V(0);
    if constexpr (!ALIGN_EPI) { if (wr == 0) PG8_BAR; }
    PG8_BAR;
    if constexpr (Epi::AFTER_DRAIN) { E.fused(acc, cur, wr, wc, fr, fq, lds, wid, lane); S.done(cur); }
#undef PG8_SA
#undef PG8_SB
#undef PG8_STAGE
#undef PG8_STAGE_A
#undef PG8_GOFF
#undef PG8_LDA
#undef PG8_LDB
#undef PG8_MMA
#undef PG8_WAIT_V
#undef PG8_WAIT_L
#undef PG8_BAR
#undef PG8_SCHED
}
}

#define DEVI __device__ __forceinline__
typedef unsigned short bf16_t;
typedef float f32x4 __attribute__((ext_vector_type(4)));
typedef unsigned u32x4 __attribute__((ext_vector_type(4)));
typedef unsigned u32x2 __attribute__((ext_vector_type(2)));

constexpr int T = 65536, D = 1024, SEQ = 2048, NB = 32, DEPTH = 2;
constexpr int NZ = 3328;
constexpr int ZQA = 0, ZKA = 384, ZVA = 768, ZIF = 1152, ZQB = 1280, ZKB = 1664, ZVB = 2048, ZOB = 2432, ZUC = 2816, ZVC = 3072;
constexpr int NEXP = 32, DEXP = 256, PDIM = 256;
constexpr int MAXROWS = 2 * T + NEXP * 256;
constexpr float EPS = 1e-6f;

constexpr size_t MiB = 1u << 20;
constexpr size_t WS_CTL = 0;
constexpr size_t WS_GATES = 1 * MiB;
constexpr size_t WS_SSP = 3 * MiB;
constexpr size_t WS_TOKE = 7 * MiB;
constexpr size_t WS_TOKW = 7 * MiB + 512 * 1024;
constexpr size_t WS_RSTD2 = 8 * MiB;
constexpr size_t WS_RSTD3 = 8 * MiB + 256 * 1024;
constexpr size_t WS_RANK = 8 * MiB + 512 * 1024;
constexpr size_t WS_ROWTS = 9 * MiB;
constexpr size_t WS_ROWW = 10 * MiB;
constexpr size_t WS_ROWRS = 11 * MiB + 64 * 1024;
constexpr size_t WS_TILEE = 11 * MiB;
constexpr size_t WS_PSTART = 11 * MiB + 4096;
constexpr size_t WS_WR = 12 * MiB;
constexpr size_t WS_WSGU = 13 * MiB;
constexpr size_t WS_WTS = 16 * MiB;
constexpr size_t WL_IN = 0, WL_OUT = 6656 * 1024, WL_GU = WL_OUT + 2 * MiB, WL_DN = WL_GU + 32 * MiB, WL_PG = WL_DN + 16 * MiB, WL_PP = WL_PG + 2 * MiB, WL_SIZE = 59 * MiB;
constexpr size_t WS_PB = 134 * MiB;
constexpr size_t WS_HBA = 198 * MiB;
constexpr size_t WS_HBB = 326 * MiB;
constexpr size_t WS_YMIX = 454 * MiB;
constexpr size_t WS_Z = 582 * MiB;
constexpr size_t WS_XS = WS_Z, WS_Y = WS_Z, WS_HID = WS_Z + 272 * MiB;
constexpr size_t WS_SSP2 = 998 * MiB;
constexpr size_t WS_END = 1002 * MiB;
static_assert(WL_PP + 512 * 1024 <= WL_SIZE, "weights map");
static_assert((size_t)MAXROWS * 1024 * 2 <= 272 * MiB && (size_t)MAXROWS * 256 * 2 <= 68 * MiB, "overlay map");
constexpr int CW_COUNT = 0;
constexpr int CW_NTILES = 64;
constexpr int TABF = 12, TAB_OFF = 131072 + 4096;

DEVI float bf2f(unsigned short b) { return __uint_as_float((unsigned)b << 16); }
typedef float f32x2_t __attribute__((ext_vector_type(2))); typedef __bf16 bf16x2_t __attribute__((ext_vector_type(2)));
DEVI unsigned pk2(float lo, float hi) { const f32x2_t v = {lo, hi}; return __builtin_bit_cast(unsigned, __builtin_convertvector(v, bf16x2_t)); }
DEVI unsigned f2bf(float f) { return pk2(f, 0.f) & 0xffffu; }
DEVI float wave_sum(float v) {
#pragma unroll
    for (int o = 1; o < 64; o <<= 1) v += __shfl_xor(v, o);
    return v;
}
DEVI float sigmoidf_(float x) { return 1.0f / (1.0f + __expf(-x)); }
DEVI float siluf_(float x) { return x * sigmoidf_(x); }
DEVI float gelu_tanh(float x) { const float u = 0.7978845608028654f * (x + 0.044715f * x * x * x); return 0.5f * x * (1.0f + tanhf(u)); }
DEVI float softplusf_(float x) { return fmaxf(x, 0.f) + log1pf(__expf(-fabsf(x))); }

using pg8::Unit;
struct EpiZ {
    static constexpr bool PERM = true, AFTER_DRAIN = false;
    bf16_t* Z; const float* rtab; float* gates;
    const float* cin; bf16_t* cout; int G, c;
    static constexpr int CVT_NCH = DEPTH * T * PDIM / 8, CVT_CPU = (CVT_NCH + 13 * 256 - 1) / (13 * 256);
    DEVI void operator()(const f32x4 (&acc)[2][2][4][2], const Unit& u, int wr, int wc, int fr, int fq) const {
        int row0 = u.pm * 256 + wr * 64 + fr, col0 = u.pn * 256 + wc * 32 + 8 * fq; asm volatile("" : "+v"(row0), "+v"(col0));
        const float* rt = rtab + u.ord * 256 + wr * 64 + fr;
        f32x4 cv[3][2]; int cch[3];
        if (cin != nullptr) { int t_ = (wr * 4 + wc) * 64 + fq * 16 + fr; asm volatile("" : "+v"(t_)); const int ch0 = (u.ord * G + c) * CVT_CPU;
#pragma unroll
            for (int k = 0; k < 3; ++k) { const int o_ = t_ + 512 * k; cch[k] = (o_ < CVT_CPU && ch0 + o_ < CVT_NCH) ? ch0 + o_ : -1;
                if (cch[k] >= 0) { cv[k][0] = ((const f32x4*)cin)[2 * (size_t)cch[k]]; cv[k][1] = ((const f32x4*)cin)[2 * (size_t)cch[k] + 1]; } } }
#pragma unroll
        for (int ai = 0; ai < 2; ++ai)
#pragma unroll
            for (int m = 0; m < 4; ++m) {
                const int row = row0 + ai * 128 + m * 16;
                const float rs = rt[ai * 128 + m * 16];
                bf16_t* rowp = Z + (size_t)row * NZ + col0;
#pragma unroll
                for (int bj = 0; bj < 2; ++bj) {
                    const float sc = (u.pn == 0 || (u.pn == 1 && bj == 0)) ? rs * (0.125f * 1.4426950408889634f) : rs;
                    const f32x4 v0 = acc[ai][bj][m][0] * sc, v1 = acc[ai][bj][m][1] * sc;
                    u32x4 w; w.x = pk2(v0[0], v0[1]); w.y = pk2(v0[2], v0[3]); w.z = pk2(v1[0], v1[1]); w.w = pk2(v1[2], v1[3]);
                    *(u32x4*)(rowp + bj * 128) = w;
                    if (bj == 1 && u.pn == 4 && wc == 0 && fq == 0) { *(f32x4*)(gates + (size_t)row * 8) = v0; *(f32x4*)(gates + (size_t)row * 8 + 4) = v1; }
                }
            }
        if (cin != nullptr) {
#pragma unroll
            for (int k = 0; k < 3; ++k) if (cch[k] >= 0) { u32x4 w; w.x = pk2(cv[k][0][0], cv[k][0][1]); w.y = pk2(cv[k][0][2], cv[k][0][3]); w.z = pk2(cv[k][1][0], cv[k][1][1]); w.w = pk2(cv[k][1][2], cv[k][1][3]); ((u32x4*)cout)[cch[k]] = w; } }
    }
};
DEVI void unpack8(const u32x4 w, float (&f)[8]) { f[0] = __uint_as_float(w.x << 16); f[1] = __uint_as_float(w.x & 0xffff0000u); f[2] = __uint_as_float(w.y << 16); f[3] = __uint_as_float(w.y & 0xffff0000u);
    f[4] = __uint_as_float(w.z << 16); f[5] = __uint_as_float(w.z & 0xffff0000u); f[6] = __uint_as_float(w.w << 16); f[7] = __uint_as_float(w.w & 0xffff0000u); }
struct EpiResid {
    static constexpr bool PERM = true, AFTER_DRAIN = false;
    const bf16_t* hin; bf16_t* hout; float* ssp;
    DEVI void operator()(const f32x4 (&acc)[2][2][4][2], const Unit& u, int wr, int wc, int fr, int fq) const {
        int row0 = u.pm * 256 + wr * 64 + fr, col0 = u.pn * 256 + wc * 32 + 8 * fq; asm volatile("" : "+v"(row0), "+v"(col0));
#pragma unroll
        for (int ai = 0; ai < 2; ++ai) {
            u32x4 hv[4][2];
#pragma unroll
            for (int m = 0; m < 4; ++m)
#pragma unroll
                for (int bj = 0; bj < 2; ++bj) hv[m][bj] = *(const u32x4*)(hin + (size_t)(row0 + ai * 128 + m * 16) * D + col0 + bj * 128);
#pragma unroll
            for (int m = 0; m < 4; ++m) {
                const int row = row0 + ai * 128 + m * 16; const size_t off = (size_t)row * D + col0; float sacc = 0.f;
#pragma unroll
                for (int bj = 0; bj < 2; ++bj) {
                    float f[8]; unpack8(hv[m][bj], f);
                    const f32x4 v0 = acc[ai][bj][m][0], v1 = acc[ai][bj][m][1];
                    f[0] += v0[0]; f[1] += v0[1]; f[2] += v0[2]; f[3] += v0[3]; f[4] += v1[0]; f[5] += v1[1]; f[6] += v1[2]; f[7] += v1[3];
                    sacc += ((f[0] * f[0] + f[1] * f[1]) + (f[2] * f[2] + f[3] * f[3])) + ((f[4] * f[4] + f[5] * f[5]) + (f[6] * f[6] + f[7] * f[7]));
                    u32x4 w; w.x = pk2(f[0], f[1]); w.y = pk2(f[2], f[3]); w.z = pk2(f[4], f[5]); w.w = pk2(f[6], f[7]);
                    *(u32x4*)(hout + off + bj * 128) = w;
                }
                sacc += __shfl_xor(sacc, 16); sacc += __shfl_xor(sacc, 32);
                if (fq == 0) ssp[(size_t)row * 16 + u.pn * 4 + wc] = sacc;
            }
        }
    }
};
struct EpiPLE {
    static constexpr bool PERM = true, AFTER_DRAIN = false;
    const float* rstd3; const bf16_t* pp; const bf16_t* hin; bf16_t* hout; float* ssp;
    DEVI void operator()(const f32x4 (&acc)[2][2][4][2], const Unit& u, int wr, int wc, int fr, int fq) const {
        int row0 = u.pm * 256 + wr * 64 + fr, col0 = u.pn * 256 + wc * 32 + 8 * fq; asm volatile("" : "+v"(row0), "+v"(col0));
#pragma unroll
        for (int ai = 0; ai < 2; ++ai) {
            u32x4 hv[4][2], pvv[4][2]; float rsv[4];
#pragma unroll
            for (int m = 0; m < 4; ++m) { const int row = row0 + ai * 128 + m * 16; rsv[m] = rstd3[row];
#pragma unroll
                for (int bj = 0; bj < 2; ++bj) { hv[m][bj] = *(const u32x4*)(hin + (size_t)row * D + col0 + bj * 128); pvv[m][bj] = *(const u32x4*)(pp + (size_t)row * D + col0 + bj * 128); } }
#pragma unroll
            for (int m = 0; m < 4; ++m) {
                const int row = row0 + ai * 128 + m * 16; const size_t off = (size_t)row * D + col0; const float rs = rsv[m];
                float sacc = 0.f;
#pragma unroll
                for (int bj = 0; bj < 2; ++bj) {
                    float hf[8], pf[8]; unpack8(hv[m][bj], hf); unpack8(pvv[m][bj], pf);
                    float o[8];
#pragma unroll
                    for (int i = 0; i < 8; ++i) { const float a = acc[ai][bj][m][i >> 2][i & 3] * rs; o[i] = hf[i] + __builtin_amdgcn_rcpf(1.0f + __expf(-a)) * pf[i]; sacc += o[i] * o[i]; }
                    u32x4 w; w.x = pk2(o[0], o[1]); w.y = pk2(o[2], o[3]); w.z = pk2(o[4], o[5]); w.w = pk2(o[6], o[7]);
                    *(u32x4*)(hout + off + bj * 128) = w;
                }
                sacc += __shfl_xor(sacc, 16); sacc += __shfl_xor(sacc, 32);
                if (fq == 0) ssp[(size_t)row * 16 + u.pn * 4 + wc] = sacc;
            }
        }
    }
};
struct EpiGU {
    static constexpr bool PERM = true, AFTER_DRAIN = false;
    const float* row_rs; bf16_t* hid; const float* tab; int ntab;
    DEVI void operator()(const f32x4 (&acc)[2][2][4][2], const Unit& u, int wr, int wc, int fr, int fq) const {
        int row0 = u.pm * 256 + wr * 64 + fr; asm volatile("" : "+v"(row0));
        float rsv[2][4];
        { const float* tp = tab + (u.ord < ntab ? u.ord : 0) * 256 + wr * 64 + fr;
#pragma unroll
            for (int ai = 0; ai < 2; ++ai)
#pragma unroll
                for (int m = 0; m < 4; ++m) { rsv[ai][m] = tp[ai * 128 + m * 16]; asm volatile("" : "+v"(rsv[ai][m])); } }
        if (u.ord >= ntab) {
#pragma unroll
            for (int ai = 0; ai < 2; ++ai)
#pragma unroll
                for (int m = 0; m < 4; ++m) rsv[ai][m] = row_rs[row0 + ai * 128 + m * 16];
        }
#pragma unroll
        for (int ai = 0; ai < 2; ++ai)
#pragma unroll
            for (int m = 0; m < 4; ++m) {
                const int row = row0 + ai * 128 + m * 16;
                const float rs = rsv[ai][m];
                float hv[8];
#pragma unroll
                for (int n = 0; n < 2; ++n)
#pragma unroll
                    for (int i = 0; i < 4; ++i) { const float g = acc[ai][0][m][n][i] * rs, uu = acc[ai][1][m][n][i] * rs; hv[n * 4 + i] = siluf_(g) * uu; }
                u32x4 w; w.x = pk2(hv[0], hv[1]); w.y = pk2(hv[2], hv[3]); w.z = pk2(hv[4], hv[5]); w.w = pk2(hv[6], hv[7]);
                *(u32x4*)(hid + (size_t)row * DEXP + u.pn * 128 + wc * 32 + 8 * fq) = w;
            }
    }
};
struct EpiDown {
    static constexpr bool PERM = true, AFTER_DRAIN = false;
    const float* row_w; bf16_t* Y; const float* tab; int ntab;
    DEVI void operator()(const f32x4 (&acc)[2][2][4][2], const Unit& u, int wr, int wc, int fr, int fq) const {
        int row0 = u.pm * 256 + wr * 64 + fr, col0 = u.pn * 256 + wc * 32 + 8 * fq; asm volatile("" : "+v"(row0), "+v"(col0));
        float wv[2][4];
        { const float* tp = tab + (u.ord < ntab ? u.ord : 0) * 256 + wr * 64 + fr;
#pragma unroll
            for (int ai = 0; ai < 2; ++ai)
#pragma unroll
                for (int m = 0; m < 4; ++m) { wv[ai][m] = tp[ai * 128 + m * 16]; asm volatile("" : "+v"(wv[ai][m])); } }
        if (u.ord >= ntab) {
#pragma unroll
            for (int ai = 0; ai < 2; ++ai)
#pragma unroll
                for (int m = 0; m < 4; ++m) wv[ai][m] = row_w[row0 + ai * 128 + m * 16];
        }
#pragma unroll
        for (int ai = 0; ai < 2; ++ai)
#pragma unroll
            for (int m = 0; m < 4; ++m) {
                const float wt = wv[ai][m];
                bf16_t* rowp = Y + (size_t)(row0 + ai * 128 + m * 16) * D + col0;
#pragma unroll
                for (int bj = 0; bj < 2; ++bj) {
                    const f32x4 v0 = acc[ai][bj][m][0] * wt, v1 = acc[ai][bj][m][1] * wt;
                    u32x4 w; w.x = pk2(v0[0], v0[1]); w.y = pk2(v0[2], v0[3]); w.z = pk2(v1[0], v1[1]); w.w = pk2(v1[2], v1[3]);
                    __builtin_nontemporal_store(w, (u32x4*)(rowp + bj * 128));
                }
            }
    }
};
struct EpiNull {
    static constexpr bool PERM = true, AFTER_DRAIN = false;
    float* sink;
    DEVI void operator()(const f32x4 (&acc)[2][2][4][2], const Unit& u, int wr, int wc, int fr, int fq) const {
        float s = 0.f;
#pragma unroll
        for (int ai = 0; ai < 2; ++ai)
#pragma unroll
            for (int bj = 0; bj < 2; ++bj)
#pragma unroll
                for (int m = 0; m < 4; ++m)
#pragma unroll
                    for (int n = 0; n < 2; ++n) s += acc[ai][bj][m][n][0];
        if (s == 1.2345e-30f) sink[0] = s;
    }
};
struct EpiRouter {
    static constexpr bool PERM = false, AFTER_DRAIN = true;
    const float* ssp; const float* rgb; const float* reb; int* tokE; float* tokW; float* rstd2; int* rank; unsigned* count;
    DEVI void fused(f32x4 (&acc)[2][2][4][2], const Unit& u, int wr, int wc, int fr, int fq, PG8_LAS unsigned char* lds, int wid, int lane) const {
        PG8_LAS float* lg = (PG8_LAS float*)lds;
        PG8_LAS int* hist = (PG8_LAS int*)(lds + 256 * 97 * 4); PG8_LAS int* wgb = hist + 32; PG8_LAS int* selE = wgb + 32; PG8_LAS int* selR = selE + 512;
        const int tid = wid * 64 + lane;
        if (tid < 32) hist[tid] = 0;
        if (wc < 3) {
#pragma unroll
            for (int ai = 0; ai < 2; ++ai)
#pragma unroll
                for (int m = 0; m < 4; ++m) { const int r = ai * 128 + wr * 64 + m * 16 + fr;
#pragma unroll
                    for (int n = 0; n < 2; ++n)
#pragma unroll
                        for (int i = 0; i < 4; ++i) lg[r * 97 + 32 * wc + 16 * n + 4 * fq + i] = acc[ai][0][m][n][i]; }
        }
        asm volatile("s_waitcnt lgkmcnt(0)" ::: "memory"); __builtin_amdgcn_s_barrier(); asm volatile("" ::: "memory");
        if (tid < 256) {
            const int t = u.pm * 256 + tid; PG8_LAS const float* l0 = lg + tid * 97;
            const f32x4* sp = (const f32x4*)(ssp + (size_t)t * 16); const f32x4 st = (sp[0] + sp[1]) + (sp[2] + sp[3]);
            const float rs = rsqrtf(((st[0] + st[1]) + (st[2] + st[3])) * (1.0f / 1024.0f) + EPS);
            float gl[4]; int gtop = 0; float gmax;
#pragma unroll
            for (int n = 0; n < 4; ++n) gl[n] = (l0[n] + l0[48 + n]) * rs + rgb[n];
            gmax = gl[0];
#pragma unroll
            for (int n = 1; n < 4; ++n) if (gl[n] > gmax) { gmax = gl[n]; gtop = n; }
            float den = 0.f;
#pragma unroll
            for (int n = 0; n < 4; ++n) den += __expf(gl[n] - gmax);
            const float gw = 1.0f / den;
            float el[8];
#pragma unroll
            for (int jj = 0; jj < 8; ++jj) el[jj] = (l0[4 + gtop * 8 + jj] + l0[52 + gtop * 8 + jj]) * rs + reb[gtop * 8 + jj];
            int i1 = 0; float v1 = el[0];
#pragma unroll
            for (int jj = 1; jj < 8; ++jj) if (el[jj] > v1) { v1 = el[jj]; i1 = jj; }
            int i2 = -1; float v2 = -INFINITY;
#pragma unroll
            for (int jj = 0; jj < 8; ++jj) if (jj != i1 && el[jj] > v2) { v2 = el[jj]; i2 = jj; }
            const float ex = __expf(v2 - v1), w1 = 1.0f / (1.0f + ex), w2 = ex * w1;
            const int e1 = gtop * 8 + i1, e2 = gtop * 8 + i2;
            tokE[t * 2] = e1; tokE[t * 2 + 1] = e2; tokW[t * 2] = w1 * gw; tokW[t * 2 + 1] = w2 * gw; rstd2[t] = rs;
            selE[tid * 2] = e1; selE[tid * 2 + 1] = e2; selR[tid * 2] = __hip_atomic_fetch_add(hist + e1, 1, __ATOMIC_RELAXED, __HIP_MEMORY_SCOPE_WORKGROUP); selR[tid * 2 + 1] = __hip_atomic_fetch_add(hist + e2, 1, __ATOMIC_RELAXED, __HIP_MEMORY_SCOPE_WORKGROUP);
        }
        asm volatile("s_waitcnt lgkmcnt(0)" ::: "memory"); __builtin_amdgcn_s_barrier(); asm volatile("" ::: "memory");
        if (tid < 32) wgb[tid] = (int)atomicAdd(count + tid, (unsigned)hist[tid]);
        asm volatile("s_waitcnt vmcnt(0) lgkmcnt(0)" ::: "memory"); __builtin_amdgcn_s_barrier(); asm volatile("" ::: "memory");
        rank[u.pm * 512 + tid] = wgb[selE[tid]] + selR[tid];
        asm volatile("s_waitcnt lgkmcnt(0)" ::: "memory"); __builtin_amdgcn_s_barrier(); asm volatile("" ::: "memory");
    }
};
struct EpiPlain {
    static constexpr bool PERM = true, AFTER_DRAIN = false;
    bf16_t* O; int ldc, pad;
    DEVI void operator()(const f32x4 (&acc)[2][2][4][2], const Unit& u, int wr, int wc, int fr, int fq) const {
        int row0 = u.pm * 256 + wr * 64 + fr, col0 = u.pn * 256 + wc * 32 + 8 * fq; asm volatile("" : "+v"(row0), "+v"(col0));
#pragma unroll
        for (int ai = 0; ai < 2; ++ai)
#pragma unroll
            for (int m = 0; m < 4; ++m) {
                bf16_t* rowp = O + (size_t)(row0 + ai * 128 + m * 16) * ldc + col0;
#pragma unroll
                for (int bj = 0; bj < 2; ++bj) {
                    const f32x4 v0 = acc[ai][bj][m][0], v1 = acc[ai][bj][m][1];
                    u32x4 w; w.x = pk2(v0[0], v0[1]); w.y = pk2(v0[2], v0[3]); w.z = pk2(v1[0], v1[1]); w.w = pk2(v1[2], v1[3]);
                    *(u32x4*)(rowp + bj * 128) = w;
                }
            }
    }
};
struct MoeOrder {
    static constexpr bool GATHER = false;
    int ntot, nN, G, c; const int* tile_e; size_t estride;
    DEVI void bind(const int* n_tiles_ptr, int G_, int c_) { ntot = __builtin_amdgcn_readfirstlane(*n_tiles_ptr) * nN; G = G_; c = c_; }
    DEVI bool next(int i, Unit& u) const { const long L = (long)i * G + c; if (L >= ntot) return false; u.pm = (int)(L / nN); u.pn = (int)(L % nN); return true; }
    DEVI size_t bbase(const Unit& u, size_t tstep) const { return (size_t)__builtin_amdgcn_readfirstlane(tile_e[u.pm]) * estride + (size_t)u.pn * tstep; }
    DEVI int arow(const Unit&, int) const { return 0; }
    DEVI void a_ready(const Unit&) const {}
    DEVI void done(const Unit&) const {}
};
struct MoeGatherOrder : MoeOrder {
    static constexpr bool GATHER = true;
    const int* row_ts;
    DEVI int arow(const Unit& u, int r) const { const int ts = row_ts[u.pm * 256 + r]; return ts >= 0 ? (ts >> 1) : 0; }
};
struct MoeDealOrder : MoeOrder {
    static constexpr int H = 8;
    int mt0, ntail, nD;
    DEVI bool next(int i, Unit& u) const {
        const int w = c;
        if (w < ntail) { if (i < 4) { u.pm = mt0 + w; u.pn = i; return true; } i -= 4; }
        const int nf = G - ntail; int d;
        if (w >= ntail && i < H) d = (w - ntail) + i * nf;
        else { const int ii = (w >= ntail) ? i - H : i, j = (w >= ntail) ? (w - ntail) : (w - ntail + G); d = H * nf + j + G * ii; }
        if (d >= nD) return false;
        u.pm = d >> 2; u.pn = d & 3; return true;
    }
};


#ifndef REP_SB
#define REP_SB 1
#endif
#ifndef REP_ML
#define REP_ML 1
#endif
#ifndef REP_SGU
#define REP_SGU 1
#endif
#ifndef REP_Z
#define REP_Z 1
#endif
#ifndef REP_PRO
#define REP_PRO 1
#endif
#ifndef REP_GATHER
#define REP_GATHER 1
#endif
#ifndef REP_GU
#define REP_GU 1
#endif
#ifndef REP_DOWN
#define REP_DOWN 1
#endif
#ifndef REP_PP
#define REP_PP 1
#endif
#ifndef REP_WOUT0
#define REP_WOUT0 1
#endif
#ifndef REP_BAR
#define REP_BAR 1
#endif
#ifndef REP_PLACE
#define REP_PLACE 1
#endif
#ifndef REP_PLE
#define REP_PLE 1
#endif
#ifndef REP_RTR
#define REP_RTR 1
#endif
#ifndef STG_Z
#define STG_Z 0
#endif
#ifndef STG_WOUT
#define STG_WOUT 0
#endif
#ifndef STG_GU
#define STG_GU 0
#endif
#ifndef STG_DOWN
#define STG_DOWN 0
#endif
#ifndef STG_PP
#define STG_PP 0
#endif
#ifndef STG_PLE
#define STG_PLE 0
#endif
#ifndef AL_Z
#define AL_Z true
#endif
#ifndef AL_WOUT
#define AL_WOUT true
#endif
#ifndef AL_GU
#define AL_GU true
#endif
#ifndef AL_DOWN
#define AL_DOWN true
#endif
#ifndef AL_PP
#define AL_PP true
#endif
#ifndef AL_PLE
#define AL_PLE true
#endif
constexpr int NTHR = 512;
constexpr int RING_BYTES = 147456;
constexpr int MISC_OFF = RING_BYTES;
constexpr int LDS_BYTES = RING_BYTES + 4096;
constexpr int CW_BAR = 4096;

#define XB_TMO      128
#define XB_XCNT(j)  (256  + 64 * (j))
#define XB_XSUB(j)  (1280 + 64 * (j))
#define XB_XGEN(j)  (2304 + 64 * (j))
#define XB_TOP      3328
#define XB_TOPGEN   3392
#define XCD_BAR_WORDS 3456
#define XB_SPIN_CAP (1u << 18)
#define LAS __attribute__((address_space(3)))

__device__ __forceinline__ unsigned xb_ld(unsigned* p)              { return __hip_atomic_load(p, __ATOMIC_RELAXED, __HIP_MEMORY_SCOPE_AGENT); }
__device__ __forceinline__ unsigned xb_add(unsigned* p, unsigned v) { return __hip_atomic_fetch_add(p, v, __ATOMIC_RELAXED, __HIP_MEMORY_SCOPE_AGENT); }
__device__ __forceinline__ unsigned xb_xcc_id() { return (unsigned)__builtin_amdgcn_s_getreg((3 << 11) | 20) & 0xFu; }
#define XB_SPIN(cond, bar) do { unsigned _sp = 0; while (cond) { __builtin_amdgcn_s_sleep(1); \
    if ((++_sp & 255u) == 0u) { if (xb_ld(&(bar)[XB_TMO])) break; if (_sp > XB_SPIN_CAP) { atomicAdd(&(bar)[XB_TMO], 1u); break; } } } } while (0)

struct XcdBarrier {
    unsigned* bar; unsigned x;
    volatile LAS unsigned* st;
};

__device__ __forceinline__ XcdBarrier xcd_barrier_post(unsigned* bar, volatile LAS unsigned* st) {
    XcdBarrier b; b.bar = bar; b.x = xb_xcc_id(); b.st = st;
    if (threadIdx.x == 0) (void)xb_add(&bar[XB_XCNT(b.x)], 1u);
    return b;
}
__device__ __forceinline__ void xcd_barrier_complete(unsigned* bar, unsigned x, unsigned& nloc, unsigned& nx) {
    const unsigned G = gridDim.x * gridDim.y * gridDim.z;
    unsigned sum, cnt, mine, sp = 0u;
    for (;;) {
        sum = 0u; cnt = 0u; mine = 0u;
#pragma unroll
        for (unsigned j = 0; j < 16; ++j) { const unsigned c = xb_ld(&bar[XB_XCNT(j)]); sum += c; cnt += (c > 0u) ? 1u : 0u; mine = (j == x) ? c : mine; }
        if (sum == G) break;
        __builtin_amdgcn_s_sleep(1);
        if ((++sp & 255u) == 0u) { if (xb_ld(&bar[XB_TMO])) break; if (sp > XB_SPIN_CAP) { atomicAdd(&bar[XB_TMO], 1u); break; } }
    }
    nloc = mine > 0u ? mine : 1u; nx = cnt > 0u ? cnt : 1u;
}

__device__ __forceinline__ void xcd_barrier(const XcdBarrier& b) {
    asm volatile("s_waitcnt vmcnt(0)" ::: "memory");
    __syncthreads();
    if (threadIdx.x == 0) {
        unsigned* bar = b.bar;
        __builtin_amdgcn_s_waitcnt(0);
        unsigned nloc = b.st[0], nx = b.st[1];
        if (nloc == 0u) { xcd_barrier_complete(bar, b.x, nloc, nx); b.st[0] = nloc; b.st[1] = nx; }
        const unsigned old = xb_add(&bar[XB_XSUB(b.x)], 1u);
        const unsigned gen = old / nloc;
        if (old + 1u == (gen + 1u) * nloc) {
            __builtin_amdgcn_fence(__ATOMIC_RELEASE, "agent");
            asm volatile("s_waitcnt vmcnt(0)" ::: "memory");
            const unsigned og = xb_add(&bar[XB_TOP], 1u);
            const unsigned tg = og / nx;
            if (og + 1u == (tg + 1u) * nx) xb_add(&bar[XB_TOPGEN], 1u);
            else XB_SPIN(xb_ld(&bar[XB_TOPGEN]) == tg, bar);
            __builtin_amdgcn_fence(__ATOMIC_ACQUIRE, "agent");
            xb_add(&bar[XB_XGEN(b.x)], 1u);
            asm volatile("s_waitcnt vmcnt(0)" ::: "memory");
        } else {
            XB_SPIN(xb_ld(&bar[XB_XGEN(b.x)]) == gen, bar);
            __builtin_amdgcn_fence(__ATOMIC_ACQUIRE, "agent");
            asm volatile("s_waitcnt vmcnt(0)" ::: "memory");
        }
    }
    __syncthreads();
}


DEVI int otid() { int t = threadIdx.x; asm volatile("" : "+v"(t)); return t; }
DEVI void stagger(int wg, unsigned ticks) { const unsigned long long t0 = __builtin_amdgcn_s_memrealtime(), d = (unsigned long long)((wg & 3) * ticks); while (__builtin_amdgcn_s_memrealtime() - t0 < d) __builtin_amdgcn_s_sleep(8); }
struct PrepJob { const float* in; const float* in2; const float* gain; bf16_t* out; int ldin, K, Nout, mode, ne, pad; size_t in_es, out_es; };
DEVI void ph_prep_w(const PrepJob& j, unsigned char* sm, int wg, int nwg) {
    const int tid = otid(), lane = tid & 63, wave = tid >> 6;
    float* scr = (float*)sm + wave * (64 * 33);
    const int nb = j.Nout / 32, kb = j.K / 64, per = nb * kb, total = per * j.ne;
    for (int it = wg * 8 + wave; it < total; it += nwg * 8) {
        const int e = it / per, r = it - e * per, k0 = (r / nb) * 64, n0 = (r % nb) * 32;
        const int n = n0 + (lane & 31); const float* src = j.in + (size_t)e * j.in_es; int col = n; bool valid = true;
        if (j.mode == 1) {
            if (n < 1152) col = n; else if (n < 1160) col = 2688 + (n - 1152); else if (n < 1280) valid = false; else if (n < 2816) col = 1152 + (n - 1280); else col = 2696 + (n - 2816);
        } else if (j.mode == 2) { const int pn = n >> 8, bj = (n >> 7) & 1; col = pn * 128 + (n & 127); if (bj) src = j.in2 + (size_t)e * j.in_es; }
        const float* sp = src + (size_t)(k0 + (lane >> 5)) * j.ldin + col; const float* gp = j.gain ? j.gain + k0 + (lane >> 5) : nullptr;
        float vv[32];
#pragma unroll
        for (int i = 0; i < 32; ++i) vv[i] = valid ? sp[(size_t)(2 * i) * j.ldin] : 0.f;
#pragma unroll
        for (int i = 0; i < 32; ++i) { float v = vv[i]; if (gp) v *= gp[2 * i]; scr[(2 * i + (lane >> 5)) * 33 + (lane & 31)] = v; }
        asm volatile("s_waitcnt lgkmcnt(0)" ::: "memory");
        const int c = lane & 7; bf16_t* o = j.out + (size_t)e * j.out_es;
#pragma unroll
        for (int jj = 0; jj < 4; ++jj) { const int nn = (lane >> 3) + 8 * jj; const float* q = scr + (8 * c) * 33 + nn;
            u32x4 w; w.x = pk2(q[0 * 33], q[1 * 33]); w.y = pk2(q[2 * 33], q[3 * 33]); w.z = pk2(q[4 * 33], q[5 * 33]); w.w = pk2(q[6 * 33], q[7 * 33]);
            *(u32x4*)(o + (size_t)(n0 + nn) * j.K + k0 + 8 * c) = w; }
        asm volatile("s_waitcnt lgkmcnt(0)" ::: "memory");
    }
}
DEVI void ph_prep_router(const float* rgw, const float* rew, const float* g, bf16_t* WRt, int wg, int nwg) {
    for (int idx = wg * NTHR + otid(); idx < 256 * 1024; idx += nwg * NTHR) { const int r = idx / 1024, k = idx % 1024, n = r < 48 ? r : r - 48;
        float w = (r < 96 && n < 36) ? g[k] * (n < 4 ? rgw[k * 4 + n] : rew[k * 32 + (n - 4)]) : 0.f;
        const unsigned hb = f2bf(w); WRt[idx] = (bf16_t)(r < 48 ? hb : f2bf(w - __uint_as_float(hb << 16))); }
}
DEVI void ph_prep_x(const float* x, bf16_t* hb, float* ssp, int wg, int nwg) {
    const int tid = otid(), lane = tid & 63, gw = wg * 8 + (tid >> 6), ngw = nwg * 8;
    for (int row = 2 * gw; row < T; row += 2 * ngw) {
        f32x4 v[2][4];
#pragma unroll
        for (int r = 0; r < 2; ++r)
#pragma unroll
            for (int jj = 0; jj < 4; ++jj) v[r][jj] = ((const f32x4*)(x + (size_t)(row + r) * D) + lane)[64 * jj];
#pragma unroll
        for (int r = 0; r < 2; ++r) { float s = 0.f; u32x2* o = (u32x2*)(hb + (size_t)(row + r) * D) + lane;
#pragma unroll
            for (int jj = 0; jj < 4; ++jj) { const f32x4 a = v[r][jj]; s += (a[0] * a[0] + a[1] * a[1]) + (a[2] * a[2] + a[3] * a[3]); u32x2 w; w.x = pk2(a[0], a[1]); w.y = pk2(a[2], a[3]); o[64 * jj] = w; }
            s = wave_sum(s);
            if (lane < 16) ssp[(size_t)(row + r) * 16 + lane] = lane == 0 ? s : 0.f; }
    }
}
DEVI void ph_cvt_bf16(const float* in, bf16_t* out, size_t n4, int wg, int nwg) {
    const size_t stride = (size_t)nwg * NTHR;
    for (size_t i0 = (size_t)wg * NTHR + otid(); i0 < n4; i0 += 8 * stride) {
        f32x4 v[8];
#pragma unroll
        for (int k = 0; k < 8; ++k) { const size_t i = i0 + k * stride; v[k] = i < n4 ? ((const f32x4*)in)[i] : (f32x4){0.f, 0.f, 0.f, 0.f}; }
#pragma unroll
        for (int k = 0; k < 8; ++k) { const size_t i = i0 + k * stride; if (i < n4) { u32x2 w; w.x = pk2(v[k][0], v[k][1]); w.y = pk2(v[k][2], v[k][3]); ((u32x2*)out)[i] = w; } }
    }
}

namespace sb {
typedef short bf16x8 __attribute__((ext_vector_type(8)));
typedef short s16x4 __attribute__((ext_vector_type(4)));
typedef float f32x16 __attribute__((ext_vector_type(16)));
constexpr float QSCALE = 0.125f * 1.4426950408889634f;
constexpr int WAVE_LDS = 12288;
DEVI int crow(int r, int hi) { return (r & 3) + 8 * (r >> 2) + 4 * hi; }
DEVI void glds16(const void* gsrc, unsigned lds_dst) { unsigned keep;
    asm volatile("s_mov_b32 %0, m0\n\ts_mov_b32 m0, %2\n\ts_nop 0\n\tglobal_load_lds_dwordx4 %1, off\n\ts_mov_b32 m0, %0" : "=&s"(keep) : "v"(gsrc), "s"(lds_dst) : "memory"); }
DEVI unsigned cvtpk(float lo, float hi) { unsigned r; asm("v_cvt_pk_bf16_f32 %0, %1, %2" : "=v"(r) : "v"(lo), "v"(hi)); return r; }
DEVI void pv(f32x16* o, int vb, bf16x8 pa0, bf16x8 pa1, bf16x8 pa2, bf16x8 pa3) {
#pragma unroll
    for (int d0 = 0; d0 < 2; ++d0) { s16x4 lo[4], hi[4];
#pragma unroll
        for (int ks = 0; ks < 4; ++ks) {
            asm volatile("ds_read_b64_tr_b16 %0,%1 offset:%c2" : "=&v"(lo[ks]) : "v"(vb), "i"(d0 * 4096 + ks * 1024) : "memory");
            asm volatile("ds_read_b64_tr_b16 %0,%1 offset:%c2" : "=&v"(hi[ks]) : "v"(vb), "i"(d0 * 4096 + ks * 1024 + 512) : "memory"); }
        asm volatile("s_waitcnt lgkmcnt(0)" ::: "memory"); __builtin_amdgcn_sched_barrier(0);
#define SB_PK(k) (bf16x8){lo[k][0], lo[k][1], lo[k][2], lo[k][3], hi[k][0], hi[k][1], hi[k][2], hi[k][3]}
        o[d0] = __builtin_amdgcn_mfma_f32_32x32x16_bf16(pa0, SB_PK(0), o[d0], 0, 0, 0);
        o[d0] = __builtin_amdgcn_mfma_f32_32x32x16_bf16(pa1, SB_PK(1), o[d0], 0, 0, 0);
        o[d0] = __builtin_amdgcn_mfma_f32_32x32x16_bf16(pa2, SB_PK(2), o[d0], 0, 0, 0);
        o[d0] = __builtin_amdgcn_mfma_f32_32x32x16_bf16(pa3, SB_PK(3), o[d0], 0, 0, 0);
#undef SB_PK
    }
}
}
DEVI void ph_sb(const bf16_t* Z, const float* og, bf16_t* Ymix, unsigned char* smb, int wg, int nwg) {
    using namespace sb;
    const int tid = otid(), lane = tid & 63, wave = __builtin_amdgcn_readfirstlane(tid >> 6), r32 = lane & 31, hi = lane >> 5;
    unsigned char* vt = smb + wave * 16384;
    const unsigned vt_lds = (unsigned)(uintptr_t)vt;
    const int vbl = ((lane >> 4) & 1) * 32 + (lane & 3) * 8 + (4 * hi + ((lane & 15) >> 2)) * 64;
    const unsigned vK0 = (unsigned)(r32 * NZ + ZKA + hi * 8) * 2u, vK1 = vK0 + 32u * NZ * 2u, vV = (unsigned)((lane >> 2) * NZ + ZVA + (lane & 3) * 8) * 2u, vQ = (unsigned)(r32 * NZ + ZQA + hi * 8) * 2u;
#define SB_TILE(hh, jj) ((const char*)Z + ((size_t)(bbase + (jj) * 64) * NZ + (hh) * 64) * 2)
#define SB_LOADK(dst, hh, jj) do { const char* kb_ = SB_TILE(hh, jj); _Pragma("unroll") for (int d0 = 0; d0 < 4; ++d0) { dst[2 * d0] = *(const bf16x8*)(kb_ + vK0 + d0 * 32); dst[2 * d0 + 1] = *(const bf16x8*)(kb_ + vK1 + d0 * 32); } } while (0)
#define SB_DMAV(buf, hh, jj) do { const char* kb_ = SB_TILE(hh, jj); _Pragma("unroll") for (int w8 = 0; w8 < 8; ++w8) \
        glds16(kb_ + ((size_t)(16 * (w8 & 3)) * NZ + (w8 >> 2) * 32) * 2 + vV, (unsigned)__builtin_amdgcn_readfirstlane(vt_lds + (buf) * 8192 + w8 * 1024)); } while (0)
#define SB_LOADQ(dst, hh) do { const char* qp_ = (const char*)Z + ((size_t)row0 * NZ + (hh) * 64) * 2 + vQ; _Pragma("unroll") for (int d0 = 0; d0 < 4; ++d0) dst[d0] = *(const bf16x8*)(qp_ + d0 * 32); } while (0)
    for (int wu = wg * 8 + wave; wu < T / 32; wu += nwg * 8) {
        const int row0 = wu * 32, bbase = (row0 / SEQ) * SEQ, t0 = row0 - bbase, tq = t0 + r32, jt0 = t0 >> 6;
        float ssq[4] = {0.f, 0.f, 0.f, 0.f};
        int cb = 0, pf = 0;
        bf16x8 kf[8], qr[4];
        asm volatile("s_waitcnt lgkmcnt(0)" ::: "memory");
        SB_DMAV(0, 0, jt0); SB_LOADK(kf, 0, jt0); SB_LOADQ(qr, 0);
#pragma unroll 1
        for (int h = 0; h < 6; ++h) {
            f32x16 o[2]; o[0] = f32x16{}; o[1] = f32x16{};
            float carry = 1.f; bool diag = true;
#pragma unroll 1
            for (int jt = jt0; ; --jt) {
                const int kv0 = jt * 64;
                f32x16 p0 = __builtin_amdgcn_mfma_f32_32x32x16_bf16(kf[0], qr[0], f32x16{}, 0, 0, 0), p1 = __builtin_amdgcn_mfma_f32_32x32x16_bf16(kf[1], qr[0], f32x16{}, 0, 0, 0);
#pragma unroll
                for (int d0 = 1; d0 < 4; ++d0) { p0 = __builtin_amdgcn_mfma_f32_32x32x16_bf16(kf[2 * d0], qr[d0], p0, 0, 0, 0); p1 = __builtin_amdgcn_mfma_f32_32x32x16_bf16(kf[2 * d0 + 1], qr[d0], p1, 0, 0, 0); }
                if (diag && jt > 0) { SB_DMAV(cb ^ 1, h, jt - 1); SB_LOADK(kf, h, jt - 1); pf = 1; }
                else if (h + 1 < 6) { SB_DMAV(cb ^ 1, h + 1, jt0); SB_LOADK(kf, h + 1, jt0); pf = 2; }
                else pf = 0;
                if (diag) {
#pragma unroll
                    for (int r = 0; r < 16; ++r) { const int kv = kv0 + crow(r, hi); if (kv >= tq) p0[r] = -INFINITY; if (kv + 32 >= tq) p1[r] = -INFINITY; }
                }
                float total = 1.f; u32x4 pw0, pw1, pw2, pw3;
#define SB_HALF(P, PWA, PWB) do { f32x16 R; \
                    _Pragma("unroll") for (int r = 0; r < 16; ++r) { float c_; asm("v_min_f32 %0, %1, %2" : "=v"(c_) : "v"(P[r]), "v"(100.f)); const float e_ = __builtin_amdgcn_exp2f(c_); R[r] = __builtin_amdgcn_rcpf(1.0f + e_); P[r] = e_ * R[r]; } \
                    _Pragma("unroll") for (int g = 3; g >= 0; --g) { const float mine = (R[4 * g] * R[4 * g + 1]) * (R[4 * g + 2] * R[4 * g + 3]); const auto sw_ = __builtin_amdgcn_permlane32_swap(__float_as_uint(mine), __float_as_uint(mine), false, false); const float og_ = __uint_as_float(hi ? sw_[0] : sw_[1]);     \
                        float t = carry * (hi == 0 ? total * og_ : total); total *= mine * og_; \
                        P[4 * g + 3] *= t; t *= R[4 * g + 3]; P[4 * g + 2] *= t; t *= R[4 * g + 2]; P[4 * g + 1] *= t; t *= R[4 * g + 1]; P[4 * g] *= t; } \
                    PWA = (u32x4){cvtpk(P[0], P[1]), cvtpk(P[2], P[3]), cvtpk(P[4], P[5]), cvtpk(P[6], P[7])}; PWB = (u32x4){cvtpk(P[8], P[9]), cvtpk(P[10], P[11]), cvtpk(P[12], P[13]), cvtpk(P[14], P[15])}; } while (0)
                SB_HALF(p1, pw2, pw3);
                SB_HALF(p0, pw0, pw1);
#undef SB_HALF
                carry *= total;
                if (pf) asm volatile("s_waitcnt vmcnt(16)" ::: "memory");
                else asm volatile("s_waitcnt vmcnt(0)" ::: "memory");
                pv(o, (int)vt_lds + cb * 8192 + vbl, __builtin_bit_cast(bf16x8, pw0), __builtin_bit_cast(bf16x8, pw1), __builtin_bit_cast(bf16x8, pw2), __builtin_bit_cast(bf16x8, pw3));
                diag = false;
                if (jt == 0 || !__any(carry > 9.0949470177e-13f)) break;
                if (pf == 1) { cb ^= 1; pf = 0; }
                else { SB_DMAV(cb, h, jt - 1); SB_LOADK(kf, h, jt - 1); pf = 0; }
            }
            const bool hit = (pf == 2);
            pf = 0;
            if (h + 1 < 6) SB_LOADQ(qr, h + 1);
            bf16_t* stg = (bf16_t*)(vt + cb * 8192);
#pragma unroll
            for (int r = 0; r < 16; ++r) { const int orow = crow(r, hi); stg[orow * 64 + r32] = (bf16_t)f2bf(o[0][r]); stg[orow * 64 + 32 + r32] = (bf16_t)f2bf(o[1][r]); }
            asm volatile("s_waitcnt lgkmcnt(0)" ::: "memory");
#pragma unroll
            for (int i = 0; i < 4; ++i) { const int row = i * 8 + (lane >> 3), ch = lane & 7; const u32x4 v = *(const u32x4*)(stg + row * 64 + ch * 8);
                float a[8]; unpack8(v, a);
                ssq[i] += ((a[0] * a[0] + a[1] * a[1]) + (a[2] * a[2] + a[3] * a[3])) + ((a[4] * a[4] + a[5] * a[5]) + (a[6] * a[6] + a[7] * a[7]));
                *(u32x4*)(Ymix + (size_t)(row0 + row) * D + h * 64 + ch * 8) = v; }
            asm volatile("s_waitcnt lgkmcnt(0)" ::: "memory");
            if (h + 1 < 6) {
                if (!hit) { SB_DMAV(cb ^ 1, h + 1, jt0); SB_LOADK(kf, h + 1, jt0); }
                cb ^= 1;
            }
        }
        asm volatile("s_waitcnt vmcnt(0)" ::: "memory");
        float rs[4];
#pragma unroll
        for (int i = 0; i < 4; ++i) { float s = ssq[i]; s += __shfl_xor(s, 1); s += __shfl_xor(s, 2); s += __shfl_xor(s, 4); rs[i] = rsqrtf(s * (1.0f / 384.0f) + EPS); }
#pragma unroll 1
        for (int h = 0; h < 6; ++h) { const int ch = lane & 7; const f32x4 g0 = *(const f32x4*)(og + h * 64 + ch * 8), g1 = *(const f32x4*)(og + h * 64 + ch * 8 + 4);
#pragma unroll
            for (int i = 0; i < 4; ++i) { const int row = i * 8 + (lane >> 3); u32x4* pp = (u32x4*)(Ymix + (size_t)(row0 + row) * D + h * 64 + ch * 8); float a[8]; unpack8(*pp, a); const float r = rs[i];
                u32x4 w; w.x = pk2(a[0] * r * g0[0], a[1] * r * g0[1]); w.y = pk2(a[2] * r * g0[2], a[3] * r * g0[3]); w.z = pk2(a[4] * r * g1[0], a[5] * r * g1[1]); w.w = pk2(a[6] * r * g1[2], a[7] * r * g1[3]);
                *pp = w; } }
    }
#undef SB_TILE
#undef SB_LOADK
#undef SB_DMAV
#undef SB_LOADQ
}

namespace ml {
constexpr int QROW = 208, TROW = 144;
constexpr int O_QN = 0, O_KN = 13312, O_KWT = 26624, O_VT = 40448, O_CT = 54272, CT_BYTES = 96 * QROW, O_NV = O_CT + 2 * CT_BYTES, O_TB = O_NV + 768, O_SC = O_TB + 2 * 1280,
              O_MNG = O_SC + 64, O_CW = O_MNG + 384, O_RAW = O_CW + 5 * 192 * 4, NP_QK = 67 * 24, NP_ALL = NP_QK + 64 * 12, O_RAWV = O_RAW + NP_QK * 16, O_DUMMY = O_RAW + 40 * 1024, O_END = O_DUMMY + 1024;
static_assert(O_END <= 147456 && NP_ALL <= 40 * 64 && O_RAW % 16 == 0, "mLSTM LDS map");
typedef short bf16x8 __attribute__((ext_vector_type(8)));
}
DEVI void ph_mlstm(const bf16_t* Z, const float* gates, const float* conv_w, const float* conv_b, const float* igb, const float* fgb, const float* mng, bf16_t* Ymix,
                   unsigned char* smb, int wg, int nwg) {
    using namespace ml;
    const int tid = otid(), lane = tid & 63, wave = __builtin_amdgcn_readfirstlane(tid >> 6), l16 = lane & 15, quad = lane >> 4;
    float* NV = (float*)(smb + O_NV);
    const unsigned raw_lds = (unsigned)(uintptr_t)(smb + O_RAW);
    for (int unit = wg; unit < NB * 4; unit += nwg) {
        const int b = unit >> 2, h = unit & 3; const size_t rb = (size_t)b * SEQ;
#define ML_DMA(n1) do { const char* zb_ = (const char*)Z + ((long)rb + (long)(n1) * 64 - 3) * (NZ * 2); \
            _Pragma("unroll") for (int ins = 0; ins < 5; ++ins) if ((ins * 8 + wave) * 64 + lane < NP_ALL) sb::glds16(zb_ + doff[ins], (unsigned)__builtin_amdgcn_readfirstlane(raw_lds + (ins * 8 + wave) * 1024)); } while (0)
        unsigned doff[5];
#pragma unroll
        for (int ins = 0; ins < 5; ++ins) { const int pidx = (ins * 8 + wave) * 64 + lane;
            if (pidx < NP_QK) { const int r = pidx / 24, seg = pidx - 24 * r; doff[ins] = (unsigned)(r * NZ + (seg < 12 ? ZQB + h * 96 + 8 * seg : ZKB + h * 96 + 8 * (seg - 12))) * 2u; }
            else { const int j = pidx - NP_QK, l = j / 12, seg = j - 12 * l; doff[ins] = (unsigned)((l + 3) * NZ + ZVB + h * 96 + 8 * seg) * 2u; } }
#define ML_WARM(n2) do { if (wave >= 4) { const unsigned dl_ = (unsigned)__builtin_amdgcn_readfirstlane((unsigned)(uintptr_t)(smb + O_DUMMY)); const int wq_ = wave - 4; \
            if ((n2) < 32) { const char* rp_ = (const char*)Z + ((size_t)rb + (size_t)(n2) * 64 + lane) * (NZ * 2) + (size_t)((wq_ == 0 ? ZQB : wq_ == 1 ? ZKB : wq_ == 2 ? ZVB : ZOB) + h * 96) * 2; \
                sb::glds16(rp_, dl_); sb::glds16(rp_ + 128, dl_); } \
            if (wq_ == 3 && (n2) + 1 < 32) { const char* gp_ = (const char*)gates + ((size_t)rb + (size_t)((n2) + 1) * 64) * 32 + lane * 16; sb::glds16(gp_, dl_); sb::glds16(gp_ + 1024, dl_); } } } while (0)
#define ML_GATES(n1, ip, fp) do { float* TBn = (float*)(smb + O_TB) + ((n1) & 1) * 320; float* SCn = (float*)(smb + O_SC) + ((n1) & 1) * 4; \
            float c = -softplusf_(-(fp)); _Pragma("unroll") for (int o = 1; o < 64; o <<= 1) { const float t_ = __shfl_up(c, o); if (lane >= o) c += t_; } \
            const float btot = __shfl(c, 63), a_ = btot - c + (ip), g_ = (ip) - c; float mloc = a_; \
            _Pragma("unroll") for (int o = 32; o >= 1; o >>= 1) mloc = fmaxf(mloc, __shfl_xor(mloc, o)); \
            float pm = g_; _Pragma("unroll") for (int o = 1; o < 64; o <<= 1) { const float t_ = __shfl_up(pm, o); if (lane >= o) pm = fmaxf(pm, t_); } \
            const float mn = fmaxf(btot + mrun, mloc); \
            TBn[lane] = a_; TBn[64 + lane] = g_; TBn[128 + lane] = pm; TBn[192 + lane] = c; TBn[256 + lane] = __expf(a_ - mn); \
            if (lane == 0) { SCn[0] = mrun; SCn[1] = mn; SCn[2] = __expf(btot + mrun - mn); } mrun = mn; } while (0)
#define ML_CONVERT(n1) do { const float* WLn = (const float*)(smb + O_TB) + ((n1) & 1) * 320 + 256; \
            if (tid < 384) { const unsigned char* rw = smb + O_RAW + cc * 2; const int l0 = 16 * rseg; const bool z0 = ((n1) == 0 && rseg == 0); \
                const f32x2_t* cwp_ = (const f32x2_t*)((const float*)(smb + O_CW) + cc); const f32x2_t cw0 = cwp_[0], cw1 = cwp_[96], cw2 = cwp_[192], cw3 = cwp_[288], cbias = cwp_[384]; \
                f32x2_t x0, x1, x2; { const unsigned u0 = *(const unsigned*)(rw + (l0 + 0) * 384), u1 = *(const unsigned*)(rw + (l0 + 1) * 384), u2 = *(const unsigned*)(rw + (l0 + 2) * 384); \
                    x0 = z0 ? (f32x2_t){0.f, 0.f} : (f32x2_t){__uint_as_float(u0 << 16), __uint_as_float(u0 & 0xffff0000u)}; x1 = z0 ? (f32x2_t){0.f, 0.f} : (f32x2_t){__uint_as_float(u1 << 16), __uint_as_float(u1 & 0xffff0000u)}; \
                    x2 = z0 ? (f32x2_t){0.f, 0.f} : (f32x2_t){__uint_as_float(u2 << 16), __uint_as_float(u2 & 0xffff0000u)}; } \
                unsigned char* qk = smb + (which ? O_KN : O_QN) + cd * 2; unsigned char* kwt = smb + O_KWT + cd * TROW; \
                _Pragma("unroll 2") for (int i = 0; i < 16; i += 2) { const int l = l0 + i; \
                    const unsigned ua = *(const unsigned*)(rw + (l + 3) * 384), ub = *(const unsigned*)(rw + (l + 4) * 384); \
                    const f32x2_t xa = {__uint_as_float(ua << 16), __uint_as_float(ua & 0xffff0000u)}, xb = {__uint_as_float(ub << 16), __uint_as_float(ub & 0xffff0000u)}; \
                    f32x2_t ya = cbias + cw0 * x0 + cw1 * x1 + cw2 * x2 + cw3 * xa, yb = cbias + cw0 * x1 + cw1 * x2 + cw2 * xa + cw3 * xb; x0 = x2; x1 = xa; x2 = xb; \
                    f32x2_t oa, ob_; oa.x = ya.x * __builtin_amdgcn_rcpf(1.0f + __expf(-ya.x)); oa.y = ya.y * __builtin_amdgcn_rcpf(1.0f + __expf(-ya.y)); ob_.x = yb.x * __builtin_amdgcn_rcpf(1.0f + __expf(-yb.x)); ob_.y = yb.y * __builtin_amdgcn_rcpf(1.0f + __expf(-yb.y)); \
                    if (which) { oa = oa * 0.10206207261596575f; ob_ = ob_ * 0.10206207261596575f; const float wa = WLn[l], wb = WLn[l + 1]; \
                        *(unsigned*)(kwt + l * 2) = pk2(oa.x * wa, ob_.x * wb); *(unsigned*)(kwt + TROW + l * 2) = pk2(oa.y * wa, ob_.y * wb); } \
                    *(unsigned*)(qk + l * QROW) = pk2(oa.x, oa.y); *(unsigned*)(qk + (l + 1) * QROW) = pk2(ob_.x, ob_.y); } \
            } else { const int idx = tid - 384, lp = idx >> 2, eq = idx & 3; const u32x4* s0 = (const u32x4*)(smb + O_RAWV + (2 * lp) * 192 + eq * 48); const u32x4* s1 = (const u32x4*)(smb + O_RAWV + (2 * lp + 1) * 192 + eq * 48); \
                unsigned char* vt = smb + O_VT + (eq * 24) * TROW + lp * 4; \
                _Pragma("unroll") for (int i = 0; i < 3; ++i) { const u32x4 a = s0[i], b = s1[i]; \
                    *(unsigned*)(vt + (i * 8 + 0) * TROW) = (a.x & 0xffffu) | (b.x << 16); *(unsigned*)(vt + (i * 8 + 1) * TROW) = (a.x >> 16) | (b.x & 0xffff0000u); \
                    *(unsigned*)(vt + (i * 8 + 2) * TROW) = (a.y & 0xffffu) | (b.y << 16); *(unsigned*)(vt + (i * 8 + 3) * TROW) = (a.y >> 16) | (b.y & 0xffff0000u); \
                    *(unsigned*)(vt + (i * 8 + 4) * TROW) = (a.z & 0xffffu) | (b.z << 16); *(unsigned*)(vt + (i * 8 + 5) * TROW) = (a.z >> 16) | (b.z & 0xffff0000u); \
                    *(unsigned*)(vt + (i * 8 + 6) * TROW) = (a.w & 0xffffu) | (b.w << 16); *(unsigned*)(vt + (i * 8 + 7) * TROW) = (a.w >> 16) | (b.w & 0xffff0000u); } } } while (0)
        const int cc = tid < 384 ? 2 * (tid % 96) : 0, rseg = tid < 384 ? tid / 96 : 0, which = cc >= 96 ? 1 : 0, cd = cc - 96 * which;
        if (tid < 192) { const int w_ = tid >= 96 ? 1 : 0, ch_ = w_ * 384 + h * 96 + (tid - 96 * w_); float* cwt = (float*)(smb + O_CW);
            cwt[tid] = conv_w[ch_]; cwt[192 + tid] = conv_w[768 + ch_]; cwt[384 + tid] = conv_w[2 * 768 + ch_]; cwt[576 + tid] = conv_w[3 * 768 + ch_]; cwt[768 + tid] = conv_b[ch_]; }
        float mrun = 0.f;
        ML_DMA(0);
        for (int i = tid; i < CT_BYTES / 4; i += NTHR) ((unsigned*)(smb + O_CT))[i] = 0u;
        if (tid < 96) { NV[tid] = 0.f; ((float*)(smb + O_MNG))[tid] = mng[h * 96 + tid]; }
        if (wave == 7) { const size_t row = rb + lane; const float ip = gates[row * 8 + h] + igb[h], fp = gates[row * 8 + 4 + h] + fgb[h]; ML_GATES(0, ip, fp); }
        asm volatile("s_waitcnt vmcnt(0)" ::: "memory");
        __syncthreads();
        ML_CONVERT(0);
        __syncthreads();
        f32x4 Cst[9];
#pragma unroll
        for (int k = 0; k < 9; ++k) Cst[k] = (f32x4){0.f, 0.f, 0.f, 0.f};
#pragma unroll 1
        for (int n = 0; n < 32; ++n) {
            const int cur = n & 1, nxt = cur ^ 1; const float* SCc = (const float*)(smb + O_SC) + cur * 4; const float m_in = SCc[0], dec = SCc[2];
            const float* TBc = (const float*)(smb + O_TB) + cur * 320;
            const size_t r0 = rb + n * 64;
            if (n + 1 < 32) ML_DMA(n + 1);
            if (wave < 4) {
                const int tt = wave, t = 16 * tt + l16; const size_t row = r0 + t;
                const unsigned char* qn = smb + O_QN; const unsigned char* kn = smb + O_KN; const unsigned char* vtb = smb + O_VT; const unsigned char* ct = smb + O_CT + cur * CT_BYTES;
                bf16x8 bq[3];
#pragma unroll
                for (int ks = 0; ks < 3; ++ks) bq[ks] = *(const bf16x8*)(qn + t * QROW + (32 * ks + 8 * quad) * 2);
                const float Mt = fmaxf(m_in, TBc[128 + t]), inter = __expf(m_in - Mt), flr = __expf(-(TBc[192 + t] + Mt));
                f32x4 P[4]; float psum = 0.f;
#pragma unroll
                for (int st = 0; st < 4; ++st) { P[st] = (f32x4){0.f, 0.f, 0.f, 0.f};
                    if (st <= tt) {
#pragma unroll
                        for (int ks = 0; ks < 3; ++ks) P[st] = __builtin_amdgcn_mfma_f32_16x16x32_bf16(*(const bf16x8*)(kn + (16 * st + l16) * QROW + (32 * ks + 8 * quad) * 2), bq[ks], P[st], 0, 0, 0);
                        const f32x4 gs = *(const f32x4*)(TBc + 64 + 16 * st + 4 * quad);
#pragma unroll
                        for (int j = 0; j < 4; ++j) { const int s_ = 16 * st + 4 * quad + j; const float w = s_ <= t ? __expf(gs[j] - Mt) : 0.f; P[st][j] *= w; psum += P[st][j]; }
                    } }
                psum += __shfl_xor(psum, 16); psum += __shfl_xor(psum, 32);
                float qn_ = 0.f; { const float* nv = NV + cur * 96 + quad * 24; const unsigned char* qp = qn + t * QROW + quad * 48;
#pragma unroll
                    for (int i = 0; i < 3; ++i) { const u32x4 w = *(const u32x4*)(qp + i * 16);
                        qn_ += __uint_as_float(w.x << 16) * nv[i * 8 + 0] + __uint_as_float(w.x & 0xffff0000u) * nv[i * 8 + 1] + __uint_as_float(w.y << 16) * nv[i * 8 + 2] + __uint_as_float(w.y & 0xffff0000u) * nv[i * 8 + 3]
                             + __uint_as_float(w.z << 16) * nv[i * 8 + 4] + __uint_as_float(w.z & 0xffff0000u) * nv[i * 8 + 5] + __uint_as_float(w.w << 16) * nv[i * 8 + 6] + __uint_as_float(w.w & 0xffff0000u) * nv[i * 8 + 7]; } }
                qn_ += __shfl_xor(qn_, 16); qn_ += __shfl_xor(qn_, 32);
                float den = psum + inter * qn_; den = fmaxf(fabsf(den), flr); const float rden = 1.0f / den;
                bf16x8 pk[2];
#pragma unroll
                for (int i = 0; i < 2; ++i) { u32x4 w; w.x = pk2(P[2 * i][0], P[2 * i][1]); w.y = pk2(P[2 * i][2], P[2 * i][3]); w.z = pk2(P[2 * i + 1][0], P[2 * i + 1][1]); w.w = pk2(P[2 * i + 1][2], P[2 * i + 1][3]); pk[i] = __builtin_bit_cast(bf16x8, w); }
                float hv[6][4]; float ss = 0.f;
#pragma unroll
                for (int et = 0; et < 6; ++et) {
                    f32x4 n1 = (f32x4){0.f, 0.f, 0.f, 0.f}, n2 = (f32x4){0.f, 0.f, 0.f, 0.f};
#pragma unroll
                    for (int i = 0; i < 2; ++i) if (2 * i <= tt) { const unsigned char* vp = vtb + (16 * et + l16) * TROW + (32 * i + 4 * quad) * 2;
                        const u32x2 lo = *(const u32x2*)vp, hi2 = *(const u32x2*)(vp + 32); const u32x4 a = {lo.x, lo.y, hi2.x, hi2.y};
                        n1 = __builtin_amdgcn_mfma_f32_16x16x32_bf16(__builtin_bit_cast(bf16x8, a), pk[i], n1, 0, 0, 0); }
#pragma unroll
                    for (int ks = 0; ks < 3; ++ks) n2 = __builtin_amdgcn_mfma_f32_16x16x32_bf16(*(const bf16x8*)(ct + (16 * et + l16) * QROW + (32 * ks + 8 * quad) * 2), bq[ks], n2, 0, 0, 0);
#pragma unroll
                    for (int j = 0; j < 4; ++j) { const float v = (n1[j] + inter * n2[j]) * rden; hv[et][j] = v; ss += v * v; }
                    __builtin_amdgcn_sched_barrier(0);
                }
                u32x2 obv[6];
#pragma unroll
                for (int et = 0; et < 6; ++et) obv[et] = *(const u32x2*)(Z + row * NZ + ZOB + h * 96 + 16 * et + 4 * quad);
                ss += __shfl_xor(ss, 16); ss += __shfl_xor(ss, 32);
                const float rs = rsqrtf(ss * (1.0f / 96.0f) + EPS);
#pragma unroll
                for (int et = 0; et < 6; ++et) { const int e = 16 * et + 4 * quad; const u32x2 ob = obv[et]; const f32x4 mg = *(const f32x4*)((const float*)(smb + O_MNG) + e);
                    u32x2 w; w.x = pk2(hv[et][0] * rs * mg[0] * sigmoidf_(__uint_as_float(ob.x << 16)), hv[et][1] * rs * mg[1] * sigmoidf_(__uint_as_float(ob.x & 0xffff0000u)));
                    w.y = pk2(hv[et][2] * rs * mg[2] * sigmoidf_(__uint_as_float(ob.y << 16)), hv[et][3] * rs * mg[3] * sigmoidf_(__uint_as_float(ob.y & 0xffff0000u)));
                    *(u32x2*)(Ymix + row * D + 384 + h * 96 + e) = w; }
            } else {
                const int wq = wave - 4; const unsigned char* kwt = smb + O_KWT; const unsigned char* vtb = smb + O_VT; unsigned char* ctn = smb + O_CT + nxt * CT_BYTES;
                float gip = 0.f, gfp = 0.f;
                if (wq == 3 && n + 1 < 32) { const size_t row = r0 + 64 + lane; gip = gates[row * 8 + h] + igb[h]; gfp = gates[row * 8 + 4 + h] + fgb[h]; }
#pragma unroll
                for (int k = 0; k < 9; ++k) { const int idx = wq + 4 * k, dt = idx / 6, et = idx - 6 * dt; f32x4 U = (f32x4){0.f, 0.f, 0.f, 0.f};
#pragma unroll
                    for (int ks = 0; ks < 2; ++ks) U = __builtin_amdgcn_mfma_f32_16x16x32_bf16(*(const bf16x8*)(kwt + (16 * dt + l16) * TROW + (32 * ks + 8 * quad) * 2), *(const bf16x8*)(vtb + (16 * et + l16) * TROW + (32 * ks + 8 * quad) * 2), U, 0, 0, 0);
                    Cst[k] = Cst[k] * dec + U;
                    u32x2 w; w.x = pk2(Cst[k][0], Cst[k][1]); w.y = pk2(Cst[k][2], Cst[k][3]);
                    *(u32x2*)(ctn + (16 * et + l16) * QROW + (16 * dt + 4 * quad) * 2) = w; __builtin_amdgcn_sched_barrier(0); }
                if (wq == 0 || (wq == 1 && lane < 32)) { const int d = wq * 64 + lane; const u32x4* kp = (const u32x4*)(kwt + d * TROW); float sacc = 0.f;
#pragma unroll
                    for (int i = 0; i < 8; ++i) { const u32x4 w = kp[i];
                        sacc += (__uint_as_float(w.x << 16) + __uint_as_float(w.x & 0xffff0000u)) + (__uint_as_float(w.y << 16) + __uint_as_float(w.y & 0xffff0000u))
                              + (__uint_as_float(w.z << 16) + __uint_as_float(w.z & 0xffff0000u)) + (__uint_as_float(w.w << 16) + __uint_as_float(w.w & 0xffff0000u)); }
                    NV[nxt * 96 + d] = dec * NV[cur * 96 + d] + sacc; }
                if (wq == 3 && n + 1 < 32) ML_GATES(n + 1, gip, gfp);
            }
            asm volatile("s_waitcnt vmcnt(0)" ::: "memory");
            __syncthreads();
            ML_WARM(n + 2);
            if (n + 1 < 32) ML_CONVERT(n + 1);
            __syncthreads();
        }
#undef ML_DMA
#undef ML_WARM
#undef ML_GATES
#undef ML_CONVERT
    }
}

namespace sgu {
constexpr int VROW = 272, VGRP = 64 * VROW + 32, MROW = 528, MST_OFF = 71680;
static_assert(4 * VGRP <= MST_OFF && MST_OFF + 128 * MROW <= 147456, "SGU LDS map");
DEVI float gelu_fast(float x) { const float u = 1.5957691216057308f * (x + 0.044715f * x * x * x); return x * __builtin_amdgcn_rcpf(1.0f + __expf(-u)); }
}
DEVI void ph_sgu(const bf16_t* Z, const float* ln_g, const float* ln_b, const bf16_t* Wm, const float* bs, const float* og, bf16_t* Ymix, unsigned char* smb, int wg, int nwg) {
    using namespace sgu; typedef short bf16x8 __attribute__((ext_vector_type(8))); typedef float f32x16 __attribute__((ext_vector_type(16)));
    const int tid = otid(), lane = tid & 63, wave = __builtin_amdgcn_readfirstlane(tid >> 6), r32 = lane & 31, hi = lane >> 5;
    for (int blk = wg; blk < T / 128; blk += nwg) {
        const size_t row0 = (size_t)blk * 128;
        u32x4 uv[8]; { const u32x4* up = (const u32x4*)(Z + (row0 + (tid >> 2)) * NZ + ZUC + (tid & 3) * 64);
#pragma unroll
            for (int i = 0; i < 8; ++i) uv[i] = up[i]; }
        {
            const int tp = tid >> 3, g = (tid >> 1) & 3, hf = tid & 1, c0 = g * 64 + hf * 32;
            u32x4 raw[2][4];
#pragma unroll
            for (int k = 0; k < 2; ++k) { const u32x4* src = (const u32x4*)(Z + (row0 + 2 * tp + k) * NZ + ZVC + c0);
#pragma unroll
                for (int i = 0; i < 4; ++i) raw[k][i] = src[i]; }
            float v[2][32];
#pragma unroll
            for (int k = 0; k < 2; ++k)
#pragma unroll
                for (int i = 0; i < 4; ++i) { float f[8]; unpack8(raw[k][i], f);
#pragma unroll
                    for (int j = 0; j < 8; ++j) v[k][i * 8 + j] = gelu_fast(f[j]); }
            float mu[2], rstd[2];
#pragma unroll
            for (int k = 0; k < 2; ++k) { float s1 = 0.f;
#pragma unroll
                for (int c = 0; c < 32; ++c) s1 += v[k][c];
                s1 += __shfl_xor(s1, 1); mu[k] = s1 * (1.0f / 64.0f); float s2 = 0.f;
#pragma unroll
                for (int c = 0; c < 32; ++c) { const float dd = v[k][c] - mu[k]; s2 += dd * dd; }
                s2 += __shfl_xor(s2, 1); rstd[k] = rsqrtf(s2 * (1.0f / 64.0f) + EPS); }
            unsigned char* dst = smb + g * VGRP + (hf * 32) * VROW + tp * 4;
#pragma unroll
            for (int c = 0; c < 32; ++c) { const float gg = ln_g[c0 + c], bb = ln_b[c0 + c];
                *(unsigned*)(dst + c * VROW) = pk2((v[0][c] - mu[0]) * rstd[0] * gg + bb, (v[1][c] - mu[1]) * rstd[1] * gg + bb); }
        }
        const int g2 = wave >> 1, mh = wave & 1;
        bf16x8 af[2][8];
        { const bf16_t* wa = Wm + ((size_t)g2 * 128 + 64 * mh + r32) * 128 + 8 * hi;
#pragma unroll
            for (int ks = 0; ks < 8; ++ks) if (ks < 4 || mh) { af[0][ks] = *(const bf16x8*)(wa + ks * 16); af[1][ks] = *(const bf16x8*)(wa + 32 * 128 + ks * 16); } }
        asm volatile("s_waitcnt lgkmcnt(0)" ::: "memory"); __builtin_amdgcn_s_barrier(); asm volatile("" ::: "memory");
        {
            f32x16 acc[2][2];
#pragma unroll
            for (int i = 0; i < 2; ++i)
#pragma unroll
                for (int j = 0; j < 2; ++j) acc[i][j] = f32x16{};
            const unsigned char* vb = smb + g2 * VGRP + r32 * VROW + 16 * hi;
#pragma unroll
            for (int ks = 0; ks < 8; ++ks) if (ks < 4 || mh) {
                const bf16x8 b0 = *(const bf16x8*)(vb + ks * 32), b1 = *(const bf16x8*)(vb + 32 * VROW + ks * 32);
                acc[0][0] = __builtin_amdgcn_mfma_f32_32x32x16_bf16(af[0][ks], b0, acc[0][0], 0, 0, 0); acc[0][1] = __builtin_amdgcn_mfma_f32_32x32x16_bf16(af[0][ks], b1, acc[0][1], 0, 0, 0);
                acc[1][0] = __builtin_amdgcn_mfma_f32_32x32x16_bf16(af[1][ks], b0, acc[1][0], 0, 0, 0); acc[1][1] = __builtin_amdgcn_mfma_f32_32x32x16_bf16(af[1][ks], b1, acc[1][1], 0, 0, 0);
            }
            bf16_t* mst = (bf16_t*)(smb + MST_OFF);
#pragma unroll
            for (int mt = 0; mt < 2; ++mt)
#pragma unroll
                for (int r = 0; r < 16; ++r) { const int t = 64 * mh + 32 * mt + (r & 3) + 8 * (r >> 2) + 4 * hi; const float bias = bs[g2 * 128 + t];
                    bf16_t* mp = mst + t * (MROW / 2) + g2 * 64 + r32;
                    mp[0] = (bf16_t)f2bf(acc[mt][0][r] + bias); mp[32] = (bf16_t)f2bf(acc[mt][1][r] + bias); }
        }
        asm volatile("s_waitcnt lgkmcnt(0)" ::: "memory"); __builtin_amdgcn_s_barrier(); asm volatile("" ::: "memory");
        {
            const int t = tid >> 2, g = tid & 3; const size_t row = row0 + t;
            const u32x4* mp = (const u32x4*)(smb + MST_OFF + t * MROW + g * 128);
            float y[64]; float ss = 0.f;
#pragma unroll
            for (int i = 0; i < 8; ++i) { float uf[8], mf[8]; unpack8(uv[i], uf); unpack8(mp[i], mf);
#pragma unroll
                for (int j = 0; j < 8; ++j) { y[i * 8 + j] = gelu_fast(uf[j]) * mf[j]; ss += y[i * 8 + j] * y[i * 8 + j]; } }
            ss += __shfl_xor(ss, 1); ss += __shfl_xor(ss, 2);
            const float rs = rsqrtf(ss * (1.0f / 256.0f) + EPS);
            u32x4* yp = (u32x4*)(Ymix + row * D + 768 + g * 64); const f32x4* gp = (const f32x4*)(og + g * 64);
#pragma unroll
            for (int i = 0; i < 8; ++i) { const f32x4 g0 = gp[2 * i], g1 = gp[2 * i + 1];
                u32x4 w; w.x = pk2(y[i * 8 + 0] * rs * g0[0], y[i * 8 + 1] * rs * g0[1]); w.y = pk2(y[i * 8 + 2] * rs * g0[2], y[i * 8 + 3] * rs * g0[3]);
                w.z = pk2(y[i * 8 + 4] * rs * g1[0], y[i * 8 + 5] * rs * g1[1]); w.w = pk2(y[i * 8 + 6] * rs * g1[2], y[i * 8 + 7] * rs * g1[3]); yp[i] = w; }
        }
        asm volatile("s_waitcnt lgkmcnt(0)" ::: "memory"); __builtin_amdgcn_s_barrier(); asm volatile("" ::: "memory");
    }
}
DEVI void ph_prep_sgu(const float* w, bf16_t* Wm, int wg, int nwg) {
    for (int idx = wg * NTHR + otid(); idx < 4 * 128 * 128; idx += nwg * NTHR) { const int t = (idx >> 7) & 127, s = idx & 127; Wm[idx] = (bf16_t)f2bf(((s >> 6) <= (t >> 6)) ? w[idx] : 0.f); }
}

template <class Sched> DEVI void fill_f32_table(const Sched& S, const float* srcv, unsigned char* smb) {
    const int tid_ = otid();
    for (int i = tid_ >> 8; i < TABF; i += 2) { pg8::Unit u_; if (!S.next(i, u_)) break; ((float*)(smb + TAB_OFF))[i * 256 + (tid_ & 255)] = srcv[u_.pm * 256 + (tid_ & 255)]; }
    __syncthreads();
}
DEVI void ph_place_all(const unsigned* count, const int* tokE, const float* tokW, int* rank, const float* rstd2, int* row_ts, float* row_w, float* row_rs, int* tile_e, int* n_tiles, unsigned char* smb, int wg, int nwg) {
    int* ps = (int*)smb; int* cnt = ps + 40;
    const int tid = otid(), lane = tid & 63;
    if (tid < 64) { const int c = lane < 32 ? (int)__hip_atomic_load(count + lane, __ATOMIC_RELAXED, __HIP_MEMORY_SCOPE_AGENT) : 0; const int pad = (c + 255) & ~255;
        int incl = pad;
#pragma unroll
        for (int o = 1; o < 32; o <<= 1) { const int t_ = __shfl_up(incl, o); if (lane >= o) incl += t_; }
        if (lane < 32) { cnt[lane] = c; ps[lane] = incl - pad; if (lane == 31) ps[32] = incl; } }
    __syncthreads();
    if (wg == 0) {
        const int nt = ps[32] >> 8;
        if (tid == 0) *n_tiles = nt;
        for (int i = tid; i < nt; i += NTHR) { int e = 0;
#pragma unroll 1
            for (int k = 1; k < 32; ++k) if ((ps[k] >> 8) <= i) e = k;
            tile_e[i] = e; }
        for (int e = 0; e < 32; ++e) for (int r = cnt[e] + tid; r < ps[e + 1] - ps[e]; r += NTHR) { row_ts[ps[e] + r] = -1; row_rs[ps[e] + r] = 0.f; }
    }
    for (int idx = wg * NTHR + tid; idx < 2 * T; idx += nwg * NTHR) { const int pos = ps[tokE[idx]] + rank[idx]; row_ts[pos] = idx; row_w[pos] = tokW[idx]; row_rs[pos] = rstd2[idx >> 1]; rank[idx] = pos; }
    __syncthreads();
}
DEVI void ph_combine(bf16_t* h, const bf16_t* Y, const int* tokpos, float* rstd3, int wg, int nwg) {
    const int tid = otid(), lane = tid & 63, gw = wg * 8 + (tid >> 6), ngw = nwg * 8;
    for (int base = 2 * gw; base < T; base += 32 * ngw) {
        const int myrow = base + 2 * ngw * (lane >> 2) + ((lane >> 1) & 1);
        const int tp = myrow < T ? tokpos[myrow * 2 + (lane & 1)] : 0;
#pragma unroll 1
        for (int k = 0; k < 16; ++k) {
            const int row = base + 2 * ngw * k; if (row >= T) break;
            u32x4 hv[2][2], y0[2][2], y1[2][2];
#pragma unroll
            for (int r = 0; r < 2; ++r) { const int p0 = __builtin_amdgcn_readfirstlane(__shfl(tp, 4 * k + 2 * r)), p1 = __builtin_amdgcn_readfirstlane(__shfl(tp, 4 * k + 2 * r + 1));
#pragma unroll
                for (int jj = 0; jj < 2; ++jj) { hv[r][jj] = ((const u32x4*)(h + (size_t)(row + r) * D) + lane)[64 * jj];
                    y0[r][jj] = __builtin_nontemporal_load((const u32x4*)(Y + (size_t)p0 * D) + lane + 64 * jj); y1[r][jj] = __builtin_nontemporal_load((const u32x4*)(Y + (size_t)p1 * D) + lane + 64 * jj); } }
#pragma unroll
            for (int r = 0; r < 2; ++r) { float s = 0.f;
#pragma unroll
                for (int jj = 0; jj < 2; ++jj) { float a[8], b0[8], b1[8]; unpack8(hv[r][jj], a); unpack8(y0[r][jj], b0); unpack8(y1[r][jj], b1);
#pragma unroll
                    for (int i = 0; i < 8; ++i) { a[i] += b0[i] + b1[i]; s += a[i] * a[i]; }
                    u32x4 w; w.x = pk2(a[0], a[1]); w.y = pk2(a[2], a[3]); w.z = pk2(a[4], a[5]); w.w = pk2(a[6], a[7]); ((u32x4*)(h + (size_t)(row + r) * D) + lane)[64 * jj] = w; }
                s = wave_sum(s);
                if (lane == 0) rstd3[row + r] = rsqrtf(s * (1.0f / 1024.0f) + EPS); }
        }
    }
}
DEVI void ph_final(const bf16_t* h, float* out, const float* ssp, const float* g, int wg, int nwg) {
    const int tid = otid(), lane = tid & 63, gw = wg * 8 + (tid >> 6), ngw = nwg * 8;
    const f32x4* gp = (const f32x4*)g + 2 * lane; const f32x4 g00 = gp[0], g01 = gp[1], g10 = gp[128], g11 = gp[129];
    for (int row = 2 * gw; row < T; row += 2 * ngw) {
        u32x4 hv[2][2]; float sp[2];
#pragma unroll
        for (int r = 0; r < 2; ++r) { sp[r] = lane < 16 ? ssp[(size_t)(row + r) * 16 + lane] : 0.f;
#pragma unroll
            for (int jj = 0; jj < 2; ++jj) hv[r][jj] = ((const u32x4*)(h + (size_t)(row + r) * D) + lane)[64 * jj]; }
#pragma unroll
        for (int r = 0; r < 2; ++r) { const float rs = rsqrtf(wave_sum(sp[r]) * (1.0f / 1024.0f) + EPS); f32x4* op = (f32x4*)(out + (size_t)(row + r) * D) + 2 * lane;
#pragma unroll
            for (int jj = 0; jj < 2; ++jj) { float a[8]; unpack8(hv[r][jj], a); const f32x4 g0 = jj ? g10 : g00, g1 = jj ? g11 : g01;
                op[128 * jj] = (f32x4){a[0] * rs * g0[0], a[1] * rs * g0[1], a[2] * rs * g0[2], a[3] * rs * g0[3]}; op[128 * jj + 1] = (f32x4){a[4] * rs * g1[0], a[5] * rs * g1[1], a[6] * rs * g1[2], a[7] * rs * g1[3]}; } }
    }
}

enum { IN_X = 0, IN_P, IN_NORM1G, IN_WIN, IN_CONVW, IN_CONVB, IN_IGB, IN_FGB, IN_MNG, IN_SBOG, IN_SGULNG, IN_SGULNB, IN_SGUW, IN_SGUB, IN_SGUOG, IN_WOUT, IN_NORM2G,
       IN_RGW, IN_RGB, IN_REW, IN_REB, IN_WGATE, IN_WUP, IN_WDOWN, IN_PLENG, IN_PLEGW, IN_PLEPW, IN_FINALG, N_INPUTS };
constexpr int NPH_LAYER = 9, NPHASES = 1 + DEPTH * NPH_LAYER + 1;
struct Params { const float* in[N_INPUTS]; float* out; unsigned char* ws; int ph_lo, ph_hi; };
static_assert(sizeof(Params) == N_INPUTS * 8 + 8 + 8 + 8, "Params has no padding");

__global__ void __launch_bounds__(NTHR, 2) mega(Params p) {
    extern __shared__ __attribute__((aligned(16))) unsigned char lds[];
    const int tid = threadIdx.x, wg = blockIdx.x, nwg = gridDim.x;
    for (int u = tid; u < (LDS_BYTES - MISC_OFF) / 4; u += NTHR) ((LAS unsigned*)(lds + MISC_OFF))[u] = 0u;
    __syncthreads();
    unsigned char* const ws0 = p.ws;
    const bool fused = (p.ph_hi - p.ph_lo) > 1;
    XcdBarrier bar; bar.bar = (unsigned*)(ws0 + WS_CTL) + CW_BAR; bar.x = 0; bar.st = nullptr;
    if (fused) bar = xcd_barrier_post((unsigned*)(ws0 + WS_CTL) + CW_BAR, (volatile LAS unsigned*)(lds + MISC_OFF));
    PG8_LAS unsigned char* ring = (PG8_LAS unsigned char*)lds;
#define WSP(type, off) ((type)(ws + (off)))
#define PH_LOCALS size_t zo_ = 0; asm volatile("" : "+s"(zo_)); unsigned char* ws = ws0 + zo_; float* out = p.out + zo_;   \
        unsigned char* wl = ws + WS_WTS + (size_t)l * WL_SIZE; (void)wl; (void)out; \
        bf16_t* const HIN = (bf16_t*)(ws + ((l & 1) ? WS_HBB : WS_HBA)); bf16_t* const HOUT = (bf16_t*)(ws + ((l & 1) ? WS_HBA : WS_HBB)); (void)HIN; (void)HOUT;

    int gp = 0;
#define PH_ON (p.ph_lo <= gp && gp < p.ph_hi)
#define PH_END do { if (fused && gp + 1 < p.ph_hi) for (int rb_ = 0; rb_ < REP_BAR; ++rb_) xcd_barrier(bar); ++gp; } while (0)

    if (PH_ON) for (int rep = 0; rep < REP_PRO; ++rep) {
#pragma unroll 1
        for (int l = 0; l < DEPTH; ++l) {
            PH_LOCALS
            { const PrepJob j{p.in[IN_WIN] + (size_t)l * D * 3208, nullptr, p.in[IN_NORM1G] + l * D, (bf16_t*)(wl + WL_IN), 3208, D, NZ, 1, 1, 0, 0, 0}; ph_prep_w(j, lds, wg, nwg); }
            { const PrepJob j{p.in[IN_WOUT] + (size_t)l * D * D, nullptr, nullptr, (bf16_t*)(wl + WL_OUT), D, D, D, 0, 1, 0, 0, 0}; ph_prep_w(j, lds, wg, nwg); }
            { const PrepJob j{p.in[IN_WGATE] + (size_t)l * NEXP * D * DEXP, p.in[IN_WUP] + (size_t)l * NEXP * D * DEXP, p.in[IN_NORM2G] + l * D, (bf16_t*)(wl + WL_GU), DEXP, D, 512, 2, NEXP, 0, (size_t)D * DEXP, (size_t)512 * D};
              ph_prep_w(j, lds, wg, nwg); }
            { const PrepJob j{p.in[IN_WDOWN] + (size_t)l * NEXP * DEXP * D, nullptr, nullptr, (bf16_t*)(wl + WL_DN), D, DEXP, D, 0, NEXP, 0, (size_t)DEXP * D, (size_t)D * DEXP}; ph_prep_w(j, lds, wg, nwg); }
            { const PrepJob j{p.in[IN_PLEGW] + (size_t)l * D * D, nullptr, p.in[IN_PLENG] + l * D, (bf16_t*)(wl + WL_PG), D, D, D, 0, 1, 0, 0, 0}; ph_prep_w(j, lds, wg, nwg); }
            { const PrepJob j{p.in[IN_PLEPW] + (size_t)l * PDIM * D, nullptr, nullptr, (bf16_t*)(wl + WL_PP), D, PDIM, D, 0, 1, 0, 0, 0}; ph_prep_w(j, lds, wg, nwg); }
            ph_prep_sgu(p.in[IN_SGUW] + (size_t)l * 4 * 128 * 128, WSP(bf16_t*, WS_WSGU) + (size_t)l * 4 * 128 * 128, wg, nwg);
            ph_prep_router(p.in[IN_RGW] + l * D * 4, p.in[IN_REW] + l * D * 32, p.in[IN_NORM2G] + l * D, WSP(bf16_t*, WS_WR) + (size_t)l * 256 * D, wg, nwg);
        }
        { const int l = 0; PH_LOCALS
          ph_prep_x(p.in[IN_X], WSP(bf16_t*, WS_HBA), WSP(float*, WS_SSP), wg, nwg);
            }
    }
    PH_END;

#pragma clang loop unroll(full)
    for (int l = 0; l < DEPTH; ++l) {
        if (PH_ON) { PH_LOCALS
            pg8::Gemm g{HIN, (const bf16_t*)(wl + WL_IN), T, NZ, D, 0}; pg8::StaticOrder S; S.init(T, NZ, nwg, wg); const float* rtab = (const float*)(lds + 131072);
            { const int tid_ = otid(); const float* ssp_ = WSP(const float*, WS_SSP);
              for (int i = tid_ >> 8; ; i += 2) { pg8::Unit u_; if (!S.next(i & ~1, u_)) break; if (S.next(i, u_)) { const f32x4* sp = (const f32x4*)(ssp_ + (size_t)(u_.pm * 256 + (tid_ & 255)) * 16);
                  const f32x4 st = (sp[0] + sp[1]) + (sp[2] + sp[3]); ((float*)(lds + 131072))[i * 256 + (tid_ & 255)] = rsqrtf(((st[0] + st[1]) + (st[2] + st[3])) * (1.0f / 1024.0f) + EPS); } }
              __syncthreads(); }
            EpiZ E{WSP(bf16_t*, WS_Z), rtab, WSP(float*, WS_GATES), l == 0 ? p.in[IN_P] : nullptr, WSP(bf16_t*, WS_PB), nwg, wg};
            if (STG_Z) stagger(wg, STG_Z);
            for (int rep = 0; rep < REP_Z; ++rep) pg8::gemm_phase<EpiZ, pg8::StaticOrder, AL_Z, true>(ring, g, S, E); }
        PH_END;
        if (PH_ON) { PH_LOCALS
            const int nh = nwg >> 1;
            if (wg < nh) {
                for (int rep = 0; rep < REP_ML; ++rep) ph_mlstm(WSP(const bf16_t*, WS_Z), WSP(const float*, WS_GATES), p.in[IN_CONVW] + l * 4 * 768, p.in[IN_CONVB] + l * 768, p.in[IN_IGB] + l * 4, p.in[IN_FGB] + l * 4, p.in[IN_MNG] + l * 384, WSP(bf16_t*, WS_YMIX), lds, wg, nh);
            } else {
                for (int rep = 0; rep < REP_SB; ++rep) { ph_sb(WSP(const bf16_t*, WS_Z), p.in[IN_SBOG] + l * 384, WSP(bf16_t*, WS_YMIX), lds, wg - nh, nwg - nh); __syncthreads(); }
                for (int rep = 0; rep < REP_SGU; ++rep) ph_sgu(WSP(const bf16_t*, WS_Z), p.in[IN_SGULNG] + l * 256, p.in[IN_SGULNB] + l * 256, WSP(const bf16_t*, WS_WSGU) + (size_t)l * 4 * 128 * 128, p.in[IN_SGUB] + l * 4 * 128, p.in[IN_SGUOG] + l * 256, WSP(bf16_t*, WS_YMIX), lds, wg - nh, nwg - nh);
            }
        }
        PH_END;
        if (PH_ON) { PH_LOCALS
            pg8::Gemm g{WSP(const bf16_t*, WS_YMIX), (const bf16_t*)(wl + WL_OUT), T, D, D, 0}; pg8::StaticOrder S; S.init(T, D, nwg, wg); EpiResid E{HIN, HIN, WSP(float*, WS_SSP2)};
            if (REP_WOUT0 > 1) { EpiResid E2{HIN, WSP(bf16_t*, WS_Z), WSP(float*, WS_Z + 400 * MiB)}; for (int rep = 1; rep < REP_WOUT0; ++rep) pg8::gemm_phase<EpiResid, pg8::StaticOrder, AL_WOUT, true>(ring, g, S, E2); }
            if (STG_WOUT) stagger(wg, STG_WOUT);
            pg8::gemm_phase<EpiResid, pg8::StaticOrder, AL_WOUT, true>(ring, g, S, E); }
        PH_END;
        if (PH_ON) { PH_LOCALS
            pg8::Gemm g{HIN, WSP(const bf16_t*, WS_WR) + (size_t)l * 256 * D, T, 256, D, 0}; pg8::StaticOrder S; S.init(T, 256, nwg, wg);
            EpiRouter E{WSP(const float*, WS_SSP2), p.in[IN_RGB] + l * 4, p.in[IN_REB] + l * 32, WSP(int*, WS_TOKE), WSP(float*, WS_TOKW), WSP(float*, WS_RSTD2), WSP(int*, WS_RANK), WSP(unsigned*, WS_CTL) + CW_COUNT + 32 * l};
            pg8::gemm_phase<EpiRouter, pg8::StaticOrder, false, true>(ring, g, S, E); }
        PH_END;
        if (PH_ON) { PH_LOCALS
            for (int rep = 0; rep < REP_PLACE; ++rep) ph_place_all(WSP(const unsigned*, WS_CTL) + CW_COUNT + 32 * l, WSP(const int*, WS_TOKE), WSP(const float*, WS_TOKW), WSP(int*, WS_RANK), WSP(const float*, WS_RSTD2), WSP(int*, WS_ROWTS), WSP(float*, WS_ROWW), WSP(float*, WS_ROWRS),
                         WSP(int*, WS_TILEE), WSP(int*, WS_CTL) + CW_NTILES + l, lds, wg, nwg); }
        PH_END;
        if (PH_ON) { PH_LOCALS
            pg8::Gemm g{HIN, (const bf16_t*)(wl + WL_GU), MAXROWS, 512, D, 0}; MoeGatherOrder S; S.ntot = 0; S.nN = 2; S.G = 0; S.c = 0; S.tile_e = (const int*)(lds + 131072); S.estride = (size_t)512 * D * 2; S.row_ts = WSP(const int*, WS_ROWTS);
            { const int tid_ = otid(); const int nt_ = *(WSP(const int*, WS_CTL) + CW_NTILES + l); for (int i = tid_; i < nt_; i += NTHR) ((int*)(lds + 131072))[i] = WSP(const int*, WS_TILEE)[i]; __syncthreads(); }
            S.bind(WSP(const int*, WS_CTL) + CW_NTILES + l, nwg, wg);
            S.ntot = (S.ntot / nwg) * nwg;
            fill_f32_table(S, WSP(const float*, WS_ROWRS), lds);
            EpiGU E{WSP(const float*, WS_ROWRS), WSP(bf16_t*, WS_HID), (const float*)(lds + TAB_OFF), TABF};
            if (STG_GU) stagger(wg, STG_GU);
            for (int rep = 0; rep < REP_GU; ++rep) pg8::gemm_phase<EpiGU, MoeGatherOrder, AL_GU, true>(ring, g, S, E); }
        PH_END;
        if (PH_ON) { PH_LOCALS
            { const int tid_ = otid(); const int nt_ = *(WSP(const int*, WS_CTL) + CW_NTILES + l); for (int i = tid_; i < nt_; i += NTHR) ((int*)(lds + 131072))[i] = WSP(const int*, WS_TILEE)[i]; __syncthreads(); }
            const int ntl = __builtin_amdgcn_readfirstlane(*(WSP(const int*, WS_CTL) + CW_NTILES + l)), mt0 = ((ntl * 2) / nwg) * (nwg / 2), ntail = ntl - mt0;
            if (wg < ntail) {
                pg8::Gemm g{HIN, (const bf16_t*)(wl + WL_GU), MAXROWS, 512, D, 0}; MoeGatherOrder S; S.nN = 2; S.G = 1; S.c = (mt0 + wg) * 2; S.ntot = S.c + 2; S.tile_e = (const int*)(lds + 131072); S.estride = (size_t)512 * D * 2; S.row_ts = WSP(const int*, WS_ROWTS);
                EpiGU E{WSP(const float*, WS_ROWRS), WSP(bf16_t*, WS_HID), (const float*)(lds + TAB_OFF), 0};
                pg8::gemm_phase<EpiGU, MoeGatherOrder, AL_GU, true>(ring, g, S, E);
                __syncthreads();
            }
            pg8::Gemm g{WSP(const bf16_t*, WS_HID), (const bf16_t*)(wl + WL_DN), MAXROWS, D, DEXP, 0}; MoeDealOrder S; S.ntot = 0; S.nN = 4; S.G = nwg; S.c = wg; S.tile_e = (const int*)(lds + 131072); S.estride = (size_t)D * DEXP * 2; S.mt0 = mt0; S.ntail = ntail; S.nD = mt0 * 4;
            fill_f32_table(S, WSP(const float*, WS_ROWW), lds);
            EpiDown E{WSP(const float*, WS_ROWW), WSP(bf16_t*, WS_Y), (const float*)(lds + TAB_OFF), TABF};
            if (STG_DOWN) stagger(wg, STG_DOWN);
            for (int rep = 0; rep < REP_DOWN; ++rep) pg8::gemm_phase<EpiDown, MoeDealOrder, AL_DOWN, true>(ring, g, S, E); }
        PH_END;
        if (PH_ON) { PH_LOCALS
            ph_combine(HIN, WSP(const bf16_t*, WS_Y), WSP(const int*, WS_RANK), WSP(float*, WS_RSTD3), wg, nwg);
            __syncthreads();
            pg8::Gemm g{WSP(const bf16_t*, WS_PB) + (size_t)l * T * PDIM, (const bf16_t*)(wl + WL_PP), T, D, PDIM, 0}; pg8::StaticOrder S; S.init(T, D, nwg, wg); EpiPlain E{WSP(bf16_t*, WS_YMIX), D, 0};
            for (int rep = 0; rep < REP_PP; ++rep) pg8::gemm_phase<EpiPlain, pg8::StaticOrder, AL_PP, true>(ring, g, S, E);
        }
        PH_END;
        if (PH_ON) { PH_LOCALS
            pg8::Gemm g{HIN, (const bf16_t*)(wl + WL_PG), T, D, D, 0}; pg8::StaticOrder S; S.init(T, D, nwg, wg); EpiPLE E{WSP(const float*, WS_RSTD3), WSP(const bf16_t*, WS_YMIX), HIN, HOUT, WSP(float*, WS_SSP)};
            if (STG_PLE) stagger(wg, STG_PLE);
            if (REP_PLE > 1) { EpiPLE E2{WSP(const float*, WS_RSTD3), WSP(const bf16_t*, WS_YMIX), HIN, WSP(bf16_t*, WS_Z), WSP(float*, WS_Z + 400 * MiB)}; for (int rep = 1; rep < REP_PLE; ++rep) pg8::gemm_phase<EpiPLE, pg8::StaticOrder, AL_PLE, true>(ring, g, S, E2); }
            pg8::gemm_phase<EpiPLE, pg8::StaticOrder, AL_PLE, true>(ring, g, S, E); }
        PH_END;
    }
    if (PH_ON) { const int l = 0; PH_LOCALS
        ph_final(WSP(const bf16_t*, (DEPTH & 1) ? WS_HBB : WS_HBA), out, WSP(const float*, WS_SSP), p.in[IN_FINALG], wg, nwg); }
#undef PH_ON
#undef PH_END
}

#ifndef REP_SB
#define REP_SB 1
#endif
#ifndef REP_ML
#define REP_ML 1
#endif
#ifndef REP_SGU
#define REP_SGU 1
#endif
#ifndef MK_SPLIT
#define MK_SPLIT 0
#endif
extern "C" void kernel_launch(void* const* d_in, const int* in_sizes, int n_in, void* d_out, int out_size, void* d_ws, size_t ws_size, hipStream_t stream) {
    static int grid = 0;
    if (grid == 0) {
        if (n_in != N_INPUTS || in_sizes[0] != T * D || out_size != T * D || ws_size < WS_END) { fprintf(stderr, "kernel_launch: unexpected shapes / workspace (%d inputs, ws %zu)\n", n_in, ws_size); grid = -1; return; }
        int dev = 0, cus = 0;
        if (hipGetDevice(&dev) != hipSuccess || hipDeviceGetAttribute(&cus, hipDeviceAttributeMultiprocessorCount, dev) != hipSuccess) { grid = -1; return; }
        if (hipFuncSetAttribute((const void*)mega, hipFuncAttributeMaxDynamicSharedMemorySize, LDS_BYTES) != hipSuccess) { grid = -1; return; }
        int per_cu = 0;
        if (hipOccupancyMaxActiveBlocksPerMultiprocessor(&per_cu, (const void*)mega, NTHR, LDS_BYTES) != hipSuccess || per_cu < 1) fprintf(stderr, "kernel_launch: occupancy query says %d\n", per_cu);
        (void)hipGetLastError();
        grid = cus;
        if (grid != 256) { fprintf(stderr, "kernel_launch: built for 256 CUs (one router unit per workgroup)\n"); grid = -1; return; }
        if (grid < 208) { fprintf(stderr, "kernel_launch: built for >= 208 CUs (LDS table of 16 units per workgroup in the input projection)\n"); grid = -1; return; }
    }
    if (grid < 0) return;
    (void)hipMemsetAsync((unsigned char*)d_ws + WS_CTL, 0, 1 * MiB, stream);
    Params p{};
    for (int i = 0; i < N_INPUTS; ++i) p.in[i] = (const float*)d_in[i];
    p.out = (float*)d_out; p.ws = (unsigned char*)d_ws;
#if MK_SPLIT
    for (int ph = 0; ph < NPHASES; ++ph) { p.ph_lo = ph; p.ph_hi = ph + 1; hipLaunchKernelGGL(mega, dim3(grid), dim3(NTHR), LDS_BYTES, stream, p); }
#else
    p.ph_lo = 0; p.ph_hi = NPHASES;
    hipLaunchKernelGGL(mega, dim3(grid), dim3(NTHR), LDS_BYTES, stream, p);
#endif
}
```

```cpp
#include <hip/hip_runtime.h>
#include <cstdio>
#include <cstdint>
namespace pg8 {
#define PG8_LAS __attribute__((address_space(3)))
typedef unsigned short bf16_t;
typedef short bf16x8 __attribute__((ext_vector_type(8)));
typedef float f32x4 __attribute__((ext_vector_type(4)));
typedef unsigned u32x4 __attribute__((ext_vector_type(4)));
constexpr int BM = 256, BK = 64, HALF = 128, HTB = HALF * BK * 2  , STAGE_BYTES = 8 * HTB, NXCD = 8, WGM = 8;

__host__ __device__ __forceinline__ int lds_byte(int r, int c) { const int st = (r >> 4) * 2 + (c >> 5), rr = r & 15, cc = c & 31, ob = rr * 64 + cc * 2; return st * 1024 + (ob ^ (((ob >> 9) & 1) << 5)); }
__host__ __device__ __forceinline__ void stage_rc(int b, int& R, int& C) { const int st = b / 1024, sb = b % 1024, swz = sb ^ (((sb >> 9) & 1) << 5); R = (st >> 1) * 16 + swz / 64; C = (st & 1) * 32 + (swz % 64) / 2; }
__host__ __device__ __forceinline__ int perm32(int rho) { const int n = rho >> 4, i = rho & 15; return 8 * (i >> 2) + 4 * n + (i & 3); }

struct Unit { int pm, pn, ord; };
struct Gemm { const bf16_t* A; const bf16_t* Bt; int M, N, K, pad; };

struct StaticOrder {
    static constexpr bool GATHER = false;
    int nM, nN, nwg, G, c;
    __host__ __device__ __forceinline__ void init(int M, int N, int G_, int c_) { nM = M / BM; nN = N / BM; nwg = nM * nN; G = G_; c = c_; }
    __host__ __device__ __forceinline__ bool next(int i, Unit& u) const {
        const long L = (long)i * G + c; if (L >= nwg) return false;
        int wgid = (int)L; { const int q = nwg / NXCD, r = nwg % NXCD, xcd = wgid % NXCD, off = wgid / NXCD; wgid = (xcd < r ? xcd * (q + 1) : r * (q + 1) + (xcd - r) * q) + off; }
        const int nig = WGM * nN, gid = wgid / nig, fm = gid * WGM, gsz = (nM - fm) < WGM ? (nM - fm) : WGM;
        u.pm = fm + ((wgid % nig) % gsz); u.pn = (wgid % nig) / gsz; return true;
    }
    __device__ __forceinline__ size_t bbase(const Unit& u, size_t tstep) const { return (size_t)u.pn * tstep; }
    __device__ __forceinline__ int arow(const Unit&, int) const { return 0; }
    __device__ __forceinline__ void a_ready(const Unit&) const {}
    __device__ __forceinline__ void done(const Unit&) const {}
};

__device__ __forceinline__ unsigned cvt_pk_bf16(float lo, float hi) { unsigned r; asm volatile("v_cvt_pk_bf16_f32 %0, %1, %2" : "=v"(r) : "v"(lo), "v"(hi)); return r; }
typedef float f32x2 __attribute__((ext_vector_type(2)));
template <class Epi, class Sched, bool ALIGN_EPI = false, bool SP2 = false>
__device__ __forceinline__ void gemm_phase(PG8_LAS unsigned char* lds, const Gemm g, const Sched& S, const Epi& E) {
    int tid_ = threadIdx.x; asm volatile("" : "+v"(tid_));
    const int tid = tid_, wid = __builtin_amdgcn_readfirstlane(tid >> 6), lane = tid & 63, wr = wid >> 2, wc = wid & 3, fr = lane & 15, fq = lane >> 4;
    int K_ = g.K; asm volatile("" : "+s"(K_));
    const int K = K_, nt = K / BK;
    unsigned voffA[2], voffB[2]; int gR[2], gC[2]; unsigned va[2][2], vnx[2][2];
#pragma unroll
    for (int i = 0; i < 2; ++i) { int R, C; stage_rc(tid * 16 + i * 8192, R, C); const int Rb = Epi::PERM ? ((R & ~31) + perm32(R & 31)) : R;
        voffA[i] = (unsigned)(R * K + C) * 2u; voffB[i] = (unsigned)(Rb * K + C) * 2u; gR[i] = R; gC[i] = C; }
    const size_t kstep = (size_t)(BK * 2);
    const size_t hstep = (size_t)HALF * K * 2;
    const size_t tstep = 2 * hstep;
    const unsigned ldsw = (unsigned)wid * 1024u;
    const int aoff = lds_byte(wr * 64 + fr, fq * 8), boff = lds_byte(wc * 32 + fr, fq * 8);
#define PG8_SA(b, h) (((b) * 2 + (h)) * HTB)
#define PG8_SB(b, h) ((4 + (b) * 2 + (h)) * HTB)
#define PG8_STAGE(bufoff, gbase, voff) do { _Pragma("unroll") for (int _i = 0; _i < 2; ++_i) \
        __builtin_amdgcn_global_load_lds((const unsigned*)((const char*)(gbase) + (voff)[_i]), (PG8_LAS unsigned*)(lds + (bufoff) + ldsw + _i * 8192), 16, 0, 0); } while (0)
#define PG8_STAGE_A(bufoff, kptr, h, nx) do { if constexpr (Sched::GATHER) { const unsigned o_[2] = {(nx) ? vnx[h][0] : va[h][0], (nx) ? vnx[h][1] : va[h][1]}; PG8_STAGE(bufoff, kptr, o_); } \
        else { PG8_STAGE(bufoff, (kptr) + (h) * hstep, voffA); } } while (0)
#define PG8_GOFF(dst, u) do { _Pragma("unroll") for (int h_ = 0; h_ < 2; ++h_) _Pragma("unroll") for (int i_ = 0; i_ < 2; ++i_) dst[h_][i_] = (unsigned)S.arow(u, h_ * HALF + gR[i_]) * (unsigned)(K * 2) + (unsigned)(gC[i_] * 2); } while (0)
#define PG8_LDA(dst, b, h) do { _Pragma("unroll") for (int m = 0; m < 4; ++m) _Pragma("unroll") for (int k = 0; k < 2; ++k) dst[m][k] = *(const PG8_LAS bf16x8*)(lds + PG8_SA(b, h) + aoff + m * 2048 + k * 1024); } while (0)
#define PG8_LDB(dst, b, h) do { _Pragma("unroll") for (int n = 0; n < 2; ++n) _Pragma("unroll") for (int k = 0; k < 2; ++k) dst[n][k] = *(const PG8_LAS bf16x8*)(lds + PG8_SB(b, h) + boff + n * 2048 + k * 1024); } while (0)
#define PG8_MMA(ai, bj, At, Bt) do { __builtin_amdgcn_s_setprio(1); _Pragma("unroll") for (int m = 0; m < 4; ++m) _Pragma("unroll") for (int n = 0; n < 2; ++n) _Pragma("unroll") for (int k = 0; k < 2; ++k) \
        acc[ai][bj][m][n] = __builtin_amdgcn_mfma_f32_16x16x32_bf16(Bt[n][k], At[m][k], acc[ai][bj][m][n], 0, 0, 0); __builtin_amdgcn_s_setprio(0); } while (0)
#define PG8_WAIT_V(n) asm volatile("s_waitcnt vmcnt(" #n ")" ::: "memory")
#define PG8_WAIT_L(n) asm volatile("s_waitcnt lgkmcnt(" #n ")" ::: "memory")
#define PG8_BAR __builtin_amdgcn_s_barrier()
#define PG8_SCHED __builtin_amdgcn_sched_barrier(0)
    Unit cur, nxt; int ui = 0;
    if (!S.next(0, cur)) return;
    cur.ord = 0;
    f32x4 acc[2][2][4][2];
#pragma unroll
    for (int a = 0; a < 2; ++a)
#pragma unroll
        for (int b = 0; b < 2; ++b)
#pragma unroll
            for (int m = 0; m < 4; ++m)
#pragma unroll
                for (int n = 0; n < 2; ++n) acc[a][b][m][n] = (f32x4){0.f, 0.f, 0.f, 0.f};
    bf16x8 At[4][2], B0[2][2], B1[2][2];
    static_assert(!Sched::GATHER || SP2, "the gathered A operand is wired into the SP2 loop only");
    const char* cA = (const char*)g.A + (Sched::GATHER ? (size_t)0 : (size_t)cur.pm * tstep); const char* cB = (const char*)g.Bt + S.bbase(cur, tstep);
    if constexpr (Sched::GATHER) { PG8_GOFF(va, cur); _Pragma("unroll") for (int h_ = 0; h_ < 2; ++h_) _Pragma("unroll") for (int i_ = 0; i_ < 2; ++i_) vnx[h_][i_] = va[h_][i_]; }
    S.a_ready(cur);
    if constexpr (SP2) {
        PG8_STAGE(PG8_SB(0, 0), cB, voffB); PG8_STAGE(PG8_SB(0, 1), cB + hstep, voffB); PG8_STAGE_A(PG8_SA(0, 0), cA, 0, false); PG8_STAGE_A(PG8_SA(0, 1), cA, 1, false);
        if (wr == 1) PG8_BAR;
        PG8_WAIT_V(2); PG8_BAR;
        PG8_STAGE(PG8_SB(1, 0), cB + kstep, voffB); PG8_STAGE_A(PG8_SA(1, 0), cA + kstep, 0, false); PG8_STAGE(PG8_SB(1, 1), cB + hstep + kstep, voffB);
        PG8_WAIT_V(6); PG8_BAR;
    } else {
        PG8_STAGE(PG8_SB(0, 0), cB, voffB); PG8_STAGE(PG8_SA(0, 0), cA, voffA); PG8_STAGE(PG8_SB(0, 1), cB + hstep, voffB); PG8_STAGE(PG8_SA(0, 1), cA + hstep, voffA);
        if (wr == 1) PG8_BAR;
        PG8_WAIT_V(4); PG8_BAR;
        PG8_STAGE(PG8_SB(1, 0), cB + kstep, voffB); PG8_STAGE(PG8_SA(1, 0), cA + kstep, voffA); PG8_STAGE(PG8_SB(1, 1), cB + hstep + kstep, voffB);
        PG8_WAIT_V(6); PG8_BAR;
    }
    for (;;) {
        const bool has_next = S.next(ui + 1, nxt); nxt.ord = ui + 1;
        if constexpr (Sched::GATHER) { if (has_next) PG8_GOFF(vnx, nxt); }
        const char* nA = (has_next && !Sched::GATHER) ? (const char*)g.A + (size_t)nxt.pm * tstep : cA; const char* nB = has_next ? (const char*)g.Bt + S.bbase(nxt, tstep) : cB;
        for (int t = 0; t < nt; t += 2) {
            const bool last = (t == nt - 2); const bool lastnx = last && has_next; (void)lastnx;
            const char* a1 = cA + (size_t)(t + 1) * kstep;
            const char* a2 = last ? nA : cA + (size_t)(t + 2) * kstep; const char* b2 = last ? nB : cB + (size_t)(t + 2) * kstep;
            const char* a3 = a2 + kstep; const char* b3 = b2 + kstep;
            if (last && has_next) S.a_ready(nxt);
            if constexpr (SP2) {
            PG8_LDB(B0, 0, 0); PG8_LDB(B1, 0, 1); PG8_SCHED; PG8_LDA(At, 0, 0); PG8_STAGE_A(PG8_SA(1, 1), a1, 1, false);
            PG8_WAIT_V(8); PG8_WAIT_L(0); PG8_BAR; PG8_MMA(0, 0, At, B0); PG8_MMA(0, 1, At, B1); PG8_BAR; PG8_SCHED;
            PG8_LDA(At, 0, 1); PG8_STAGE(PG8_SB(0, 0), b2, voffB); PG8_STAGE(PG8_SB(0, 1), b2 + hstep, voffB); PG8_STAGE_A(PG8_SA(0, 0), a2, 0, lastnx);
            PG8_WAIT_V(8); PG8_WAIT_L(0); PG8_BAR; PG8_MMA(1, 0, At, B0); PG8_MMA(1, 1, At, B1); PG8_BAR; PG8_SCHED;
            PG8_LDB(B0, 1, 0); PG8_LDB(B1, 1, 1); PG8_SCHED; PG8_LDA(At, 1, 0); PG8_STAGE_A(PG8_SA(0, 1), a2, 1, lastnx);
            PG8_WAIT_V(8); PG8_WAIT_L(0); PG8_BAR; PG8_MMA(0, 0, At, B0); PG8_MMA(0, 1, At, B1); PG8_BAR; PG8_SCHED;
            PG8_LDA(At, 1, 1); PG8_STAGE(PG8_SB(1, 0), b3, voffB); PG8_STAGE(PG8_SB(1, 1), b3 + hstep, voffB); PG8_STAGE_A(PG8_SA(1, 0), a3, 0, lastnx);
            PG8_WAIT_V(8); PG8_WAIT_L(0); PG8_BAR; PG8_MMA(1, 0, At, B0); PG8_MMA(1, 1, At, B1); PG8_BAR; PG8_SCHED;
            } else {
            PG8_LDB(B0, 0, 0); PG8_SCHED; PG8_LDA(At, 0, 0); PG8_STAGE(PG8_SA(1, 1), a1 + hstep, voffA);
            PG8_WAIT_L(8); PG8_BAR; PG8_WAIT_L(0); PG8_MMA(0, 0, At, B0); PG8_BAR; PG8_SCHED;
            PG8_LDB(B1, 0, 1); PG8_STAGE(PG8_SB(0, 0), b2, voffB);
            PG8_BAR; PG8_WAIT_L(0); PG8_MMA(0, 1, At, B1); PG8_BAR;
            PG8_LDA(At, 0, 1); PG8_STAGE(PG8_SA(0, 0), a2, voffA);
            PG8_BAR; PG8_WAIT_L(0); PG8_MMA(1, 0, At, B0); PG8_BAR; PG8_SCHED;
            PG8_STAGE(PG8_SB(0, 1), b2 + hstep, voffB);
            PG8_WAIT_V(6); PG8_BAR; PG8_MMA(1, 1, At, B1); PG8_BAR;
            PG8_LDB(B0, 1, 0); PG8_SCHED; PG8_LDA(At, 1, 0); PG8_STAGE(PG8_SA(0, 1), a2 + hstep, voffA);
            PG8_WAIT_L(8); PG8_BAR; PG8_WAIT_L(0); PG8_MMA(0, 0, At, B0); PG8_BAR; PG8_SCHED;
            PG8_LDB(B1, 1, 1); PG8_STAGE(PG8_SB(1, 0), b3, voffB);
            PG8_BAR; PG8_WAIT_L(0); PG8_MMA(0, 1, At, B1); PG8_BAR;
            PG8_LDA(At, 1, 1); PG8_STAGE(PG8_SA(1, 0), a3, voffA);
            PG8_BAR; PG8_WAIT_L(0); PG8_MMA(1, 0, At, B0); PG8_BAR; PG8_SCHED;
            PG8_STAGE(PG8_SB(1, 1), b3 + hstep, voffB);
            PG8_WAIT_V(6); PG8_BAR; PG8_MMA(1, 1, At, B1); PG8_BAR;
            }
        }
        if constexpr (ALIGN_EPI) { if (wr == 0) PG8_BAR; }
        if constexpr (!Epi::AFTER_DRAIN) { E(acc, cur, wr, wc, fr, fq); S.done(cur); }
        if (!has_next) break;
#pragma unroll
        for (int a = 0; a < 2; ++a)
#pragma unroll
            for (int b = 0; b < 2; ++b)
#pragma unroll
                for (int m = 0; m < 4; ++m)
#pragma unroll
                    for (int n = 0; n < 2; ++n) acc[a][b][m][n] = (f32x4){0.f, 0.f, 0.f, 0.f};
        cur = nxt; cA = nA; cB = nB; ++ui;
        if constexpr (Sched::GATHER) { _Pragma("unroll") for (int h_ = 0; h_ < 2; ++h_) _Pragma("unroll") for (int i_ = 0; i_ < 2; ++i_) va[h_][i_] = vnx[h_][i_]; }
        if constexpr (ALIGN_EPI) { if (wr == 1) PG8_BAR; }
    }
    PG8_WAIT_V(0);
    if constexpr (!ALIGN_EPI) { if (wr == 0) PG8_BAR; }
    PG8_BAR;
    if constexpr (Epi::AFTER_DRAIN) { E.fused(acc, cur, wr, wc, fr, fq, lds, wid, lane); S.done(cur); }
#undef PG8_SA
#undef PG8_SB
#undef PG8_STAGE
#undef PG8_STAGE_A
#undef PG8_GOFF
#undef PG8_LDA
#undef PG8_LDB
#undef PG8_MMA
#undef PG8_WAIT_V
#undef PG8_WAIT_L
#undef PG8_BAR
#undef PG8_SCHED
}
}

#define DEVI __device__ __forceinline__
typedef unsigned short bf16_t;
typedef float f32x4 __attribute__((ext_vector_type(4)));
typedef unsigned u32x4 __attribute__((ext_vector_type(4)));
typedef unsigned u32x2 __attribute__((ext_vector_type(2)));

constexpr int T = 65536, D = 1024, SEQ = 2048, NB = 32, DEPTH = 2;
constexpr int NZ = 3328;
constexpr int ZQA = 0, ZKA = 384, ZVA = 768, ZIF = 1152, ZQB = 1280, ZKB = 1664, ZVB = 2048, ZOB = 2432, ZUC = 2816, ZVC = 3072;
constexpr int NEXP = 32, DEXP = 256, PDIM = 256;
constexpr int MAXROWS = 2 * T + NEXP * 256;
constexpr float EPS = 1e-6f;

constexpr size_t MiB = 1u << 20;
constexpr size_t WS_CTL = 0;
constexpr size_t WS_GATES = 1 * MiB;
constexpr size_t WS_SSP = 3 * MiB;
constexpr size_t WS_TOKE = 7 * MiB;
constexpr size_t WS_TOKW = 7 * MiB + 512 * 1024;
constexpr size_t WS_RSTD2 = 8 * MiB;
constexpr size_t WS_RSTD3 = 8 * MiB + 256 * 1024;
constexpr size_t WS_RANK = 8 * MiB + 512 * 1024;
constexpr size_t WS_ROWTS = 9 * MiB;
constexpr size_t WS_ROWW = 10 * MiB;
constexpr size_t WS_ROWRS = 11 * MiB + 64 * 1024;
constexpr size_t WS_TILEE = 11 * MiB;
constexpr size_t WS_PSTART = 11 * MiB + 4096;
constexpr size_t WS_WR = 12 * MiB;
constexpr size_t WS_WSGU = 13 * MiB;
constexpr size_t WS_WTS = 16 * MiB;
constexpr size_t WL_IN = 0, WL_OUT = 6656 * 1024, WL_GU = WL_OUT + 2 * MiB, WL_DN = WL_GU + 32 * MiB, WL_PG = WL_DN + 16 * MiB, WL_PP = WL_PG + 2 * MiB, WL_SIZE = 59 * MiB;
constexpr size_t WS_PB = 134 * MiB;
constexpr size_t WS_HBA = 198 * MiB;
constexpr size_t WS_HBB = 326 * MiB;
constexpr size_t WS_YMIX = 454 * MiB;
constexpr size_t WS_Z = 582 * MiB;
constexpr size_t WS_XS = WS_Z, WS_Y = WS_Z, WS_HID = WS_Z + 272 * MiB;
constexpr size_t WS_SSP2 = 998 * MiB;
constexpr size_t WS_END = 1002 * MiB;
static_assert(WL_PP + 512 * 1024 <= WL_SIZE, "weights map");
static_assert((size_t)MAXROWS * 1024 * 2 <= 272 * MiB && (size_t)MAXROWS * 256 * 2 <= 68 * MiB, "overlay map");
constexpr int CW_COUNT = 0;
constexpr int CW_NTILES = 64;
constexpr int TABF = 12, TAB_OFF = 131072 + 4096;

DEVI float bf2f(unsigned short b) { return __uint_as_float((unsigned)b << 16); }
typedef float f32x2_t __attribute__((ext_vector_type(2))); typedef __bf16 bf16x2_t __attribute__((ext_vector_type(2)));
DEVI unsigned pk2(float lo, float hi) { const f32x2_t v = {lo, hi}; return __builtin_bit_cast(unsigned, __builtin_convertvector(v, bf16x2_t)); }
DEVI unsigned f2bf(float f) { return pk2(f, 0.f) & 0xffffu; }
DEVI float wave_sum(float v) {
#pragma unroll
    for (int o = 1; o < 64; o <<= 1) v += __shfl_xor(v, o);
    return v;
}
DEVI float sigmoidf_(float x) { return 1.0f / (1.0f + __expf(-x)); }
DEVI float siluf_(float x) { return x * sigmoidf_(x); }
DEVI float gelu_tanh(float x) { const float u = 0.7978845608028654f * (x + 0.044715f * x * x * x); return 0.5f * x * (1.0f + tanhf(u)); }
DEVI float softplusf_(float x) { return fmaxf(x, 0.f) + log1pf(__expf(-fabsf(x))); }

using pg8::Unit;
struct EpiZ {
    static constexpr bool PERM = true, AFTER_DRAIN = false;
    bf16_t* Z; const float* rtab; float* gates;
    const float* cin; bf16_t* cout; int G, c;
    static constexpr int CVT_NCH = DEPTH * T * PDIM / 8, CVT_CPU = (CVT_NCH + 13 * 256 - 1) / (13 * 256);
    DEVI void operator()(const f32x4 (&acc)[2][2][4][2], const Unit& u, int wr, int wc, int fr, int fq) const {
        int row0 = u.pm * 256 + wr * 64 + fr, col0 = u.pn * 256 + wc * 32 + 8 * fq; asm volatile("" : "+v"(row0), "+v"(col0));
        const float* rt = rtab + u.ord * 256 + wr * 64 + fr;
        f32x4 cv[3][2]; int cch[3];
        if (cin != nullptr) { int t_ = (wr * 4 + wc) * 64 + fq * 16 + fr; asm volatile("" : "+v"(t_)); const int ch0 = (u.ord * G + c) * CVT_CPU;
#pragma unroll
            for (int k = 0; k < 3; ++k) { const int o_ = t_ + 512 * k; cch[k] = (o_ < CVT_CPU && ch0 + o_ < CVT_NCH) ? ch0 + o_ : -1;
                if (cch[k] >= 0) { cv[k][0] = ((const f32x4*)cin)[2 * (size_t)cch[k]]; cv[k][1] = ((const f32x4*)cin)[2 * (size_t)cch[k] + 1]; } } }
#pragma unroll
        for (int ai = 0; ai < 2; ++ai)
#pragma unroll
            for (int m = 0; m < 4; ++m) {
                const int row = row0 + ai * 128 + m * 16;
                const float rs = rt[ai * 128 + m * 16];
                bf16_t* rowp = Z + (size_t)row * NZ + col0;
#pragma unroll
                for (int bj = 0; bj < 2; ++bj) {
                    const float sc = (u.pn == 0 || (u.pn == 1 && bj == 0)) ? rs * (0.125f * 1.4426950408889634f) : rs;
                    const f32x4 v0 = acc[ai][bj][m][0] * sc, v1 = acc[ai][bj][m][1] * sc;
                    u32x4 w; w.x = pk2(v0[0], v0[1]); w.y = pk2(v0[2], v0[3]); w.z = pk2(v1[0], v1[1]); w.w = pk2(v1[2], v1[3]);
                    *(u32x4*)(rowp + bj * 128) = w;
                    if (bj == 1 && u.pn == 4 && wc == 0 && fq == 0) { *(f32x4*)(gates + (size_t)row * 8) = v0; *(f32x4*)(gates + (size_t)row * 8 + 4) = v1; }
                }
            }
        if (cin != nullptr) {
#pragma unroll
            for (int k = 0; k < 3; ++k) if (cch[k] >= 0) { u32x4 w; w.x = pk2(cv[k][0][0], cv[k][0][1]); w.y = pk2(cv[k][0][2], cv[k][0][3]); w.z = pk2(cv[k][1][0], cv[k][1][1]); w.w = pk2(cv[k][1][2], cv[k][1][3]); ((u32x4*)cout)[cch[k]] = w; } }
    }
};
DEVI void unpack8(const u32x4 w, float (&f)[8]) { f[0] = __uint_as_float(w.x << 16); f[1] = __uint_as_float(w.x & 0xffff0000u); f[2] = __uint_as_float(w.y << 16); f[3] = __uint_as_float(w.y & 0xffff0000u);
    f[4] = __uint_as_float(w.z << 16); f[5] = __uint_as_float(w.z & 0xffff0000u); f[6] = __uint_as_float(w.w << 16); f[7] = __uint_as_float(w.w & 0xffff0000u); }
struct EpiResid {
    static constexpr bool PERM = true, AFTER_DRAIN = false;
    const bf16_t* hin; bf16_t* hout; float* ssp;
    DEVI void operator()(const f32x4 (&acc)[2][2][4][2], const Unit& u, int wr, int wc, int fr, int fq) const {
        int row0 = u.pm * 256 + wr * 64 + fr, col0 = u.pn * 256 + wc * 32 + 8 * fq; asm volatile("" : "+v"(row0), "+v"(col0));
#pragma unroll
        for (int ai = 0; ai < 2; ++ai) {
            u32x4 hv[4][2];
#pragma unroll
            for (int m = 0; m < 4; ++m)
#pragma unroll
                for (int bj = 0; bj < 2; ++bj) hv[m][bj] = *(const u32x4*)(hin + (size_t)(row0 + ai * 128 + m * 16) * D + col0 + bj * 128);
#pragma unroll
            for (int m = 0; m < 4; ++m) {
                const int row = row0 + ai * 128 + m * 16; const size_t off = (size_t)row * D + col0; float sacc = 0.f;
#pragma unroll
                for (int bj = 0; bj < 2; ++bj) {
                    float f[8]; unpack8(hv[m][bj], f);
                    const f32x4 v0 = acc[ai][bj][m][0], v1 = acc[ai][bj][m][1];
                    f[0] += v0[0]; f[1] += v0[1]; f[2] += v0[2]; f[3] += v0[3]; f[4] += v1[0]; f[5] += v1[1]; f[6] += v1[2]; f[7] += v1[3];
                    sacc += ((f[0] * f[0] + f[1] * f[1]) + (f[2] * f[2] + f[3] * f[3])) + ((f[4] * f[4] + f[5] * f[5]) + (f[6] * f[6] + f[7] * f[7]));
                    u32x4 w; w.x = pk2(f[0], f[1]); w.y = pk2(f[2], f[3]); w.z = pk2(f[4], f[5]); w.w = pk2(f[6], f[7]);
                    *(u32x4*)(hout + off + bj * 128) = w;
                }
                sacc += __shfl_xor(sacc, 16); sacc += __shfl_xor(sacc, 32);
                if (fq == 0) ssp[(size_t)row * 16 + u.pn * 4 + wc] = sacc;
            }
        }
    }
};
struct EpiPLE {
    static constexpr bool PERM = true, AFTER_DRAIN = false;
    const float* rstd3; const bf16_t* pp; const bf16_t* hin; bf16_t* hout; float* ssp;
    DEVI void operator()(const f32x4 (&acc)[2][2][4][2], const Unit& u, int wr, int wc, int fr, int fq) const {
        int row0 = u.pm * 256 + wr * 64 + fr, col0 = u.pn * 256 + wc * 32 + 8 * fq; asm volatile("" : "+v"(row0), "+v"(col0));
#pragma unroll
        for (int ai = 0; ai < 2; ++ai) {
            u32x4 hv[4][2], pvv[4][2]; float rsv[4];
#pragma unroll
            for (int m = 0; m < 4; ++m) { const int row = row0 + ai * 128 + m * 16; rsv[m] = rstd3[row];
#pragma unroll
                for (int bj = 0; bj < 2; ++bj) { hv[m][bj] = *(const u32x4*)(hin + (size_t)row * D + col0 + bj * 128); pvv[m][bj] = *(const u32x4*)(pp + (size_t)row * D + col0 + bj * 128); } }
#pragma unroll
            for (int m = 0; m < 4; ++m) {
                const int row = row0 + ai * 128 + m * 16; const size_t off = (size_t)row * D + col0; const float rs = rsv[m];
                float sacc = 0.f;
#pragma unroll
                for (int bj = 0; bj < 2; ++bj) {
                    float hf[8], pf[8]; unpack8(hv[m][bj], hf); unpack8(pvv[m][bj], pf);
                    float o[8];
#pragma unroll
                    for (int i = 0; i < 8; ++i) { const float a = acc[ai][bj][m][i >> 2][i & 3] * rs; o[i] = hf[i] + __builtin_amdgcn_rcpf(1.0f + __expf(-a)) * pf[i]; sacc += o[i] * o[i]; }
                    u32x4 w; w.x = pk2(o[0], o[1]); w.y = pk2(o[2], o[3]); w.z = pk2(o[4], o[5]); w.w = pk2(o[6], o[7]);
                    *(u32x4*)(hout + off + bj * 128) = w;
                }
                sacc += __shfl_xor(sacc, 16); sacc += __shfl_xor(sacc, 32);
                if (fq == 0) ssp[(size_t)row * 16 + u.pn * 4 + wc] = sacc;
            }
        }
    }
};
struct EpiGU {
    static constexpr bool PERM = true, AFTER_DRAIN = false;
    const float* row_rs; bf16_t* hid; const float* tab; int ntab;
    DEVI void operator()(const f32x4 (&acc)[2][2][4][2], const Unit& u, int wr, int wc, int fr, int fq) const {
        int row0 = u.pm * 256 + wr * 64 + fr; asm volatile("" : "+v"(row0));
        float rsv[2][4];
        { const float* tp = tab + (u.ord < ntab ? u.ord : 0) * 256 + wr * 64 + fr;
#pragma unroll
            for (int ai = 0; ai < 2; ++ai)
#pragma unroll
                for (int m = 0; m < 4; ++m) { rsv[ai][m] = tp[ai * 128 + m * 16]; asm volatile("" : "+v"(rsv[ai][m])); } }
        if (u.ord >= ntab) {
#pragma unroll
            for (int ai = 0; ai < 2; ++ai)
#pragma unroll
                for (int m = 0; m < 4; ++m) rsv[ai][m] = row_rs[row0 + ai * 128 + m * 16];
        }
#pragma unroll
        for (int ai = 0; ai < 2; ++ai)
#pragma unroll
            for (int m = 0; m < 4; ++m) {
                const int row = row0 + ai * 128 + m * 16;
                const float rs = rsv[ai][m];
                float hv[8];
#pragma unroll
                for (int n = 0; n < 2; ++n)
#pragma unroll
                    for (int i = 0; i < 4; ++i) { const float g = acc[ai][0][m][n][i] * rs, uu = acc[ai][1][m][n][i] * rs; hv[n * 4 + i] = siluf_(g) * uu; }
                u32x4 w; w.x = pk2(hv[0], hv[1]); w.y = pk2(hv[2], hv[3]); w.z = pk2(hv[4], hv[5]); w.w = pk2(hv[6], hv[7]);
                *(u32x4*)(hid + (size_t)row * DEXP + u.pn * 128 + wc * 32 + 8 * fq) = w;
            }
    }
};
struct EpiDown {
    static constexpr bool PERM = true, AFTER_DRAIN = false;
    const float* row_w; bf16_t* Y; const float* tab; int ntab;
    DEVI void operator()(const f32x4 (&acc)[2][2][4][2], const Unit& u, int wr, int wc, int fr, int fq) const {
        int row0 = u.pm * 256 + wr * 64 + fr, col0 = u.pn * 256 + wc * 32 + 8 * fq; asm volatile("" : "+v"(row0), "+v"(col0));
        float wv[2][4];
        { const float* tp = tab + (u.ord < ntab ? u.ord : 0) * 256 + wr * 64 + fr;
#pragma unroll
            for (int ai = 0; ai < 2; ++ai)
#pragma unroll
                for (int m = 0; m < 4; ++m) { wv[ai][m] = tp[ai * 128 + m * 16]; asm volatile("" : "+v"(wv[ai][m])); } }
        if (u.ord >= ntab) {
#pragma unroll
            for (int ai = 0; ai < 2; ++ai)
#pragma unroll
                for (int m = 0; m < 4; ++m) wv[ai][m] = row_w[row0 + ai * 128 + m * 16];
        }
#pragma unroll
        for (int ai = 0; ai < 2; ++ai)
#pragma unroll
            for (int m = 0; m < 4; ++m) {
                const float wt = wv[ai][m];
                bf16_t* rowp = Y + (size_t)(row0 + ai * 128 + m * 16) * D + col0;
#pragma unroll
                for (int bj = 0; bj < 2; ++bj) {
                    const f32x4 v0 = acc[ai][bj][m][0] * wt, v1 = acc[ai][bj][m][1] * wt;
                    u32x4 w; w.x = pk2(v0[0], v0[1]); w.y = pk2(v0[2], v0[3]); w.z = pk2(v1[0], v1[1]); w.w = pk2(v1[2], v1[3]);
                    __builtin_nontemporal_store(w, (u32x4*)(rowp + bj * 128));
                }
            }
    }
};
struct EpiNull {
    static constexpr bool PERM = true, AFTER_DRAIN = false;
    float* sink;
    DEVI void operator()(const f32x4 (&acc)[2][2][4][2], const Unit& u, int wr, int wc, int fr, int fq) const {
        float s = 0.f;
#pragma unroll
        for (int ai = 0; ai < 2; ++ai)
#pragma unroll
            for (int bj = 0; bj < 2; ++bj)
#pragma unroll
                for (int m = 0; m < 4; ++m)
#pragma unroll
                    for (int n = 0; n < 2; ++n) s += acc[ai][bj][m][n][0];
        if (s == 1.2345e-30f) sink[0] = s;
    }
};
struct EpiRouter {
    static constexpr bool PERM = false, AFTER_DRAIN = true;
    const float* ssp; const float* rgb; const float* reb; int* tokE; float* tokW; float* rstd2; int* rank; unsigned* count;
    DEVI void fused(f32x4 (&acc)[2][2][4][2], const Unit& u, int wr, int wc, int fr, int fq, PG8_LAS unsigned char* lds, int wid, int lane) const {
        PG8_LAS float* lg = (PG8_LAS float*)lds;
        PG8_LAS int* hist = (PG8_LAS int*)(lds + 256 * 97 * 4); PG8_LAS int* wgb = hist + 32; PG8_LAS int* selE = wgb + 32; PG8_LAS int* selR = selE + 512;
        const int tid = wid * 64 + lane;
        if (tid < 32) hist[tid] = 0;
        if (wc < 3) {
#pragma unroll
            for (int ai = 0; ai < 2; ++ai)
#pragma unroll
                for (int m = 0; m < 4; ++m) { const int r = ai * 128 + wr * 64 + m * 16 + fr;
#pragma unroll
                    for (int n = 0; n < 2; ++n)
#pragma unroll
                        for (int i = 0; i < 4; ++i) lg[r * 97 + 32 * wc + 16 * n + 4 * fq + i] = acc[ai][0][m][n][i]; }
        }
        asm volatile("s_waitcnt lgkmcnt(0)" ::: "memory"); __builtin_amdgcn_s_barrier(); asm volatile("" ::: "memory");
        if (tid < 256) {
            const int t = u.pm * 256 + tid; PG8_LAS const float* l0 = lg + tid * 97;
            const f32x4* sp = (const f32x4*)(ssp + (size_t)t * 16); const f32x4 st = (sp[0] + sp[1]) + (sp[2] + sp[3]);
            const float rs = rsqrtf(((st[0] + st[1]) + (st[2] + st[3])) * (1.0f / 1024.0f) + EPS);
            float gl[4]; int gtop = 0; float gmax;
#pragma unroll
            for (int n = 0; n < 4; ++n) gl[n] = (l0[n] + l0[48 + n]) * rs + rgb[n];
            gmax = gl[0];
#pragma unroll
            for (int n = 1; n < 4; ++n) if (gl[n] > gmax) { gmax = gl[n]; gtop = n; }
            float den = 0.f;
#pragma unroll
            for (int n = 0; n < 4; ++n) den += __expf(gl[n] - gmax);
            const float gw = 1.0f / den;
            float el[8];
#pragma unroll
            for (int jj = 0; jj < 8; ++jj) el[jj] = (l0[4 + gtop * 8 + jj] + l0[52 + gtop * 8 + jj]) * rs + reb[gtop * 8 + jj];
            int i1 = 0; float v1 = el[0];
#pragma unroll
            for (int jj = 1; jj < 8; ++jj) if (el[jj] > v1) { v1 = el[jj]; i1 = jj; }
            int i2 = -1; float v2 = -INFINITY;
#pragma unroll
            for (int jj = 0; jj < 8; ++jj) if (jj != i1 && el[jj] > v2) { v2 = el[jj]; i2 = jj; }
            const float ex = __expf(v2 - v1), w1 = 1.0f / (1.0f + ex), w2 = ex * w1;
            const int e1 = gtop * 8 + i1, e2 = gtop * 8 + i2;
            tokE[t * 2] = e1; tokE[t * 2 + 1] = e2; tokW[t * 2] = w1 * gw; tokW[t * 2 + 1] = w2 * gw; rstd2[t] = rs;
            selE[tid * 2] = e1; selE[tid * 2 + 1] = e2; selR[tid * 2] = __hip_atomic_fetch_add(hist + e1, 1, __ATOMIC_RELAXED, __HIP_MEMORY_SCOPE_WORKGROUP); selR[tid * 2 + 1] = __hip_atomic_fetch_add(hist + e2, 1, __ATOMIC_RELAXED, __HIP_MEMORY_SCOPE_WORKGROUP);
        }
        asm volatile("s_waitcnt lgkmcnt(0)" ::: "memory"); __builtin_amdgcn_s_barrier(); asm volatile("" ::: "memory");
        if (tid < 32) wgb[tid] = (int)atomicAdd(count + tid, (unsigned)hist[tid]);
        asm volatile("s_waitcnt vmcnt(0) lgkmcnt(0)" ::: "memory"); __builtin_amdgcn_s_barrier(); asm volatile("" ::: "memory");
        rank[u.pm * 512 + tid] = wgb[selE[tid]] + selR[tid];
        asm volatile("s_waitcnt lgkmcnt(0)" ::: "memory"); __builtin_amdgcn_s_barrier(); asm volatile("" ::: "memory");
    }
};
struct EpiPlain {
    static constexpr bool PERM = true, AFTER_DRAIN = false;
    bf16_t* O; int ldc, pad;
    DEVI void operator()(const f32x4 (&acc)[2][2][4][2], const Unit& u, int wr, int wc, int fr, int fq) const {
        int row0 = u.pm * 256 + wr * 64 + fr, col0 = u.pn * 256 + wc * 32 + 8 * fq; asm volatile("" : "+v"(row0), "+v"(col0));
#pragma unroll
        for (int ai = 0; ai < 2; ++ai)
#pragma unroll
            for (int m = 0; m < 4; ++m) {
                bf16_t* rowp = O + (size_t)(row0 + ai * 128 + m * 16) * ldc + col0;
#pragma unroll
                for (int bj = 0; bj < 2; ++bj) {
                    const f32x4 v0 = acc[ai][bj][m][0], v1 = acc[ai][bj][m][1];
                    u32x4 w; w.x = pk2(v0[0], v0[1]); w.y = pk2(v0[2], v0[3]); w.z = pk2(v1[0], v1[1]); w.w = pk2(v1[2], v1[3]);
                    *(u32x4*)(rowp + bj * 128) = w;
                }
            }
    }
};
struct MoeOrder {
    static constexpr bool GATHER = false;
    int ntot, nN, G, c; const int* tile_e; size_t estride;
    DEVI void bind(const int* n_tiles_ptr, int G_, int c_) { ntot = __builtin_amdgcn_readfirstlane(*n_tiles_ptr) * nN; G = G_; c = c_; }
    DEVI bool next(int i, Unit& u) const { const long L = (long)i * G + c; if (L >= ntot) return false; u.pm = (int)(L / nN); u.pn = (int)(L % nN); return true; }
    DEVI size_t bbase(const Unit& u, size_t tstep) const { return (size_t)__builtin_amdgcn_readfirstlane(tile_e[u.pm]) * estride + (size_t)u.pn * tstep; }
    DEVI int arow(const Unit&, int) const { return 0; }
    DEVI void a_ready(const Unit&) const {}
    DEVI void done(const Unit&) const {}
};
struct MoeGatherOrder : MoeOrder {
    static constexpr bool GATHER = true;
    const int* row_ts;
    DEVI int arow(const Unit& u, int r) const { const int ts = row_ts[u.pm * 256 + r]; return ts >= 0 ? (ts >> 1) : 0; }
};
struct MoeDealOrder : MoeOrder {
    static constexpr int H = 8;
    int mt0, ntail, nD;
    DEVI bool next(int i, Unit& u) const {
        const int w = c;
        if (w < ntail) { if (i < 4) { u.pm = mt0 + w; u.pn = i; return true; } i -= 4; }
        const int nf = G - ntail; int d;
        if (w >= ntail && i < H) d = (w - ntail) + i * nf;
        else { const int ii = (w >= ntail) ? i - H : i, j = (w >= ntail) ? (w - ntail) : (w - ntail + G); d = H * nf + j + G * ii; }
        if (d >= nD) return false;
        u.pm = d >> 2; u.pn = d & 3; return true;
    }
};


#ifndef REP_SB
#define REP_SB 1
#endif
#ifndef REP_ML
#define REP_ML 1
#endif
#ifndef REP_SGU
#define REP_SGU 1
#endif
#ifndef REP_Z
#define REP_Z 1
#endif
#ifndef REP_PRO
#define REP_PRO 1
#endif
#ifndef REP_GATHER
#define REP_GATHER 1
#endif
#ifndef REP_GU
#define REP_GU 1
#endif
#ifndef REP_DOWN
#define REP_DOWN 1
#endif
#ifndef REP_PP
#define REP_PP 1
#endif
#ifndef REP_WOUT0
#define REP_WOUT0 1
#endif
#ifndef REP_BAR
#define REP_BAR 1
#endif
#ifndef REP_PLACE
#define REP_PLACE 1
#endif
#ifndef REP_PLE
#define REP_PLE 1
#endif
#ifndef REP_RTR
#define REP_RTR 1
#endif
#ifndef STG_Z
#define STG_Z 0
#endif
#ifndef STG_WOUT
#define STG_WOUT 0
#endif
#ifndef STG_GU
#define STG_GU 0
#endif
#ifndef STG_DOWN
#define STG_DOWN 0
#endif
#ifndef STG_PP
#define STG_PP 0
#endif
#ifndef STG_PLE
#define STG_PLE 0
#endif
#ifndef AL_Z
#define AL_Z true
#endif
#ifndef AL_WOUT
#define AL_WOUT true
#endif
#ifndef AL_GU
#define AL_GU true
#endif
#ifndef AL_DOWN
#define AL_DOWN true
#endif
#ifndef AL_PP
#define AL_PP true
#endif
#ifndef AL_PLE
#define AL_PLE true
#endif
constexpr int NTHR = 512;
constexpr int RING_BYTES = 147456;
constexpr int MISC_OFF = RING_BYTES;
constexpr int LDS_BYTES = RING_BYTES + 4096;
constexpr int CW_BAR = 4096;

#define XB_TMO      128
#define XB_XCNT(j)  (256  + 64 * (j))
#define XB_XSUB(j)  (1280 + 64 * (j))
#define XB_XGEN(j)  (2304 + 64 * (j))
#define XB_TOP      3328
#define XB_TOPGEN   3392
#define XCD_BAR_WORDS 3456
#define XB_SPIN_CAP (1u << 18)
#define LAS __attribute__((address_space(3)))

__device__ __forceinline__ unsigned xb_ld(unsigned* p)              { return __hip_atomic_load(p, __ATOMIC_RELAXED, __HIP_MEMORY_SCOPE_AGENT); }
__device__ __forceinline__ unsigned xb_add(unsigned* p, unsigned v) { return __hip_atomic_fetch_add(p, v, __ATOMIC_RELAXED, __HIP_MEMORY_SCOPE_AGENT); }
__device__ __forceinline__ unsigned xb_xcc_id() { return (unsigned)__builtin_amdgcn_s_getreg((3 << 11) | 20) & 0xFu; }
#define XB_SPIN(cond, bar) do { unsigned _sp = 0; while (cond) { __builtin_amdgcn_s_sleep(1); \
    if ((++_sp & 255u) == 0u) { if (xb_ld(&(bar)[XB_TMO])) break; if (_sp > XB_SPIN_CAP) { atomicAdd(&(bar)[XB_TMO], 1u); break; } } } } while (0)

struct XcdBarrier {
    unsigned* bar; unsigned x;
    volatile LAS unsigned* st;
};

__device__ __forceinline__ XcdBarrier xcd_barrier_post(unsigned* bar, volatile LAS unsigned* st) {
    XcdBarrier b; b.bar = bar; b.x = xb_xcc_id(); b.st = st;
    if (threadIdx.x == 0) (void)xb_add(&bar[XB_XCNT(b.x)], 1u);
    return b;
}
__device__ __forceinline__ void xcd_barrier_complete(unsigned* bar, unsigned x, unsigned& nloc, unsigned& nx) {
    const unsigned G = gridDim.x * gridDim.y * gridDim.z;
    unsigned sum, cnt, mine, sp = 0u;
    for (;;) {
        sum = 0u; cnt = 0u; mine = 0u;
#pragma unroll
        for (unsigned j = 0; j < 16; ++j) { const unsigned c = xb_ld(&bar[XB_XCNT(j)]); sum += c; cnt += (c > 0u) ? 1u : 0u; mine = (j == x) ? c : mine; }
        if (sum == G) break;
        __builtin_amdgcn_s_sleep(1);
        if ((++sp & 255u) == 0u) { if (xb_ld(&bar[XB_TMO])) break; if (sp > XB_SPIN_CAP) { atomicAdd(&bar[XB_TMO], 1u); break; } }
    }
    nloc = mine > 0u ? mine : 1u; nx = cnt > 0u ? cnt : 1u;
}

__device__ __forceinline__ void xcd_barrier(const XcdBarrier& b) {
    asm volatile("s_waitcnt vmcnt(0)" ::: "memory");
    __syncthreads();
    if (threadIdx.x == 0) {
        unsigned* bar = b.bar;
        __builtin_amdgcn_s_waitcnt(0);
        unsigned nloc = b.st[0], nx = b.st[1];
        if (nloc == 0u) { xcd_barrier_complete(bar, b.x, nloc, nx); b.st[0] = nloc; b.st[1] = nx; }
        const unsigned old = xb_add(&bar[XB_XSUB(b.x)], 1u);
        const unsigned gen = old / nloc;
        if (old + 1u == (gen + 1u) * nloc) {
            __builtin_amdgcn_fence(__ATOMIC_RELEASE, "agent");
            asm volatile("s_waitcnt vmcnt(0)" ::: "memory");
            const unsigned og = xb_add(&bar[XB_TOP], 1u);
            const unsigned tg = og / nx;
            if (og + 1u == (tg + 1u) * nx) xb_add(&bar[XB_TOPGEN], 1u);
            else XB_SPIN(xb_ld(&bar[XB_TOPGEN]) == tg, bar);
            __builtin_amdgcn_fence(__ATOMIC_ACQUIRE, "agent");
            xb_add(&bar[XB_XGEN(b.x)], 1u);
            asm volatile("s_waitcnt vmcnt(0)" ::: "memory");
        } else {
            XB_SPIN(xb_ld(&bar[XB_XGEN(b.x)]) == gen, bar);
            __builtin_amdgcn_fence(__ATOMIC_ACQUIRE, "agent");
            asm volatile("s_waitcnt vmcnt(0)" ::: "memory");
        }
    }
    __syncthreads();
}


DEVI int otid() { int t = threadIdx.x; asm volatile("" : "+v"(t)); return t; }
DEVI void stagger(int wg, unsigned ticks) { const unsigned long long t0 = __builtin_amdgcn_s_memrealtime(), d = (unsigned long long)((wg & 3) * ticks); while (__builtin_amdgcn_s_memrealtime() - t0 < d) __builtin_amdgcn_s_sleep(8); }
struct PrepJob { const float* in; const float* in2; const float* gain; bf16_t* out; int ldin, K, Nout, mode, ne, pad; size_t in_es, out_es; };
DEVI void ph_prep_w(const PrepJob& j, unsigned char* sm, int wg, int nwg) {
    const int tid = otid(), lane = tid & 63, wave = tid >> 6;
    float* scr = (float*)sm + wave * (64 * 33);
    const int nb = j.Nout / 32, kb = j.K / 64, per = nb * kb, total = per * j.ne;
    for (int it = wg * 8 + wave; it < total; it += nwg * 8) {
        const int e = it / per, r = it - e * per, k0 = (r / nb) * 64, n0 = (r % nb) * 32;
        const int n = n0 + (lane & 31); const float* src = j.in + (size_t)e * j.in_es; int col = n; bool valid = true;
        if (j.mode == 1) {
            if (n < 1152) col = n; else if (n < 1160) col = 2688 + (n - 1152); else if (n < 1280) valid = false; else if (n < 2816) col = 1152 + (n - 1280); else col = 2696 + (n - 2816);
        } else if (j.mode == 2) { const int pn = n >> 8, bj = (n >> 7) & 1; col = pn * 128 + (n & 127); if (bj) src = j.in2 + (size_t)e * j.in_es; }
        const float* sp = src + (size_t)(k0 + (lane >> 5)) * j.ldin + col; const float* gp = j.gain ? j.gain + k0 + (lane >> 5) : nullptr;
        float vv[32];
#pragma unroll
        for (int i = 0; i < 32; ++i) vv[i] = valid ? sp[(size_t)(2 * i) * j.ldin] : 0.f;
#pragma unroll
        for (int i = 0; i < 32; ++i) { float v = vv[i]; if (gp) v *= gp[2 * i]; scr[(2 * i + (lane >> 5)) * 33 + (lane & 31)] = v; }
        asm volatile("s_waitcnt lgkmcnt(0)" ::: "memory");
        const int c = lane & 7; bf16_t* o = j.out + (size_t)e * j.out_es;
#pragma unroll
        for (int jj = 0; jj < 4; ++jj) { const int nn = (lane >> 3) + 8 * jj; const float* q = scr + (8 * c) * 33 + nn;
            u32x4 w; w.x = pk2(q[0 * 33], q[1 * 33]); w.y = pk2(q[2 * 33], q[3 * 33]); w.z = pk2(q[4 * 33], q[5 * 33]); w.w = pk2(q[6 * 33], q[7 * 33]);
            *(u32x4*)(o + (size_t)(n0 + nn) * j.K + k0 + 8 * c) = w; }
        asm volatile("s_waitcnt lgkmcnt(0)" ::: "memory");
    }
}
DEVI void ph_prep_router(const float* rgw, const float* rew, const float* g, bf16_t* WRt, int wg, int nwg) {
    for (int idx = wg * NTHR + otid(); idx < 256 * 1024; idx += nwg * NTHR) { const int r = idx / 1024, k = idx % 1024, n = r < 48 ? r : r - 48;
        float w = (r < 96 && n < 36) ? g[k] * (n < 4 ? rgw[k * 4 + n] : rew[k * 32 + (n - 4)]) : 0.f;
        const unsigned hb = f2bf(w); WRt[idx] = (bf16_t)(r < 48 ? hb : f2bf(w - __uint_as_float(hb << 16))); }
}
DEVI void ph_prep_x(const float* x, bf16_t* hb, float* ssp, int wg, int nwg) {
    const int tid = otid(), lane = tid & 63, gw = wg * 8 + (tid >> 6), ngw = nwg * 8;
    for (int row = 2 * gw; row < T; row += 2 * ngw) {
        f32x4 v[2][4];
#pragma unroll
        for (int r = 0; r < 2; ++r)
#pragma unroll
            for (int jj = 0; jj < 4; ++jj) v[r][jj] = ((const f32x4*)(x + (size_t)(row + r) * D) + lane)[64 * jj];
#pragma unroll
        for (int r = 0; r < 2; ++r) { float s = 0.f; u32x2* o = (u32x2*)(hb + (size_t)(row + r) * D) + lane;
#pragma unroll
            for (int jj = 0; jj < 4; ++jj) { const f32x4 a = v[r][jj]; s += (a[0] * a[0] + a[1] * a[1]) + (a[2] * a[2] + a[3] * a[3]); u32x2 w; w.x = pk2(a[0], a[1]); w.y = pk2(a[2], a[3]); o[64 * jj] = w; }
            s = wave_sum(s);
            if (lane < 16) ssp[(size_t)(row + r) * 16 + lane] = lane == 0 ? s : 0.f; }
    }
}
DEVI void ph_cvt_bf16(const float* in, bf16_t* out, size_t n4, int wg, int nwg) {
    const size_t stride = (size_t)nwg * NTHR;
    for (size_t i0 = (size_t)wg * NTHR + otid(); i0 < n4; i0 += 8 * stride) {
        f32x4 v[8];
#pragma unroll
        for (int k = 0; k < 8; ++k) { const size_t i = i0 + k * stride; v[k] = i < n4 ? ((const f32x4*)in)[i] : (f32x4){0.f, 0.f, 0.f, 0.f}; }
#pragma unroll
        for (int k = 0; k < 8; ++k) { const size_t i = i0 + k * stride; if (i < n4) { u32x2 w; w.x = pk2(v[k][0], v[k][1]); w.y = pk2(v[k][2], v[k][3]); ((u32x2*)out)[i] = w; } }
    }
}

namespace sb {
typedef short bf16x8 __attribute__((ext_vector_type(8)));
typedef short s16x4 __attribute__((ext_vector_type(4)));
typedef float f32x16 __attribute__((ext_vector_type(16)));
constexpr float QSCALE = 0.125f * 1.4426950408889634f;
constexpr int WAVE_LDS = 12288;
DEVI int crow(int r, int hi) { return (r & 3) + 8 * (r >> 2) + 4 * hi; }
DEVI void glds16(const void* gsrc, unsigned lds_dst) { unsigned keep;
    asm volatile("s_mov_b32 %0, m0\n\ts_mov_b32 m0, %2\n\ts_nop 0\n\tglobal_load_lds_dwordx4 %1, off\n\ts_mov_b32 m0, %0" : "=&s"(keep) : "v"(gsrc), "s"(lds_dst) : "memory"); }
DEVI unsigned cvtpk(float lo, float hi) { unsigned r; asm("v_cvt_pk_bf16_f32 %0, %1, %2" : "=v"(r) : "v"(lo), "v"(hi)); return r; }
DEVI void pv(f32x16* o, int vb, bf16x8 pa0, bf16x8 pa1, bf16x8 pa2, bf16x8 pa3) {
#pragma unroll
    for (int d0 = 0; d0 < 2; ++d0) { s16x4 lo[4], hi[4];
#pragma unroll
        for (int ks = 0; ks < 4; ++ks) {
            asm volatile("ds_read_b64_tr_b16 %0,%1 offset:%c2" : "=&v"(lo[ks]) : "v"(vb), "i"(d0 * 4096 + ks * 1024) : "memory");
            asm volatile("ds_read_b64_tr_b16 %0,%1 offset:%c2" : "=&v"(hi[ks]) : "v"(vb), "i"(d0 * 4096 + ks * 1024 + 512) : "memory"); }
        asm volatile("s_waitcnt lgkmcnt(0)" ::: "memory"); __builtin_amdgcn_sched_barrier(0);
#define SB_PK(k) (bf16x8){lo[k][0], lo[k][1], lo[k][2], lo[k][3], hi[k][0], hi[k][1], hi[k][2], hi[k][3]}
        o[d0] = __builtin_amdgcn_mfma_f32_32x32x16_bf16(pa0, SB_PK(0), o[d0], 0, 0, 0);
        o[d0] = __builtin_amdgcn_mfma_f32_32x32x16_bf16(pa1, SB_PK(1), o[d0], 0, 0, 0);
        o[d0] = __builtin_amdgcn_mfma_f32_32x32x16_bf16(pa2, SB_PK(2), o[d0], 0, 0, 0);
        o[d0] = __builtin_amdgcn_mfma_f32_32x32x16_bf16(pa3, SB_PK(3), o[d0], 0, 0, 0);
#undef SB_PK
    }
}
}
DEVI void ph_sb(const bf16_t* Z, const float* og, bf16_t* Ymix, unsigned char* smb, int wg, int nwg) {
    using namespace sb;
    const int tid = otid(), lane = tid & 63, wave = __builtin_amdgcn_readfirstlane(tid >> 6), r32 = lane & 31, hi = lane >> 5;
    unsigned char* vt = smb + wave * 16384;
    const unsigned vt_lds = (unsigned)(uintptr_t)vt;
    const int vbl = ((lane >> 4) & 1) * 32 + (lane & 3) * 8 + (4 * hi + ((lane & 15) >> 2)) * 64;
    const unsigned vK0 = (unsigned)(r32 * NZ + ZKA + hi * 8) * 2u, vK1 = vK0 + 32u * NZ * 2u, vV = (unsigned)((lane >> 2) * NZ + ZVA + (lane & 3) * 8) * 2u, vQ = (unsigned)(r32 * NZ + ZQA + hi * 8) * 2u;
#define SB_TILE(hh, jj) ((const char*)Z + ((size_t)(bbase + (jj) * 64) * NZ + (hh) * 64) * 2)
#define SB_LOADK(dst, hh, jj) do { const char* kb_ = SB_TILE(hh, jj); _Pragma("unroll") for (int d0 = 0; d0 < 4; ++d0) { dst[2 * d0] = *(const bf16x8*)(kb_ + vK0 + d0 * 32); dst[2 * d0 + 1] = *(const bf16x8*)(kb_ + vK1 + d0 * 32); } } while (0)
#define SB_DMAV(buf, hh, jj) do { const char* kb_ = SB_TILE(hh, jj); _Pragma("unroll") for (int w8 = 0; w8 < 8; ++w8) \
        glds16(kb_ + ((size_t)(16 * (w8 & 3)) * NZ + (w8 >> 2) * 32) * 2 + vV, (unsigned)__builtin_amdgcn_readfirstlane(vt_lds + (buf) * 8192 + w8 * 1024)); } while (0)
#define SB_LOADQ(dst, hh) do { const char* qp_ = (const char*)Z + ((size_t)row0 * NZ + (hh) * 64) * 2 + vQ; _Pragma("unroll") for (int d0 = 0; d0 < 4; ++d0) dst[d0] = *(const bf16x8*)(qp_ + d0 * 32); } while (0)
    for (int wu = wg * 8 + wave; wu < T / 32; wu += nwg * 8) {
        const int row0 = wu * 32, bbase = (row0 / SEQ) * SEQ, t0 = row0 - bbase, tq = t0 + r32, jt0 = t0 >> 6;
        float ssq[4] = {0.f, 0.f, 0.f, 0.f};
        int cb = 0, pf = 0;
        bf16x8 kf[8], qr[4];
        asm volatile("s_waitcnt lgkmcnt(0)" ::: "memory");
        SB_DMAV(0, 0, jt0); SB_LOADK(kf, 0, jt0); SB_LOADQ(qr, 0);
#pragma unroll 1
        for (int h = 0; h < 6; ++h) {
            f32x16 o[2]; o[0] = f32x16{}; o[1] = f32x16{};
            float carry = 1.f; bool diag = true;
#pragma unroll 1
            for (int jt = jt0; ; --jt) {
                const int kv0 = jt * 64;
                f32x16 p0 = __builtin_amdgcn_mfma_f32_32x32x16_bf16(kf[0], qr[0], f32x16{}, 0, 0, 0), p1 = __builtin_amdgcn_mfma_f32_32x32x16_bf16(kf[1], qr[0], f32x16{}, 0, 0, 0);
#pragma unroll
                for (int d0 = 1; d0 < 4; ++d0) { p0 = __builtin_amdgcn_mfma_f32_32x32x16_bf16(kf[2 * d0], qr[d0], p0, 0, 0, 0); p1 = __builtin_amdgcn_mfma_f32_32x32x16_bf16(kf[2 * d0 + 1], qr[d0], p1, 0, 0, 0); }
                if (diag && jt > 0) { SB_DMAV(cb ^ 1, h, jt - 1); SB_LOADK(kf, h, jt - 1); pf = 1; }
                else if (h + 1 < 6) { SB_DMAV(cb ^ 1, h + 1, jt0); SB_LOADK(kf, h + 1, jt0); pf = 2; }
                else pf = 0;
                if (diag) {
#pragma unroll
                    for (int r = 0; r < 16; ++r) { const int kv = kv0 + crow(r, hi); if (kv >= tq) p0[r] = -INFINITY; if (kv + 32 >= tq) p1[r] = -INFINITY; }
                }
                float total = 1.f; u32x4 pw0, pw1, pw2, pw3;
#define SB_HALF(P, PWA, PWB) do { f32x16 R; \
                    _Pragma("unroll") for (int r = 0; r < 16; ++r) { float c_; asm("v_min_f32 %0, %1, %2" : "=v"(c_) : "v"(P[r]), "v"(100.f)); const float e_ = __builtin_amdgcn_exp2f(c_); R[r] = __builtin_amdgcn_rcpf(1.0f + e_); P[r] = e_ * R[r]; } \
                    _Pragma("unroll") for (int g = 3; g >= 0; --g) { const float mine = (R[4 * g] * R[4 * g + 1]) * (R[4 * g + 2] * R[4 * g + 3]); const auto sw_ = __builtin_amdgcn_permlane32_swap(__float_as_uint(mine), __float_as_uint(mine), false, false); const float og_ = __uint_as_float(hi ? sw_[0] : sw_[1]);     \
                        float t = carry * (hi == 0 ? total * og_ : total); total *= mine * og_; \
                        P[4 * g + 3] *= t; t *= R[4 * g + 3]; P[4 * g + 2] *= t; t *= R[4 * g + 2]; P[4 * g + 1] *= t; t *= R[4 * g + 1]; P[4 * g] *= t; } \
                    PWA = (u32x4){cvtpk(P[0], P[1]), cvtpk(P[2], P[3]), cvtpk(P[4], P[5]), cvtpk(P[6], P[7])}; PWB = (u32x4){cvtpk(P[8], P[9]), cvtpk(P[10], P[11]), cvtpk(P[12], P[13]), cvtpk(P[14], P[15])}; } while (0)
                SB_HALF(p1, pw2, pw3);
                SB_HALF(p0, pw0, pw1);
#undef SB_HALF
                carry *= total;
                if (pf) asm volatile("s_waitcnt vmcnt(16)" ::: "memory");
                else asm volatile("s_waitcnt vmcnt(0)" ::: "memory");
                pv(o, (int)vt_lds + cb * 8192 + vbl, __builtin_bit_cast(bf16x8, pw0), __builtin_bit_cast(bf16x8, pw1), __builtin_bit_cast(bf16x8, pw2), __builtin_bit_cast(bf16x8, pw3));
                diag = false;
                if (jt == 0 || !__any(carry > 9.0949470177e-13f)) break;
                if (pf == 1) { cb ^= 1; pf = 0; }
                else { SB_DMAV(cb, h, jt - 1); SB_LOADK(kf, h, jt - 1); pf = 0; }
            }
            const bool hit = (pf == 2);
            pf = 0;
            if (h + 1 < 6) SB_LOADQ(qr, h + 1);
            bf16_t* stg = (bf16_t*)(vt + cb * 8192);
#pragma unroll
            for (int r = 0; r < 16; ++r) { const int orow = crow(r, hi); stg[orow * 64 + r32] = (bf16_t)f2bf(o[0][r]); stg[orow * 64 + 32 + r32] = (bf16_t)f2bf(o[1][r]); }
            asm volatile("s_waitcnt lgkmcnt(0)" ::: "memory");
#pragma unroll
            for (int i = 0; i < 4; ++i) { const int row = i * 8 + (lane >> 3), ch = lane & 7; const u32x4 v = *(const u32x4*)(stg + row * 64 + ch * 8);
                float a[8]; unpack8(v, a);
                ssq[i] += ((a[0] * a[0] + a[1] * a[1]) + (a[2] * a[2] + a[3] * a[3])) + ((a[4] * a[4] + a[5] * a[5]) + (a[6] * a[6] + a[7] * a[7]));
                *(u32x4*)(Ymix + (size_t)(row0 + row) * D + h * 64 + ch * 8) = v; }
            asm volatile("s_waitcnt lgkmcnt(0)" ::: "memory");
            if (h + 1 < 6) {
                if (!hit) { SB_DMAV(cb ^ 1, h + 1, jt0); SB_LOADK(kf, h + 1, jt0); }
                cb ^= 1;
            }
        }
        asm volatile("s_waitcnt vmcnt(0)" ::: "memory");
        float rs[4];
#pragma unroll
        for (int i = 0; i < 4; ++i) { float s = ssq[i]; s += __shfl_xor(s, 1); s += __shfl_xor(s, 2); s += __shfl_xor(s, 4); rs[i] = rsqrtf(s * (1.0f / 384.0f) + EPS); }
#pragma unroll 1
        for (int h = 0; h < 6; ++h) { const int ch = lane & 7; const f32x4 g0 = *(const f32x4*)(og + h * 64 + ch * 8), g1 = *(const f32x4*)(og + h * 64 + ch * 8 + 4);
#pragma unroll
            for (int i = 0; i < 4; ++i) { const int row = i * 8 + (lane >> 3); u32x4* pp = (u32x4*)(Ymix + (size_t)(row0 + row) * D + h * 64 + ch * 8); float a[8]; unpack8(*pp, a); const float r = rs[i];
                u32x4 w; w.x = pk2(a[0] * r * g0[0], a[1] * r * g0[1]); w.y = pk2(a[2] * r * g0[2], a[3] * r * g0[3]); w.z = pk2(a[4] * r * g1[0], a[5] * r * g1[1]); w.w = pk2(a[6] * r * g1[2], a[7] * r * g1[3]);
                *pp = w; } }
    }
#undef SB_TILE
#undef SB_LOADK
#undef SB_DMAV
#undef SB_LOADQ
}

namespace ml {
constexpr int QROW = 208, TROW = 144;
constexpr int O_QN = 0, O_KN = 13312, O_KWT = 26624, O_VT = 40448, O_CT = 54272, CT_BYTES = 96 * QROW, O_NV = O_CT + 2 * CT_BYTES, O_TB = O_NV + 768, O_SC = O_TB + 2 * 1280,
              O_MNG = O_SC + 64, O_CW = O_MNG + 384, O_RAW = O_CW + 5 * 192 * 4, NP_QK = 67 * 24, NP_ALL = NP_QK + 64 * 12, O_RAWV = O_RAW + NP_QK * 16, O_DUMMY = O_RAW + 40 * 1024, O_END = O_DUMMY + 1024;
static_assert(O_END <= 147456 && NP_ALL <= 40 * 64 && O_RAW % 16 == 0, "mLSTM LDS map");
typedef short bf16x8 __attribute__((ext_vector_type(8)));
}
DEVI void ph_mlstm(const bf16_t* Z, const float* gates, const float* conv_w, const float* conv_b, const float* igb, const float* fgb, const float* mng, bf16_t* Ymix,
                   unsigned char* smb, int wg, int nwg) {
    using namespace ml;
    const int tid = otid(), lane = tid & 63, wave = __builtin_amdgcn_readfirstlane(tid >> 6), l16 = lane & 15, quad = lane >> 4;
    float* NV = (float*)(smb + O_NV);
    const unsigned raw_lds = (unsigned)(uintptr_t)(smb + O_RAW);
    for (int unit = wg; unit < NB * 4; unit += nwg) {
        const int b = unit >> 2, h = unit & 3; const size_t rb = (size_t)b * SEQ;
#define ML_DMA(n1) do { const char* zb_ = (const char*)Z + ((long)rb + (long)(n1) * 64 - 3) * (NZ * 2); \
            _Pragma("unroll") for (int ins = 0; ins < 5; ++ins) if ((ins * 8 + wave) * 64 + lane < NP_ALL) sb::glds16(zb_ + doff[ins], (unsigned)__builtin_amdgcn_readfirstlane(raw_lds + (ins * 8 + wave) * 1024)); } while (0)
        unsigned doff[5];
#pragma unroll
        for (int ins = 0; ins < 5; ++ins) { const int pidx = (ins * 8 + wave) * 64 + lane;
            if (pidx < NP_QK) { const int r = pidx / 24, seg = pidx - 24 * r; doff[ins] = (unsigned)(r * NZ + (seg < 12 ? ZQB + h * 96 + 8 * seg : ZKB + h * 96 + 8 * (seg - 12))) * 2u; }
            else { const int j = pidx - NP_QK, l = j / 12, seg = j - 12 * l; doff[ins] = (unsigned)((l + 3) * NZ + ZVB + h * 96 + 8 * seg) * 2u; } }
#define ML_WARM(n2) do { if (wave >= 4) { const unsigned dl_ = (unsigned)__builtin_amdgcn_readfirstlane((unsigned)(uintptr_t)(smb + O_DUMMY)); const int wq_ = wave - 4; \
            if ((n2) < 32) { const char* rp_ = (const char*)Z + ((size_t)rb + (size_t)(n2) * 64 + lane) * (NZ * 2) + (size_t)((wq_ == 0 ? ZQB : wq_ == 1 ? ZKB : wq_ == 2 ? ZVB : ZOB) + h * 96) * 2; \
                sb::glds16(rp_, dl_); sb::glds16(rp_ + 128, dl_); } \
            if (wq_ == 3 && (n2) + 1 < 32) { const char* gp_ = (const char*)gates + ((size_t)rb + (size_t)((n2) + 1) * 64) * 32 + lane * 16; sb::glds16(gp_, dl_); sb::glds16(gp_ + 1024, dl_); } } } while (0)
#define ML_GATES(n1, ip, fp) do { float* TBn = (float*)(smb + O_TB) + ((n1) & 1) * 320; float* SCn = (float*)(smb + O_SC) + ((n1) & 1) * 4; \
            float c = -softplusf_(-(fp)); _Pragma("unroll") for (int o = 1; o < 64; o <<= 1) { const float t_ = __shfl_up(c, o); if (lane >= o) c += t_; } \
            const float btot = __shfl(c, 63), a_ = btot - c + (ip), g_ = (ip) - c; float mloc = a_; \
            _Pragma("unroll") for (int o = 32; o >= 1; o >>= 1) mloc = fmaxf(mloc, __shfl_xor(mloc, o)); \
            float pm = g_; _Pragma("unroll") for (int o = 1; o < 64; o <<= 1) { const float t_ = __shfl_up(pm, o); if (lane >= o) pm = fmaxf(pm, t_); } \
            const float mn = fmaxf(btot + mrun, mloc); \
            TBn[lane] = a_; TBn[64 + lane] = g_; TBn[128 + lane] = pm; TBn[192 + lane] = c; TBn[256 + lane] = __expf(a_ - mn); \
            if (lane == 0) { SCn[0] = mrun; SCn[1] = mn; SCn[2] = __expf(btot + mrun - mn); } mrun = mn; } while (0)
#define ML_CONVERT(n1) do { const float* WLn = (const float*)(smb + O_TB) + ((n1) & 1) * 320 + 256; \
            if (tid < 384) { const unsigned char* rw = smb + O_RAW + cc * 2; const int l0 = 16 * rseg; const bool z0 = ((n1) == 0 && rseg == 0); \
                const f32x2_t* cwp_ = (const f32x2_t*)((const float*)(smb + O_CW) + cc); const f32x2_t cw0 = cwp_[0], cw1 = cwp_[96], cw2 = cwp_[192], cw3 = cwp_[288], cbias = cwp_[384]; \
                f32x2_t x0, x1, x2; { const unsigned u0 = *(const unsigned*)(rw + (l0 + 0) * 384), u1 = *(const unsigned*)(rw + (l0 + 1) * 384), u2 = *(const unsigned*)(rw + (l0 + 2) * 384); \
                    x0 = z0 ? (f32x2_t){0.f, 0.f} : (f32x2_t){__uint_as_float(u0 << 16), __uint_as_float(u0 & 0xffff0000u)}; x1 = z0 ? (f32x2_t){0.f, 0.f} : (f32x2_t){__uint_as_float(u1 << 16), __uint_as_float(u1 & 0xffff0000u)}; \
                    x2 = z0 ? (f32x2_t){0.f, 0.f} : (f32x2_t){__uint_as_float(u2 << 16), __uint_as_float(u2 & 0xffff0000u)}; } \
                unsigned char* qk = smb + (which ? O_KN : O_QN) + cd * 2; unsigned char* kwt = smb + O_KWT + cd * TROW; \
                _Pragma("unroll 2") for (int i = 0; i < 16; i += 2) { const int l = l0 + i; \
                    const unsigned ua = *(const unsigned*)(rw + (l + 3) * 384), ub = *(const unsigned*)(rw + (l + 4) * 384); \
                    const f32x2_t xa = {__uint_as_float(ua << 16), __uint_as_float(ua & 0xffff0000u)}, xb = {__uint_as_float(ub << 16), __uint_as_float(ub & 0xffff0000u)}; \
                    f32x2_t ya = cbias + cw0 * x0 + cw1 * x1 + cw2 * x2 + cw3 * xa, yb = cbias + cw0 * x1 + cw1 * x2 + cw2 * xa + cw3 * xb; x0 = x2; x1 = xa; x2 = xb; \
                    f32x2_t oa, ob_; oa.x = ya.x * __builtin_amdgcn_rcpf(1.0f + __expf(-ya.x)); oa.y = ya.y * __builtin_amdgcn_rcpf(1.0f + __expf(-ya.y)); ob_.x = yb.x * __builtin_amdgcn_rcpf(1.0f + __expf(-yb.x)); ob_.y = yb.y * __builtin_amdgcn_rcpf(1.0f + __expf(-yb.y)); \
                    if (which) { oa = oa * 0.10206207261596575f; ob_ = ob_ * 0.10206207261596575f; const float wa = WLn[l], wb = WLn[l + 1]; \
                        *(unsigned*)(kwt + l * 2) = pk2(oa.x * wa, ob_.x * wb); *(unsigned*)(kwt + TROW + l * 2) = pk2(oa.y * wa, ob_.y * wb); } \
                    *(unsigned*)(qk + l * QROW) = pk2(oa.x, oa.y); *(unsigned*)(qk + (l + 1) * QROW) = pk2(ob_.x, ob_.y); } \
            } else { const int idx = tid - 384, lp = idx >> 2, eq = idx & 3; const u32x4* s0 = (const u32x4*)(smb + O_RAWV + (2 * lp) * 192 + eq * 48); const u32x4* s1 = (const u32x4*)(smb + O_RAWV + (2 * lp + 1) * 192 + eq * 48); \
                unsigned char* vt = smb + O_VT + (eq * 24) * TROW + lp * 4; \
                _Pragma("unroll") for (int i = 0; i < 3; ++i) { const u32x4 a = s0[i], b = s1[i]; \
                    *(unsigned*)(vt + (i * 8 + 0) * TROW) = (a.x & 0xffffu) | (b.x << 16); *(unsigned*)(vt + (i * 8 + 1) * TROW) = (a.x >> 16) | (b.x & 0xffff0000u); \
                    *(unsigned*)(vt + (i * 8 + 2) * TROW) = (a.y & 0xffffu) | (b.y << 16); *(unsigned*)(vt + (i * 8 + 3) * TROW) = (a.y >> 16) | (b.y & 0xffff0000u); \
                    *(unsigned*)(vt + (i * 8 + 4) * TROW) = (a.z & 0xffffu) | (b.z << 16); *(unsigned*)(vt + (i * 8 + 5) * TROW) = (a.z >> 16) | (b.z & 0xffff0000u); \
                    *(unsigned*)(vt + (i * 8 + 6) * TROW) = (a.w & 0xffffu) | (b.w << 16); *(unsigned*)(vt + (i * 8 + 7) * TROW) = (a.w >> 16) | (b.w & 0xffff0000u); } } } while (0)
        const int cc = tid < 384 ? 2 * (tid % 96) : 0, rseg = tid < 384 ? tid / 96 : 0, which = cc >= 96 ? 1 : 0, cd = cc - 96 * which;
        if (tid < 192) { const int w_ = tid >= 96 ? 1 : 0, ch_ = w_ * 384 + h * 96 + (tid - 96 * w_); float* cwt = (float*)(smb + O_CW);
            cwt[tid] = conv_w[ch_]; cwt[192 + tid] = conv_w[768 + ch_]; cwt[384 + tid] = conv_w[2 * 768 + ch_]; cwt[576 + tid] = conv_w[3 * 768 + ch_]; cwt[768 + tid] = conv_b[ch_]; }
        float mrun = 0.f;
        ML_DMA(0);
        for (int i = tid; i < CT_BYTES / 4; i += NTHR) ((unsigned*)(smb + O_CT))[i] = 0u;
        if (tid < 96) { NV[tid] = 0.f; ((float*)(smb + O_MNG))[tid] = mng[h * 96 + tid]; }
        if (wave == 7) { const size_t row = rb + lane; const float ip = gates[row * 8 + h] + igb[h], fp = gates[row * 8 + 4 + h] + fgb[h]; ML_GATES(0, ip, fp); }
        asm volatile("s_waitcnt vmcnt(0)" ::: "memory");
        __syncthreads();
        ML_CONVERT(0);
        __syncthreads();
        f32x4 Cst[9];
#pragma unroll
        for (int k = 0; k < 9; ++k) Cst[k] = (f32x4){0.f, 0.f, 0.f, 0.f};
#pragma unroll 1
        for (int n = 0; n < 32; ++n) {
            const int cur = n & 1, nxt = cur ^ 1; const float* SCc = (const float*)(smb + O_SC) + cur * 4; const float m_in = SCc[0], dec = SCc[2];
            const float* TBc = (const float*)(smb + O_TB) + cur * 320;
            const size_t r0 = rb + n * 64;
            if (n + 1 < 32) ML_DMA(n + 1);
            if (wave < 4) {
                const int tt = wave, t = 16 * tt + l16; const size_t row = r0 + t;
                const unsigned char* qn = smb + O_QN; const unsigned char* kn = smb + O_KN; const unsigned char* vtb = smb + O_VT; const unsigned char* ct = smb + O_CT + cur * CT_BYTES;
                bf16x8 bq[3];
#pragma unroll
                for (int ks = 0; ks < 3; ++ks) bq[ks] = *(const bf16x8*)(qn + t * QROW + (32 * ks + 8 * quad) * 2);
                const float Mt = fmaxf(m_in, TBc[128 + t]), inter = __expf(m_in - Mt), flr = __expf(-(TBc[192 + t] + Mt));
                f32x4 P[4]; float psum = 0.f;
#pragma unroll
                for (int st = 0; st < 4; ++st) { P[st] = (f32x4){0.f, 0.f, 0.f, 0.f};
                    if (st <= tt) {
#pragma unroll
                        for (int ks = 0; ks < 3; ++ks) P[st] = __builtin_amdgcn_mfma_f32_16x16x32_bf16(*(const bf16x8*)(kn + (16 * st + l16) * QROW + (32 * ks + 8 * quad) * 2), bq[ks], P[st], 0, 0, 0);
                        const f32x4 gs = *(const f32x4*)(TBc + 64 + 16 * st + 4 * quad);
#pragma unroll
                        for (int j = 0; j < 4; ++j) { const int s_ = 16 * st + 4 * quad + j; const float w = s_ <= t ? __expf(gs[j] - Mt) : 0.f; P[st][j] *= w; psum += P[st][j]; }
                    } }
                psum += __shfl_xor(psum, 16); psum += __shfl_xor(psum, 32);
                float qn_ = 0.f; { const float* nv = NV + cur * 96 + quad * 24; const unsigned char* qp = qn + t * QROW + quad * 48;
#pragma unroll
                    for (int i = 0; i < 3; ++i) { const u32x4 w = *(const u32x4*)(qp + i * 16);
                        qn_ += __uint_as_float(w.x << 16) * nv[i * 8 + 0] + __uint_as_float(w.x & 0xffff0000u) * nv[i * 8 + 1] + __uint_as_float(w.y << 16) * nv[i * 8 + 2] + __uint_as_float(w.y & 0xffff0000u) * nv[i * 8 + 3]
                             + __uint_as_float(w.z << 16) * nv[i * 8 + 4] + __uint_as_float(w.z & 0xffff0000u) * nv[i * 8 + 5] + __uint_as_float(w.w << 16) * nv[i * 8 + 6] + __uint_as_float(w.w & 0xffff0000u) * nv[i * 8 + 7]; } }
                qn_ += __shfl_xor(qn_, 16); qn_ += __shfl_xor(qn_, 32);
                float den = psum + inter * qn_; den = fmaxf(fabsf(den), flr); const float rden = 1.0f / den;
                bf16x8 pk[2];
#pragma unroll
                for (int i = 0; i < 2; ++i) { u32x4 w; w.x = pk2(P[2 * i][0], P[2 * i][1]); w.y = pk2(P[2 * i][2], P[2 * i][3]); w.z = pk2(P[2 * i + 1][0], P[2 * i + 1][1]); w.w = pk2(P[2 * i + 1][2], P[2 * i + 1][3]); pk[i] = __builtin_bit_cast(bf16x8, w); }
                float hv[6][4]; float ss = 0.f;
#pragma unroll
                for (int et = 0; et < 6; ++et) {
                    f32x4 n1 = (f32x4){0.f, 0.f, 0.f, 0.f}, n2 = (f32x4){0.f, 0.f, 0.f, 0.f};
#pragma unroll
                    for (int i = 0; i < 2; ++i) if (2 * i <= tt) { const unsigned char* vp = vtb + (16 * et + l16) * TROW + (32 * i + 4 * quad) * 2;
                        const u32x2 lo = *(const u32x2*)vp, hi2 = *(const u32x2*)(vp + 32); const u32x4 a = {lo.x, lo.y, hi2.x, hi2.y};
                        n1 = __builtin_amdgcn_mfma_f32_16x16x32_bf16(__builtin_bit_cast(bf16x8, a), pk[i], n1, 0, 0, 0); }
#pragma unroll
                    for (int ks = 0; ks < 3; ++ks) n2 = __builtin_amdgcn_mfma_f32_16x16x32_bf16(*(const bf16x8*)(ct + (16 * et + l16) * QROW + (32 * ks + 8 * quad) * 2), bq[ks], n2, 0, 0, 0);
#pragma unroll
                    for (int j = 0; j < 4; ++j) { const float v = (n1[j] + inter * n2[j]) * rden; hv[et][j] = v; ss += v * v; }
                    __builtin_amdgcn_sched_barrier(0);
                }
                u32x2 obv[6];
#pragma unroll
                for (int et = 0; et < 6; ++et) obv[et] = *(const u32x2*)(Z + row * NZ + ZOB + h * 96 + 16 * et + 4 * quad);
                ss += __shfl_xor(ss, 16); ss += __shfl_xor(ss, 32);
                const float rs = rsqrtf(ss * (1.0f / 96.0f) + EPS);
#pragma unroll
                for (int et = 0; et < 6; ++et) { const int e = 16 * et + 4 * quad; const u32x2 ob = obv[et]; const f32x4 mg = *(const f32x4*)((const float*)(smb + O_MNG) + e);
                    u32x2 w; w.x = pk2(hv[et][0] * rs * mg[0] * sigmoidf_(__uint_as_float(ob.x << 16)), hv[et][1] * rs * mg[1] * sigmoidf_(__uint_as_float(ob.x & 0xffff0000u)));
                    w.y = pk2(hv[et][2] * rs * mg[2] * sigmoidf_(__uint_as_float(ob.y << 16)), hv[et][3] * rs * mg[3] * sigmoidf_(__uint_as_float(ob.y & 0xffff0000u)));
                    *(u32x2*)(Ymix + row * D + 384 + h * 96 + e) = w; }
            } else {
                const int wq = wave - 4; const unsigned char* kwt = smb + O_KWT; const unsigned char* vtb = smb + O_VT; unsigned char* ctn = smb + O_CT + nxt * CT_BYTES;
                float gip = 0.f, gfp = 0.f;
                if (wq == 3 && n + 1 < 32) { const size_t row = r0 + 64 + lane; gip = gates[row * 8 + h] + igb[h]; gfp = gates[row * 8 + 4 + h] + fgb[h]; }
#pragma unroll
                for (int k = 0; k < 9; ++k) { const int idx = wq + 4 * k, dt = idx / 6, et = idx - 6 * dt; f32x4 U = (f32x4){0.f, 0.f, 0.f, 0.f};
#pragma unroll
                    for (int ks = 0; ks < 2; ++ks) U = __builtin_amdgcn_mfma_f32_16x16x32_bf16(*(const bf16x8*)(kwt + (16 * dt + l16) * TROW + (32 * ks + 8 * quad) * 2), *(const bf16x8*)(vtb + (16 * et + l16) * TROW + (32 * ks + 8 * quad) * 2), U, 0, 0, 0);
                    Cst[k] = Cst[k] * dec + U;
                    u32x2 w; w.x = pk2(Cst[k][0], Cst[k][1]); w.y = pk2(Cst[k][2], Cst[k][3]);
                    *(u32x2*)(ctn + (16 * et + l16) * QROW + (16 * dt + 4 * quad) * 2) = w; __builtin_amdgcn_sched_barrier(0); }
                if (wq == 0 || (wq == 1 && lane < 32)) { const int d = wq * 64 + lane; const u32x4* kp = (const u32x4*)(kwt + d * TROW); float sacc = 0.f;
#pragma unroll
                    for (int i = 0; i < 8; ++i) { const u32x4 w = kp[i];
                        sacc += (__uint_as_float(w.x << 16) + __uint_as_float(w.x & 0xffff0000u)) + (__uint_as_float(w.y << 16) + __uint_as_float(w.y & 0xffff0000u))
                              + (__uint_as_float(w.z << 16) + __uint_as_float(w.z & 0xffff0000u)) + (__uint_as_float(w.w << 16) + __uint_as_float(w.w & 0xffff0000u)); }
                    NV[nxt * 96 + d] = dec * NV[cur * 96 + d] + sacc; }
                if (wq == 3 && n + 1 < 32) ML_GATES(n + 1, gip, gfp);
            }
            asm volatile("s_waitcnt vmcnt(0)" ::: "memory");
            __syncthreads();
            ML_WARM(n + 2);
            if (n + 1 < 32) ML_CONVERT(n + 1);
            __syncthreads();
        }
#undef ML_DMA
#undef ML_WARM
#undef ML_GATES
#undef ML_CONVERT
    }
}

namespace sgu {
constexpr int VROW = 272, VGRP = 64 * VROW + 32, MROW = 528, MST_OFF = 71680;
static_assert(4 * VGRP <= MST_OFF && MST_OFF + 128 * MROW <= 147456, "SGU LDS map");
DEVI float gelu_fast(float x) { const float u = 1.5957691216057308f * (x + 0.044715f * x * x * x); return x * __builtin_amdgcn_rcpf(1.0f + __expf(-u)); }
}
DEVI void ph_sgu(const bf16_t* Z, const float* ln_g, const float* ln_b, const bf16_t* Wm, const float* bs, const float* og, bf16_t* Ymix, unsigned char* smb, int wg, int nwg) {
    using namespace sgu; typedef short bf16x8 __attribute__((ext_vector_type(8))); typedef float f32x16 __attribute__((ext_vector_type(16)));
    const int tid = otid(), lane = tid & 63, wave = __builtin_amdgcn_readfirstlane(tid >> 6), r32 = lane & 31, hi = lane >> 5;
    for (int blk = wg; blk < T / 128; blk += nwg) {
        const size_t row0 = (size_t)blk * 128;
        u32x4 uv[8]; { const u32x4* up = (const u32x4*)(Z + (row0 + (tid >> 2)) * NZ + ZUC + (tid & 3) * 64);
#pragma unroll
            for (int i = 0; i < 8; ++i) uv[i] = up[i]; }
        {
            const int tp = tid >> 3, g = (tid >> 1) & 3, hf = tid & 1, c0 = g * 64 + hf * 32;
            u32x4 raw[2][4];
#pragma unroll
            for (int k = 0; k < 2; ++k) { const u32x4* src = (const u32x4*)(Z + (row0 + 2 * tp + k) * NZ + ZVC + c0);
#pragma unroll
                for (int i = 0; i < 4; ++i) raw[k][i] = src[i]; }
            float v[2][32];
#pragma unroll
            for (int k = 0; k < 2; ++k)
#pragma unroll
                for (int i = 0; i < 4; ++i) { float f[8]; unpack8(raw[k][i], f);
#pragma unroll
                    for (int j = 0; j < 8; ++j) v[k][i * 8 + j] = gelu_fast(f[j]); }
            float mu[2], rstd[2];
#pragma unroll
            for (int k = 0; k < 2; ++k) { float s1 = 0.f;
#pragma unroll
                for (int c = 0; c < 32; ++c) s1 += v[k][c];
                s1 += __shfl_xor(s1, 1); mu[k] = s1 * (1.0f / 64.0f); float s2 = 0.f;
#pragma unroll
                for (int c = 0; c < 32; ++c) { const float dd = v[k][c] - mu[k]; s2 += dd * dd; }
                s2 += __shfl_xor(s2, 1); rstd[k] = rsqrtf(s2 * (1.0f / 64.0f) + EPS); }
            unsigned char* dst = smb + g * VGRP + (hf * 32) * VROW + tp * 4;
#pragma unroll
            for (int c = 0; c < 32; ++c) { const float gg = ln_g[c0 + c], bb = ln_b[c0 + c];
                *(unsigned*)(dst + c * VROW) = pk2((v[0][c] - mu[0]) * rstd[0] * gg + bb, (v[1][c] - mu[1]) * rstd[1] * gg + bb); }
        }
        const int g2 = wave >> 1, mh = wave & 1;
        bf16x8 af[2][8];
        { const bf16_t* wa = Wm + ((size_t)g2 * 128 + 64 * mh + r32) * 128 + 8 * hi;
#pragma unroll
            for (int ks = 0; ks < 8; ++ks) if (ks < 4 || mh) { af[0][ks] = *(const bf16x8*)(wa + ks * 16); af[1][ks] = *(const bf16x8*)(wa + 32 * 128 + ks * 16); } }
        asm volatile("s_waitcnt lgkmcnt(0)" ::: "memory"); __builtin_amdgcn_s_barrier(); asm volatile("" ::: "memory");
        {
            f32x16 acc[2][2];
#pragma unroll
            for (int i = 0; i < 2; ++i)
#pragma unroll
                for (int j = 0; j < 2; ++j) acc[i][j] = f32x16{};
            const unsigned char* vb = smb + g2 * VGRP + r32 * VROW + 16 * hi;
#pragma unroll
            for (int ks = 0; ks < 8; ++ks) if (ks < 4 || mh) {
                const bf16x8 b0 = *(const bf16x8*)(vb + ks * 32), b1 = *(const bf16x8*)(vb + 32 * VROW + ks * 32);
                acc[0][0] = __builtin_amdgcn_mfma_f32_32x32x16_bf16(af[0][ks], b0, acc[0][0], 0, 0, 0); acc[0][1] = __builtin_amdgcn_mfma_f32_32x32x16_bf16(af[0][ks], b1, acc[0][1], 0, 0, 0);
                acc[1][0] = __builtin_amdgcn_mfma_f32_32x32x16_bf16(af[1][ks], b0, acc[1][0], 0, 0, 0); acc[1][1] = __builtin_amdgcn_mfma_f32_32x32x16_bf16(af[1][ks], b1, acc[1][1], 0, 0, 0);
            }
            bf16_t* mst = (bf16_t*)(smb + MST_OFF);
#pragma unroll
            for (int mt = 0; mt < 2; ++mt)
#pragma unroll
                for (int r = 0; r < 16; ++r) { const int t = 64 * mh + 32 * mt + (r & 3) + 8 * (r >> 2) + 4 * hi; const float bias = bs[g2 * 128 + t];
                    bf16_t* mp = mst + t * (MROW / 2) + g2 * 64 + r32;
                    mp[0] = (bf16_t)f2bf(acc[mt][0][r] + bias); mp[32] = (bf16_t)f2bf(acc[mt][1][r] + bias); }
        }
        asm volatile("s_waitcnt lgkmcnt(0)" ::: "memory"); __builtin_amdgcn_s_barrier(); asm volatile("" ::: "memory");
        {
            const int t = tid >> 2, g = tid & 3; const size_t row = row0 + t;
            const u32x4* mp = (const u32x4*)(smb + MST_OFF + t * MROW + g * 128);
            float y[64]; float ss = 0.f;
#pragma unroll
            for (int i = 0; i < 8; ++i) { float uf[8], mf[8]; unpack8(uv[i], uf); unpack8(mp[i], mf);
#pragma unroll
                for (int j = 0; j < 8; ++j) { y[i * 8 + j] = gelu_fast(uf[j]) * mf[j]; ss += y[i * 8 + j] * y[i * 8 + j]; } }
            ss += __shfl_xor(ss, 1); ss += __shfl_xor(ss, 2);
            const float rs = rsqrtf(ss * (1.0f / 256.0f) + EPS);
            u32x4* yp = (u32x4*)(Ymix + row * D + 768 + g * 64); const f32x4* gp = (const f32x4*)(og + g * 64);
#pragma unroll
            for (int i = 0; i < 8; ++i) { const f32x4 g0 = gp[2 * i], g1 = gp[2 * i + 1];
                u32x4 w; w.x = pk2(y[i * 8 + 0] * rs * g0[0], y[i * 8 + 1] * rs * g0[1]); w.y = pk2(y[i * 8 + 2] * rs * g0[2], y[i * 8 + 3] * rs * g0[3]);
                w.z = pk2(y[i * 8 + 4] * rs * g1[0], y[i * 8 + 5] * rs * g1[1]); w.w = pk2(y[i * 8 + 6] * rs * g1[2], y[i * 8 + 7] * rs * g1[3]); yp[i] = w; }
        }
        asm volatile("s_waitcnt lgkmcnt(0)" ::: "memory"); __builtin_amdgcn_s_barrier(); asm volatile("" ::: "memory");
    }
}
DEVI void ph_prep_sgu(const float* w, bf16_t* Wm, int wg, int nwg) {
    for (int idx = wg * NTHR + otid(); idx < 4 * 128 * 128; idx += nwg * NTHR) { const int t = (idx >> 7) & 127, s = idx & 127; Wm[idx] = (bf16_t)f2bf(((s >> 6) <= (t >> 6)) ? w[idx] : 0.f); }
}

template <class Sched> DEVI void fill_f32_table(const Sched& S, const float* srcv, unsigned char* smb) {
    const int tid_ = otid();
    for (int i = tid_ >> 8; i < TABF; i += 2) { pg8::Unit u_; if (!S.next(i, u_)) break; ((float*)(smb + TAB_OFF))[i * 256 + (tid_ & 255)] = srcv[u_.pm * 256 + (tid_ & 255)]; }
    __syncthreads();
}
DEVI void ph_place_all(const unsigned* count, const int* tokE, const float* tokW, int* rank, const float* rstd2, int* row_ts, float* row_w, float* row_rs, int* tile_e, int* n_tiles, unsigned char* smb, int wg, int nwg) {
    int* ps = (int*)smb; int* cnt = ps + 40;
    const int tid = otid(), lane = tid & 63;
    if (tid < 64) { const int c = lane < 32 ? (int)__hip_atomic_load(count + lane, __ATOMIC_RELAXED, __HIP_MEMORY_SCOPE_AGENT) : 0; const int pad = (c + 255) & ~255;
        int incl = pad;
#pragma unroll
        for (int o = 1; o < 32; o <<= 1) { const int t_ = __shfl_up(incl, o); if (lane >= o) incl += t_; }
        if (lane < 32) { cnt[lane] = c; ps[lane] = incl - pad; if (lane == 31) ps[32] = incl; } }
    __syncthreads();
    if (wg == 0) {
        const int nt = ps[32] >> 8;
        if (tid == 0) *n_tiles = nt;
        for (int i = tid; i < nt; i += NTHR) { int e = 0;
#pragma unroll 1
            for (int k = 1; k < 32; ++k) if ((ps[k] >> 8) <= i) e = k;
            tile_e[i] = e; }
        for (int e = 0; e < 32; ++e) for (int r = cnt[e] + tid; r < ps[e + 1] - ps[e]; r += NTHR) { row_ts[ps[e] + r] = -1; row_rs[ps[e] + r] = 0.f; }
    }
    for (int idx = wg * NTHR + tid; idx < 2 * T; idx += nwg * NTHR) { const int pos = ps[tokE[idx]] + rank[idx]; row_ts[pos] = idx; row_w[pos] = tokW[idx]; row_rs[pos] = rstd2[idx >> 1]; rank[idx] = pos; }
    __syncthreads();
}
DEVI void ph_combine(bf16_t* h, const bf16_t* Y, const int* tokpos, float* rstd3, int wg, int nwg) {
    const int tid = otid(), lane = tid & 63, gw = wg * 8 + (tid >> 6), ngw = nwg * 8;
    for (int base = 2 * gw; base < T; base += 32 * ngw) {
        const int myrow = base + 2 * ngw * (lane >> 2) + ((lane >> 1) & 1);
        const int tp = myrow < T ? tokpos[myrow * 2 + (lane & 1)] : 0;
#pragma unroll 1
        for (int k = 0; k < 16; ++k) {
            const int row = base + 2 * ngw * k; if (row >= T) break;
            u32x4 hv[2][2], y0[2][2], y1[2][2];
#pragma unroll
            for (int r = 0; r < 2; ++r) { const int p0 = __builtin_amdgcn_readfirstlane(__shfl(tp, 4 * k + 2 * r)), p1 = __builtin_amdgcn_readfirstlane(__shfl(tp, 4 * k + 2 * r + 1));
#pragma unroll
                for (int jj = 0; jj < 2; ++jj) { hv[r][jj] = ((const u32x4*)(h + (size_t)(row + r) * D) + lane)[64 * jj];
                    y0[r][jj] = __builtin_nontemporal_load((const u32x4*)(Y + (size_t)p0 * D) + lane + 64 * jj); y1[r][jj] = __builtin_nontemporal_load((const u32x4*)(Y + (size_t)p1 * D) + lane + 64 * jj); } }
#pragma unroll
            for (int r = 0; r < 2; ++r) { float s = 0.f;
#pragma unroll
                for (int jj = 0; jj < 2; ++jj) { float a[8], b0[8], b1[8]; unpack8(hv[r][jj], a); unpack8(y0[r][jj], b0); unpack8(y1[r][jj], b1);
#pragma unroll
                    for (int i = 0; i < 8; ++i) { a[i] += b0[i] + b1[i]; s += a[i] * a[i]; }
                    u32x4 w; w.x = pk2(a[0], a[1]); w.y = pk2(a[2], a[3]); w.z = pk2(a[4], a[5]); w.w = pk2(a[6], a[7]); ((u32x4*)(h + (size_t)(row + r) * D) + lane)[64 * jj] = w; }
                s = wave_sum(s);
                if (lane == 0) rstd3[row + r] = rsqrtf(s * (1.0f / 1024.0f) + EPS); }
        }
    }
}
DEVI void ph_final(const bf16_t* h, float* out, const float* ssp, const float* g, int wg, int nwg) {
    const int tid = otid(), lane = tid & 63, gw = wg * 8 + (tid >> 6), ngw = nwg * 8;
    const f32x4* gp = (const f32x4*)g + 2 * lane; const f32x4 g00 = gp[0], g01 = gp[1], g10 = gp[128], g11 = gp[129];
    for (int row = 2 * gw; row < T; row += 2 * ngw) {
        u32x4 hv[2][2]; float sp[2];
#pragma unroll
        for (int r = 0; r < 2; ++r) { sp[r] = lane < 16 ? ssp[(size_t)(row + r) * 16 + lane] : 0.f;
#pragma unroll
            for (int jj = 0; jj < 2; ++jj) hv[r][jj] = ((const u32x4*)(h + (size_t)(row + r) * D) + lane)[64 * jj]; }
#pragma unroll
        for (int r = 0; r < 2; ++r) { const float rs = rsqrtf(wave_sum(sp[r]) * (1.0f / 1024.0f) + EPS); f32x4* op = (f32x4*)(out + (size_t)(row + r) * D) + 2 * lane;
#pragma unroll
            for (int jj = 0; jj < 2; ++jj) { float a[8]; unpack8(hv[r][jj], a); const f32x4 g0 = jj ? g10 : g00, g1 = jj ? g11 : g01;
                op[128 * jj] = (f32x4){a[0] * rs * g0[0], a[1] * rs * g0[1], a[2] * rs * g0[2], a[3] * rs * g0[3]}; op[128 * jj + 1] = (f32x4){a[4] * rs * g1[0], a[5] * rs * g1[1], a[6] * rs * g1[2], a[7] * rs * g1[3]}; } }
    }
}

enum { IN_X = 0, IN_P, IN_NORM1G, IN_WIN, IN_CONVW, IN_CONVB, IN_IGB, IN_FGB, IN_MNG, IN_SBOG, IN_SGULNG, IN_SGULNB, IN_SGUW, IN_SGUB, IN_SGUOG, IN_WOUT, IN_NORM2G,
       IN_RGW, IN_RGB, IN_REW, IN_REB, IN_WGATE, IN_WUP, IN_WDOWN, IN_PLENG, IN_PLEGW, IN_PLEPW, IN_FINALG, N_INPUTS };
constexpr int NPH_LAYER = 9, NPHASES = 1 + DEPTH * NPH_LAYER + 1;
struct Params { const float* in[N_INPUTS]; float* out; unsigned char* ws; int ph_lo, ph_hi; };
static_assert(sizeof(Params) == N_INPUTS * 8 + 8 + 8 + 8, "Params has no padding");

__global__ void __launch_bounds__(NTHR, 2) mega(Params p) {
    extern __shared__ __attribute__((aligned(16))) unsigned char lds[];
    const int tid = threadIdx.x, wg = blockIdx.x, nwg = gridDim.x;
    for (int u = tid; u < (LDS_BYTES - MISC_OFF) / 4; u += NTHR) ((LAS unsigned*)(lds + MISC_OFF))[u] = 0u;
    __syncthreads();
    unsigned char* const ws0 = p.ws;
    const bool fused = (p.ph_hi - p.ph_lo) > 1;
    XcdBarrier bar; bar.bar = (unsigned*)(ws0 + WS_CTL) + CW_BAR; bar.x = 0; bar.st = nullptr;
    if (fused) bar = xcd_barrier_post((unsigned*)(ws0 + WS_CTL) + CW_BAR, (volatile LAS unsigned*)(lds + MISC_OFF));
    PG8_LAS unsigned char* ring = (PG8_LAS unsigned char*)lds;
#define WSP(type, off) ((type)(ws + (off)))
#define PH_LOCALS size_t zo_ = 0; asm volatile("" : "+s"(zo_)); unsigned char* ws = ws0 + zo_; float* out = p.out + zo_;   \
        unsigned char* wl = ws + WS_WTS + (size_t)l * WL_SIZE; (void)wl; (void)out; \
        bf16_t* const HIN = (bf16_t*)(ws + ((l & 1) ? WS_HBB : WS_HBA)); bf16_t* const HOUT = (bf16_t*)(ws + ((l & 1) ? WS_HBA : WS_HBB)); (void)HIN; (void)HOUT;

    int gp = 0;
#define PH_ON (p.ph_lo <= gp && gp < p.ph_hi)
#define PH_END do { if (fused && gp + 1 < p.ph_hi) for (int rb_ = 0; rb_ < REP_BAR; ++rb_) xcd_barrier(bar); ++gp; } while (0)

    if (PH_ON) for (int rep = 0; rep < REP_PRO; ++rep) {
#pragma unroll 1
        for (int l = 0; l < DEPTH; ++l) {
            PH_LOCALS
            { const PrepJob j{p.in[IN_WIN] + (size_t)l * D * 3208, nullptr, p.in[IN_NORM1G] + l * D, (bf16_t*)(wl + WL_IN), 3208, D, NZ, 1, 1, 0, 0, 0}; ph_prep_w(j, lds, wg, nwg); }
            { const PrepJob j{p.in[IN_WOUT] + (size_t)l * D * D, nullptr, nullptr, (bf16_t*)(wl + WL_OUT), D, D, D, 0, 1, 0, 0, 0}; ph_prep_w(j, lds, wg, nwg); }
            { const PrepJob j{p.in[IN_WGATE] + (size_t)l * NEXP * D * DEXP, p.in[IN_WUP] + (size_t)l * NEXP * D * DEXP, p.in[IN_NORM2G] + l * D, (bf16_t*)(wl + WL_GU), DEXP, D, 512, 2, NEXP, 0, (size_t)D * DEXP, (size_t)512 * D};
              ph_prep_w(j, lds, wg, nwg); }
            { const PrepJob j{p.in[IN_WDOWN] + (size_t)l * NEXP * DEXP * D, nullptr, nullptr, (bf16_t*)(wl + WL_DN), D, DEXP, D, 0, NEXP, 0, (size_t)DEXP * D, (size_t)D * DEXP}; ph_prep_w(j, lds, wg, nwg); }
            { const PrepJob j{p.in[IN_PLEGW] + (size_t)l * D * D, nullptr, p.in[IN_PLENG] + l * D, (bf16_t*)(wl + WL_PG), D, D, D, 0, 1, 0, 0, 0}; ph_prep_w(j, lds, wg, nwg); }
            { const PrepJob j{p.in[IN_PLEPW] + (size_t)l * PDIM * D, nullptr, nullptr, (bf16_t*)(wl + WL_PP), D, PDIM, D, 0, 1, 0, 0, 0}; ph_prep_w(j, lds, wg, nwg); }
            ph_prep_sgu(p.in[IN_SGUW] + (size_t)l * 4 * 128 * 128, WSP(bf16_t*, WS_WSGU) + (size_t)l * 4 * 128 * 128, wg, nwg);
            ph_prep_router(p.in[IN_RGW] + l * D * 4, p.in[IN_REW] + l * D * 32, p.in[IN_NORM2G] + l * D, WSP(bf16_t*, WS_WR) + (size_t)l * 256 * D, wg, nwg);
        }
        { const int l = 0; PH_LOCALS
          ph_prep_x(p.in[IN_X], WSP(bf16_t*, WS_HBA), WSP(float*, WS_SSP), wg, nwg);
            }
    }
    PH_END;

#pragma clang loop unroll(full)
    for (int l = 0; l < DEPTH; ++l) {
        if (PH_ON) { PH_LOCALS
            pg8::Gemm g{HIN, (const bf16_t*)(wl + WL_IN), T, NZ, D, 0}; pg8::StaticOrder S; S.init(T, NZ, nwg, wg); const float* rtab = (const float*)(lds + 131072);
            { const int tid_ = otid(); const float* ssp_ = WSP(const float*, WS_SSP);
              for (int i = tid_ >> 8; ; i += 2) { pg8::Unit u_; if (!S.next(i & ~1, u_)) break; if (S.next(i, u_)) { const f32x4* sp = (const f32x4*)(ssp_ + (size_t)(u_.pm * 256 + (tid_ & 255)) * 16);
                  const f32x4 st = (sp[0] + sp[1]) + (sp[2] + sp[3]); ((float*)(lds + 131072))[i * 256 + (tid_ & 255)] = rsqrtf(((st[0] + st[1]) + (st[2] + st[3])) * (1.0f / 1024.0f) + EPS); } }
              __syncthreads(); }
            EpiZ E{WSP(bf16_t*, WS_Z), rtab, WSP(float*, WS_GATES), l == 0 ? p.in[IN_P] : nullptr, WSP(bf16_t*, WS_PB), nwg, wg};
            if (STG_Z) stagger(wg, STG_Z);
            for (int rep = 0; rep < REP_Z; ++rep) pg8::gemm_phase<EpiZ, pg8::StaticOrder, AL_Z, true>(ring, g, S, E); }
        PH_END;
        if (PH_ON) { PH_LOCALS
            const int nh = nwg >> 1;
            if (wg < nh) {
                for (int rep = 0; rep < REP_ML; ++rep) ph_mlstm(WSP(const bf16_t*, WS_Z), WSP(const float*, WS_GATES), p.in[IN_CONVW] + l * 4 * 768, p.in[IN_CONVB] + l * 768, p.in[IN_IGB] + l * 4, p.in[IN_FGB] + l * 4, p.in[IN_MNG] + l * 384, WSP(bf16_t*, WS_YMIX), lds, wg, nh);
            } else {
                for (int rep = 0; rep < REP_SB; ++rep) { ph_sb(WSP(const bf16_t*, WS_Z), p.in[IN_SBOG] + l * 384, WSP(bf16_t*, WS_YMIX), lds, wg - nh, nwg - nh); __syncthreads(); }
                for (int rep = 0; rep < REP_SGU; ++rep) ph_sgu(WSP(const bf16_t*, WS_Z), p.in[IN_SGULNG] + l * 256, p.in[IN_SGULNB] + l * 256, WSP(const bf16_t*, WS_WSGU) + (size_t)l * 4 * 128 * 128, p.in[IN_SGUB] + l * 4 * 128, p.in[IN_SGUOG] + l * 256, WSP(bf16_t*, WS_YMIX), lds, wg - nh, nwg - nh);
            }
        }
        PH_END;
        if (PH_ON) { PH_LOCALS
            pg8::Gemm g{WSP(const bf16_t*, WS_YMIX), (const bf16_t*)(wl + WL_OUT), T, D, D, 0}; pg8::StaticOrder S; S.init(T, D, nwg, wg); EpiResid E{HIN, HIN, WSP(float*, WS_SSP2)};
            if (REP_WOUT0 > 1) { EpiResid E2{HIN, WSP(bf16_t*, WS_Z), WSP(float*, WS_Z + 400 * MiB)}; for (int rep = 1; rep < REP_WOUT0; ++rep) pg8::gemm_phase<EpiResid, pg8::StaticOrder, AL_WOUT, true>(ring, g, S, E2); }
            if (STG_WOUT) stagger(wg, STG_WOUT);
            pg8::gemm_phase<EpiResid, pg8::StaticOrder, AL_WOUT, true>(ring, g, S, E); }
        PH_END;
        if (PH_ON) { PH_LOCALS
            pg8::Gemm g{HIN, WSP(const bf16_t*, WS_WR) + (size_t)l * 256 * D, T, 256, D, 0}; pg8::StaticOrder S; S.init(T, 256, nwg, wg);
            EpiRouter E{WSP(const float*, WS_SSP2), p.in[IN_RGB] + l * 4, p.in[IN_REB] + l * 32, WSP(int*, WS_TOKE), WSP(float*, WS_TOKW), WSP(float*, WS_RSTD2), WSP(int*, WS_RANK), WSP(unsigned*, WS_CTL) + CW_COUNT + 32 * l};
            pg8::gemm_phase<EpiRouter, pg8::StaticOrder, false, true>(ring, g, S, E); }
        PH_END;
        if (PH_ON) { PH_LOCALS
            for (int rep = 0; rep < REP_PLACE; ++rep) ph_place_all(WSP(const unsigned*, WS_CTL) + CW_COUNT + 32 * l, WSP(const int*, WS_TOKE), WSP(const float*, WS_TOKW), WSP(int*, WS_RANK), WSP(const float*, WS_RSTD2), WSP(int*, WS_ROWTS), WSP(float*, WS_ROWW), WSP(float*, WS_ROWRS),
                         WSP(int*, WS_TILEE), WSP(int*, WS_CTL) + CW_NTILES + l, lds, wg, nwg); }
        PH_END;
        if (PH_ON) { PH_LOCALS
            pg8::Gemm g{HIN, (const bf16_t*)(wl + WL_GU), MAXROWS, 512, D, 0}; MoeGatherOrder S; S.ntot = 0; S.nN = 2; S.G = 0; S.c = 0; S.tile_e = (const int*)(lds + 131072); S.estride = (size_t)512 * D * 2; S.row_ts = WSP(const int*, WS_ROWTS);
            { const int tid_ = otid(); const int nt_ = *(WSP(const int*, WS_CTL) + CW_NTILES + l); for (int i = tid_; i < nt_; i += NTHR) ((int*)(lds + 131072))[i] = WSP(const int*, WS_TILEE)[i]; __syncthreads(); }
            S.bind(WSP(const int*, WS_CTL) + CW_NTILES + l, nwg, wg);
            S.ntot = (S.ntot / nwg) * nwg;
            fill_f32_table(S, WSP(const float*, WS_ROWRS), lds);
            EpiGU E{WSP(const float*, WS_ROWRS), WSP(bf16_t*, WS_HID), (const float*)(lds + TAB_OFF), TABF};
            if (STG_GU) stagger(wg, STG_GU);
            for (int rep = 0; rep < REP_GU; ++rep) pg8::gemm_phase<EpiGU, MoeGatherOrder, AL_GU, true>(ring, g, S, E); }
        PH_END;
        if (PH_ON) { PH_LOCALS
            { const int tid_ = otid(); const int nt_ = *(WSP(const int*, WS_CTL) + CW_NTILES + l); for (int i = tid_; i < nt_; i += NTHR) ((int*)(lds + 131072))[i] = WSP(const int*, WS_TILEE)[i]; __syncthreads(); }
            const int ntl = __builtin_amdgcn_readfirstlane(*(WSP(const int*, WS_CTL) + CW_NTILES + l)), mt0 = ((ntl * 2) / nwg) * (nwg / 2), ntail = ntl - mt0;
            if (wg < ntail) {
                pg8::Gemm g{HIN, (const bf16_t*)(wl + WL_GU), MAXROWS, 512, D, 0}; MoeGatherOrder S; S.nN = 2; S.G = 1; S.c = (mt0 + wg) * 2; S.ntot = S.c + 2; S.tile_e = (const int*)(lds + 131072); S.estride = (size_t)512 * D * 2; S.row_ts = WSP(const int*, WS_ROWTS);
                EpiGU E{WSP(const float*, WS_ROWRS), WSP(bf16_t*, WS_HID), (const float*)(lds + TAB_OFF), 0};
                pg8::gemm_phase<EpiGU, MoeGatherOrder, AL_GU, true>(ring, g, S, E);
                __syncthreads();
            }
            pg8::Gemm g{WSP(const bf16_t*, WS_HID), (const bf16_t*)(wl + WL_DN), MAXROWS, D, DEXP, 0}; MoeDealOrder S; S.ntot = 0; S.nN = 4; S.G = nwg; S.c = wg; S.tile_e = (const int*)(lds + 131072); S.estride = (size_t)D * DEXP * 2; S.mt0 = mt0; S.ntail = ntail; S.nD = mt0 * 4;
            fill_f32_table(S, WSP(const float*, WS_ROWW), lds);
            EpiDown E{WSP(const float*, WS_ROWW), WSP(bf16_t*, WS_Y), (const float*)(lds + TAB_OFF), TABF};
            if (STG_DOWN) stagger(wg, STG_DOWN);
            for (int rep = 0; rep < REP_DOWN; ++rep) pg8::gemm_phase<EpiDown, MoeDealOrder, AL_DOWN, true>(ring, g, S, E); }
        PH_END;
        if (PH_ON) { PH_LOCALS
            const bool ppfirst = (wg & 1) != 0;
            if (!ppfirst) { ph_combine(HIN, WSP(const bf16_t*, WS_Y), WSP(const int*, WS_RANK), WSP(float*, WS_RSTD3), wg, nwg); __syncthreads(); }
            pg8::Gemm g{WSP(const bf16_t*, WS_PB) + (size_t)l * T * PDIM, (const bf16_t*)(wl + WL_PP), T, D, PDIM, 0}; pg8::StaticOrder S; S.init(T, D, nwg, wg); EpiPlain E{WSP(bf16_t*, WS_YMIX), D, 0};
            for (int rep = 0; rep < REP_PP; ++rep) pg8::gemm_phase<EpiPlain, pg8::StaticOrder, AL_PP, true>(ring, g, S, E);
            if (ppfirst) { __syncthreads(); ph_combine(HIN, WSP(const bf16_t*, WS_Y), WSP(const int*, WS_RANK), WSP(float*, WS_RSTD3), wg, nwg); }
        }
        PH_END;
        if (PH_ON) { PH_LOCALS
            pg8::Gemm g{HIN, (const bf16_t*)(wl + WL_PG), T, D, D, 0}; pg8::StaticOrder S; S.init(T, D, nwg, wg); EpiPLE E{WSP(const float*, WS_RSTD3), WSP(const bf16_t*, WS_YMIX), HIN, HOUT, WSP(float*, WS_SSP)};
            if (STG_PLE) stagger(wg, STG_PLE);
            if (REP_PLE > 1) { EpiPLE E2{WSP(const float*, WS_RSTD3), WSP(const bf16_t*, WS_YMIX), HIN, WSP(bf16_t*, WS_Z), WSP(float*, WS_Z + 400 * MiB)}; for (int rep = 1; rep < REP_PLE; ++rep) pg8::gemm_phase<EpiPLE, pg8::StaticOrder, AL_PLE, true>(ring, g, S, E2); }
            pg8::gemm_phase<EpiPLE, pg8::StaticOrder, AL_PLE, true>(ring, g, S, E); }
        PH_END;
    }
    if (PH_ON) { const int l = 0; PH_LOCALS
        ph_final(WSP(const bf16_t*, (DEPTH & 1) ? WS_HBB : WS_HBA), out, WSP(const float*, WS_SSP), p.in[IN_FINALG], wg, nwg); }
#undef PH_ON
#undef PH_END
}

#ifndef REP_SB
#define REP_SB 1
#endif
#ifndef REP_ML
#define REP_ML 1
#endif
#ifndef REP_SGU
#define REP_SGU 1
#endif
#ifndef MK_SPLIT
#define MK_SPLIT 0
#endif
extern "C" void kernel_launch(void* const* d_in, const int* in_sizes, int n_in, void* d_out, int out_size, void* d_ws, size_t ws_size, hipStream_t stream) {
    static int grid = 0;
    if (grid == 0) {
        if (n_in != N_INPUTS || in_sizes[0] != T * D || out_size != T * D || ws_size < WS_END) { fprintf(stderr, "kernel_launch: unexpected shapes / workspace (%d inputs, ws %zu)\n", n_in, ws_size); grid = -1; return; }
        int dev = 0, cus = 0;
        if (hipGetDevice(&dev) != hipSuccess || hipDeviceGetAttribute(&cus, hipDeviceAttributeMultiprocessorCount, dev) != hipSuccess) { grid = -1; return; }
        if (hipFuncSetAttribute((const void*)mega, hipFuncAttributeMaxDynamicSharedMemorySize, LDS_BYTES) != hipSuccess) { grid = -1; return; }
        int per_cu = 0;
        if (hipOccupancyMaxActiveBlocksPerMultiprocessor(&per_cu, (const void*)mega, NTHR, LDS_BYTES) != hipSuccess || per_cu < 1) fprintf(stderr, "kernel_launch: occupancy query says %d\n", per_cu);
        (void)hipGetLastError();
        grid = cus;
        if (grid != 256) { fprintf(stderr, "kernel_launch: built for 256 CUs (one router unit per workgroup)\n"); grid = -1; return; }
        if (grid < 208) { fprintf(stderr, "kernel_launch: built for >= 208 CUs (LDS table of 16 units per workgroup in the input projection)\n"); grid = -1; return; }
    }
    if (grid < 0) return;
    (void)hipMemsetAsync((unsigned char*)d_ws + WS_CTL, 0, 1 * MiB, stream);
    Params p{};
    for (int i = 0; i < N_INPUTS; ++i) p.in[i] = (const float*)d_in[i];
    p.out = (float*)d_out; p.ws = (unsigned char*)d_ws;
#if MK_SPLIT
    for (int ph = 0; ph < NPHASES; ++ph) { p.ph_lo = ph; p.ph_hi = ph + 1; hipLaunchKernelGGL(mega, dim3(grid), dim3(NTHR), LDS_BYTES, stream, p); }
#else
    p.ph_lo = 0; p.ph_hi = NPHASES;
    hipLaunchKernelGGL(mega, dim3(grid), dim3(NTHR), LDS_BYTES, stream, p);
#endif
}
```

```cpp
#include <hip/hip_runtime.h>
#include <cstdio>
#include <cstdint>
namespace pg8 {
#define PG8_LAS __attribute__((address_space(3)))
typedef unsigned short bf16_t;
typedef short bf16x8 __attribute__((ext_vector_type(8)));
typedef float f32x4 __attribute__((ext_vector_type(4)));
typedef unsigned u32x4 __attribute__((ext_vector_type(4)));
constexpr int BM = 256, BK = 64, HALF = 128, HTB = HALF * BK * 2  , STAGE_BYTES = 8 * HTB, NXCD = 8, WGM = 8;

__host__ __device__ __forceinline__ int lds_byte(int r, int c) { const int st = (r >> 4) * 2 + (c >> 5), rr = r & 15, cc = c & 31, ob = rr * 64 + cc * 2; return st * 1024 + (ob ^ (((ob >> 9) & 1) << 5)); }
__host__ __device__ __forceinline__ void stage_rc(int b, int& R, int& C) { const int st = b / 1024, sb = b % 1024, swz = sb ^ (((sb >> 9) & 1) << 5); R = (st >> 1) * 16 + swz / 64; C = (st & 1) * 32 + (swz % 64) / 2; }
__host__ __device__ __forceinline__ int perm32(int rho) { const int n = rho >> 4, i = rho & 15; return 8 * (i >> 2) + 4 * n + (i & 3); }

struct Unit { int pm, pn, ord; };
struct Gemm { const bf16_t* A; const bf16_t* Bt; int M, N, K, pad; };

template <class E, class = void> struct UseF8 { static constexpr bool v = false; };
template <class E> struct UseF8<E, decltype((void)E::F8)> { static constexpr bool v = E::F8; };
typedef int i32x4_t __attribute__((ext_vector_type(4))); typedef int i32x8_t __attribute__((ext_vector_type(8)));
template <bool F8> struct FragT { bf16x8 f[2]; __device__ __forceinline__ void set(int k, bf16x8 x) { f[k] = x; } };
template <> struct FragT<true> { i32x8_t v;
    __device__ __forceinline__ void set(int k, bf16x8 x) { const i32x4_t y = __builtin_bit_cast(i32x4_t, x); const i32x8_t y8 = __builtin_shufflevector(y, y, 0, 1, 2, 3, 0, 1, 2, 3);
        if (k == 0) v = __builtin_shufflevector(y8, v, 0, 1, 2, 3, 12, 13, 14, 15); else v = __builtin_shufflevector(v, y8, 0, 1, 2, 3, 8, 9, 10, 11); } };
__device__ __forceinline__ i32x8_t cat16(bf16x8 a, bf16x8 b) { const i32x4_t x = __builtin_bit_cast(i32x4_t, a), y = __builtin_bit_cast(i32x4_t, b); return __builtin_shufflevector(x, y, 0, 1, 2, 3, 4, 5, 6, 7); }
struct StaticOrder {
    static constexpr bool GATHER = false;
    int nM, nN, nwg, G, c;
    __host__ __device__ __forceinline__ void init(int M, int N, int G_, int c_) { nM = M / BM; nN = N / BM; nwg = nM * nN; G = G_; c = c_; }
    __host__ __device__ __forceinline__ bool next(int i, Unit& u) const {
        const long L = (long)i * G + c; if (L >= nwg) return false;
        int wgid = (int)L; { const int q = nwg / NXCD, r = nwg % NXCD, xcd = wgid % NXCD, off = wgid / NXCD; wgid = (xcd < r ? xcd * (q + 1) : r * (q + 1) + (xcd - r) * q) + off; }
        const int nig = WGM * nN, gid = wgid / nig, fm = gid * WGM, gsz = (nM - fm) < WGM ? (nM - fm) : WGM;
        u.pm = fm + ((wgid % nig) % gsz); u.pn = (wgid % nig) / gsz; return true;
    }
    __device__ __forceinline__ size_t bbase(const Unit& u, size_t tstep) const { return (size_t)u.pn * tstep; }
    __device__ __forceinline__ int arow(const Unit&, int) const { return 0; }
    __device__ __forceinline__ void a_ready(const Unit&) const {}
    __device__ __forceinline__ void done(const Unit&) const {}
};

__device__ __forceinline__ unsigned cvt_pk_bf16(float lo, float hi) { unsigned r; asm volatile("v_cvt_pk_bf16_f32 %0, %1, %2" : "=v"(r) : "v"(lo), "v"(hi)); return r; }
typedef float f32x2 __attribute__((ext_vector_type(2)));
template <class Epi, class Sched, bool ALIGN_EPI = false, bool SP2 = false>
__device__ __forceinline__ void gemm_phase(PG8_LAS unsigned char* lds, const Gemm g, const Sched& S, const Epi& E) {
    int tid_ = threadIdx.x; asm volatile("" : "+v"(tid_));
    const int tid = tid_, wid = __builtin_amdgcn_readfirstlane(tid >> 6), lane = tid & 63, wr = wid >> 2, wc = wid & 3, fr = lane & 15, fq = lane >> 4;
    int K_ = g.K; asm volatile("" : "+s"(K_));
    const int K = K_, nt = K / BK;
    unsigned voffA[2], voffB[2]; int gR[2], gC[2]; unsigned va[2][2], vnx[2][2];
#pragma unroll
    for (int i = 0; i < 2; ++i) { int R, C; stage_rc(tid * 16 + i * 8192, R, C); const int Rb = Epi::PERM ? ((R & ~31) + perm32(R & 31)) : R;
        voffA[i] = (unsigned)(R * K + C) * 2u; voffB[i] = (unsigned)(Rb * K + C) * 2u; gR[i] = R; gC[i] = C; }
    const size_t kstep = (size_t)(BK * 2);
    const size_t hstep = (size_t)HALF * K * 2;
    const size_t tstep = 2 * hstep;
    const unsigned ldsw = (unsigned)wid * 1024u;
    const int aoff = lds_byte(wr * 64 + fr, fq * 8), boff = lds_byte(wc * 32 + fr, fq * 8);
#define PG8_SA(b, h) (((b) * 2 + (h)) * HTB)
#define PG8_SB(b, h) ((4 + (b) * 2 + (h)) * HTB)
#define PG8_STAGE(bufoff, gbase, voff) do { _Pragma("unroll") for (int _i = 0; _i < 2; ++_i) \
        __builtin_amdgcn_global_load_lds((const unsigned*)((const char*)(gbase) + (voff)[_i]), (PG8_LAS unsigned*)(lds + (bufoff) + ldsw + _i * 8192), 16, 0, 0); } while (0)
#define PG8_STAGE_A(bufoff, kptr, h, nx) do { if constexpr (Sched::GATHER) { const unsigned o_[2] = {(nx) ? vnx[h][0] : va[h][0], (nx) ? vnx[h][1] : va[h][1]}; PG8_STAGE(bufoff, kptr, o_); } \
        else { PG8_STAGE(bufoff, (kptr) + (h) * hstep, voffA); } } while (0)
#define PG8_GOFF(dst, u) do { _Pragma("unroll") for (int h_ = 0; h_ < 2; ++h_) _Pragma("unroll") for (int i_ = 0; i_ < 2; ++i_) dst[h_][i_] = (unsigned)S.arow(u, h_ * HALF + gR[i_]) * (unsigned)(K * 2) + (unsigned)(gC[i_] * 2); } while (0)
#define PG8_LDA(dst, b, h) do { _Pragma("unroll") for (int m = 0; m < 4; ++m) _Pragma("unroll") for (int k = 0; k < 2; ++k) dst[m].set(k, *(const PG8_LAS bf16x8*)(lds + PG8_SA(b, h) + aoff + m * 2048 + k * 1024)); } while (0)
#define PG8_LDB(dst, b, h) do { _Pragma("unroll") for (int n = 0; n < 2; ++n) _Pragma("unroll") for (int k = 0; k < 2; ++k) dst[n].set(k, *(const PG8_LAS bf16x8*)(lds + PG8_SB(b, h) + boff + n * 2048 + k * 1024)); } while (0)
#define PG8_MMA(ai, bj, At, Bt) do { __builtin_amdgcn_s_setprio(1); if constexpr (UseF8<Epi>::v) { _Pragma("unroll") for (int m = 0; m < 4; ++m) _Pragma("unroll") for (int n = 0; n < 2; ++n) \
        asm("v_mfma_scale_f32_16x16x128_f8f6f4 %0, %1, %2, %0, %3, %3 op_sel_hi:[0,0,0]" : "+v"(acc[ai][bj][m][n]) : "v"(Bt[n].v), "v"(At[m].v), "v"(0x7f7f7f7f));     \
        } else { \
        _Pragma("unroll") for (int m = 0; m < 4; ++m) _Pragma("unroll") for (int n = 0; n < 2; ++n) _Pragma("unroll") for (int k = 0; k < 2; ++k) \
        acc[ai][bj][m][n] = __builtin_amdgcn_mfma_f32_16x16x32_bf16(Bt[n].f[k], At[m].f[k], acc[ai][bj][m][n], 0, 0, 0); } __builtin_amdgcn_s_setprio(0); } while (0)
#define PG8_WAIT_V(n) asm volatile("s_waitcnt vmcnt(" #n ")" ::: "memory")
#define PG8_WAIT_L(n) asm volatile("s_waitcnt lgkmcnt(" #n ")" ::: "memory")
#define PG8_BAR __builtin_amdgcn_s_barrier()
#define PG8_SCHED __builtin_amdgcn_sched_barrier(0)
    Unit cur, nxt; int ui = 0;
    if (!S.next(0, cur)) return;
    cur.ord = 0;
    f32x4 acc[2][2][4][2];
#pragma unroll
    for (int a = 0; a < 2; ++a)
#pragma unroll
        for (int b = 0; b < 2; ++b)
#pragma unroll
            for (int m = 0; m < 4; ++m)
#pragma unroll
                for (int n = 0; n < 2; ++n) acc[a][b][m][n] = (f32x4){0.f, 0.f, 0.f, 0.f};
    FragT<UseF8<Epi>::v> At[4], B0[2], B1[2];
    static_assert(!Sched::GATHER || SP2, "the gathered A operand is wired into the SP2 loop only");
    const char* cA = (const char*)g.A + (Sched::GATHER ? (size_t)0 : (size_t)cur.pm * tstep); const char* cB = (const char*)g.Bt + S.bbase(cur, tstep);
    if constexpr (Sched::GATHER) { PG8_GOFF(va, cur); _Pragma("unroll") for (int h_ = 0; h_ < 2; ++h_) _Pragma("unroll") for (int i_ = 0; i_ < 2; ++i_) vnx[h_][i_] = va[h_][i_]; }
    S.a_ready(cur);
    if constexpr (SP2) {
        PG8_STAGE(PG8_SB(0, 0), cB, voffB); PG8_STAGE(PG8_SB(0, 1), cB + hstep, voffB); PG8_STAGE_A(PG8_SA(0, 0), cA, 0, false); PG8_STAGE_A(PG8_SA(0, 1), cA, 1, false);
        if (wr == 1) PG8_BAR;
        PG8_WAIT_V(2); PG8_BAR;
        PG8_STAGE(PG8_SB(1, 0), cB + kstep, voffB); PG8_STAGE_A(PG8_SA(1, 0), cA + kstep, 0, false); PG8_STAGE(PG8_SB(1, 1), cB + hstep + kstep, voffB);
        PG8_WAIT_V(6); PG8_BAR;
    } else {
        PG8_STAGE(PG8_SB(0, 0), cB, voffB); PG8_STAGE(PG8_SA(0, 0), cA, voffA); PG8_STAGE(PG8_SB(0, 1), cB + hstep, voffB); PG8_STAGE(PG8_SA(0, 1), cA + hstep, voffA);
        if (wr == 1) PG8_BAR;
        PG8_WAIT_V(4); PG8_BAR;
        PG8_STAGE(PG8_SB(1, 0), cB + kstep, voffB); PG8_STAGE(PG8_SA(1, 0), cA + kstep, voffA); PG8_STAGE(PG8_SB(1, 1), cB + hstep + kstep, voffB);
        PG8_WAIT_V(6); PG8_BAR;
    }
    for (;;) {
        const bool has_next = S.next(ui + 1, nxt); nxt.ord = ui + 1;
        if constexpr (Sched::GATHER) { if (has_next) PG8_GOFF(vnx, nxt); }
        const char* nA = (has_next && !Sched::GATHER) ? (const char*)g.A + (size_t)nxt.pm * tstep : cA; const char* nB = has_next ? (const char*)g.Bt + S.bbase(nxt, tstep) : cB;
        for (int t = 0; t < nt; t += 2) {
            const bool last = (t == nt - 2); const bool lastnx = last && has_next; (void)lastnx;
            const char* a1 = cA + (size_t)(t + 1) * kstep;
            const char* a2 = last ? nA : cA + (size_t)(t + 2) * kstep; const char* b2 = last ? nB : cB + (size_t)(t + 2) * kstep;
            const char* a3 = a2 + kstep; const char* b3 = b2 + kstep;
            if (last && has_next) S.a_ready(nxt);
            if constexpr (SP2) {
            PG8_LDB(B0, 0, 0); PG8_LDB(B1, 0, 1); PG8_SCHED; PG8_LDA(At, 0, 0); PG8_STAGE_A(PG8_SA(1, 1), a1, 1, false);
            PG8_WAIT_V(8); PG8_WAIT_L(0); PG8_BAR; PG8_MMA(0, 0, At, B0); PG8_MMA(0, 1, At, B1); PG8_BAR; PG8_SCHED;
            PG8_LDA(At, 0, 1); PG8_STAGE(PG8_SB(0, 0), b2, voffB); PG8_STAGE(PG8_SB(0, 1), b2 + hstep, voffB); PG8_STAGE_A(PG8_SA(0, 0), a2, 0, lastnx);
            PG8_WAIT_V(8); PG8_WAIT_L(0); PG8_BAR; PG8_MMA(1, 0, At, B0); PG8_MMA(1, 1, At, B1); PG8_BAR; PG8_SCHED;
            PG8_LDB(B0, 1, 0); PG8_LDB(B1, 1, 1); PG8_SCHED; PG8_LDA(At, 1, 0); PG8_STAGE_A(PG8_SA(0, 1), a2, 1, lastnx);
            PG8_WAIT_V(8); PG8_WAIT_L(0); PG8_BAR; PG8_MMA(0, 0, At, B0); PG8_MMA(0, 1, At, B1); PG8_BAR; PG8_SCHED;
            PG8_LDA(At, 1, 1); PG8_STAGE(PG8_SB(1, 0), b3, voffB); PG8_STAGE(PG8_SB(1, 1), b3 + hstep, voffB); PG8_STAGE_A(PG8_SA(1, 0), a3, 0, lastnx);
            PG8_WAIT_V(8); PG8_WAIT_L(0); PG8_BAR; PG8_MMA(1, 0, At, B0); PG8_MMA(1, 1, At, B1); PG8_BAR; PG8_SCHED;
            } else {
            PG8_LDB(B0, 0, 0); PG8_SCHED; PG8_LDA(At, 0, 0); PG8_STAGE(PG8_SA(1, 1), a1 + hstep, voffA);
            PG8_WAIT_L(8); PG8_BAR; PG8_WAIT_L(0); PG8_MMA(0, 0, At, B0); PG8_BAR; PG8_SCHED;
            PG8_LDB(B1, 0, 1); PG8_STAGE(PG8_SB(0, 0), b2, voffB);
            PG8_BAR; PG8_WAIT_L(0); PG8_MMA(0, 1, At, B1); PG8_BAR;
            PG8_LDA(At, 0, 1); PG8_STAGE(PG8_SA(0, 0), a2, voffA);
            PG8_BAR; PG8_WAIT_L(0); PG8_MMA(1, 0, At, B0); PG8_BAR; PG8_SCHED;
            PG8_STAGE(PG8_SB(0, 1), b2 + hstep, voffB);
            PG8_WAIT_V(6); PG8_BAR; PG8_MMA(1, 1, At, B1); PG8_BAR;
            PG8_LDB(B0, 1, 0); PG8_SCHED; PG8_LDA(At, 1, 0); PG8_STAGE(PG8_SA(0, 1), a2 + hstep, voffA);
            PG8_WAIT_L(8); PG8_BAR; PG8_WAIT_L(0); PG8_MMA(0, 0, At, B0); PG8_BAR; PG8_SCHED;
            PG8_LDB(B1, 1, 1); PG8_STAGE(PG8_SB(1, 0), b3, voffB);
            PG8_BAR; PG8_WAIT_L(0); PG8_MMA(0, 1, At, B1); PG8_BAR;
            PG8_LDA(At, 1, 1); PG8_STAGE(PG8_SA(1, 0), a3, voffA);
            PG8_BAR; PG8_WAIT_L(0); PG8_MMA(1, 0, At, B0); PG8_BAR; PG8_SCHED;
            PG8_STAGE(PG8_SB(1, 1), b3 + hstep, voffB);
            PG8_WAIT_V(6); PG8_BAR; PG8_MMA(1, 1, At, B1); PG8_BAR;
            }
        }
        if constexpr (ALIGN_EPI) { if (wr == 0) PG8_BAR; }
        if constexpr (!Epi::AFTER_DRAIN) { E(acc, cur, wr, wc, fr, fq); S.done(cur); }
        if (!has_next) break;
#pragma unroll
        for (int a = 0; a < 2; ++a)
#pragma unroll
            for (int b = 0; b < 2; ++b)
#pragma unroll
                for (int m = 0; m < 4; ++m)
#pragma unroll
                    for (int n = 0; n < 2; ++n) acc[a][b][m][n] = (f32x4){0.f, 0.f, 0.f, 0.f};
        cur = nxt; cA = nA; cB = nB; ++ui;
        if constexpr (Sched::GATHER) { _Pragma("unroll") for (int h_ = 0; h_ < 2; ++h_) _Pragma("unroll") for (int i_ = 0; i_ < 2; ++i_) va[h_][i_] = vnx[h_][i_]; }
        if constexpr (ALIGN_EPI) { if (wr == 1) PG8_BAR; }
    }
    PG8_WAIT_V(0);
    if constexpr (!ALIGN_EPI) { if (wr == 0) PG8_BAR; }
    PG8_BAR;
    if constexpr (Epi::AFTER_DRAIN) { E.fused(acc, cur, wr, wc, fr, fq, lds, wid, lane); S.done(cur); }
#undef PG8_SA
#undef PG8_SB
#undef PG8_STAGE
#undef PG8_STAGE_A
#undef PG8_GOFF
#undef PG8_LDA
#undef PG8_LDB
#undef PG8_MMA
#undef PG8_WAIT_V
#undef PG8_WAIT_L
#undef PG8_BAR
#undef PG8_SCHED
}
}

#define DEVI __device__ __forceinline__
typedef unsigned short bf16_t;
typedef float f32x4 __attribute__((ext_vector_type(4)));
typedef unsigned u32x4 __attribute__((ext_vector_type(4)));
typedef unsigned u32x2 __attribute__((ext_vector_type(2)));

constexpr int T = 65536, D = 1024, SEQ = 2048, NB = 32, DEPTH = 2;
constexpr int NZ = 3328;
constexpr int ZQA = 0, ZKA = 384, ZVA = 768, ZIF = 1152, ZQB = 1280, ZKB = 1664, ZVB = 2048, ZOB = 2432, ZUC = 2816, ZVC = 3072;
constexpr int NEXP = 32, DEXP = 256, PDIM = 256;
constexpr int MAXROWS = 2 * T + NEXP * 256;
constexpr float EPS = 1e-6f;

constexpr size_t MiB = 1u << 20;
constexpr size_t WS_CTL = 0;
constexpr size_t WS_GATES = 1 * MiB;
constexpr size_t WS_SSP = 3 * MiB;
constexpr size_t WS_TOKE = 7 * MiB;
constexpr size_t WS_TOKW = 7 * MiB + 512 * 1024;
constexpr size_t WS_RSTD2 = 8 * MiB;
constexpr size_t WS_RSTD3 = 8 * MiB + 256 * 1024;
constexpr size_t WS_RANK = 8 * MiB + 512 * 1024;
constexpr size_t WS_ROWTS = 9 * MiB;
constexpr size_t WS_ROWW = 10 * MiB;
constexpr size_t WS_ROWRS = 11 * MiB + 64 * 1024;
constexpr size_t WS_TILEE = 11 * MiB;
constexpr size_t WS_PSTART = 11 * MiB + 4096;
constexpr size_t WS_WR = 12 * MiB;
constexpr size_t WS_WSGU = 13 * MiB;
constexpr size_t WS_WTS = 16 * MiB;
constexpr size_t WL_IN = 0, WL_OUT = 6656 * 1024, WL_GU = WL_OUT + 2 * MiB, WL_DN = WL_GU + 32 * MiB, WL_PG = WL_DN + 16 * MiB, WL_PP = WL_PG + 2 * MiB, WL_SIZE = 59 * MiB;
constexpr size_t WS_PB = 134 * MiB;
constexpr size_t WS_HBA = 198 * MiB;
constexpr size_t WS_HBB = 326 * MiB;
constexpr size_t WS_YMIX = 454 * MiB;
constexpr size_t WS_A8 = 454 * MiB + 64 * MiB;
constexpr size_t WS_Z = 582 * MiB;
constexpr size_t WS_XS = WS_Z, WS_Y = WS_Z, WS_YSCL = WS_Z + 144 * MiB, WS_H8 = WS_Z + 160 * MiB, WS_PPSCL = WS_Z + 224 * MiB, WS_HID = WS_Z + 272 * MiB;
constexpr size_t WS_SSP2 = 998 * MiB;
constexpr size_t WS_END = 1002 * MiB;
static_assert(WL_PP + 512 * 1024 <= WL_SIZE, "weights map");
static_assert((size_t)MAXROWS * 1024 * 2 <= 272 * MiB && (size_t)MAXROWS * 256 * 2 <= 68 * MiB, "overlay map");
constexpr int CW_COUNT = 0;
constexpr int CW_NTILES = 64;
constexpr int TABF = 12, TAB_OFF = 131072 + 4096;

DEVI float bf2f(unsigned short b) { return __uint_as_float((unsigned)b << 16); }
typedef float f32x2_t __attribute__((ext_vector_type(2))); typedef __bf16 bf16x2_t __attribute__((ext_vector_type(2)));
DEVI unsigned pk2(float lo, float hi) { const f32x2_t v = {lo, hi}; return __builtin_bit_cast(unsigned, __builtin_convertvector(v, bf16x2_t)); }
DEVI unsigned f2bf(float f) { return pk2(f, 0.f) & 0xffffu; }
DEVI float wave_sum(float v) {
#pragma unroll
    for (int o = 1; o < 64; o <<= 1) v += __shfl_xor(v, o);
    return v;
}
DEVI float sigmoidf_(float x) { return 1.0f / (1.0f + __expf(-x)); }
DEVI float siluf_(float x) { return x * sigmoidf_(x); }
DEVI float gelu_tanh(float x) { const float u = 0.7978845608028654f * (x + 0.044715f * x * x * x); return 0.5f * x * (1.0f + tanhf(u)); }
DEVI float softplusf_(float x) { return fmaxf(x, 0.f) + log1pf(__expf(-fabsf(x))); }

using pg8::Unit;
struct EpiZ {
    static constexpr bool PERM = true, AFTER_DRAIN = false;
    bf16_t* Z; const float* rtab; float* gates;
    int ordbase;
    const float* cin; bf16_t* cout; int G, c;
    static constexpr int CVT_NCH = DEPTH * T * PDIM / 8, CVT_CPU = (CVT_NCH + 13 * 256 - 1) / (13 * 256);
    DEVI void operator()(const f32x4 (&acc)[2][2][4][2], const Unit& u, int wr, int wc, int fr, int fq) const {
        int row0 = u.pm * 256 + wr * 64 + fr, col0 = u.pn * 256 + wc * 32 + 8 * fq; asm volatile("" : "+v"(row0), "+v"(col0));
        const float* rt = rtab + u.ord * 256 + wr * 64 + fr;
        f32x4 cv[3][2]; int cch[3];
        if (cin != nullptr) { int t_ = (wr * 4 + wc) * 64 + fq * 16 + fr; asm volatile("" : "+v"(t_)); const int ch0 = ((u.ord + ordbase) * G + c) * CVT_CPU;
#pragma unroll
            for (int k = 0; k < 3; ++k) { const int o_ = t_ + 512 * k; cch[k] = (o_ < CVT_CPU && ch0 + o_ < CVT_NCH) ? ch0 + o_ : -1;
                if (cch[k] >= 0) { cv[k][0] = ((const f32x4*)cin)[2 * (size_t)cch[k]]; cv[k][1] = ((const f32x4*)cin)[2 * (size_t)cch[k] + 1]; } } }
#pragma unroll
        for (int ai = 0; ai < 2; ++ai)
#pragma unroll
            for (int m = 0; m < 4; ++m) {
                const int row = row0 + ai * 128 + m * 16;
                const float rs = rt[ai * 128 + m * 16];
                bf16_t* rowp = Z + (size_t)row * NZ + col0;
#pragma unroll
                for (int bj = 0; bj < 2; ++bj) {
                    const float sc = (u.pn == 0 || (u.pn == 1 && bj == 0)) ? rs * (0.125f * 1.4426950408889634f) : rs;
                    const f32x4 v0 = acc[ai][bj][m][0] * sc, v1 = acc[ai][bj][m][1] * sc;
                    u32x4 w; w.x = pk2(v0[0], v0[1]); w.y = pk2(v0[2], v0[3]); w.z = pk2(v1[0], v1[1]); w.w = pk2(v1[2], v1[3]);
                    *(u32x4*)(rowp + bj * 128) = w;
                    if (bj == 1 && u.pn == 4 && wc == 0 && fq == 0) { *(f32x4*)(gates + (size_t)row * 8) = v0; *(f32x4*)(gates + (size_t)row * 8 + 4) = v1; }
                }
            }
        if (cin != nullptr) {
#pragma unroll
            for (int k = 0; k < 3; ++k) if (cch[k] >= 0) { u32x4 w; w.x = pk2(cv[k][0][0], cv[k][0][1]); w.y = pk2(cv[k][0][2], cv[k][0][3]); w.z = pk2(cv[k][1][0], cv[k][1][1]); w.w = pk2(cv[k][1][2], cv[k][1][3]); ((u32x4*)cout)[cch[k]] = w; } }
    }
};
struct EpiZ8 : EpiZ { static constexpr bool F8 = true; };
struct SubsetOrder : pg8::StaticOrder {
    int kind;
    DEVI bool next(int i, Unit& u) const { if (!pg8::StaticOrder::next(i, u)) return false; u.pn = kind == 0 ? (u.pn < 2 ? u.pn + 3 : u.pn + 6) : (u.pn < 3 ? u.pn : u.pn + 2); return true; }
};
DEVI void unpack8(const u32x4 w, float (&f)[8]) { f[0] = __uint_as_float(w.x << 16); f[1] = __uint_as_float(w.x & 0xffff0000u); f[2] = __uint_as_float(w.y << 16); f[3] = __uint_as_float(w.y & 0xffff0000u);
    f[4] = __uint_as_float(w.z << 16); f[5] = __uint_as_float(w.z & 0xffff0000u); f[6] = __uint_as_float(w.w << 16); f[7] = __uint_as_float(w.w & 0xffff0000u); }
struct EpiResid {
    static constexpr bool PERM = true, AFTER_DRAIN = false;
    const bf16_t* hin; bf16_t* hout; float* ssp; unsigned char* h8;
    DEVI void operator()(const f32x4 (&acc)[2][2][4][2], const Unit& u, int wr, int wc, int fr, int fq) const {
        int row0 = u.pm * 256 + wr * 64 + fr, col0 = u.pn * 256 + wc * 32 + 8 * fq, cofs = u.pn * 256 + wc * 64 + fq * 16; asm volatile("" : "+v"(row0), "+v"(col0), "+v"(cofs));
#pragma unroll
        for (int ai = 0; ai < 2; ++ai) {
            u32x4 hv[4][2];
#pragma unroll
            for (int m = 0; m < 4; ++m)
#pragma unroll
                for (int bj = 0; bj < 2; ++bj) hv[m][bj] = *(const u32x4*)(hin + (size_t)(row0 + ai * 128 + m * 16) * D + col0 + bj * 128);
#pragma unroll
            for (int m = 0; m < 4; ++m) {
                const int row = row0 + ai * 128 + m * 16; const size_t off = (size_t)row * D + col0; float sacc = 0.f; u32x4 w8;
#pragma unroll
                for (int bj = 0; bj < 2; ++bj) {
                    float f[8]; unpack8(hv[m][bj], f);
                    const f32x4 v0 = acc[ai][bj][m][0], v1 = acc[ai][bj][m][1];
                    f[0] += v0[0]; f[1] += v0[1]; f[2] += v0[2]; f[3] += v0[3]; f[4] += v1[0]; f[5] += v1[1]; f[6] += v1[2]; f[7] += v1[3];
                    sacc += ((f[0] * f[0] + f[1] * f[1]) + (f[2] * f[2] + f[3] * f[3])) + ((f[4] * f[4] + f[5] * f[5]) + (f[6] * f[6] + f[7] * f[7]));
                    u32x4 w; w.x = pk2(f[0], f[1]); w.y = pk2(f[2], f[3]); w.z = pk2(f[4], f[5]); w.w = pk2(f[6], f[7]);
                    *(u32x4*)(hout + off + bj * 128) = w;
                    { int t = __builtin_amdgcn_cvt_pk_fp8_f32(f[0], f[1], 0, false); t = __builtin_amdgcn_cvt_pk_fp8_f32(f[2], f[3], t, true); w8[2 * bj] = (unsigned)t;
                      t = __builtin_amdgcn_cvt_pk_fp8_f32(f[4], f[5], 0, false); t = __builtin_amdgcn_cvt_pk_fp8_f32(f[6], f[7], t, true); w8[2 * bj + 1] = (unsigned)t; }
                }
                *(u32x4*)(h8 + (size_t)row * 1024 + cofs) = w8;
                sacc += __shfl_xor(sacc, 16); sacc += __shfl_xor(sacc, 32);
                if (fq == 0) ssp[(size_t)row * 16 + u.pn * 4 + wc] = sacc;
            }
        }
    }
};
struct EpiPLE {
    static constexpr bool PERM = true, AFTER_DRAIN = false, F8 = true;
    const float* rstd3; const unsigned char* pp8; const float* ppscl; const bf16_t* hin; bf16_t* hout; float* ssp; unsigned char* a8;
    DEVI void operator()(const f32x4 (&acc)[2][2][4][2], const Unit& u, int wr, int wc, int fr, int fq) const {
        int row0 = u.pm * 256 + wr * 64 + fr, col0 = u.pn * 256 + wc * 32 + 8 * fq, cofs = u.pn * 256 + wc * 64 + fq * 16; asm volatile("" : "+v"(row0), "+v"(col0), "+v"(cofs));
#pragma unroll
        for (int b = 0; b < 4; ++b) {
            const int ai = b >> 1, m0 = (b & 1) * 2;
            u32x4 hv[2][2], pv8[2]; float rsv[2], psc[2];
#pragma unroll
            for (int j = 0; j < 2; ++j) { const int row = row0 + ai * 128 + (m0 + j) * 16; rsv[j] = rstd3[row]; psc[j] = ppscl[(size_t)row * 16 + u.pn * 4 + wc]; pv8[j] = *(const u32x4*)(pp8 + (size_t)row * 1024 + cofs);
#pragma unroll
                for (int bj = 0; bj < 2; ++bj) hv[j][bj] = *(const u32x4*)(hin + (size_t)row * D + col0 + bj * 128); }
#pragma unroll
            for (int j = 0; j < 2; ++j) { const int m = m0 + j;
                const int row = row0 + ai * 128 + m * 16; const size_t off = (size_t)row * D + col0; const float rs = rsv[j];
                float sacc = 0.f; u32x4 w8;
#pragma unroll
                for (int bj = 0; bj < 2; ++bj) {
                    float hf[8], pf[8]; unpack8(hv[j][bj], hf);
#pragma unroll
                    for (int d = 0; d < 2; ++d) { const int wq = (int)pv8[j][2 * bj + d]; const f32x2_t lo = __builtin_amdgcn_cvt_pk_f32_fp8(wq, false), hi2 = __builtin_amdgcn_cvt_pk_f32_fp8(wq, true);
                        pf[4 * d + 0] = lo.x * psc[j]; pf[4 * d + 1] = lo.y * psc[j]; pf[4 * d + 2] = hi2.x * psc[j]; pf[4 * d + 3] = hi2.y * psc[j]; }
                    float o[8];
#pragma unroll
                    for (int i = 0; i < 8; ++i) { const float a = acc[ai][bj][m][i >> 2][i & 3] * rs; o[i] = hf[i] + __builtin_amdgcn_rcpf(1.0f + __expf(-a)) * pf[i]; sacc += o[i] * o[i]; }
                    u32x4 w; w.x = pk2(o[0], o[1]); w.y = pk2(o[2], o[3]); w.z = pk2(o[4], o[5]); w.w = pk2(o[6], o[7]);
                    *(u32x4*)(hout + off + bj * 128) = w;
                    { int t = __builtin_amdgcn_cvt_pk_fp8_f32(o[0], o[1], 0, false); t = __builtin_amdgcn_cvt_pk_fp8_f32(o[2], o[3], t, true); w8[2 * bj] = (unsigned)t;
                      t = __builtin_amdgcn_cvt_pk_fp8_f32(o[4], o[5], 0, false); t = __builtin_amdgcn_cvt_pk_fp8_f32(o[6], o[7], t, true); w8[2 * bj + 1] = (unsigned)t; }
                }
                if (a8 != nullptr) *(u32x4*)(a8 + (size_t)row * 1024 + cofs) = w8;
                sacc += __shfl_xor(sacc, 16); sacc += __shfl_xor(sacc, 32);
                if (fq == 0) ssp[(size_t)row * 16 + u.pn * 4 + wc] = sacc;
            }
        }
    }
};
struct EpiGU {
    static constexpr bool PERM = true, AFTER_DRAIN = false, F8 = true;
    const float* row_rs; unsigned char* hid; const float* tab; int ntab;
    DEVI void operator()(const f32x4 (&acc)[2][2][4][2], const Unit& u, int wr, int wc, int fr, int fq) const {
        int row0 = u.pm * 256 + wr * 64 + fr; asm volatile("" : "+v"(row0));
        float rsv[2][4];
        { const float* tp = tab + (u.ord < ntab ? u.ord : 0) * 256 + wr * 64 + fr;
#pragma unroll
            for (int ai = 0; ai < 2; ++ai)
#pragma unroll
                for (int m = 0; m < 4; ++m) { rsv[ai][m] = tp[ai * 128 + m * 16]; asm volatile("" : "+v"(rsv[ai][m])); } }
        if (u.ord >= ntab) {
#pragma unroll
            for (int ai = 0; ai < 2; ++ai)
#pragma unroll
                for (int m = 0; m < 4; ++m) rsv[ai][m] = row_rs[row0 + ai * 128 + m * 16];
        }
#pragma unroll
        for (int ai = 0; ai < 2; ++ai)
#pragma unroll
            for (int m = 0; m < 4; ++m) {
                const int row = row0 + ai * 128 + m * 16;
                const float rs = rsv[ai][m];
                float hv[8];
#pragma unroll
                for (int n = 0; n < 2; ++n)
#pragma unroll
                    for (int i = 0; i < 4; ++i) { const float g = acc[ai][0][m][n][i] * rs, uu = acc[ai][1][m][n][i] * rs; hv[n * 4 + i] = siluf_(g) * uu; }
                u32x2 w; { int t = __builtin_amdgcn_cvt_pk_fp8_f32(hv[0], hv[1], 0, false); t = __builtin_amdgcn_cvt_pk_fp8_f32(hv[2], hv[3], t, true); w.x = (unsigned)t;
                    t = __builtin_amdgcn_cvt_pk_fp8_f32(hv[4], hv[5], 0, false); t = __builtin_amdgcn_cvt_pk_fp8_f32(hv[6], hv[7], t, true); w.y = (unsigned)t; }
                *(u32x2*)(hid + (size_t)row * DEXP + u.pn * 128 + wc * 32 + 8 * fq) = w;
            }
    }
};
struct EpiDown {
    static constexpr bool PERM = true, AFTER_DRAIN = false, F8 = true;
    const float* row_w; unsigned char* Y8; float* yscl; const float* tab; int ntab;
    DEVI void operator()(const f32x4 (&acc)[2][2][4][2], const Unit& u, int wr, int wc, int fr, int fq) const {
        int row0 = u.pm * 256 + wr * 64 + fr, cofs = u.pn * 256 + wc * 64 + fq * 16; asm volatile("" : "+v"(row0), "+v"(cofs));
        float wv[2][4];
        { const float* tp = tab + (u.ord < ntab ? u.ord : 0) * 256 + wr * 64 + fr;
#pragma unroll
            for (int ai = 0; ai < 2; ++ai)
#pragma unroll
                for (int m = 0; m < 4; ++m) { wv[ai][m] = tp[ai * 128 + m * 16]; asm volatile("" : "+v"(wv[ai][m])); } }
        if (u.ord >= ntab) {
#pragma unroll
            for (int ai = 0; ai < 2; ++ai)
#pragma unroll
                for (int m = 0; m < 4; ++m) wv[ai][m] = row_w[row0 + ai * 128 + m * 16];
        }
#pragma unroll
        for (int ai = 0; ai < 2; ++ai)
#pragma unroll
            for (int m = 0; m < 4; ++m) {
                const float wt = wv[ai][m]; const int row = row0 + ai * 128 + m * 16;
                f32x4 v[4]; float amax = 0.f;
#pragma unroll
                for (int bj = 0; bj < 2; ++bj)
#pragma unroll
                    for (int n = 0; n < 2; ++n) { v[bj * 2 + n] = acc[ai][bj][m][n] * wt;
#pragma unroll
                        for (int i = 0; i < 4; ++i) amax = fmaxf(amax, fabsf(v[bj * 2 + n][i])); }
                amax = fmaxf(amax, __shfl_xor(amax, 16)); amax = fmaxf(amax, __shfl_xor(amax, 32));
                const float sc = amax > 1e-30f ? 440.0f * __builtin_amdgcn_rcpf(amax) : 0.f;
                u32x4 w;
#pragma unroll
                for (int d = 0; d < 4; ++d) { const f32x4 q = v[d] * sc; int t = __builtin_amdgcn_cvt_pk_fp8_f32(q[0], q[1], 0, false); t = __builtin_amdgcn_cvt_pk_fp8_f32(q[2], q[3], t, true); w[d] = (unsigned)t; }
                __builtin_nontemporal_store(w, (u32x4*)(Y8 + (size_t)row * 1024 + cofs));
                if (fq == 0) yscl[(size_t)row * 16 + u.pn * 4 + wc] = amax * (1.0f / 440.0f);
            }
    }
};
struct EpiNull {
    static constexpr bool PERM = true, AFTER_DRAIN = false;
    float* sink;
    DEVI void operator()(const f32x4 (&acc)[2][2][4][2], const Unit& u, int wr, int wc, int fr, int fq) const {
        float s = 0.f;
#pragma unroll
        for (int ai = 0; ai < 2; ++ai)
#pragma unroll
            for (int bj = 0; bj < 2; ++bj)
#pragma unroll
                for (int m = 0; m < 4; ++m)
#pragma unroll
                    for (int n = 0; n < 2; ++n) s += acc[ai][bj][m][n][0];
        if (s == 1.2345e-30f) sink[0] = s;
    }
};
struct EpiRouter {
    static constexpr bool PERM = false, AFTER_DRAIN = true;
    const float* ssp; const float* rgb; const float* reb; int* tokE; float* tokW; float* rstd2; int* rank; unsigned* count;
    DEVI void fused(f32x4 (&acc)[2][2][4][2], const Unit& u, int wr, int wc, int fr, int fq, PG8_LAS unsigned char* lds, int wid, int lane) const {
        PG8_LAS float* lg = (PG8_LAS float*)lds;
        PG8_LAS int* hist = (PG8_LAS int*)(lds + 256 * 97 * 4); PG8_LAS int* wgb = hist + 32; PG8_LAS int* selE = wgb + 32; PG8_LAS int* selR = selE + 512;
        const int tid = wid * 64 + lane;
        if (tid < 32) hist[tid] = 0;
        if (wc < 3) {
#pragma unroll
            for (int ai = 0; ai < 2; ++ai)
#pragma unroll
                for (int m = 0; m < 4; ++m) { const int r = ai * 128 + wr * 64 + m * 16 + fr;
#pragma unroll
                    for (int n = 0; n < 2; ++n)
#pragma unroll
                        for (int i = 0; i < 4; ++i) lg[r * 97 + 32 * wc + 16 * n + 4 * fq + i] = acc[ai][0][m][n][i]; }
        }
        asm volatile("s_waitcnt lgkmcnt(0)" ::: "memory"); __builtin_amdgcn_s_barrier(); asm volatile("" ::: "memory");
        if (tid < 256) {
            const int t = u.pm * 256 + tid; PG8_LAS const float* l0 = lg + tid * 97;
            const f32x4* sp = (const f32x4*)(ssp + (size_t)t * 16); const f32x4 st = (sp[0] + sp[1]) + (sp[2] + sp[3]);
            const float rs = rsqrtf(((st[0] + st[1]) + (st[2] + st[3])) * (1.0f / 1024.0f) + EPS);
            float gl[4]; int gtop = 0; float gmax;
#pragma unroll
            for (int n = 0; n < 4; ++n) gl[n] = (l0[n] + l0[48 + n]) * rs + rgb[n];
            gmax = gl[0];
#pragma unroll
            for (int n = 1; n < 4; ++n) if (gl[n] > gmax) { gmax = gl[n]; gtop = n; }
            float den = 0.f;
#pragma unroll
            for (int n = 0; n < 4; ++n) den += __expf(gl[n] - gmax);
            const float gw = 1.0f / den;
            float el[8];
#pragma unroll
            for (int jj = 0; jj < 8; ++jj) el[jj] = (l0[4 + gtop * 8 + jj] + l0[52 + gtop * 8 + jj]) * rs + reb[gtop * 8 + jj];
            int i1 = 0; float v1 = el[0];
#pragma unroll
            for (int jj = 1; jj < 8; ++jj) if (el[jj] > v1) { v1 = el[jj]; i1 = jj; }
            int i2 = -1; float v2 = -INFINITY;
#pragma unroll
            for (int jj = 0; jj < 8; ++jj) if (jj != i1 && el[jj] > v2) { v2 = el[jj]; i2 = jj; }
            const float ex = __expf(v2 - v1), w1 = 1.0f / (1.0f + ex), w2 = ex * w1;
            const int e1 = gtop * 8 + i1, e2 = gtop * 8 + i2;
            tokE[t * 2] = e1; tokE[t * 2 + 1] = e2; tokW[t * 2] = w1 * gw; tokW[t * 2 + 1] = w2 * gw; rstd2[t] = rs;
            selE[tid * 2] = e1; selE[tid * 2 + 1] = e2; selR[tid * 2] = __hip_atomic_fetch_add(hist + e1, 1, __ATOMIC_RELAXED, __HIP_MEMORY_SCOPE_WORKGROUP); selR[tid * 2 + 1] = __hip_atomic_fetch_add(hist + e2, 1, __ATOMIC_RELAXED, __HIP_MEMORY_SCOPE_WORKGROUP);
        }
        asm volatile("s_waitcnt lgkmcnt(0)" ::: "memory"); __builtin_amdgcn_s_barrier(); asm volatile("" ::: "memory");
        if (tid < 32) wgb[tid] = (int)atomicAdd(count + tid, (unsigned)hist[tid]);
        asm volatile("s_waitcnt vmcnt(0) lgkmcnt(0)" ::: "memory"); __builtin_amdgcn_s_barrier(); asm volatile("" ::: "memory");
        rank[u.pm * 512 + tid] = wgb[selE[tid]] + selR[tid];
        asm volatile("s_waitcnt lgkmcnt(0)" ::: "memory"); __builtin_amdgcn_s_barrier(); asm volatile("" ::: "memory");
    }
};
struct EpiPlain {
    static constexpr bool PERM = true, AFTER_DRAIN = false;
    bf16_t* O; int ldc, pad;
    DEVI void operator()(const f32x4 (&acc)[2][2][4][2], const Unit& u, int wr, int wc, int fr, int fq) const {
        int row0 = u.pm * 256 + wr * 64 + fr, col0 = u.pn * 256 + wc * 32 + 8 * fq; asm volatile("" : "+v"(row0), "+v"(col0));
#pragma unroll
        for (int ai = 0; ai < 2; ++ai)
#pragma unroll
            for (int m = 0; m < 4; ++m) {
                bf16_t* rowp = O + (size_t)(row0 + ai * 128 + m * 16) * ldc + col0;
#pragma unroll
                for (int bj = 0; bj < 2; ++bj) {
                    const f32x4 v0 = acc[ai][bj][m][0], v1 = acc[ai][bj][m][1];
                    u32x4 w; w.x = pk2(v0[0], v0[1]); w.y = pk2(v0[2], v0[3]); w.z = pk2(v1[0], v1[1]); w.w = pk2(v1[2], v1[3]);
                    *(u32x4*)(rowp + bj * 128) = w;
                }
            }
    }
};
struct EpiPP8 {
    static constexpr bool PERM = true, AFTER_DRAIN = false;
    unsigned char* P8; float* pscl;
    DEVI void operator()(const f32x4 (&acc)[2][2][4][2], const Unit& u, int wr, int wc, int fr, int fq) const {
        int row0 = u.pm * 256 + wr * 64 + fr, cofs = u.pn * 256 + wc * 64 + fq * 16; asm volatile("" : "+v"(row0), "+v"(cofs));
#pragma unroll
        for (int ai = 0; ai < 2; ++ai)
#pragma unroll
            for (int m = 0; m < 4; ++m) {
                const int row = row0 + ai * 128 + m * 16; float amax = 0.f;
#pragma unroll
                for (int bj = 0; bj < 2; ++bj)
#pragma unroll
                    for (int n = 0; n < 2; ++n)
#pragma unroll
                        for (int i = 0; i < 4; ++i) amax = fmaxf(amax, fabsf(acc[ai][bj][m][n][i]));
                amax = fmaxf(amax, __shfl_xor(amax, 16)); amax = fmaxf(amax, __shfl_xor(amax, 32));
                const float sc = amax > 1e-30f ? 440.0f * __builtin_amdgcn_rcpf(amax) : 0.f;
                u32x4 w;
#pragma unroll
                for (int d = 0; d < 4; ++d) { const f32x4 q = acc[ai][d >> 1][m][d & 1] * sc; int t = __builtin_amdgcn_cvt_pk_fp8_f32(q[0], q[1], 0, false); t = __builtin_amdgcn_cvt_pk_fp8_f32(q[2], q[3], t, true); w[d] = (unsigned)t; }
                *(u32x4*)(P8 + (size_t)row * 1024 + cofs) = w;
                if (fq == 0) pscl[(size_t)row * 16 + u.pn * 4 + wc] = amax * (1.0f / 440.0f);
            }
    }
};
struct MoeOrder {
    static constexpr bool GATHER = false;
    int ntot, nN, G, c; const int* tile_e; size_t estride;
    DEVI void bind(const int* n_tiles_ptr, int G_, int c_) { ntot = __builtin_amdgcn_readfirstlane(*n_tiles_ptr) * nN; G = G_; c = c_; }
    DEVI bool next(int i, Unit& u) const { const long L = (long)i * G + c; if (L >= ntot) return false; u.pm = (int)(L / nN); u.pn = (int)(L % nN); return true; }
    DEVI size_t bbase(const Unit& u, size_t tstep) const { return (size_t)__builtin_amdgcn_readfirstlane(tile_e[u.pm]) * estride + (size_t)u.pn * tstep; }
    DEVI int arow(const Unit&, int) const { return 0; }
    DEVI void a_ready(const Unit&) const {}
    DEVI void done(const Unit&) const {}
};
struct MoeGatherOrder : MoeOrder {
    static constexpr bool GATHER = true;
    const int* row_ts;
    DEVI int arow(const Unit& u, int r) const { const int ts = row_ts[u.pm * 256 + r]; return ts >= 0 ? (ts >> 1) : 0; }
};
struct MoeDealOrder : MoeOrder {
    static constexpr int H = 8;
    int mt0, ntail, nD;
    DEVI bool next(int i, Unit& u) const {
        const int w = c;
        if (w < ntail) { if (i < 4) { u.pm = mt0 + w; u.pn = i; return true; } i -= 4; }
        const int nf = G - ntail; int d;
        if (w >= ntail && i < H) d = (w - ntail) + i * nf;
        else { const int ii = (w >= ntail) ? i - H : i, j = (w >= ntail) ? (w - ntail) : (w - ntail + G); d = H * nf + j + G * ii; }
        if (d >= nD) return false;
        u.pm = d >> 2; u.pn = d & 3; return true;
    }
};


#ifndef REP_SB
#define REP_SB 1
#endif
#ifndef REP_ML
#define REP_ML 1
#endif
#ifndef REP_SGU
#define REP_SGU 1
#endif
#ifndef REP_Z
#define REP_Z 1
#endif
#ifndef REP_PRO
#define REP_PRO 1
#endif
#ifndef REP_GATHER
#define REP_GATHER 1
#endif
#ifndef REP_GU
#define REP_GU 1
#endif
#ifndef REP_DOWN
#define REP_DOWN 1
#endif
#ifndef REP_PP
#define REP_PP 1
#endif
#ifndef REP_WOUT0
#define REP_WOUT0 1
#endif
#ifndef REP_BAR
#define REP_BAR 1
#endif
#ifndef REP_PLACE
#define REP_PLACE 1
#endif
#ifndef REP_PLE
#define REP_PLE 1
#endif
#ifndef REP_RTR
#define REP_RTR 1
#endif
#ifndef STG_Z
#define STG_Z 0
#endif
#ifndef STG_WOUT
#define STG_WOUT 0
#endif
#ifndef STG_GU
#define STG_GU 0
#endif
#ifndef STG_DOWN
#define STG_DOWN 0
#endif
#ifndef STG_PP
#define STG_PP 0
#endif
#ifndef STG_PLE
#define STG_PLE 0
#endif
#ifndef AL_Z
#define AL_Z true
#endif
#ifndef AL_WOUT
#define AL_WOUT true
#endif
#ifndef AL_GU
#define AL_GU true
#endif
#ifndef AL_DOWN
#define AL_DOWN true
#endif
#ifndef AL_PP
#define AL_PP true
#endif
#ifndef AL_PLE
#define AL_PLE true
#endif
constexpr int NTHR = 512;
constexpr int RING_BYTES = 147456;
constexpr int MISC_OFF = RING_BYTES;
constexpr int LDS_BYTES = RING_BYTES + 4096;
constexpr int CW_BAR = 4096;

#define XB_TMO      128
#define XB_XCNT(j)  (256  + 64 * (j))
#define XB_XSUB(j)  (1280 + 64 * (j))
#define XB_XGEN(j)  (2304 + 64 * (j))
#define XB_TOP      3328
#define XB_TOPGEN   3392
#define XCD_BAR_WORDS 3456
#define XB_SPIN_CAP (1u << 18)
#define LAS __attribute__((address_space(3)))

__device__ __forceinline__ unsigned xb_ld(unsigned* p)              { return __hip_atomic_load(p, __ATOMIC_RELAXED, __HIP_MEMORY_SCOPE_AGENT); }
__device__ __forceinline__ unsigned xb_add(unsigned* p, unsigned v) { return __hip_atomic_fetch_add(p, v, __ATOMIC_RELAXED, __HIP_MEMORY_SCOPE_AGENT); }
__device__ __forceinline__ unsigned xb_xcc_id() { return (unsigned)__builtin_amdgcn_s_getreg((3 << 11) | 20) & 0xFu; }
#define XB_SPIN(cond, bar) do { unsigned _sp = 0; while (cond) { __builtin_amdgcn_s_sleep(1); \
    if ((++_sp & 255u) == 0u) { if (xb_ld(&(bar)[XB_TMO])) break; if (_sp > XB_SPIN_CAP) { atomicAdd(&(bar)[XB_TMO], 1u); break; } } } } while (0)

struct XcdBarrier {
    unsigned* bar; unsigned x;
    volatile LAS unsigned* st;
};

__device__ __forceinline__ XcdBarrier xcd_barrier_post(unsigned* bar, volatile LAS unsigned* st) {
    XcdBarrier b; b.bar = bar; b.x = xb_xcc_id(); b.st = st;
    if (threadIdx.x == 0) (void)xb_add(&bar[XB_XCNT(b.x)], 1u);
    return b;
}
__device__ __forceinline__ void xcd_barrier_complete(unsigned* bar, unsigned x, unsigned& nloc, unsigned& nx) {
    const unsigned G = gridDim.x * gridDim.y * gridDim.z;
    unsigned sum, cnt, mine, sp = 0u;
    for (;;) {
        sum = 0u; cnt = 0u; mine = 0u;
#pragma unroll
        for (unsigned j = 0; j < 16; ++j) { const unsigned c = xb_ld(&bar[XB_XCNT(j)]); sum += c; cnt += (c > 0u) ? 1u : 0u; mine = (j == x) ? c : mine; }
        if (sum == G) break;
        __builtin_amdgcn_s_sleep(1);
        if ((++sp & 255u) == 0u) { if (xb_ld(&bar[XB_TMO])) break; if (sp > XB_SPIN_CAP) { atomicAdd(&bar[XB_TMO], 1u); break; } }
    }
    nloc = mine > 0u ? mine : 1u; nx = cnt > 0u ? cnt : 1u;
}

__device__ __forceinline__ void xcd_barrier(const XcdBarrier& b) {
    asm volatile("s_waitcnt vmcnt(0)" ::: "memory");
    __syncthreads();
    if (threadIdx.x == 0) {
        unsigned* bar = b.bar;
        __builtin_amdgcn_s_waitcnt(0);
        unsigned nloc = b.st[0], nx = b.st[1];
        if (nloc == 0u) { xcd_barrier_complete(bar, b.x, nloc, nx); b.st[0] = nloc; b.st[1] = nx; }
        const unsigned old = xb_add(&bar[XB_XSUB(b.x)], 1u);
        const unsigned gen = old / nloc;
        if (old + 1u == (gen + 1u) * nloc) {
            __builtin_amdgcn_fence(__ATOMIC_RELEASE, "agent");
            asm volatile("s_waitcnt vmcnt(0)" ::: "memory");
            const unsigned og = xb_add(&bar[XB_TOP], 1u);
            const unsigned tg = og / nx;
            if (og + 1u == (tg + 1u) * nx) xb_add(&bar[XB_TOPGEN], 1u);
            else XB_SPIN(xb_ld(&bar[XB_TOPGEN]) == tg, bar);
            __builtin_amdgcn_fence(__ATOMIC_ACQUIRE, "agent");
            xb_add(&bar[XB_XGEN(b.x)], 1u);
            asm volatile("s_waitcnt vmcnt(0)" ::: "memory");
        } else {
            XB_SPIN(xb_ld(&bar[XB_XGEN(b.x)]) == gen, bar);
            __builtin_amdgcn_fence(__ATOMIC_ACQUIRE, "agent");
            asm volatile("s_waitcnt vmcnt(0)" ::: "memory");
        }
    }
    __syncthreads();
}


DEVI int otid() { int t = threadIdx.x; asm volatile("" : "+v"(t)); return t; }
DEVI void stagger(int wg, unsigned ticks) { const unsigned long long t0 = __builtin_amdgcn_s_memrealtime(), d = (unsigned long long)((wg & 3) * ticks); while (__builtin_amdgcn_s_memrealtime() - t0 < d) __builtin_amdgcn_s_sleep(8); }
struct PrepJob { const float* in; const float* in2; const float* gain; bf16_t* out; int ldin, K, Nout, mode, ne, pad; size_t in_es, out_es; };
DEVI void ph_prep_w(const PrepJob& j, unsigned char* sm, int wg, int nwg) {
    const int tid = otid(), lane = tid & 63, wave = tid >> 6;
    float* scr = (float*)sm + wave * (64 * 33);
    const int nb = j.Nout / 32, kb = j.K / 64, per = nb * kb, total = per * j.ne;
    for (int it = wg * 8 + wave; it < total; it += nwg * 8) {
        const int e = it / per, r = it - e * per, k0 = (r / nb) * 64, n0 = (r % nb) * 32;
        const int n = n0 + (lane & 31); const float* src = j.in + (size_t)e * j.in_es; int col = n; bool valid = true;
        if (j.mode == 1) {
            if (n < 1152) col = n; else if (n < 1160) col = 2688 + (n - 1152); else if (n < 1280) valid = false; else if (n < 2816) col = 1152 + (n - 1280); else col = 2696 + (n - 2816);
        } else if (j.mode == 2) { const int pn = n >> 8, bj = (n >> 7) & 1; col = pn * 128 + (n & 127); if (bj) src = j.in2 + (size_t)e * j.in_es; }
        const float* sp = src + (size_t)(k0 + (lane >> 5)) * j.ldin + col; const float* gp = j.gain ? j.gain + k0 + (lane >> 5) : nullptr;
        float vv[32];
#pragma unroll
        for (int i = 0; i < 32; ++i) vv[i] = valid ? sp[(size_t)(2 * i) * j.ldin] : 0.f;
#pragma unroll
        for (int i = 0; i < 32; ++i) { float v = vv[i]; if (gp) v *= gp[2 * i]; scr[(2 * i + (lane >> 5)) * 33 + (lane & 31)] = v; }
        asm volatile("s_waitcnt lgkmcnt(0)" ::: "memory");
        const int c = lane & 7; bf16_t* o = j.out + (size_t)e * j.out_es;
        if (j.pad != 0) {
            const float ws_ = (float)(1 << (j.pad & 255)); const int kk_ = k0 + 8 * c;
            const int kp_ = (j.pad & 256) ? ((((kk_ >> 8) * 16 + ((kk_ >> 5) & 3) * 4 + ((kk_ >> 3) & 3)) * 16) + ((kk_ >> 7) & 1) * 8) : kk_;
#pragma unroll
            for (int jj = 0; jj < 4; ++jj) { const int nn = (lane >> 3) + 8 * jj; const float* q = scr + (8 * c) * 33 + nn; float v8[8];
#pragma unroll
                for (int i = 0; i < 8; ++i) v8[i] = fminf(fmaxf(q[i * 33] * ws_, -448.0f), 448.0f);
                u32x2 w8;
#pragma unroll
                for (int d = 0; d < 2; ++d) { int t = __builtin_amdgcn_cvt_pk_fp8_f32(v8[4 * d], v8[4 * d + 1], 0, false); t = __builtin_amdgcn_cvt_pk_fp8_f32(v8[4 * d + 2], v8[4 * d + 3], t, true); w8[d] = (unsigned)t; }
                *(u32x2*)((unsigned char*)o + (size_t)(n0 + nn) * j.K + kp_) = w8; }
        } else {
#pragma unroll
        for (int jj = 0; jj < 4; ++jj) { const int nn = (lane >> 3) + 8 * jj; const float* q = scr + (8 * c) * 33 + nn;
            u32x4 w; w.x = pk2(q[0 * 33], q[1 * 33]); w.y = pk2(q[2 * 33], q[3 * 33]); w.z = pk2(q[4 * 33], q[5 * 33]); w.w = pk2(q[6 * 33], q[7 * 33]);
            *(u32x4*)(o + (size_t)(n0 + nn) * j.K + k0 + 8 * c) = w; }
        }
        asm volatile("s_waitcnt lgkmcnt(0)" ::: "memory");
    }
}
DEVI void ph_prep_router(const float* rgw, const float* rew, const float* g, bf16_t* WRt, int wg, int nwg) {
    for (int idx = wg * NTHR + otid(); idx < 256 * 1024; idx += nwg * NTHR) { const int r = idx / 1024, k = idx % 1024, n = r < 48 ? r : r - 48;
        float w = (r < 96 && n < 36) ? g[k] * (n < 4 ? rgw[k * 4 + n] : rew[k * 32 + (n - 4)]) : 0.f;
        const unsigned hb = f2bf(w); WRt[idx] = (bf16_t)(r < 48 ? hb : f2bf(w - __uint_as_float(hb << 16))); }
}
DEVI void ph_prep_x(const float* x, bf16_t* hb, unsigned char* h8, float* ssp, int wg, int nwg) {
    const int tid = otid(), lane = tid & 63, gw = wg * 8 + (tid >> 6), ngw = nwg * 8;
    for (int row = 2 * gw; row < T; row += 2 * ngw) {
        f32x4 v[2][4];
#pragma unroll
        for (int r = 0; r < 2; ++r)
#pragma unroll
            for (int jj = 0; jj < 4; ++jj) v[r][jj] = ((const f32x4*)(x + (size_t)(row + r) * D) + lane)[64 * jj];
#pragma unroll
        for (int r = 0; r < 2; ++r) { float s = 0.f; u32x2* o = (u32x2*)(hb + (size_t)(row + r) * D) + lane;
#pragma unroll
            for (int jj = 0; jj < 4; ++jj) { const f32x4 a = v[r][jj]; s += (a[0] * a[0] + a[1] * a[1]) + (a[2] * a[2] + a[3] * a[3]); u32x2 w; w.x = pk2(a[0], a[1]); w.y = pk2(a[2], a[3]); o[64 * jj] = w;
                int t8 = __builtin_amdgcn_cvt_pk_fp8_f32(a[0], a[1], 0, false); t8 = __builtin_amdgcn_cvt_pk_fp8_f32(a[2], a[3], t8, true); ((unsigned*)(h8 + (size_t)(row + r) * 1024))[lane + 64 * jj] = (unsigned)t8; }
            s = wave_sum(s);
            if (lane < 16) ssp[(size_t)(row + r) * 16 + lane] = lane == 0 ? s : 0.f; }
    }
}
DEVI void ph_cvt_bf16(const float* in, bf16_t* out, size_t n4, int wg, int nwg) {
    const size_t stride = (size_t)nwg * NTHR;
    for (size_t i0 = (size_t)wg * NTHR + otid(); i0 < n4; i0 += 8 * stride) {
        f32x4 v[8];
#pragma unroll
        for (int k = 0; k < 8; ++k) { const size_t i = i0 + k * stride; v[k] = i < n4 ? ((const f32x4*)in)[i] : (f32x4){0.f, 0.f, 0.f, 0.f}; }
#pragma unroll
        for (int k = 0; k < 8; ++k) { const size_t i = i0 + k * stride; if (i < n4) { u32x2 w; w.x = pk2(v[k][0], v[k][1]); w.y = pk2(v[k][2], v[k][3]); ((u32x2*)out)[i] = w; } }
    }
}

namespace sb {
typedef short bf16x8 __attribute__((ext_vector_type(8)));
typedef short s16x4 __attribute__((ext_vector_type(4)));
typedef float f32x16 __attribute__((ext_vector_type(16)));
constexpr float QSCALE = 0.125f * 1.4426950408889634f;
constexpr int WAVE_LDS = 12288;
DEVI int crow(int r, int hi) { return (r & 3) + 8 * (r >> 2) + 4 * hi; }
DEVI void glds16(const void* gsrc, unsigned lds_dst) { unsigned keep;
    asm volatile("s_mov_b32 %0, m0\n\ts_mov_b32 m0, %2\n\ts_nop 0\n\tglobal_load_lds_dwordx4 %1, off\n\ts_mov_b32 m0, %0" : "=&s"(keep) : "v"(gsrc), "s"(lds_dst) : "memory"); }
DEVI unsigned cvtpk(float lo, float hi) { unsigned r; asm("v_cvt_pk_bf16_f32 %0, %1, %2" : "=v"(r) : "v"(lo), "v"(hi)); return r; }
DEVI void pv(f32x16* o, int vb, bf16x8 pa0, bf16x8 pa1, bf16x8 pa2, bf16x8 pa3) {
#pragma unroll
    for (int d0 = 0; d0 < 2; ++d0) { s16x4 lo[4], hi[4];
#pragma unroll
        for (int ks = 0; ks < 4; ++ks) {
            asm volatile("ds_read_b64_tr_b16 %0,%1 offset:%c2" : "=&v"(lo[ks]) : "v"(vb), "i"(d0 * 4096 + ks * 1024) : "memory");
            asm volatile("ds_read_b64_tr_b16 %0,%1 offset:%c2" : "=&v"(hi[ks]) : "v"(vb), "i"(d0 * 4096 + ks * 1024 + 512) : "memory"); }
        asm volatile("s_waitcnt lgkmcnt(0)" ::: "memory"); __builtin_amdgcn_sched_barrier(0);
#define SB_PK(k) (bf16x8){lo[k][0], lo[k][1], lo[k][2], lo[k][3], hi[k][0], hi[k][1], hi[k][2], hi[k][3]}
        o[d0] = __builtin_amdgcn_mfma_f32_32x32x16_bf16(pa0, SB_PK(0), o[d0], 0, 0, 0);
        o[d0] = __builtin_amdgcn_mfma_f32_32x32x16_bf16(pa1, SB_PK(1), o[d0], 0, 0, 0);
        o[d0] = __builtin_amdgcn_mfma_f32_32x32x16_bf16(pa2, SB_PK(2), o[d0], 0, 0, 0);
        o[d0] = __builtin_amdgcn_mfma_f32_32x32x16_bf16(pa3, SB_PK(3), o[d0], 0, 0, 0);
#undef SB_PK
    }
}
}
DEVI void ph_sb(const bf16_t* Z, const float* og, bf16_t* Ymix, unsigned char* smb, int wg, int nwg) {
    using namespace sb;
    const int tid = otid(), lane = tid & 63, wave = __builtin_amdgcn_readfirstlane(tid >> 6), r32 = lane & 31, hi = lane >> 5;
    unsigned char* vt = smb + wave * 16384;
    const unsigned vt_lds = (unsigned)(uintptr_t)vt;
    const int vbl = ((lane >> 4) & 1) * 32 + (lane & 3) * 8 + (4 * hi + ((lane & 15) >> 2)) * 64;
    const unsigned vK0 = (unsigned)(r32 * NZ + ZKA + hi * 8) * 2u, vK1 = vK0 + 32u * NZ * 2u, vV = (unsigned)((lane >> 2) * NZ + ZVA + (lane & 3) * 8) * 2u, vQ = (unsigned)(r32 * NZ + ZQA + hi * 8) * 2u;
#define SB_TILE(hh, jj) ((const char*)Z + ((size_t)(bbase + (jj) * 64) * NZ + (hh) * 64) * 2)
#define SB_LOADK(dst, hh, jj) do { const char* kb_ = SB_TILE(hh, jj); _Pragma("unroll") for (int d0 = 0; d0 < 4; ++d0) { dst[2 * d0] = *(const bf16x8*)(kb_ + vK0 + d0 * 32); dst[2 * d0 + 1] = *(const bf16x8*)(kb_ + vK1 + d0 * 32); } } while (0)
#define SB_DMAV(buf, hh, jj) do { const char* kb_ = SB_TILE(hh, jj); _Pragma("unroll") for (int w8 = 0; w8 < 8; ++w8) \
        glds16(kb_ + ((size_t)(16 * (w8 & 3)) * NZ + (w8 >> 2) * 32) * 2 + vV, (unsigned)__builtin_amdgcn_readfirstlane(vt_lds + (buf) * 8192 + w8 * 1024)); } while (0)
#define SB_LOADQ(dst, hh) do { const char* qp_ = (const char*)Z + ((size_t)row0 * NZ + (hh) * 64) * 2 + vQ; _Pragma("unroll") for (int d0 = 0; d0 < 4; ++d0) dst[d0] = *(const bf16x8*)(qp_ + d0 * 32); } while (0)
    for (int wu = wg * 8 + wave; wu < T / 32; wu += nwg * 8) {
        const int row0 = wu * 32, bbase = (row0 / SEQ) * SEQ, t0 = row0 - bbase, tq = t0 + r32, jt0 = t0 >> 6;
        float ssq[4] = {0.f, 0.f, 0.f, 0.f};
        int cb = 0, pf = 0;
        bf16x8 kf[8], qr[4], qn[4];
        asm volatile("s_waitcnt lgkmcnt(0)" ::: "memory");
        SB_DMAV(0, 0, jt0); SB_LOADK(kf, 0, jt0); SB_LOADQ(qr, 0);
#pragma unroll 1
        for (int h = 0; h < 6; ++h) {
            f32x16 o[2]; o[0] = f32x16{}; o[1] = f32x16{};
            float carry = 1.f; bool diag = true;
#pragma unroll 1
            for (int jt = jt0; ; --jt) {
                const int kv0 = jt * 64;
                f32x16 p0 = __builtin_amdgcn_mfma_f32_32x32x16_bf16(kf[0], qr[0], f32x16{}, 0, 0, 0), p1 = __builtin_amdgcn_mfma_f32_32x32x16_bf16(kf[1], qr[0], f32x16{}, 0, 0, 0);
#pragma unroll
                for (int d0 = 1; d0 < 4; ++d0) { p0 = __builtin_amdgcn_mfma_f32_32x32x16_bf16(kf[2 * d0], qr[d0], p0, 0, 0, 0); p1 = __builtin_amdgcn_mfma_f32_32x32x16_bf16(kf[2 * d0 + 1], qr[d0], p1, 0, 0, 0); }
                if (diag && jt > 0) { SB_DMAV(cb ^ 1, h, jt - 1); SB_LOADK(kf, h, jt - 1); pf = 1; }
                else if (h + 1 < 6) { SB_DMAV(cb ^ 1, h + 1, jt0); SB_LOADK(kf, h + 1, jt0); pf = 2; }
                else pf = 0;
                const bool qpf = diag && (h + 1 < 6);
                if (qpf) SB_LOADQ(qn, h + 1);
                if (diag) {
#pragma unroll
                    for (int r = 0; r < 16; ++r) { const int kv = kv0 + crow(r, hi); if (kv >= tq) p0[r] = -INFINITY; if (kv + 32 >= tq) p1[r] = -INFINITY; }
                }
                float total = 1.f; u32x4 pw0, pw1, pw2, pw3;
#define SB_HALF(P, PWA, PWB) do { f32x16 R; \
                    _Pragma("unroll") for (int r = 0; r < 16; ++r) { float c_; asm("v_min_f32 %0, %1, %2" : "=v"(c_) : "v"(P[r]), "v"(100.f)); const float e_ = __builtin_amdgcn_exp2f(c_); R[r] = __builtin_amdgcn_rcpf(1.0f + e_); P[r] = e_ * R[r]; } \
                    _Pragma("unroll") for (int g = 3; g >= 0; --g) { const float mine = (R[4 * g] * R[4 * g + 1]) * (R[4 * g + 2] * R[4 * g + 3]); const auto sw_ = __builtin_amdgcn_permlane32_swap(__float_as_uint(mine), __float_as_uint(mine), false, false); const float og_ = __uint_as_float(hi ? sw_[0] : sw_[1]);     \
                        float t = carry * (hi == 0 ? total * og_ : total); total *= mine * og_; \
                        P[4 * g + 3] *= t; t *= R[4 * g + 3]; P[4 * g + 2] *= t; t *= R[4 * g + 2]; P[4 * g + 1] *= t; t *= R[4 * g + 1]; P[4 * g] *= t; } \
                    PWA = (u32x4){cvtpk(P[0], P[1]), cvtpk(P[2], P[3]), cvtpk(P[4], P[5]), cvtpk(P[6], P[7])}; PWB = (u32x4){cvtpk(P[8], P[9]), cvtpk(P[10], P[11]), cvtpk(P[12], P[13]), cvtpk(P[14], P[15])}; } while (0)
                if (diag && !(t0 & 32)) { pw2 = (u32x4){0u, 0u, 0u, 0u}; pw3 = pw2; }
                else SB_HALF(p1, pw2, pw3);
                SB_HALF(p0, pw0, pw1);
#undef SB_HALF
                carry *= total;
                if (pf && qpf) asm volatile("s_waitcnt vmcnt(20)" ::: "memory");
                else if (pf) asm volatile("s_waitcnt vmcnt(16)" ::: "memory");
                else asm volatile("s_waitcnt vmcnt(0)" ::: "memory");
                pv(o, (int)vt_lds + cb * 8192 + vbl, __builtin_bit_cast(bf16x8, pw0), __builtin_bit_cast(bf16x8, pw1), __builtin_bit_cast(bf16x8, pw2), __builtin_bit_cast(bf16x8, pw3));
                diag = false;
                if (jt == 0 || !__any(carry > 9.0949470177e-13f)) break;
                if (pf == 1) { cb ^= 1; pf = 0; }
                else { SB_DMAV(cb, h, jt - 1); SB_LOADK(kf, h, jt - 1); pf = 0; }
            }
            const bool hit = (pf == 2);
            pf = 0;
            if (h + 1 < 6) {
#pragma unroll
                for (int d0 = 0; d0 < 4; ++d0) qr[d0] = qn[d0]; }
            bf16_t* stg = (bf16_t*)(vt + cb * 8192);
#pragma unroll
            for (int r = 0; r < 16; ++r) { const int orow = crow(r, hi); stg[orow * 64 + r32] = (bf16_t)f2bf(o[0][r]); stg[orow * 64 + 32 + r32] = (bf16_t)f2bf(o[1][r]); }
            asm volatile("s_waitcnt lgkmcnt(0)" ::: "memory");
#pragma unroll
            for (int i = 0; i < 4; ++i) { const int row = i * 8 + (lane >> 3), ch = lane & 7; const u32x4 v = *(const u32x4*)(stg + row * 64 + ch * 8);
                float a[8]; unpack8(v, a);
                ssq[i] += ((a[0] * a[0] + a[1] * a[1]) + (a[2] * a[2] + a[3] * a[3])) + ((a[4] * a[4] + a[5] * a[5]) + (a[6] * a[6] + a[7] * a[7]));
                *(u32x4*)(Ymix + (size_t)(row0 + row) * D + h * 64 + ch * 8) = v; }
            asm volatile("s_waitcnt lgkmcnt(0)" ::: "memory");
            if (h + 1 < 6) {
                if (!hit) { SB_DMAV(cb ^ 1, h + 1, jt0); SB_LOADK(kf, h + 1, jt0); }
                cb ^= 1;
            }
        }
        asm volatile("s_waitcnt vmcnt(0)" ::: "memory");
        float rs[4];
#pragma unroll
        for (int i = 0; i < 4; ++i) { float s = ssq[i]; s += __shfl_xor(s, 1); s += __shfl_xor(s, 2); s += __shfl_xor(s, 4); rs[i] = rsqrtf(s * (1.0f / 384.0f) + EPS); }
#pragma unroll 1
        for (int h = 0; h < 6; ++h) { const int ch = lane & 7; const f32x4 g0 = *(const f32x4*)(og + h * 64 + ch * 8), g1 = *(const f32x4*)(og + h * 64 + ch * 8 + 4);
#pragma unroll
            for (int i = 0; i < 4; ++i) { const int row = i * 8 + (lane >> 3); u32x4* pp = (u32x4*)(Ymix + (size_t)(row0 + row) * D + h * 64 + ch * 8); float a[8]; unpack8(*pp, a); const float r = rs[i];
                u32x4 w; w.x = pk2(a[0] * r * g0[0], a[1] * r * g0[1]); w.y = pk2(a[2] * r * g0[2], a[3] * r * g0[3]); w.z = pk2(a[4] * r * g1[0], a[5] * r * g1[1]); w.w = pk2(a[6] * r * g1[2], a[7] * r * g1[3]);
                *pp = w; } }
    }
#undef SB_TILE
#undef SB_LOADK
#undef SB_DMAV
#undef SB_LOADQ
}

namespace ml {
constexpr int QROW = 208, TROW = 144;
constexpr int O_QN = 0, O_KN = 13312, O_KWT = 26624, O_VT = 40448, O_CT = 54272, CT_BYTES = 96 * QROW, O_NV = O_CT + 2 * CT_BYTES, O_TB = O_NV + 768, O_SC = O_TB + 2 * 1280,
              O_MNG = O_SC + 64, O_CW = O_MNG + 384, O_RAW = O_CW + 5 * 192 * 4, NP_QK = 67 * 24, NP_ALL = NP_QK + 64 * 12, O_RAWV = O_RAW + NP_QK * 16, O_DUMMY = O_RAW + 40 * 1024, O_END = O_DUMMY + 1024;
static_assert(O_END <= 147456 && NP_ALL <= 40 * 64 && O_RAW % 16 == 0, "mLSTM LDS map");
typedef short bf16x8 __attribute__((ext_vector_type(8)));
}
DEVI void ph_mlstm(const bf16_t* Z, const float* gates, const float* conv_w, const float* conv_b, const float* igb, const float* fgb, const float* mng, bf16_t* Ymix,
                   unsigned char* smb, int wg, int nwg) {
    using namespace ml;
    const int tid = otid(), lane = tid & 63, wave = __builtin_amdgcn_readfirstlane(tid >> 6), l16 = lane & 15, quad = lane >> 4;
    float* NV = (float*)(smb + O_NV);
    const unsigned raw_lds = (unsigned)(uintptr_t)(smb + O_RAW);
    for (int unit = wg; unit < NB * 4; unit += nwg) {
        const int b = unit >> 2, h = unit & 3; const size_t rb = (size_t)b * SEQ;
#define ML_DMA(n1) do { const char* zb_ = (const char*)Z + ((long)rb + (long)(n1) * 64 - 3) * (NZ * 2); \
            _Pragma("unroll") for (int ins = 0; ins < 5; ++ins) if ((ins * 8 + wave) * 64 + lane < NP_ALL) sb::glds16(zb_ + doff[ins], (unsigned)__builtin_amdgcn_readfirstlane(raw_lds + (ins * 8 + wave) * 1024)); } while (0)
        unsigned doff[5];
#pragma unroll
        for (int ins = 0; ins < 5; ++ins) { const int pidx = (ins * 8 + wave) * 64 + lane;
            if (pidx < NP_QK) { const int r = pidx / 24, seg = pidx - 24 * r; doff[ins] = (unsigned)(r * NZ + (seg < 12 ? ZQB + h * 96 + 8 * seg : ZKB + h * 96 + 8 * (seg - 12))) * 2u; }
            else { const int j = pidx - NP_QK, l = j / 12, seg = j - 12 * l; doff[ins] = (unsigned)((l + 3) * NZ + ZVB + h * 96 + 8 * seg) * 2u; } }
#define ML_WARM(n2) do { if (wave >= 4) { const unsigned dl_ = (unsigned)__builtin_amdgcn_readfirstlane((unsigned)(uintptr_t)(smb + O_DUMMY)); const int wq_ = wave - 4; \
            if ((n2) < 32) { const char* rp_ = (const char*)Z + ((size_t)rb + (size_t)(n2) * 64 + lane) * (NZ * 2) + (size_t)((wq_ == 0 ? ZQB : wq_ == 1 ? ZKB : wq_ == 2 ? ZVB : ZOB) + h * 96) * 2; \
                sb::glds16(rp_, dl_); sb::glds16(rp_ + 128, dl_); } \
            if (wq_ == 3 && (n2) + 1 < 32) { const char* gp_ = (const char*)gates + ((size_t)rb + (size_t)((n2) + 1) * 64) * 32 + lane * 16; sb::glds16(gp_, dl_); sb::glds16(gp_ + 1024, dl_); } } } while (0)
#define ML_GATES(n1, ip, fp) do { float* TBn = (float*)(smb + O_TB) + ((n1) & 1) * 320; float* SCn = (float*)(smb + O_SC) + ((n1) & 1) * 4; \
            float c = -softplusf_(-(fp)); _Pragma("unroll") for (int o = 1; o < 64; o <<= 1) { const float t_ = __shfl_up(c, o); if (lane >= o) c += t_; } \
            const float btot = __shfl(c, 63), a_ = btot - c + (ip), g_ = (ip) - c; float mloc = a_; \
            _Pragma("unroll") for (int o = 32; o >= 1; o >>= 1) mloc = fmaxf(mloc, __shfl_xor(mloc, o)); \
            float pm = g_; _Pragma("unroll") for (int o = 1; o < 64; o <<= 1) { const float t_ = __shfl_up(pm, o); if (lane >= o) pm = fmaxf(pm, t_); } \
            const float mn = fmaxf(btot + mrun, mloc); \
            TBn[lane] = a_; TBn[64 + lane] = g_; TBn[128 + lane] = pm; TBn[192 + lane] = c; TBn[256 + lane] = __expf(a_ - mn); \
            if (lane == 0) { SCn[0] = mrun; SCn[1] = mn; SCn[2] = __expf(btot + mrun - mn); } mrun = mn; } while (0)
#define ML_CONVERT(n1) do { const float* WLn = (const float*)(smb + O_TB) + ((n1) & 1) * 320 + 256; \
            if (tid < 384) { const unsigned char* rw = smb + O_RAW + cc * 2; const int l0 = 16 * rseg; const bool z0 = ((n1) == 0 && rseg == 0); \
                const f32x2_t* cwp_ = (const f32x2_t*)((const float*)(smb + O_CW) + cc); const f32x2_t cw0 = cwp_[0], cw1 = cwp_[96], cw2 = cwp_[192], cw3 = cwp_[288], cbias = cwp_[384]; \
                f32x2_t x0, x1, x2; { const unsigned u0 = *(const unsigned*)(rw + (l0 + 0) * 384), u1 = *(const unsigned*)(rw + (l0 + 1) * 384), u2 = *(const unsigned*)(rw + (l0 + 2) * 384); \
                    x0 = z0 ? (f32x2_t){0.f, 0.f} : (f32x2_t){__uint_as_float(u0 << 16), __uint_as_float(u0 & 0xffff0000u)}; x1 = z0 ? (f32x2_t){0.f, 0.f} : (f32x2_t){__uint_as_float(u1 << 16), __uint_as_float(u1 & 0xffff0000u)}; \
                    x2 = z0 ? (f32x2_t){0.f, 0.f} : (f32x2_t){__uint_as_float(u2 << 16), __uint_as_float(u2 & 0xffff0000u)}; } \
                unsigned char* qk = smb + (which ? O_KN : O_QN) + cd * 2; unsigned char* kwt = smb + O_KWT + cd * TROW; \
                _Pragma("unroll 2") for (int i = 0; i < 16; i += 2) { const int l = l0 + i; \
                    const unsigned ua = *(const unsigned*)(rw + (l + 3) * 384), ub = *(const unsigned*)(rw + (l + 4) * 384); \
                    const f32x2_t xa = {__uint_as_float(ua << 16), __uint_as_float(ua & 0xffff0000u)}, xb = {__uint_as_float(ub << 16), __uint_as_float(ub & 0xffff0000u)}; \
                    f32x2_t ya = cbias + cw0 * x0 + cw1 * x1 + cw2 * x2 + cw3 * xa, yb = cbias + cw0 * x1 + cw1 * x2 + cw2 * xa + cw3 * xb; x0 = x2; x1 = xa; x2 = xb; \
                    f32x2_t oa, ob_; oa.x = ya.x * __builtin_amdgcn_rcpf(1.0f + __expf(-ya.x)); oa.y = ya.y * __builtin_amdgcn_rcpf(1.0f + __expf(-ya.y)); ob_.x = yb.x * __builtin_amdgcn_rcpf(1.0f + __expf(-yb.x)); ob_.y = yb.y * __builtin_amdgcn_rcpf(1.0f + __expf(-yb.y)); \
                    if (which) { oa = oa * 0.10206207261596575f; ob_ = ob_ * 0.10206207261596575f; const float wa = WLn[l], wb = WLn[l + 1]; \
                        *(unsigned*)(kwt + l * 2) = pk2(oa.x * wa, ob_.x * wb); *(unsigned*)(kwt + TROW + l * 2) = pk2(oa.y * wa, ob_.y * wb); } \
                    *(unsigned*)(qk + l * QROW) = pk2(oa.x, oa.y); *(unsigned*)(qk + (l + 1) * QROW) = pk2(ob_.x, ob_.y); } \
            } else { const int idx = tid - 384, lp = idx >> 2, eq = idx & 3; const u32x4* s0 = (const u32x4*)(smb + O_RAWV + (2 * lp) * 192 + eq * 48); const u32x4* s1 = (const u32x4*)(smb + O_RAWV + (2 * lp + 1) * 192 + eq * 48); \
                unsigned char* vt = smb + O_VT + (eq * 24) * TROW + lp * 4; \
                _Pragma("unroll") for (int i = 0; i < 3; ++i) { const u32x4 a = s0[i], b = s1[i]; \
                    *(unsigned*)(vt + (i * 8 + 0) * TROW) = (a.x & 0xffffu) | (b.x << 16); *(unsigned*)(vt + (i * 8 + 1) * TROW) = (a.x >> 16) | (b.x & 0xffff0000u); \
                    *(unsigned*)(vt + (i * 8 + 2) * TROW) = (a.y & 0xffffu) | (b.y << 16); *(unsigned*)(vt + (i * 8 + 3) * TROW) = (a.y >> 16) | (b.y & 0xffff0000u); \
                    *(unsigned*)(vt + (i * 8 + 4) * TROW) = (a.z & 0xffffu) | (b.z << 16); *(unsigned*)(vt + (i * 8 + 5) * TROW) = (a.z >> 16) | (b.z & 0xffff0000u); \
                    *(unsigned*)(vt + (i * 8 + 6) * TROW) = (a.w & 0xffffu) | (b.w << 16); *(unsigned*)(vt + (i * 8 + 7) * TROW) = (a.w >> 16) | (b.w & 0xffff0000u); } } } while (0)
        const int cc = tid < 384 ? 2 * (tid % 96) : 0, rseg = tid < 384 ? tid / 96 : 0, which = cc >= 96 ? 1 : 0, cd = cc - 96 * which;
        if (tid < 192) { const int w_ = tid >= 96 ? 1 : 0, ch_ = w_ * 384 + h * 96 + (tid - 96 * w_); float* cwt = (float*)(smb + O_CW);
            cwt[tid] = conv_w[ch_]; cwt[192 + tid] = conv_w[768 + ch_]; cwt[384 + tid] = conv_w[2 * 768 + ch_]; cwt[576 + tid] = conv_w[3 * 768 + ch_]; cwt[768 + tid] = conv_b[ch_]; }
        float mrun = 0.f;
        ML_DMA(0);
        for (int i = tid; i < CT_BYTES / 4; i += NTHR) ((unsigned*)(smb + O_CT))[i] = 0u;
        if (tid < 96) { NV[tid] = 0.f; ((float*)(smb + O_MNG))[tid] = mng[h * 96 + tid]; }
        if (wave == 7) { const size_t row = rb + lane; const float ip = gates[row * 8 + h] + igb[h], fp = gates[row * 8 + 4 + h] + fgb[h]; ML_GATES(0, ip, fp); }
        asm volatile("s_waitcnt vmcnt(0)" ::: "memory");
        __syncthreads();
        ML_CONVERT(0);
        __syncthreads();
        f32x4 Cst[9];
#pragma unroll
        for (int k = 0; k < 9; ++k) Cst[k] = (f32x4){0.f, 0.f, 0.f, 0.f};
#pragma unroll 1
        for (int n = 0; n < 32; ++n) {
            const int cur = n & 1, nxt = cur ^ 1; const float* SCc = (const float*)(smb + O_SC) + cur * 4; const float m_in = SCc[0], dec = SCc[2];
            const float* TBc = (const float*)(smb + O_TB) + cur * 320;
            const size_t r0 = rb + n * 64;
            if (n + 1 < 32) ML_DMA(n + 1);
            if (wave < 4) {
                const int tt = wave, t = 16 * tt + l16; const size_t row = r0 + t;
                const unsigned char* qn = smb + O_QN; const unsigned char* kn = smb + O_KN; const unsigned char* vtb = smb + O_VT; const unsigned char* ct = smb + O_CT + cur * CT_BYTES;
                bf16x8 bq[3];
#pragma unroll
                for (int ks = 0; ks < 3; ++ks) bq[ks] = *(const bf16x8*)(qn + t * QROW + (32 * ks + 8 * quad) * 2);
                const float Mt = fmaxf(m_in, TBc[128 + t]), inter = __expf(m_in - Mt), flr = __expf(-(TBc[192 + t] + Mt));
                f32x4 P[4]; float psum = 0.f;
#pragma unroll
                for (int st = 0; st < 4; ++st) { P[st] = (f32x4){0.f, 0.f, 0.f, 0.f};
                    if (st <= tt) {
#pragma unroll
                        for (int ks = 0; ks < 3; ++ks) P[st] = __builtin_amdgcn_mfma_f32_16x16x32_bf16(*(const bf16x8*)(kn + (16 * st + l16) * QROW + (32 * ks + 8 * quad) * 2), bq[ks], P[st], 0, 0, 0);
                        const f32x4 gs = *(const f32x4*)(TBc + 64 + 16 * st + 4 * quad);
#pragma unroll
                        for (int j = 0; j < 4; ++j) { const int s_ = 16 * st + 4 * quad + j; const float w = s_ <= t ? __expf(gs[j] - Mt) : 0.f; P[st][j] *= w; psum += P[st][j]; }
                    } }
                psum += __shfl_xor(psum, 16); psum += __shfl_xor(psum, 32);
                float qn_ = 0.f; { const float* nv = NV + cur * 96 + quad * 24; const unsigned char* qp = qn + t * QROW + quad * 48;
#pragma unroll
                    for (int i = 0; i < 3; ++i) { const u32x4 w = *(const u32x4*)(qp + i * 16);
                        qn_ += __uint_as_float(w.x << 16) * nv[i * 8 + 0] + __uint_as_float(w.x & 0xffff0000u) * nv[i * 8 + 1] + __uint_as_float(w.y << 16) * nv[i * 8 + 2] + __uint_as_float(w.y & 0xffff0000u) * nv[i * 8 + 3]
                             + __uint_as_float(w.z << 16) * nv[i * 8 + 4] + __uint_as_float(w.z & 0xffff0000u) * nv[i * 8 + 5] + __uint_as_float(w.w << 16) * nv[i * 8 + 6] + __uint_as_float(w.w & 0xffff0000u) * nv[i * 8 + 7]; } }
                qn_ += __shfl_xor(qn_, 16); qn_ += __shfl_xor(qn_, 32);
                float den = psum + inter * qn_; den = fmaxf(fabsf(den), flr); const float rden = 1.0f / den;
                bf16x8 pk[2];
#pragma unroll
                for (int i = 0; i < 2; ++i) { u32x4 w; w.x = pk2(P[2 * i][0], P[2 * i][1]); w.y = pk2(P[2 * i][2], P[2 * i][3]); w.z = pk2(P[2 * i + 1][0], P[2 * i + 1][1]); w.w = pk2(P[2 * i + 1][2], P[2 * i + 1][3]); pk[i] = __builtin_bit_cast(bf16x8, w); }
                float hv[6][4]; float ss = 0.f;
#pragma unroll
                for (int et = 0; et < 6; ++et) {
                    f32x4 n1 = (f32x4){0.f, 0.f, 0.f, 0.f}, n2 = (f32x4){0.f, 0.f, 0.f, 0.f};
#pragma unroll
                    for (int i = 0; i < 2; ++i) if (2 * i <= tt) { const unsigned char* vp = vtb + (16 * et + l16) * TROW + (32 * i + 4 * quad) * 2;
                        const u32x2 lo = *(const u32x2*)vp, hi2 = *(const u32x2*)(vp + 32); const u32x4 a = {lo.x, lo.y, hi2.x, hi2.y};
                        n1 = __builtin_amdgcn_mfma_f32_16x16x32_bf16(__builtin_bit_cast(bf16x8, a), pk[i], n1, 0, 0, 0); }
#pragma unroll
                    for (int ks = 0; ks < 3; ++ks) n2 = __builtin_amdgcn_mfma_f32_16x16x32_bf16(*(const bf16x8*)(ct + (16 * et + l16) * QROW + (32 * ks + 8 * quad) * 2), bq[ks], n2, 0, 0, 0);
#pragma unroll
                    for (int j = 0; j < 4; ++j) { const float v = (n1[j] + inter * n2[j]) * rden; hv[et][j] = v; ss += v * v; }
                }
                u32x2 obv[6];
#pragma unroll
                for (int et = 0; et < 6; ++et) obv[et] = *(const u32x2*)(Z + row * NZ + ZOB + h * 96 + 16 * et + 4 * quad);
                ss += __shfl_xor(ss, 16); ss += __shfl_xor(ss, 32);
                const float rs = rsqrtf(ss * (1.0f / 96.0f) + EPS);
#pragma unroll
                for (int et = 0; et < 6; ++et) { const int e = 16 * et + 4 * quad; const u32x2 ob = obv[et]; const f32x4 mg = *(const f32x4*)((const float*)(smb + O_MNG) + e);
                    u32x2 w; w.x = pk2(hv[et][0] * rs * mg[0] * sigmoidf_(__uint_as_float(ob.x << 16)), hv[et][1] * rs * mg[1] * sigmoidf_(__uint_as_float(ob.x & 0xffff0000u)));
                    w.y = pk2(hv[et][2] * rs * mg[2] * sigmoidf_(__uint_as_float(ob.y << 16)), hv[et][3] * rs * mg[3] * sigmoidf_(__uint_as_float(ob.y & 0xffff0000u)));
                    *(u32x2*)(Ymix + row * D + 384 + h * 96 + e) = w; }
            } else {
                const int wq = wave - 4; const unsigned char* kwt = smb + O_KWT; const unsigned char* vtb = smb + O_VT; unsigned char* ctn = smb + O_CT + nxt * CT_BYTES;
                float gip = 0.f, gfp = 0.f;
                if (wq == 3 && n + 1 < 32) { const size_t row = r0 + 64 + lane; gip = gates[row * 8 + h] + igb[h]; gfp = gates[row * 8 + 4 + h] + fgb[h]; }
#pragma unroll
                for (int k = 0; k < 9; ++k) { const int idx = wq + 4 * k, dt = idx / 6, et = idx - 6 * dt; f32x4 U = (f32x4){0.f, 0.f, 0.f, 0.f};
#pragma unroll
                    for (int ks = 0; ks < 2; ++ks) U = __builtin_amdgcn_mfma_f32_16x16x32_bf16(*(const bf16x8*)(kwt + (16 * dt + l16) * TROW + (32 * ks + 8 * quad) * 2), *(const bf16x8*)(vtb + (16 * et + l16) * TROW + (32 * ks + 8 * quad) * 2), U, 0, 0, 0);
                    Cst[k] = Cst[k] * dec + U;
                    u32x2 w; w.x = pk2(Cst[k][0], Cst[k][1]); w.y = pk2(Cst[k][2], Cst[k][3]);
                    *(u32x2*)(ctn + (16 * et + l16) * QROW + (16 * dt + 4 * quad) * 2) = w; __builtin_amdgcn_sched_barrier(0); }
                if (wq == 0 || (wq == 1 && lane < 32)) { const int d = wq * 64 + lane; const u32x4* kp = (const u32x4*)(kwt + d * TROW); float sacc = 0.f;
#pragma unroll
                    for (int i = 0; i < 8; ++i) { const u32x4 w = kp[i];
                        sacc += (__uint_as_float(w.x << 16) + __uint_as_float(w.x & 0xffff0000u)) + (__uint_as_float(w.y << 16) + __uint_as_float(w.y & 0xffff0000u))
                              + (__uint_as_float(w.z << 16) + __uint_as_float(w.z & 0xffff0000u)) + (__uint_as_float(w.w << 16) + __uint_as_float(w.w & 0xffff0000u)); }
                    NV[nxt * 96 + d] = dec * NV[cur * 96 + d] + sacc; }
                if (wq == 3 && n + 1 < 32) ML_GATES(n + 1, gip, gfp);
            }
            if (wave < 4) asm volatile("s_waitcnt vmcnt(6)" ::: "memory"); else asm volatile("s_waitcnt vmcnt(0)" ::: "memory");
            asm volatile("s_waitcnt lgkmcnt(0)" ::: "memory"); __builtin_amdgcn_s_barrier(); asm volatile("" ::: "memory");
            ML_WARM(n + 2);
            if (n + 1 < 32) ML_CONVERT(n + 1);
            asm volatile("s_waitcnt lgkmcnt(0)" ::: "memory"); __builtin_amdgcn_s_barrier(); asm volatile("" ::: "memory");
        }
#undef ML_DMA
#undef ML_WARM
#undef ML_GATES
#undef ML_CONVERT
    }
}

namespace sgu {
constexpr int VROW = 272, VGRP = 64 * VROW + 32, MROW = 528, MST_OFF = 71680;
static_assert(4 * VGRP <= MST_OFF && MST_OFF + 128 * MROW <= 147456, "SGU LDS map");
DEVI float gelu_fast(float x) { const float u = 1.5957691216057308f * (x + 0.044715f * x * x * x); return x * __builtin_amdgcn_rcpf(1.0f + __expf(-u)); }
DEVI f32x2_t gelu2(f32x2_t x) { constexpr float C0 = -1.5957691216057308f * 1.4426950408889634f, C1 = C0 * 0.044715f; const f32x2_t t = x * x, p = t * C1 + C0, a = x * p;
    f32x2_t e = {__builtin_amdgcn_exp2f(a.x), __builtin_amdgcn_exp2f(a.y)}; e = e + 1.0f; const f32x2_t r = {__builtin_amdgcn_rcpf(e.x), __builtin_amdgcn_rcpf(e.y)}; return x * r; }
}
DEVI void ph_sgu(const bf16_t* Z, const float* ln_g, const float* ln_b, const bf16_t* Wm, const float* bs, const float* og, bf16_t* Ymix, unsigned char* smb, int wg, int nwg) {
    using namespace sgu; typedef short bf16x8 __attribute__((ext_vector_type(8))); typedef float f32x16 __attribute__((ext_vector_type(16)));
    const int tid = otid(), lane = tid & 63, wave = __builtin_amdgcn_readfirstlane(tid >> 6), r32 = lane & 31, hi = lane >> 5;
    for (int blk = wg; blk < T / 128; blk += nwg) {
        const size_t row0 = (size_t)blk * 128;
        u32x4 uv[8]; { const u32x4* up = (const u32x4*)(Z + (row0 + (tid >> 2)) * NZ + ZUC + (tid & 3) * 64);
#pragma unroll
            for (int i = 0; i < 8; ++i) uv[i] = up[i]; }
        {
            const int tp = tid >> 3, g = (tid >> 1) & 3, hf = tid & 1, c0 = g * 64 + hf * 32;
            u32x4 raw[2][4];
#pragma unroll
            for (int k = 0; k < 2; ++k) { const u32x4* src = (const u32x4*)(Z + (row0 + 2 * tp + k) * NZ + ZVC + c0);
#pragma unroll
                for (int i = 0; i < 4; ++i) raw[k][i] = src[i]; }
            float v[2][32];
#pragma unroll
            for (int k = 0; k < 2; ++k)
#pragma unroll
                for (int i = 0; i < 4; ++i) { float f[8]; unpack8(raw[k][i], f);
#pragma unroll
                    for (int j = 0; j < 8; j += 2) { const f32x2_t g2 = gelu2((f32x2_t){f[j], f[j + 1]}); v[k][i * 8 + j] = g2.x; v[k][i * 8 + j + 1] = g2.y; } }
            float mu[2], rstd[2];
#pragma unroll
            for (int k = 0; k < 2; ++k) { float s1 = 0.f;
#pragma unroll
                for (int c = 0; c < 32; ++c) s1 += v[k][c];
                s1 += __shfl_xor(s1, 1); mu[k] = s1 * (1.0f / 64.0f); float s2 = 0.f;
#pragma unroll
                for (int c = 0; c < 32; ++c) { const float dd = v[k][c] - mu[k]; s2 += dd * dd; }
                s2 += __shfl_xor(s2, 1); rstd[k] = rsqrtf(s2 * (1.0f / 64.0f) + EPS); }
            unsigned char* dst = smb + g * VGRP + (hf * 32) * VROW + tp * 4;
#pragma unroll
            for (int c = 0; c < 32; ++c) { const float gg = ln_g[c0 + c], bb = ln_b[c0 + c];
                *(unsigned*)(dst + c * VROW) = pk2((v[0][c] - mu[0]) * rstd[0] * gg + bb, (v[1][c] - mu[1]) * rstd[1] * gg + bb); }
        }
        const int g2 = wave >> 1, mh = wave & 1;
        bf16x8 af[2][8];
        { const bf16_t* wa = Wm + ((size_t)g2 * 128 + 64 * mh + r32) * 128 + 8 * hi;
#pragma unroll
            for (int ks = 0; ks < 8; ++ks) if (ks < 4 || mh) { af[0][ks] = *(const bf16x8*)(wa + ks * 16); af[1][ks] = *(const bf16x8*)(wa + 32 * 128 + ks * 16); } }
        asm volatile("s_waitcnt lgkmcnt(0)" ::: "memory"); __builtin_amdgcn_s_barrier(); asm volatile("" ::: "memory");
        {
            f32x16 acc[2][2];
#pragma unroll
            for (int i = 0; i < 2; ++i)
#pragma unroll
                for (int j = 0; j < 2; ++j) acc[i][j] = f32x16{};
            const unsigned char* vb = smb + g2 * VGRP + r32 * VROW + 16 * hi;
#pragma unroll
            for (int ks = 0; ks < 8; ++ks) if (ks < 4 || mh) {
                const bf16x8 b0 = *(const bf16x8*)(vb + ks * 32), b1 = *(const bf16x8*)(vb + 32 * VROW + ks * 32);
                acc[0][0] = __builtin_amdgcn_mfma_f32_32x32x16_bf16(af[0][ks], b0, acc[0][0], 0, 0, 0); acc[0][1] = __builtin_amdgcn_mfma_f32_32x32x16_bf16(af[0][ks], b1, acc[0][1], 0, 0, 0);
                acc[1][0] = __builtin_amdgcn_mfma_f32_32x32x16_bf16(af[1][ks], b0, acc[1][0], 0, 0, 0); acc[1][1] = __builtin_amdgcn_mfma_f32_32x32x16_bf16(af[1][ks], b1, acc[1][1], 0, 0, 0);
            }
            bf16_t* mst = (bf16_t*)(smb + MST_OFF);
#pragma unroll
            for (int mt = 0; mt < 2; ++mt)
#pragma unroll
                for (int r = 0; r < 16; ++r) { const int t = 64 * mh + 32 * mt + (r & 3) + 8 * (r >> 2) + 4 * hi; const float bias = bs[g2 * 128 + t];
                    bf16_t* mp = mst + t * (MROW / 2) + g2 * 64 + r32;
                    mp[0] = (bf16_t)f2bf(acc[mt][0][r] + bias); mp[32] = (bf16_t)f2bf(acc[mt][1][r] + bias); }
        }
        asm volatile("s_waitcnt lgkmcnt(0)" ::: "memory"); __builtin_amdgcn_s_barrier(); asm volatile("" ::: "memory");
        {
            const int t = tid >> 2, g = tid & 3; const size_t row = row0 + t;
            const u32x4* mp = (const u32x4*)(smb + MST_OFF + t * MROW + g * 128);
            float y[64]; float ss = 0.f; f32x2_t ss2 = {0.f, 0.f};
#pragma unroll
            for (int i = 0; i < 8; ++i) { float uf[8], mf[8]; unpack8(uv[i], uf); unpack8(mp[i], mf);
#pragma unroll
                for (int j = 0; j < 8; j += 2) { const f32x2_t y2 = gelu2((f32x2_t){uf[j], uf[j + 1]}) * (f32x2_t){mf[j], mf[j + 1]}; ss2 = y2 * y2 + ss2; y[i * 8 + j] = y2.x; y[i * 8 + j + 1] = y2.y; } }
            ss = ss2.x + ss2.y;
            ss += __shfl_xor(ss, 1); ss += __shfl_xor(ss, 2);
            const float rs = rsqrtf(ss * (1.0f / 256.0f) + EPS);
            u32x4* yp = (u32x4*)(Ymix + row * D + 768 + g * 64); const f32x4* gp = (const f32x4*)(og + g * 64);
#pragma unroll
            for (int i = 0; i < 8; ++i) { const f32x4 g0 = gp[2 * i], g1 = gp[2 * i + 1];
                u32x4 w; w.x = pk2(y[i * 8 + 0] * rs * g0[0], y[i * 8 + 1] * rs * g0[1]); w.y = pk2(y[i * 8 + 2] * rs * g0[2], y[i * 8 + 3] * rs * g0[3]);
                w.z = pk2(y[i * 8 + 4] * rs * g1[0], y[i * 8 + 5] * rs * g1[1]); w.w = pk2(y[i * 8 + 6] * rs * g1[2], y[i * 8 + 7] * rs * g1[3]); yp[i] = w; }
        }
        asm volatile("s_waitcnt lgkmcnt(0)" ::: "memory"); __builtin_amdgcn_s_barrier(); asm volatile("" ::: "memory");
    }
}
DEVI void ph_prep_sgu(const float* w, bf16_t* Wm, int wg, int nwg) {
    for (int idx = wg * NTHR + otid(); idx < 4 * 128 * 128; idx += nwg * NTHR) { const int t = (idx >> 7) & 127, s = idx & 127; Wm[idx] = (bf16_t)f2bf(((s >> 6) <= (t >> 6)) ? w[idx] : 0.f); }
}

template <class Sched> DEVI void fill_f32_table(const Sched& S, const float* srcv, unsigned char* smb) {
    const int tid_ = otid();
    for (int i = tid_ >> 8; i < TABF; i += 2) { pg8::Unit u_; if (!S.next(i, u_)) break; ((float*)(smb + TAB_OFF))[i * 256 + (tid_ & 255)] = srcv[u_.pm * 256 + (tid_ & 255)]; }
    __syncthreads();
}
DEVI void ph_place_all(const unsigned* count, const int* tokE, const float* tokW, int* rank, const float* rstd2, int* row_ts, float* row_w, float* row_rs, int* tile_e, int* n_tiles, unsigned char* smb, int wg, int nwg) {
    int* ps = (int*)smb; int* cnt = ps + 40;
    const int tid = otid(), lane = tid & 63;
    if (tid < 64) { const int c = lane < 32 ? (int)__hip_atomic_load(count + lane, __ATOMIC_RELAXED, __HIP_MEMORY_SCOPE_AGENT) : 0; const int pad = (c + 255) & ~255;
        int incl = pad;
#pragma unroll
        for (int o = 1; o < 32; o <<= 1) { const int t_ = __shfl_up(incl, o); if (lane >= o) incl += t_; }
        if (lane < 32) { cnt[lane] = c; ps[lane] = incl - pad; if (lane == 31) ps[32] = incl; } }
    __syncthreads();
    if (wg == 0) {
        const int nt = ps[32] >> 8;
        if (tid == 0) *n_tiles = nt;
        for (int i = tid; i < nt; i += NTHR) { int e = 0;
#pragma unroll 1
            for (int k = 1; k < 32; ++k) if ((ps[k] >> 8) <= i) e = k;
            tile_e[i] = e; }
        for (int e = 0; e < 32; ++e) for (int r = cnt[e] + tid; r < ps[e + 1] - ps[e]; r += NTHR) { row_ts[ps[e] + r] = -1; row_rs[ps[e] + r] = 0.f; }
    }
    for (int idx = wg * NTHR + tid; idx < 2 * T; idx += nwg * NTHR) { const int pos = ps[tokE[idx]] + rank[idx]; row_ts[pos] = idx; row_w[pos] = tokW[idx] * (1.0f / 256.0f); row_rs[pos] = rstd2[idx >> 1] * (1.0f / 512.0f); rank[idx] = pos; }
    __syncthreads();
}
constexpr float PG_WSCALE = 512.0f;
DEVI void ph_combine(bf16_t* h, unsigned char* h8, const unsigned char* Y8, const float* yscl, const int* tokpos, float* rstd3, int wg, int nwg) {
    const int tid = otid(), lane = tid & 63, gw = wg * 8 + (tid >> 6), ngw = nwg * 8;
    const int cb = (lane >> 4) * 256 + ((lane >> 2) & 3) * 32 + (lane & 3) * 8;
    for (int base = 2 * gw; base < T; base += 32 * ngw) {
        const int myrow = base + 2 * ngw * (lane >> 2) + ((lane >> 1) & 1);
        const int tp = myrow < T ? tokpos[myrow * 2 + (lane & 1)] : 0;
#pragma unroll 1
        for (int k = 0; k < 16; ++k) {
            const int row = base + 2 * ngw * k; if (row >= T) break;
            u32x4 hv[2][2], y0[2], y1[2]; float s0[2], s1[2];
#pragma unroll
            for (int r = 0; r < 2; ++r) { const int p0 = __builtin_amdgcn_readfirstlane(__shfl(tp, 4 * k + 2 * r)), p1 = __builtin_amdgcn_readfirstlane(__shfl(tp, 4 * k + 2 * r + 1));
#pragma unroll
                for (int jj = 0; jj < 2; ++jj) hv[r][jj] = *(const u32x4*)(h + (size_t)(row + r) * D + cb + 128 * jj);
                y0[r] = __builtin_nontemporal_load((const u32x4*)(Y8 + (size_t)p0 * 1024) + lane); y1[r] = __builtin_nontemporal_load((const u32x4*)(Y8 + (size_t)p1 * 1024) + lane);
                s0[r] = yscl[(size_t)p0 * 16 + (lane >> 2)]; s1[r] = yscl[(size_t)p1 * 16 + (lane >> 2)]; }
#pragma unroll
            for (int r = 0; r < 2; ++r) { float s = 0.f, amax = 0.f; float a[2][8];
#pragma unroll
                for (int jj = 0; jj < 2; ++jj) { unpack8(hv[r][jj], a[jj]);
#pragma unroll
                    for (int d = 0; d < 2; ++d) { const int w0 = (int)y0[r][2 * jj + d], w1 = (int)y1[r][2 * jj + d];
                        const f32x2_t l0 = __builtin_amdgcn_cvt_pk_f32_fp8(w0, false), h0 = __builtin_amdgcn_cvt_pk_f32_fp8(w0, true), l1 = __builtin_amdgcn_cvt_pk_f32_fp8(w1, false), h1 = __builtin_amdgcn_cvt_pk_f32_fp8(w1, true);
                        a[jj][4 * d + 0] += l0.x * s0[r] + l1.x * s1[r]; a[jj][4 * d + 1] += l0.y * s0[r] + l1.y * s1[r]; a[jj][4 * d + 2] += h0.x * s0[r] + h1.x * s1[r]; a[jj][4 * d + 3] += h0.y * s0[r] + h1.y * s1[r]; }
#pragma unroll
                    for (int i = 0; i < 8; ++i) { s += a[jj][i] * a[jj][i]; amax = fmaxf(amax, fabsf(a[jj][i])); }
                    u32x4 w; w.x = pk2(a[jj][0], a[jj][1]); w.y = pk2(a[jj][2], a[jj][3]); w.z = pk2(a[jj][4], a[jj][5]); w.w = pk2(a[jj][6], a[jj][7]); *(u32x4*)(h + (size_t)(row + r) * D + cb + 128 * jj) = w; }
                s = wave_sum(s);
#pragma unroll
                for (int o = 1; o < 64; o <<= 1) amax = fmaxf(amax, __shfl_xor(amax, o));
                const float sc = amax > 1e-30f ? 440.0f * __builtin_amdgcn_rcpf(amax) : 0.f;
#pragma unroll
                for (int jj = 0; jj < 2; ++jj) { u32x2 w8;
#pragma unroll
                    for (int d = 0; d < 2; ++d) { int t = __builtin_amdgcn_cvt_pk_fp8_f32(a[jj][4 * d] * sc, a[jj][4 * d + 1] * sc, 0, false); t = __builtin_amdgcn_cvt_pk_fp8_f32(a[jj][4 * d + 2] * sc, a[jj][4 * d + 3] * sc, t, true); w8[d] = (unsigned)t; }
                    *(u32x2*)(h8 + (size_t)(row + r) * 1024 + cb + 128 * jj) = w8; }
                if (lane == 0) rstd3[row + r] = rsqrtf(s * (1.0f / 1024.0f) + EPS) * amax * (1.0f / (440.0f * PG_WSCALE)); }
        }
    }
}
DEVI void ph_final(const bf16_t* h, float* out, const float* ssp, const float* g, int wg, int nwg) {
    const int tid = otid(), lane = tid & 63, gw = wg * 8 + (tid >> 6), ngw = nwg * 8;
    const f32x4* gp = (const f32x4*)g + 2 * lane; const f32x4 g00 = gp[0], g01 = gp[1], g10 = gp[128], g11 = gp[129];
    for (int row = 2 * gw; row < T; row += 2 * ngw) {
        u32x4 hv[2][2]; float sp[2];
#pragma unroll
        for (int r = 0; r < 2; ++r) { sp[r] = lane < 16 ? ssp[(size_t)(row + r) * 16 + lane] : 0.f;
#pragma unroll
            for (int jj = 0; jj < 2; ++jj) hv[r][jj] = ((const u32x4*)(h + (size_t)(row + r) * D) + lane)[64 * jj]; }
#pragma unroll
        for (int r = 0; r < 2; ++r) { const float rs = rsqrtf(wave_sum(sp[r]) * (1.0f / 1024.0f) + EPS); f32x4* op = (f32x4*)(out + (size_t)(row + r) * D) + 2 * lane;
#pragma unroll
            for (int jj = 0; jj < 2; ++jj) { float a[8]; unpack8(hv[r][jj], a); const f32x4 g0 = jj ? g10 : g00, g1 = jj ? g11 : g01;
                op[128 * jj] = (f32x4){a[0] * rs * g0[0], a[1] * rs * g0[1], a[2] * rs * g0[2], a[3] * rs * g0[3]}; op[128 * jj + 1] = (f32x4){a[4] * rs * g1[0], a[5] * rs * g1[1], a[6] * rs * g1[2], a[7] * rs * g1[3]}; } }
    }
}

enum { IN_X = 0, IN_P, IN_NORM1G, IN_WIN, IN_CONVW, IN_CONVB, IN_IGB, IN_FGB, IN_MNG, IN_SBOG, IN_SGULNG, IN_SGULNB, IN_SGUW, IN_SGUB, IN_SGUOG, IN_WOUT, IN_NORM2G,
       IN_RGW, IN_RGB, IN_REW, IN_REB, IN_WGATE, IN_WUP, IN_WDOWN, IN_PLENG, IN_PLEGW, IN_PLEPW, IN_FINALG, N_INPUTS };
constexpr int NPH_LAYER = 9, NPHASES = 1 + DEPTH * NPH_LAYER + 1;
struct Params { const float* in[N_INPUTS]; float* out; unsigned char* ws; int ph_lo, ph_hi; };
static_assert(sizeof(Params) == N_INPUTS * 8 + 8 + 8 + 8, "Params has no padding");

__global__ void __launch_bounds__(NTHR, 2) mega(Params p) {
    extern __shared__ __attribute__((aligned(16))) unsigned char lds[];
    const int tid = threadIdx.x, wg = blockIdx.x, nwg = gridDim.x;
    for (int u = tid; u < (LDS_BYTES - MISC_OFF) / 4; u += NTHR) ((LAS unsigned*)(lds + MISC_OFF))[u] = 0u;
    __syncthreads();
    unsigned char* const ws0 = p.ws;
    const bool fused = (p.ph_hi - p.ph_lo) > 1;
    XcdBarrier bar; bar.bar = (unsigned*)(ws0 + WS_CTL) + CW_BAR; bar.x = 0; bar.st = nullptr;
    if (fused) bar = xcd_barrier_post((unsigned*)(ws0 + WS_CTL) + CW_BAR, (volatile LAS unsigned*)(lds + MISC_OFF));
    PG8_LAS unsigned char* ring = (PG8_LAS unsigned char*)lds;
#define WSP(type, off) ((type)(ws + (off)))
#define PH_LOCALS size_t zo_ = 0; asm volatile("" : "+s"(zo_)); unsigned char* ws = ws0 + zo_; float* out = p.out + zo_;   \
        unsigned char* wl = ws + WS_WTS + (size_t)l * WL_SIZE; (void)wl; (void)out; \
        bf16_t* const HIN = (bf16_t*)(ws + ((l & 1) ? WS_HBB : WS_HBA)); bf16_t* const HOUT = (bf16_t*)(ws + ((l & 1) ? WS_HBA : WS_HBB)); (void)HIN; (void)HOUT;

    int gp = 0;
#define PH_ON (p.ph_lo <= gp && gp < p.ph_hi)
#define PH_END do { if (fused && gp + 1 < p.ph_hi) for (int rb_ = 0; rb_ < REP_BAR; ++rb_) xcd_barrier(bar); ++gp; } while (0)

    if (PH_ON) for (int rep = 0; rep < REP_PRO; ++rep) {
#pragma unroll 1
        for (int l = 0; l < DEPTH; ++l) {
            PH_LOCALS
            { const PrepJob j{p.in[IN_WIN] + (size_t)l * D * 3208, nullptr, p.in[IN_NORM1G] + l * D, (bf16_t*)(wl + WL_IN), 3208, D, NZ, 1, 1, 0, 0, 0}; ph_prep_w(j, lds, wg, nwg); }
            { const PrepJob j{p.in[IN_WIN] + (size_t)l * D * 3208, nullptr, p.in[IN_NORM1G] + l * D, (bf16_t*)(wl + WL_GU + 16 * MiB), 3208, D, NZ, 1, 1, l == 0 ? 9 : (9 | 256), 0, 0}; ph_prep_w(j, lds, wg, nwg); }
            { const PrepJob j{p.in[IN_WOUT] + (size_t)l * D * D, nullptr, nullptr, (bf16_t*)(wl + WL_OUT), D, D, D, 0, 1, 0, 0, 0}; ph_prep_w(j, lds, wg, nwg); }
            { const PrepJob j{p.in[IN_WGATE] + (size_t)l * NEXP * D * DEXP, p.in[IN_WUP] + (size_t)l * NEXP * D * DEXP, p.in[IN_NORM2G] + l * D, (bf16_t*)(wl + WL_GU), DEXP, D, 512, 2, NEXP, 9 | 256, (size_t)D * DEXP, (size_t)512 * D / 2};
              ph_prep_w(j, lds, wg, nwg); }
            { const PrepJob j{p.in[IN_WDOWN] + (size_t)l * NEXP * DEXP * D, nullptr, nullptr, (bf16_t*)(wl + WL_DN), D, DEXP, D, 0, NEXP, 8, (size_t)DEXP * D, (size_t)D * DEXP / 2}; ph_prep_w(j, lds, wg, nwg); }
            { const PrepJob j{p.in[IN_PLEGW] + (size_t)l * D * D, nullptr, p.in[IN_PLENG] + l * D, (bf16_t*)(wl + WL_PG), D, D, D, 0, 1, 9, 0, 0}; ph_prep_w(j, lds, wg, nwg); }
            { const PrepJob j{p.in[IN_PLEPW] + (size_t)l * PDIM * D, nullptr, nullptr, (bf16_t*)(wl + WL_PP), D, PDIM, D, 0, 1, 0, 0, 0}; ph_prep_w(j, lds, wg, nwg); }
            ph_prep_sgu(p.in[IN_SGUW] + (size_t)l * 4 * 128 * 128, WSP(bf16_t*, WS_WSGU) + (size_t)l * 4 * 128 * 128, wg, nwg);
            ph_prep_router(p.in[IN_RGW] + l * D * 4, p.in[IN_REW] + l * D * 32, p.in[IN_NORM2G] + l * D, WSP(bf16_t*, WS_WR) + (size_t)l * 256 * D, wg, nwg);
        }
        { const int l = 0; PH_LOCALS
          ph_prep_x(p.in[IN_X], WSP(bf16_t*, WS_HBA), WSP(unsigned char*, WS_A8), WSP(float*, WS_SSP), wg, nwg);
            }
    }
    PH_END;

#pragma clang loop unroll(full)
    for (int l = 0; l < DEPTH; ++l) {
        if (PH_ON) { PH_LOCALS
            const float* rtab = (const float*)(lds + 131072);
#define Z_RTAB(S_, sc_) do { const int tid_ = otid(); const float* ssp_ = WSP(const float*, WS_SSP); \
              for (int i = tid_ >> 8; ; i += 2) { pg8::Unit u_; if (!S_.next(i & ~1, u_)) break; if (S_.next(i, u_)) { const f32x4* sp = (const f32x4*)(ssp_ + (size_t)(u_.pm * 256 + (tid_ & 255)) * 16); \
                  const f32x4 st = (sp[0] + sp[1]) + (sp[2] + sp[3]); ((float*)(lds + 131072))[i * 256 + (tid_ & 255)] = rsqrtf(((st[0] + st[1]) + (st[2] + st[3])) * (1.0f / 1024.0f) + EPS) * (sc_); } } \
              __syncthreads(); } while (0)
            {
                pg8::Gemm g{HIN, (const bf16_t*)(wl + WL_IN), T, 7 * 256, D, 0}; SubsetOrder S; S.init(T, 7 * 256, nwg, wg); S.kind = 0;
                Z_RTAB(S, 1.0f);
                EpiZ E{WSP(bf16_t*, WS_Z), rtab, WSP(float*, WS_GATES), 0, l == 0 ? p.in[IN_P] : nullptr, WSP(bf16_t*, WS_PB), nwg, wg};
                pg8::gemm_phase<EpiZ, SubsetOrder, AL_Z, true>(ring, g, S, E); }
            __syncthreads();
            {
                pg8::Gemm g{WSP(const bf16_t*, WS_A8), (const bf16_t*)(wl + WL_GU + 16 * MiB), T, 6 * 256, D / 2, 0}; SubsetOrder S; S.init(T, 6 * 256, nwg, wg); S.kind = 1;
                Z_RTAB(S, 1.0f / 512.0f);
                EpiZ8 E{{WSP(bf16_t*, WS_Z), rtab, WSP(float*, WS_GATES), 7, l == 0 ? p.in[IN_P] : nullptr, WSP(bf16_t*, WS_PB), nwg, wg}};
                pg8::gemm_phase<EpiZ8, SubsetOrder, AL_Z, true>(ring, g, S, E); }
#undef Z_RTAB
        }
        PH_END;
        if (PH_ON) { PH_LOCALS
            const int nh = nwg >> 1;
            if (wg < nh) {
                for (int rep = 0; rep < REP_ML; ++rep) ph_mlstm(WSP(const bf16_t*, WS_Z), WSP(const float*, WS_GATES), p.in[IN_CONVW] + l * 4 * 768, p.in[IN_CONVB] + l * 768, p.in[IN_IGB] + l * 4, p.in[IN_FGB] + l * 4, p.in[IN_MNG] + l * 384, WSP(bf16_t*, WS_YMIX), lds, wg, nh);
            } else {
                for (int rep = 0; rep < REP_SB; ++rep) { ph_sb(WSP(const bf16_t*, WS_Z), p.in[IN_SBOG] + l * 384, WSP(bf16_t*, WS_YMIX), lds, wg - nh, nwg - nh); __syncthreads(); }
                for (int rep = 0; rep < REP_SGU; ++rep) ph_sgu(WSP(const bf16_t*, WS_Z), p.in[IN_SGULNG] + l * 256, p.in[IN_SGULNB] + l * 256, WSP(const bf16_t*, WS_WSGU) + (size_t)l * 4 * 128 * 128, p.in[IN_SGUB] + l * 4 * 128, p.in[IN_SGUOG] + l * 256, WSP(bf16_t*, WS_YMIX), lds, wg - nh, nwg - nh);
            }
        }
        PH_END;
        if (PH_ON) { PH_LOCALS
            pg8::Gemm g{WSP(const bf16_t*, WS_YMIX), (const bf16_t*)(wl + WL_OUT), T, D, D, 0}; pg8::StaticOrder S; S.init(T, D, nwg, wg); EpiResid E{HIN, HIN, WSP(float*, WS_SSP2), WSP(unsigned char*, WS_H8)};
            if (REP_WOUT0 > 1) { EpiResid E2{HIN, WSP(bf16_t*, WS_Z), WSP(float*, WS_Z + 400 * MiB), WSP(unsigned char*, WS_H8)}; for (int rep = 1; rep < REP_WOUT0; ++rep) pg8::gemm_phase<EpiResid, pg8::StaticOrder, AL_WOUT, true>(ring, g, S, E2); }
            if (STG_WOUT) stagger(wg, STG_WOUT);
            pg8::gemm_phase<EpiResid, pg8::StaticOrder, AL_WOUT, true>(ring, g, S, E); }
        PH_END;
        if (PH_ON) { PH_LOCALS
            pg8::Gemm g{HIN, WSP(const bf16_t*, WS_WR) + (size_t)l * 256 * D, T, 256, D, 0}; pg8::StaticOrder S; S.init(T, 256, nwg, wg);
            EpiRouter E{WSP(const float*, WS_SSP2), p.in[IN_RGB] + l * 4, p.in[IN_REB] + l * 32, WSP(int*, WS_TOKE), WSP(float*, WS_TOKW), WSP(float*, WS_RSTD2), WSP(int*, WS_RANK), WSP(unsigned*, WS_CTL) + CW_COUNT + 32 * l};
            pg8::gemm_phase<EpiRouter, pg8::StaticOrder, false, true>(ring, g, S, E); }
        PH_END;
        if (PH_ON) { PH_LOCALS
            for (int rep = 0; rep < REP_PLACE; ++rep) ph_place_all(WSP(const unsigned*, WS_CTL) + CW_COUNT + 32 * l, WSP(const int*, WS_TOKE), WSP(const float*, WS_TOKW), WSP(int*, WS_RANK), WSP(const float*, WS_RSTD2), WSP(int*, WS_ROWTS), WSP(float*, WS_ROWW), WSP(float*, WS_ROWRS),
                         WSP(int*, WS_TILEE), WSP(int*, WS_CTL) + CW_NTILES + l, lds, wg, nwg); }
        PH_END;
        if (PH_ON) { PH_LOCALS
            pg8::Gemm g{WSP(const bf16_t*, WS_H8), (const bf16_t*)(wl + WL_GU), MAXROWS, 512, D / 2, 0}; MoeGatherOrder S; S.ntot = 0; S.nN = 2; S.G = 0; S.c = 0; S.tile_e = (const int*)(lds + 131072); S.estride = (size_t)512 * D;     S.row_ts = WSP(const int*, WS_ROWTS);
            { const int tid_ = otid(); const int nt_ = *(WSP(const int*, WS_CTL) + CW_NTILES + l); for (int i = tid_; i < nt_; i += NTHR) ((int*)(lds + 131072))[i] = WSP(const int*, WS_TILEE)[i]; __syncthreads(); }
            S.bind(WSP(const int*, WS_CTL) + CW_NTILES + l, nwg, wg);
            S.ntot = (S.ntot / nwg) * nwg;
            fill_f32_table(S, WSP(const float*, WS_ROWRS), lds);
            EpiGU E{WSP(const float*, WS_ROWRS), WSP(unsigned char*, WS_HID), (const float*)(lds + TAB_OFF), TABF};
            if (STG_GU) stagger(wg, STG_GU);
            for (int rep = 0; rep < REP_GU; ++rep) pg8::gemm_phase<EpiGU, MoeGatherOrder, AL_GU, true>(ring, g, S, E); }
        PH_END;
        if (PH_ON) { PH_LOCALS
            { const int tid_ = otid(); const int nt_ = *(WSP(const int*, WS_CTL) + CW_NTILES + l); for (int i = tid_; i < nt_; i += NTHR) ((int*)(lds + 131072))[i] = WSP(const int*, WS_TILEE)[i]; __syncthreads(); }
            const int ntl = __builtin_amdgcn_readfirstlane(*(WSP(const int*, WS_CTL) + CW_NTILES + l)), mt0 = ((ntl * 2) / nwg) * (nwg / 2), ntail = ntl - mt0;
            if (wg < ntail) {
                pg8::Gemm g{WSP(const bf16_t*, WS_H8), (const bf16_t*)(wl + WL_GU), MAXROWS, 512, D / 2, 0}; MoeGatherOrder S; S.nN = 2; S.G = 1; S.c = (mt0 + wg) * 2; S.ntot = S.c + 2; S.tile_e = (const int*)(lds + 131072); S.estride = (size_t)512 * D; S.row_ts = WSP(const int*, WS_ROWTS);
                EpiGU E{WSP(const float*, WS_ROWRS), WSP(unsigned char*, WS_HID), (const float*)(lds + TAB_OFF), 0};
                pg8::gemm_phase<EpiGU, MoeGatherOrder, AL_GU, true>(ring, g, S, E);
                __syncthreads();
            }
            pg8::Gemm g{WSP(const bf16_t*, WS_HID), (const bf16_t*)(wl + WL_DN), MAXROWS, D, DEXP / 2, 0}; MoeDealOrder S; S.ntot = 0; S.nN = 4; S.G = nwg; S.c = wg; S.tile_e = (const int*)(lds + 131072); S.estride = (size_t)D * DEXP;     S.mt0 = mt0; S.ntail = ntail; S.nD = mt0 * 4;
            fill_f32_table(S, WSP(const float*, WS_ROWW), lds);
            EpiDown E{WSP(const float*, WS_ROWW), WSP(unsigned char*, WS_Y), WSP(float*, WS_YSCL), (const float*)(lds + TAB_OFF), TABF};
            if (STG_DOWN) stagger(wg, STG_DOWN);
            for (int rep = 0; rep < REP_DOWN; ++rep) pg8::gemm_phase<EpiDown, MoeDealOrder, AL_DOWN, true>(ring, g, S, E); }
        PH_END;
        if (PH_ON) { PH_LOCALS
            const bool ppfirst = (wg & 1) != 0;
            if (!ppfirst) { ph_combine(HIN, WSP(unsigned char*, WS_H8), WSP(const unsigned char*, WS_Y), WSP(const float*, WS_YSCL), WSP(const int*, WS_RANK), WSP(float*, WS_RSTD3), wg, nwg); __syncthreads(); }
            pg8::Gemm g{WSP(const bf16_t*, WS_PB) + (size_t)l * T * PDIM, (const bf16_t*)(wl + WL_PP), T, D, PDIM, 0}; pg8::StaticOrder S; S.init(T, D, nwg, wg); EpiPP8 E{WSP(unsigned char*, WS_YMIX), WSP(float*, WS_PPSCL)};
            for (int rep = 0; rep < REP_PP; ++rep) pg8::gemm_phase<EpiPP8, pg8::StaticOrder, AL_PP, true>(ring, g, S, E);
            if (ppfirst) { __syncthreads(); ph_combine(HIN, WSP(unsigned char*, WS_H8), WSP(const unsigned char*, WS_Y), WSP(const float*, WS_YSCL), WSP(const int*, WS_RANK), WSP(float*, WS_RSTD3), wg, nwg); }
        }
        PH_END;
        if (PH_ON) { PH_LOCALS
            pg8::Gemm g{WSP(const bf16_t*, WS_H8), (const bf16_t*)(wl + WL_PG), T, D, D / 2, 0}; pg8::StaticOrder S; S.init(T, D, nwg, wg); EpiPLE E{    WSP(const float*, WS_RSTD3), WSP(const unsigned char*, WS_YMIX), WSP(const float*, WS_PPSCL), HIN, HOUT, WSP(float*, WS_SSP), l + 1 < DEPTH ? WSP(unsigned char*, WS_A8) : nullptr};
            if (STG_PLE) stagger(wg, STG_PLE);
            if (REP_PLE > 1) { EpiPLE E2{WSP(const float*, WS_RSTD3), WSP(const unsigned char*, WS_YMIX), WSP(const float*, WS_PPSCL), HIN, WSP(bf16_t*, WS_Z), WSP(float*, WS_Z + 400 * MiB)}; for (int rep = 1; rep < REP_PLE; ++rep) pg8::gemm_phase<EpiPLE, pg8::StaticOrder, AL_PLE, true>(ring, g, S, E2); }
            pg8::gemm_phase<EpiPLE, pg8::StaticOrder, AL_PLE, true>(ring, g, S, E); }
        PH_END;
    }
    if (PH_ON) { const int l = 0; PH_LOCALS
        ph_final(WSP(const bf16_t*, (DEPTH & 1) ? WS_HBB : WS_HBA), out, WSP(const float*, WS_SSP), p.in[IN_FINALG], wg, nwg); }
#undef PH_ON
#undef PH_END
}

#ifndef REP_SB
#define REP_SB 1
#endif
#ifndef REP_ML
#define REP_ML 1
#endif
#ifndef REP_SGU
#define REP_SGU 1
#endif
#ifndef MK_SPLIT
#define MK_SPLIT 0
#endif
extern "C" void kernel_launch(void* const* d_in, const int* in_sizes, int n_in, void* d_out, int out_size, void* d_ws, size_t ws_size, hipStream_t stream) {
    static int grid = 0;
    if (grid == 0) {
        if (n_in != N_INPUTS || in_sizes[0] != T * D || out_size != T * D || ws_size < WS_END) { fprintf(stderr, "kernel_launch: unexpected shapes / workspace (%d inputs, ws %zu)\n", n_in, ws_size); grid = -1; return; }
        int dev = 0, cus = 0;
        if (hipGetDevice(&dev) != hipSuccess || hipDeviceGetAttribute(&cus, hipDeviceAttributeMultiprocessorCount, dev) != hipSuccess) { grid = -1; return; }
        if (hipFuncSetAttribute((const void*)mega, hipFuncAttributeMaxDynamicSharedMemorySize, LDS_BYTES) != hipSuccess) { grid = -1; return; }
        int per_cu = 0;
        if (hipOccupancyMaxActiveBlocksPerMultiprocessor(&per_cu, (const void*)mega, NTHR, LDS_BYTES) != hipSuccess || per_cu < 1) fprintf(stderr, "kernel_launch: occupancy query says %d\n", per_cu);
        (void)hipGetLastError();
        grid = cus;
        if (grid != 256) { fprintf(stderr, "kernel_launch: built for 256 CUs (one router unit per workgroup)\n"); grid = -1; return; }
        if (grid < 208) { fprintf(stderr, "kernel_launch: built for >= 208 CUs (LDS table of 16 units per workgroup in the input projection)\n"); grid = -1; return; }
    }
    if (grid < 0) return;
    (void)hipMemsetAsync((unsigned char*)d_ws + WS_CTL, 0, 1 * MiB, stream);
    Params p{};
    for (int i = 0; i < N_INPUTS; ++i) p.in[i] = (const float*)d_in[i];
    p.out = (float*)d_out; p.ws = (unsigned char*)d_ws;
#if MK_SPLIT
    for (int ph = 0; ph < NPHASES; ++ph) { p.ph_lo = ph; p.ph_hi = ph + 1; hipLaunchKernelGGL(mega, dim3(grid), dim3(NTHR), LDS_BYTES, stream, p); }
#else
    p.ph_lo = 0; p.ph_hi = NPHASES;
    hipLaunchKernelGGL(mega, dim3(grid), dim3(NTHR), LDS_BYTES, stream, p);
#endif
}
```
